# Optimizing an MI355X kernel written in HIP

```python
import math
import jax, jax.numpy as jnp
from jax import lax
import numpy as np

D_MODEL = 2048
BATCH = 4
SEQ = 4096
DEPTH = 4

CHUNK = 64
Q_BLOCK = 128
N_MIXERS = 4
EPS = 1e-6
NEG_INF = -1e30

A_WIDTH = D_MODEL
A_HEADS = 16
A_HEAD_DIM = A_WIDTH // (2 * A_HEADS)
T5_BUCKETS = 32
T5_MAX_DIST = 128

B_HEADS = 4
B_DK = D_MODEL // 2 // B_HEADS
B_DV = D_MODEL // B_HEADS
B_GATE_RANK = 16
B_GATE_TAU = 16.0

C_WIDTH = D_MODEL
C_BLOCKS = 8
C_BLOCK_DIM = C_WIDTH // C_BLOCKS
C_CONV = 4
C_C = 8.0

D_HEADS = 16
D_Q_RANK = 512
D_KV_RANK = 512
D_NOPE = 128
D_ROPE = 64
D_V = 128
ROPE_THETA = 10000.0


def _n_layers_of(m):
    return (DEPTH - m + N_MIXERS - 1) // N_MIXERS


N_A = _n_layers_of(0)
N_B = _n_layers_of(1)
N_C = _n_layers_of(2)
N_D = _n_layers_of(3)

kernel_name = "hybrid_chunk_causal_interleaved_trunk"


def _rmsnorm(x, g):
    xf = x.astype(jnp.float32)
    y = xf * lax.rsqrt(jnp.mean(xf * xf, axis=-1, keepdims=True) + EPS)
    return (y * g.astype(jnp.float32)).astype(x.dtype)


def _chunk_mask(qpos, kpos):
    return (kpos[None, :] // CHUNK) <= (qpos[:, None] // CHUNK)


def _t5_bucket(rel):
    nb = T5_BUCKETS // 2
    max_exact = nb // 2
    ret = jnp.where(rel > 0, nb, 0)
    n = jnp.abs(rel)
    nf = jnp.maximum(n, 1).astype(jnp.float32)
    large = max_exact + (jnp.log(nf / max_exact) / math.log(T5_MAX_DIST / max_exact)
                         * (nb - max_exact)).astype(jnp.int32)
    large = jnp.minimum(large, nb - 1)
    return ret + jnp.where(n < max_exact, n, large)


def _rope(x, pos):
    half = x.shape[-1] // 2
    inv = ROPE_THETA ** (-jnp.arange(half, dtype=jnp.float32) / half)
    ang = pos[:, None] * inv[None, :]
    cos = jnp.cos(ang)[None, :, None, :]
    sin = jnp.sin(ang)[None, :, None, :]
    xf = x.astype(jnp.float32)
    x1, x2 = xf[..., :half], xf[..., half:]
    return jnp.concatenate([x1 * cos - x2 * sin, x2 * cos + x1 * sin], axis=-1).astype(x.dtype)


def _diff_attention(h, w_in, qk_g, lam_vecs, subln_g, w_out, rel_bias, layer_idx):
    B, S, _ = h.shape
    H, d = A_HEADS, A_HEAD_DIM
    q, k, v, g = jnp.split(h @ w_in, 4, axis=-1)
    q = _rmsnorm(q.reshape(B, S, H, 2, d), qk_g[0]) * (d ** -0.5)
    k = _rmsnorm(k.reshape(B, S, H, 2, d), qk_g[1])
    v = v.reshape(B, S, H, 2 * d)
    lf = lam_vecs.astype(jnp.float32)
    lam_init = 0.8 - 0.6 * math.exp(-0.3 * layer_idx)
    lam = jnp.exp(jnp.sum(lf[0] * lf[1])) - jnp.exp(jnp.sum(lf[2] * lf[3])) + lam_init
    kpos = jnp.arange(S)
    nq = S // Q_BLOCK
    qb = q.reshape(B, nq, Q_BLOCK, H, 2, d).transpose(1, 0, 2, 3, 4, 5)

    def block(args):
        qblk, j = args
        qpos = j * Q_BLOCK + jnp.arange(Q_BLOCK)
        bias = rel_bias[_t5_bucket(kpos[None, :] - qpos[:, None])]
        s = (jnp.einsum('bqhtd,bkhtd->bthqk', qblk, k).astype(jnp.float32)
             + jnp.transpose(bias, (2, 0, 1)).astype(jnp.float32))
        s = jnp.where(_chunk_mask(qpos, kpos), s, NEG_INF)
        p = jax.nn.softmax(s, axis=-1)
        attn = p[:, 0] - lam * p[:, 1]
        return jnp.einsum('bhqk,bkhe->bqhe', attn.astype(v.dtype), v)

    o = lax.map(block, (qb, jnp.arange(nq)))
    o = o.transpose(1, 0, 2, 3, 4).reshape(B, S, H, 2 * d)
    o = _rmsnorm(o, subln_g) * (1.0 - lam_init)
    y = o.reshape(B, S, A_WIDTH) * jax.nn.silu(g)
    return y @ w_out


def _gla(h, w_in, w_gate, gate_bias, out_g, w_out):
    B, S, _ = h.shape
    H, dk, dv = B_HEADS, B_DK, B_DV
    nc = S // CHUNK
    q, k, v, g, lr = jnp.split(
        h @ w_in, [H * dk, 2 * H * dk, 2 * H * dk + H * dv, 2 * H * dk + 2 * H * dv], axis=-1)
    log_alpha = jax.nn.log_sigmoid((lr @ w_gate + gate_bias).astype(jnp.float32)) / B_GATE_TAU

    def chunks(t, e):
        return t.astype(jnp.float32).reshape(B, nc, CHUNK, H, e).transpose(1, 0, 2, 3, 4)

    qc = chunks(q, dk) * (dk ** -0.5)
    kc = chunks(k, dk)
    vc = chunks(v, dv)
    cum = jnp.cumsum(chunks(log_alpha, dk), axis=2)
    total = cum[:, :, -1]
    kc = kc * jnp.exp(total[:, :, None] - cum)

    def step(state, xs):
        qi, ki, vi, ti = xs
        state = jnp.exp(ti)[..., None] * state + jnp.einsum('bchk,bchv->bhkv', ki, vi)
        return state, jnp.einsum('bchk,bhkv->bchv', qi, state)

    s0 = jnp.zeros((B, H, dk, dv), jnp.float32)
    _, o = lax.scan(step, s0, (qc, kc, vc, total))
    o = o.transpose(1, 0, 2, 3, 4).reshape(B, S, H, dv)
    o = _rmsnorm(o, out_g).reshape(B, S, H * dv).astype(h.dtype)
    return (o * jax.nn.silu(g)) @ w_out


def _rglru(h, w_in, conv_w, conv_b, w_rg, b_rg, w_ig, b_ig, lam, w_out):
    B, S, _ = h.shape
    u, g = jnp.split(h @ w_in, 2, axis=-1)
    up = jnp.pad(u, ((0, 0), (C_CONV - 1, 0), (0, 0)))
    xc = conv_b + up[:, 0:S] * conv_w[0]
    for t in range(1, C_CONV):
        xc = xc + up[:, t:t + S] * conv_w[t]
    xb = xc.reshape(B, S, C_BLOCKS, C_BLOCK_DIM)
    r = jax.nn.sigmoid((jnp.einsum('bsnd,nde->bsne', xb, w_rg).reshape(B, S, C_WIDTH)
                        + b_rg).astype(jnp.float32))
    i = jax.nn.sigmoid((jnp.einsum('bsnd,nde->bsne', xb, w_ig).reshape(B, S, C_WIDTH)
                        + b_ig).astype(jnp.float32))
    log_a = -C_C * r * jax.nn.softplus(-lam.astype(jnp.float32))
    a = jnp.exp(log_a)
    xin = jnp.sqrt(-jnp.expm1(2.0 * log_a)) * (i * xc.astype(jnp.float32))

    def combine(left, right):
        a_l, b_l = left
        a_r, b_r = right
        return a_l * a_r, a_r * b_l + b_r

    _, hs = lax.associative_scan(combine, (a, xin), axis=1)
    y = hs.astype(h.dtype) * jax.nn.silu(g)
    return y @ w_out


def _chunk_causal_attention(q, k, v):
    B, S, H, dq = q.shape
    dv = v.shape[-1]
    nq = S // Q_BLOCK
    kpos = jnp.arange(S)
    qb = q.reshape(B, nq, Q_BLOCK, H, dq).transpose(1, 0, 2, 3, 4)

    def block(args):
        qblk, j = args
        qpos = j * Q_BLOCK + jnp.arange(Q_BLOCK)
        s = jnp.einsum('bqhd,bkhd->bhqk', qblk, k).astype(jnp.float32)
        s = jnp.where(_chunk_mask(qpos, kpos), s, NEG_INF)
        p = jax.nn.softmax(s, axis=-1)
        return jnp.einsum('bhqk,bkhe->bqhe', p.astype(v.dtype), v)

    o = lax.map(block, (qb, jnp.arange(nq)))
    return o.transpose(1, 0, 2, 3, 4).reshape(B, S, H, dv)


def _mla(h, w_in, q_lat_g, kv_lat_g, w_uq, w_ukv, qk_g, w_out):
    B, S, _ = h.shape
    H = D_HEADS
    dqk = D_NOPE + D_ROPE
    cq, ckv, k_pe, g = jnp.split(
        h @ w_in, [D_Q_RANK, D_Q_RANK + D_KV_RANK, D_Q_RANK + D_KV_RANK + D_ROPE], axis=-1)
    q = (_rmsnorm(cq, q_lat_g) @ w_uq).reshape(B, S, H, dqk)
    kv = (_rmsnorm(ckv, kv_lat_g) @ w_ukv).reshape(B, S, H, D_NOPE + D_V)
    k_nope, v = kv[..., :D_NOPE], kv[..., D_NOPE:]
    pos = jnp.arange(S, dtype=jnp.float32)
    q_nope = _rmsnorm(q[..., :D_NOPE], qk_g[0, :D_NOPE])
    q_pe = _rope(_rmsnorm(q[..., D_NOPE:], qk_g[0, D_NOPE:]), pos)
    k_nope = _rmsnorm(k_nope, qk_g[1, :D_NOPE])
    k_pe = _rope(_rmsnorm(k_pe, qk_g[1, D_NOPE:])[:, :, None, :], pos)
    q = jnp.concatenate([q_nope, q_pe], axis=-1) * (dqk ** -0.5)
    k = jnp.concatenate([k_nope, jnp.broadcast_to(k_pe, (B, S, H, D_ROPE))], axis=-1)
    o = _chunk_causal_attention(q, k, v)
    y = o.reshape(B, S, H * D_V) * jax.nn.silu(g)
    return y @ w_out


def setup_inputs(seed: int = 0) -> dict:
    key = jax.random.key(seed)
    ks = jax.random.split(key, 29)
    f32 = jnp.float32

    def nrm(k, shape, scale):
        return jax.random.normal(k, shape, f32) * scale

    def gain(k, shape):
        return 1.0 + 0.02 * jax.random.normal(k, shape, f32)

    a_in = 4 * A_WIDTH
    b_in = 2 * B_HEADS * B_DK + 2 * B_HEADS * B_DV + B_GATE_RANK
    c_in = 2 * C_WIDTH
    d_in = D_Q_RANK + D_KV_RANK + D_ROPE + D_HEADS * D_V
    u = jax.random.uniform(ks[20], (N_C, C_WIDTH), f32, minval=0.9, maxval=0.999)
    a0 = u ** (1.0 / C_C)
    c_lambda = jnp.log(a0) - jnp.log1p(-a0)
    return {
        "x": nrm(ks[0], (BATCH, SEQ, D_MODEL), 1.0),
        "norm_g": gain(ks[1], (DEPTH, D_MODEL)),
        "rel_bias": nrm(ks[2], (T5_BUCKETS, A_HEADS), 0.2),
        "a_w_in": nrm(ks[3], (N_A, D_MODEL, a_in), D_MODEL ** -0.5),
        "a_qk_g": gain(ks[4], (N_A, 2, A_HEAD_DIM)),
        "a_lambda": nrm(ks[5], (N_A, 4, A_HEAD_DIM), 0.1),
        "a_subln_g": gain(ks[6], (N_A, 2 * A_HEAD_DIM)),
        "a_w_out": nrm(ks[7], (N_A, A_WIDTH, D_MODEL), A_WIDTH ** -0.5),
        "b_w_in": nrm(ks[8], (N_B, D_MODEL, b_in), D_MODEL ** -0.5),
        "b_w_gate": nrm(ks[9], (N_B, B_GATE_RANK, B_HEADS * B_DK), B_GATE_RANK ** -0.5),
        "b_gate_bias": nrm(ks[10], (N_B, B_HEADS * B_DK), 0.1),
        "b_out_g": gain(ks[11], (N_B, B_DV)),
        "b_w_out": nrm(ks[12], (N_B, B_HEADS * B_DV, D_MODEL), (B_HEADS * B_DV) ** -0.5),
        "c_w_in": nrm(ks[13], (N_C, D_MODEL, c_in), D_MODEL ** -0.5),
        "c_conv_w": nrm(ks[14], (N_C, C_CONV, C_WIDTH), C_CONV ** -0.5),
        "c_conv_b": nrm(ks[15], (N_C, C_WIDTH), 0.02),
        "c_w_rgate": nrm(ks[16], (N_C, C_BLOCKS, C_BLOCK_DIM, C_BLOCK_DIM), C_BLOCK_DIM ** -0.5),
        "c_b_rgate": nrm(ks[17], (N_C, C_WIDTH), 0.02),
        "c_w_igate": nrm(ks[18], (N_C, C_BLOCKS, C_BLOCK_DIM, C_BLOCK_DIM), C_BLOCK_DIM ** -0.5),
        "c_b_igate": nrm(ks[19], (N_C, C_WIDTH), 0.02),
        "c_lambda": c_lambda,
        "c_w_out": nrm(ks[21], (N_C, C_WIDTH, D_MODEL), C_WIDTH ** -0.5),
        "d_w_in": nrm(ks[22], (N_D, D_MODEL, d_in), D_MODEL ** -0.5),
        "d_q_lat_g": gain(ks[23], (N_D, D_Q_RANK)),
        "d_kv_lat_g": gain(ks[24], (N_D, D_KV_RANK)),
        "d_w_uq": nrm(ks[25], (N_D, D_Q_RANK, D_HEADS * (D_NOPE + D_ROPE)), D_Q_RANK ** -0.5),
        "d_w_ukv": nrm(ks[26], (N_D, D_KV_RANK, D_HEADS * (D_NOPE + D_V)), D_KV_RANK ** -0.5),
        "d_qk_g": gain(ks[27], (N_D, 2, D_NOPE + D_ROPE)),
        "d_w_out": nrm(ks[28], (N_D, D_HEADS * D_V, D_MODEL), (D_HEADS * D_V) ** -0.5),
    }


def reference(x, norm_g, rel_bias,
              a_w_in, a_qk_g, a_lambda, a_subln_g, a_w_out,
              b_w_in, b_w_gate, b_gate_bias, b_out_g, b_w_out,
              c_w_in, c_conv_w, c_conv_b, c_w_rgate, c_b_rgate, c_w_igate, c_b_igate,
              c_lambda, c_w_out,
              d_w_in, d_q_lat_g, d_kv_lat_g, d_w_uq, d_w_ukv, d_qk_g, d_w_out):
    for i in range(DEPTH):
        m, j = i % N_MIXERS, i // N_MIXERS
        h = _rmsnorm(x, norm_g[i])
        if m == 0:
            y = _diff_attention(h, a_w_in[j], a_qk_g[j], a_lambda[j], a_subln_g[j],
                                a_w_out[j], rel_bias, i)
        elif m == 1:
            y = _gla(h, b_w_in[j], b_w_gate[j], b_gate_bias[j], b_out_g[j], b_w_out[j])
        elif m == 2:
            y = _rglru(h, c_w_in[j], c_conv_w[j], c_conv_b[j], c_w_rgate[j], c_b_rgate[j],
                       c_w_igate[j], c_b_igate[j], c_lambda[j], c_w_out[j])
        else:
            y = _mla(h, d_w_in[j], d_q_lat_g[j], d_kv_lat_g[j], d_w_uq[j], d_w_ukv[j],
                     d_qk_g[j], d_w_out[j])
        x = x + y.astype(x.dtype)
    return x
```

```cpp
#include <hip/hip_runtime.h>
#include <hip/hip_cooperative_groups.h>
#include <cstdio>
#include <cstring>
namespace cg = cooperative_groups;

#define DI __device__ __forceinline__
#define LAS __attribute__((address_space(3)))
typedef unsigned short bf16_t;
typedef short bf16x8 __attribute__((ext_vector_type(8)));
typedef short s16x4 __attribute__((ext_vector_type(4)));
typedef float f32x2 __attribute__((ext_vector_type(2)));
typedef float f32x4 __attribute__((ext_vector_type(4)));
typedef float f32x16 __attribute__((ext_vector_type(16)));
typedef unsigned u32x2 __attribute__((ext_vector_type(2)));
typedef unsigned u32x4 __attribute__((ext_vector_type(4)));
typedef __bf16 bf16v2_t __attribute__((ext_vector_type(2)));

constexpr int MTOK = 16384, DM = 2048, SEQ = 4096;
constexpr float EPS = 1e-6f, LOG2E = 1.4426950408889634f;
constexpr size_t MiB = (size_t)1 << 20;
constexpr size_t W_A_IN = 0, W_A_OUT = 32 * MiB, W_B_IN = 40 * MiB, W_B_OUT = 65 * MiB, W_C_IN = 73 * MiB, W_C_GATE = 89 * MiB,
                 W_C_OUT = 91 * MiB, W_D_IN = 99 * MiB, W_D_UQKV = 112 * MiB, W_D_OUT = 119 * MiB, HBUF = 127 * MiB, ACT = 191 * MiB,
                 WS_END = 511 * MiB;
constexpr size_t LAT = 0;
constexpr size_t EXTRA = 511 * MiB;
constexpr size_t X_BIAS = EXTRA + 16384, X_SP8 = EXTRA + 32768, X_SSQ = EXTRA + 65536;
constexpr size_t GLA_TOT = ACT + 200 * MiB;
constexpr size_t XG = ACT + 256 * MiB;
constexpr size_t WS_BAR = EXTRA;
constexpr int LDS_BYTES = 131072 + 2048;
#ifndef PHMASK
#define PHMASK 0xffffffffull
#endif
#ifndef REPMASK
#define REPMASK 0ull
#endif

struct TJob { const float* src; bf16_t* dst; const float* kscale; int K, N, ldw, ntn, tile0, pad; };
struct Params { const float* in[29]; float* out; unsigned char* ws; int njobs, ntiles; TJob jobs[44]; };

DI int otid() { int t = threadIdx.x; asm volatile("" : "+v"(t)); return t; }
template <class T> DI T* uni(T* p) {
    const unsigned long long v = (unsigned long long)p;
    const unsigned lo = __builtin_amdgcn_readfirstlane((unsigned)v), hi = __builtin_amdgcn_readfirstlane((unsigned)(v >> 32));
    return (T*)(((unsigned long long)hi << 32) | lo);
}
DI float bf2f(bf16_t v) { return __uint_as_float((unsigned)v << 16); }
DI unsigned pk2(float a, float b) { f32x2 v = {a, b}; bf16v2_t r = __builtin_convertvector(v, bf16v2_t); return __builtin_bit_cast(unsigned, r); }
DI bf16_t f2bf(float a) { return (bf16_t)(pk2(a, 0.f) & 0xffffu); }
DI void unpack8(const u32x4 w, float (&f)[8]) {
#pragma unroll
    for (int i = 0; i < 4; ++i) { f[2 * i] = __uint_as_float(w[i] << 16); f[2 * i + 1] = __uint_as_float(w[i] & 0xffff0000u); }
}
DI u32x4 pack8(const float (&f)[8]) { u32x4 w; w.x = pk2(f[0], f[1]); w.y = pk2(f[2], f[3]); w.z = pk2(f[4], f[5]); w.w = pk2(f[6], f[7]); return w; }
DI float wsum(float v) {
#pragma unroll
    for (int m = 32; m >= 1; m >>= 1) v += __shfl_xor(v, m);
    return v;
}
DI float sigm(float x) { return 1.f / (1.f + __expf(-x)); }
DI float silu(float x) { return x / (1.f + __expf(-x)); }
DI int crow(int i, int hh) { return (i & 3) + 8 * (i >> 2) + 4 * hh; }
DI f32x16 mfma32(bf16x8 a, bf16x8 b, f32x16 c) { return __builtin_amdgcn_mfma_f32_32x32x16_bf16(a, b, c, 0, 0, 0); }
DI s16x4 trread(LAS unsigned char* p) { return __builtin_amdgcn_ds_read_tr16_b64_v4i16((LAS s16x4*)p); }
DI bf16x8 cat4(s16x4 lo, s16x4 hi) { return __builtin_shufflevector(lo, hi, 0, 1, 2, 3, 4, 5, 6, 7); }

namespace pg8 {
constexpr int BM = 256, BK = 64, HALF = 128, HTB = HALF * BK * 2, STAGE_BYTES = 8 * HTB, NXCD = 8, WGM = 8;
DI int lds_byte(int r, int c) { const int st = (r >> 4) * 2 + (c >> 5), rr = r & 15, cc = c & 31, ob = rr * 64 + cc * 2; return st * 1024 + (ob ^ (((ob >> 9) & 1) << 5)); }
DI void stage_rc(int b, int& R, int& C) { const int st = b / 1024, sb = b % 1024, swz = sb ^ (((sb >> 9) & 1) << 5); R = (st >> 1) * 16 + swz / 64; C = (st & 1) * 32 + (swz % 64) / 2; }
DI int perm32(int rho) { const int n = rho >> 4, i = rho & 15; return 8 * (i >> 2) + 4 * n + (i & 3); }
struct Unit { int pm, pn; size_t aoff, boff; };
template <int MODE> struct Sched {
    int nM, nN, nwg, G, c, lda, K;
    DI void init(int M, int N, int G_, int c_, int lda_, int K_) { nM = M / BM; nN = N / BM; nwg = nM * nN; G = G_; c = c_; lda = lda_; K = K_; }
    DI bool next(int i, Unit& u) const {
        const long L = (long)i * G + c; if (L >= nwg) return false;
        int wgid = (int)L; { const int q = nwg / NXCD, r = nwg % NXCD, xcd = wgid % NXCD, off = wgid / NXCD; wgid = (xcd < r ? xcd * (q + 1) : r * (q + 1) + (xcd - r) * q) + off; }
        const int nig = WGM * nN, gid = wgid / nig, fm = gid * WGM, gsz = (nM - fm) < WGM ? (nM - fm) : WGM;
        u.pm = fm + ((wgid % nig) % gsz); u.pn = (wgid % nig) / gsz;
        u.aoff = (size_t)u.pm * 256 * lda * 2; u.boff = (size_t)u.pn * 256 * K * 2;
        if (MODE == 1 && u.pn >= 12) u.aoff += 1024;
        if (MODE == 2) u.aoff += (size_t)(u.pn >> 1) * 512;
        return true;
    }
};

template <class Epi, class SchedT>
DI void gemm_phase(LAS unsigned char* lds, const bf16_t* Ap, const bf16_t* Btp, const int K, const int lda, const SchedT& S, const Epi& E) {
    const int tid = otid(), wid = __builtin_amdgcn_readfirstlane(tid >> 6), lane = tid & 63, wr = wid >> 2, wc = wid & 3, fr = lane & 15, fq = lane >> 4;
    const int nt = K / BK;
    unsigned voffA[2], voffB[2];
#pragma unroll
    for (int i = 0; i < 2; ++i) { int R, C; stage_rc(tid * 16 + i * 8192, R, C); const int Rb = (R & ~31) + perm32(R & 31);
        voffA[i] = (unsigned)(R * lda + C) * 2u; voffB[i] = (unsigned)(Rb * K + C) * 2u; }
    const size_t kstep = (size_t)(BK * 2);
    const size_t hstepA = (size_t)HALF * lda * 2, hstepB = (size_t)HALF * K * 2;
    const unsigned ldsw = (unsigned)wid * 1024u;
    const int aoff = lds_byte(wr * 64 + fr, fq * 8), boff = lds_byte(wc * 32 + fr, fq * 8);
#define PG8_SA(b, h) (((b) * 2 + (h)) * HTB)
#define PG8_SB(b, h) ((4 + (b) * 2 + (h)) * HTB)
#define PG8_STAGE(bufoff, gbase, voff) do { _Pragma("unroll") for (int _i = 0; _i < 2; ++_i) \
        __builtin_amdgcn_global_load_lds((const unsigned*)((const char*)(gbase) + (voff)[_i]), (LAS unsigned*)(lds + (bufoff) + ldsw + _i * 8192), 16, 0, 0); } while (0)
#define PG8_LDA(dst, b, h) do { _Pragma("unroll") for (int m = 0; m < 4; ++m) _Pragma("unroll") for (int k = 0; k < 2; ++k) dst[m][k] = *(const LAS bf16x8*)(lds + PG8_SA(b, h) + aoff + m * 2048 + k * 1024); } while (0)
#define PG8_LDB(dst, b, h) do { _Pragma("unroll") for (int n = 0; n < 2; ++n) _Pragma("unroll") for (int k = 0; k < 2; ++k) dst[n][k] = *(const LAS bf16x8*)(lds + PG8_SB(b, h) + boff + n * 2048 + k * 1024); } while (0)
#define PG8_MMA(ai, bj, At, Bt) do { __builtin_amdgcn_s_setprio(1); _Pragma("unroll") for (int m = 0; m < 4; ++m) _Pragma("unroll") for (int n = 0; n < 2; ++n) _Pragma("unroll") for (int k = 0; k < 2; ++k) \
        acc[ai][bj][m][n] = __builtin_amdgcn_mfma_f32_16x16x32_bf16(Bt[n][k], At[m][k], acc[ai][bj][m][n], 0, 0, 0); __builtin_amdgcn_s_setprio(0); } while (0)
#define PG8_WAIT_V(n) asm volatile("s_waitcnt vmcnt(" #n ")" ::: "memory")
#define PG8_WAIT_L(n) asm volatile("s_waitcnt lgkmcnt(" #n ")" ::: "memory")
#define PG8_BAR __builtin_amdgcn_s_barrier()
#define PG8_SCHED __builtin_amdgcn_sched_barrier(0)
    Unit cur, nxt; int ui = 0;
    if (!S.next(0, cur)) return;
    float pre[8]; E.prefetch(cur, wr, fr, pre);
    f32x4 acc[2][2][4][2];
#pragma unroll
    for (int a = 0; a < 2; ++a)
#pragma unroll
        for (int b = 0; b < 2; ++b)
#pragma unroll
            for (int m = 0; m < 4; ++m)
#pragma unroll
                for (int n = 0; n < 2; ++n) acc[a][b][m][n] = (f32x4){0.f, 0.f, 0.f, 0.f};
    bf16x8 At[4][2], B0[2][2], B1[2][2];
    const char* cA = (const char*)Ap + cur.aoff; const char* cB = (const char*)Btp + cur.boff;
    PG8_STAGE(PG8_SB(0, 0), cB, voffB); PG8_STAGE(PG8_SA(0, 0), cA, voffA); PG8_STAGE(PG8_SB(0, 1), cB + hstepB, voffB); PG8_STAGE(PG8_SA(0, 1), cA + hstepA, voffA);
    if (wr == 1) PG8_BAR;
    PG8_WAIT_V(4); PG8_BAR;
    PG8_STAGE(PG8_SB(1, 0), cB + kstep, voffB); PG8_STAGE(PG8_SA(1, 0), cA + kstep, voffA); PG8_STAGE(PG8_SB(1, 1), cB + hstepB + kstep, voffB);
    PG8_WAIT_V(6); PG8_BAR;
    for (;;) {
        const bool has_next = S.next(ui + 1, nxt);
        const char* nA = has_next ? (const char*)Ap + nxt.aoff : cA; const char* nB = has_next ? (const char*)Btp + nxt.boff : cB;
        for (int t = 0; t < nt; t += 2) {
            const bool last = (t == nt - 2);
            const char* a1 = cA + (size_t)(t + 1) * kstep;
            const char* a2 = last ? nA : cA + (size_t)(t + 2) * kstep; const char* b2 = last ? nB : cB + (size_t)(t + 2) * kstep;
            const char* a3 = a2 + kstep; const char* b3 = b2 + kstep;
            PG8_LDB(B0, 0, 0); PG8_SCHED; PG8_LDA(At, 0, 0); PG8_STAGE(PG8_SA(1, 1), a1 + hstepA, voffA);
            PG8_WAIT_L(8); PG8_BAR; PG8_WAIT_L(0); PG8_MMA(0, 0, At, B0); PG8_BAR; PG8_SCHED;
            PG8_LDB(B1, 0, 1); PG8_STAGE(PG8_SB(0, 0), b2, voffB);
            PG8_BAR; PG8_WAIT_L(0); PG8_MMA(0, 1, At, B1); PG8_BAR;
            PG8_LDA(At, 0, 1); PG8_STAGE(PG8_SA(0, 0), a2, voffA);
            PG8_BAR; PG8_WAIT_L(0); PG8_MMA(1, 0, At, B0); PG8_BAR; PG8_SCHED;
            PG8_STAGE(PG8_SB(0, 1), b2 + hstepB, voffB);
            PG8_WAIT_V(6); PG8_BAR; PG8_MMA(1, 1, At, B1); PG8_BAR;
            PG8_LDB(B0, 1, 0); PG8_SCHED; PG8_LDA(At, 1, 0); PG8_STAGE(PG8_SA(0, 1), a2 + hstepA, voffA);
            PG8_WAIT_L(8); PG8_BAR; PG8_WAIT_L(0); PG8_MMA(0, 0, At, B0); PG8_BAR; PG8_SCHED;
            PG8_LDB(B1, 1, 1); PG8_STAGE(PG8_SB(1, 0), b3, voffB);
            PG8_BAR; PG8_WAIT_L(0); PG8_MMA(0, 1, At, B1); PG8_BAR;
            PG8_LDA(At, 1, 1); PG8_STAGE(PG8_SA(1, 0), a3, voffA);
            PG8_BAR; PG8_WAIT_L(0); PG8_MMA(1, 0, At, B0); PG8_BAR; PG8_SCHED;
            PG8_STAGE(PG8_SB(1, 1), b3 + hstepB, voffB);
            PG8_WAIT_V(6); PG8_BAR; PG8_MMA(1, 1, At, B1); PG8_BAR;
        }
        E(acc, cur, wr, wc, fr, fq, pre);
        if (!has_next) break;
#pragma unroll
        for (int a = 0; a < 2; ++a)
#pragma unroll
            for (int b = 0; b < 2; ++b)
#pragma unroll
                for (int m = 0; m < 4; ++m)
#pragma unroll
                    for (int n = 0; n < 2; ++n) acc[a][b][m][n] = (f32x4){0.f, 0.f, 0.f, 0.f};
        cur = nxt; cA = nA; cB = nB; ++ui; E.prefetch(cur, wr, fr, pre);
    }
    PG8_WAIT_V(0);
    if (wr == 0) PG8_BAR;
    PG8_BAR;
#undef PG8_SA
#undef PG8_SB
#undef PG8_STAGE
#undef PG8_LDA
#undef PG8_LDB
#undef PG8_MMA
#undef PG8_WAIT_V
#undef PG8_WAIT_L
#undef PG8_BAR
#undef PG8_SCHED
}

typedef f32x4 Acc[2][2][4][2];
struct EpiStore {
    bf16_t* O; int ldc; const float* ssq;
    DI void prefetch(const Unit& u, int wr, int fr, float (&pre)[8]) const {
#pragma unroll
        for (int i = 0; i < 8; ++i) pre[i] = ssq ? ssq[u.pm * BM + wr * 64 + fr + (i >> 2) * HALF + (i & 3) * 16] : 0.f; }
    DI void operator()(const Acc& acc, const Unit& u, int wr, int wc, int fr, int fq, const float (&pre)[8]) const {
        const int row0 = u.pm * BM + wr * 64 + fr, col0 = u.pn * BM + wc * 32 + 8 * fq;
#pragma unroll
        for (int ai = 0; ai < 2; ++ai)
#pragma unroll
            for (int m = 0; m < 4; ++m) { bf16_t* rowp = O + (size_t)(row0 + ai * HALF + m * 16) * ldc + col0;
                const float rs = ssq ? rsqrtf(pre[ai * 4 + m] * (1.f / DM) + EPS) : 1.f;
#pragma unroll
                for (int bj = 0; bj < 2; ++bj) { const f32x4 v0 = acc[ai][bj][m][0] * rs, v1 = acc[ai][bj][m][1] * rs;
                    u32x4 w; w.x = pk2(v0[0], v0[1]); w.y = pk2(v0[2], v0[3]); w.z = pk2(v1[0], v1[1]); w.w = pk2(v1[2], v1[3]);
                    *(u32x4*)(rowp + bj * HALF) = w; } }
    }
};
struct EpiStoreA {
    bf16_t* O; const float* qkg;
    DI void prefetch(const Unit&, int, int, float (&pre)[8]) const {
#pragma unroll
        for (int i = 0; i < 8; ++i) pre[i] = 0.f; }
    DI void operator()(const Acc& acc, const Unit& u, int wr, int wc, int fr, int fq, const float (&pre)[8]) const {
        const int row0 = u.pm * BM + wr * 64 + fr, col0 = u.pn * BM + wc * 64 + 8 * fq;
        const bool nrm = u.pn < 16;
        f32x4 gn[2][2];
        if (nrm) { const float* gp = qkg + (u.pn < 8 ? 0 : 64) + 8 * fq; const float gs = u.pn < 8 ? 0.125f * LOG2E : 1.f;
#pragma unroll
            for (int bj = 0; bj < 2; ++bj) { gn[bj][0] = *(const f32x4*)(gp + 32 * bj) * gs; gn[bj][1] = *(const f32x4*)(gp + 32 * bj + 4) * gs; } }
#pragma unroll
        for (int ai = 0; ai < 2; ++ai)
#pragma unroll
            for (int m = 0; m < 4; ++m) { bf16_t* rowp = O + (size_t)(row0 + ai * HALF + m * 16) * 8192 + col0;
                f32x4 v[2][2];
#pragma unroll
                for (int bj = 0; bj < 2; ++bj) { v[bj][0] = acc[ai][bj][m][0]; v[bj][1] = acc[ai][bj][m][1]; }
                if (nrm) { float ss = 0.f;
#pragma unroll
                    for (int bj = 0; bj < 2; ++bj)
#pragma unroll
                        for (int n = 0; n < 2; ++n) ss += v[bj][n][0] * v[bj][n][0] + v[bj][n][1] * v[bj][n][1] + v[bj][n][2] * v[bj][n][2] + v[bj][n][3] * v[bj][n][3];
                    ss += __shfl_xor(ss, 16); ss += __shfl_xor(ss, 32);
                    const float sc = rsqrtf(ss * (1.f / 64.f) + EPS);
#pragma unroll
                    for (int bj = 0; bj < 2; ++bj) { v[bj][0] = v[bj][0] * sc * gn[bj][0]; v[bj][1] = v[bj][1] * sc * gn[bj][1]; } }
#pragma unroll
                for (int bj = 0; bj < 2; ++bj) { u32x4 w; w.x = pk2(v[bj][0][0], v[bj][0][1]); w.y = pk2(v[bj][0][2], v[bj][0][3]); w.z = pk2(v[bj][1][0], v[bj][1][1]); w.w = pk2(v[bj][1][2], v[bj][1][3]);
                    *(u32x4*)(rowp + 32 * bj) = w; } }
    }
};
struct EpiStoreD {
    bf16_t* lat; bf16_t* g; const float* ssq; float* ssql;
    DI void prefetch(const Unit& u, int wr, int fr, float (&pre)[8]) const {
#pragma unroll
        for (int i = 0; i < 8; ++i) pre[i] = ssq[u.pm * BM + wr * 64 + fr + (i >> 2) * HALF + (i & 3) * 16]; }
    DI void operator()(const Acc& acc, const Unit& u, int wr, int wc, int fr, int fq, const float (&pre)[8]) const {
        const int row0 = u.pm * BM + wr * 64 + fr, col0 = u.pn * BM + wc * 32 + 8 * fq;
#pragma unroll
        for (int ai = 0; ai < 2; ++ai)
#pragma unroll
            for (int m = 0; m < 4; ++m) { const size_t row = (size_t)(row0 + ai * HALF + m * 16);
                const float rs = rsqrtf(pre[ai * 4 + m] * (1.f / DM) + EPS); float ss = 0.f;
#pragma unroll
                for (int bj = 0; bj < 2; ++bj) { const f32x4 v0 = acc[ai][bj][m][0] * rs, v1 = acc[ai][bj][m][1] * rs;
                    ss += v0[0] * v0[0] + v0[1] * v0[1] + v0[2] * v0[2] + v0[3] * v0[3] + v1[0] * v1[0] + v1[1] * v1[1] + v1[2] * v1[2] + v1[3] * v1[3];
                    u32x4 w; w.x = pk2(v0[0], v0[1]); w.y = pk2(v0[2], v0[3]); w.z = pk2(v1[0], v1[1]); w.w = pk2(v1[2], v1[3]);
                    const int col = col0 + bj * HALF;
                    if (col < 1088) *(u32x4*)(lat + row * 1088 + col) = w;
                    else if (col < 3136) *(u32x4*)(g + row * 2048 + (col - 1088)) = w; }
                if (u.pn < 4) { ss += __shfl_xor(ss, 16); ss += __shfl_xor(ss, 32); if (fq == 0) atomicAdd(ssql + (u.pn >> 1) * MTOK + row, ss); } }
    }
};
struct EpiStoreU {
    bf16_t* O; const float* ssql;
    DI void prefetch(const Unit& u, int wr, int fr, float (&pre)[8]) const {
        const float* sq = ssql + (u.pn >= 12 ? MTOK : 0);
#pragma unroll
        for (int i = 0; i < 8; ++i) pre[i] = sq[u.pm * BM + wr * 64 + fr + (i >> 2) * HALF + (i & 3) * 16]; }
    DI void operator()(const Acc& acc, const Unit& u, int wr, int wc, int fr, int fq, const float (&pre)[8]) const {
        const int row0 = u.pm * BM + wr * 64 + fr, col0 = u.pn * BM + wc * 32 + 8 * fq;
        const float* sq = ssql + (u.pn >= 12 ? MTOK : 0);
#pragma unroll
        for (int ai = 0; ai < 2; ++ai)
#pragma unroll
            for (int m = 0; m < 4; ++m) { bf16_t* rowp = O + (size_t)(row0 + ai * HALF + m * 16) * 7168 + col0;
                const float rs = rsqrtf(pre[ai * 4 + m] * (1.f / 512.f) + EPS);
#pragma unroll
                for (int bj = 0; bj < 2; ++bj) { const f32x4 v0 = acc[ai][bj][m][0] * rs, v1 = acc[ai][bj][m][1] * rs;
                    u32x4 w; w.x = pk2(v0[0], v0[1]); w.y = pk2(v0[2], v0[3]); w.z = pk2(v1[0], v1[1]); w.w = pk2(v1[2], v1[3]);
                    *(u32x4*)(rowp + bj * HALF) = w; } }
    }
};
template <bool INB, bool OUTF, bool OUTB, bool SSQ> struct EpiResid {
    const float* xf; const bf16_t* xb; float* of; bf16_t* ob; float* ssq;
    DI void prefetch(const Unit&, int, int, float (&pre)[8]) const {
#pragma unroll
        for (int i = 0; i < 8; ++i) pre[i] = 0.f; }
    DI void operator()(const Acc& acc, const Unit& u, int wr, int wc, int fr, int fq, const float (&pre)[8]) const {
        const int row0 = u.pm * BM + wr * 64 + fr, col0 = u.pn * BM + wc * 32 + 8 * fq;
#pragma unroll
        for (int ai = 0; ai < 2; ++ai)
#pragma unroll
            for (int m = 0; m < 4; ++m) { const int row = row0 + ai * HALF + m * 16; const size_t o = (size_t)row * DM + col0;
                float ss = 0.f;
#pragma unroll
                for (int bj = 0; bj < 2; ++bj) {
                    f32x4 x0, x1;
                    if (INB) { float f[8]; unpack8(*(const u32x4*)(xb + o + bj * HALF), f); x0 = (f32x4){f[0], f[1], f[2], f[3]}; x1 = (f32x4){f[4], f[5], f[6], f[7]}; }
                    else { x0 = __builtin_nontemporal_load((const f32x4*)(xf + o + bj * HALF)); x1 = __builtin_nontemporal_load((const f32x4*)(xf + o + bj * HALF + 4)); }
                    x0 += acc[ai][bj][m][0]; x1 += acc[ai][bj][m][1];
                    if (OUTF) { __builtin_nontemporal_store(x0, (f32x4*)(of + o + bj * HALF)); __builtin_nontemporal_store(x1, (f32x4*)(of + o + bj * HALF + 4)); }
                    if (SSQ) ss += x0[0] * x0[0] + x0[1] * x0[1] + x0[2] * x0[2] + x0[3] * x0[3] + x1[0] * x1[0] + x1[1] * x1[1] + x1[2] * x1[2] + x1[3] * x1[3];
                    if (OUTB) { u32x4 w; w.x = pk2(x0[0], x0[1]); w.y = pk2(x0[2], x0[3]); w.z = pk2(x1[0], x1[1]); w.w = pk2(x1[2], x1[3]);
                        *(u32x4*)(ob + o + bj * HALF) = w; } }
                if (SSQ) { ss += __shfl_xor(ss, 16); ss += __shfl_xor(ss, 32); if (fq == 0) atomicAdd(ssq + row, ss); } }
    }
};
struct EpiGates {
    const bf16_t* xc; const float* brg; const float* big; const float* sp8t; unsigned* ax;
    DI void prefetch(const Unit&, int, int, float (&pre)[8]) const {
#pragma unroll
        for (int i = 0; i < 8; ++i) pre[i] = 0.f; }
    DI void operator()(const Acc& acc, const Unit& u, int wr, int wc, int fr, int fq, const float (&pre)[8]) const {
        const int row0 = u.pm * BM + wr * 64 + fr, f0 = (u.pn >> 1) * 256 + (u.pn & 1) * 128 + wc * 32 + 8 * fq;
#pragma unroll
        for (int n = 0; n < 2; ++n) {
            const f32x4 br = *(const f32x4*)(brg + f0 + 4 * n), bi = *(const f32x4*)(big + f0 + 4 * n), sp = *(const f32x4*)(sp8t + f0 + 4 * n);
#pragma unroll
            for (int ai = 0; ai < 2; ++ai)
#pragma unroll
                for (int m = 0; m < 4; ++m) { const size_t o = (size_t)(row0 + ai * HALF + m * 16) * DM + f0 + 4 * n;
                    const u32x2 xw = *(const u32x2*)(xc + o);
                    const float xv[4] = {__uint_as_float(xw.x << 16), __uint_as_float(xw.x & 0xffff0000u), __uint_as_float(xw.y << 16), __uint_as_float(xw.y & 0xffff0000u)};
                    u32x4 w;
#pragma unroll
                    for (int e = 0; e < 4; ++e) { const float r = sigm(acc[ai][0][m][n][e] + br[e]), ig = sigm(acc[ai][1][m][n][e] + bi[e]);
                        const float la = -sp[e] * r, uu = -2.f * la;
                        const float om = uu * (1.f - uu * 0.5f * (1.f - uu * (1.f / 3.f) * (1.f - uu * 0.25f * (1.f - uu * 0.2f * (1.f - uu * (1.f / 6.f))))));
                        w[e] = pk2(la, sqrtf(fmaxf(om, 0.f)) * ig * xv[e]); }
                    *(u32x4*)(ax + o) = w; __builtin_amdgcn_sched_barrier(0); }
        }
    }
};
}

template <int MODE, class Epi>
DI void run_gemm(LAS unsigned char* lds, const bf16_t* A, const bf16_t* Bt, int N, int K, int lda, const Epi& E) {
    asm volatile("" : "+s"(K));
    pg8::Sched<MODE> S; S.init(MTOK, N, (int)gridDim.x, (int)blockIdx.x, lda, K);
    pg8::gemm_phase(lds, A, Bt, K, lda, S, E);
    __syncthreads();
}

DI void phase_convert(const Params& p, LAS unsigned char* lds) {
    LAS float* sm = (LAS float*)lds;
    const int tid = otid();
    for (int t = blockIdx.x; t < p.ntiles; t += gridDim.x) {
        int j = 0; while (j + 1 < p.njobs && p.jobs[j + 1].tile0 <= t) ++j;
        const float* src = p.jobs[j].src; bf16_t* dst = p.jobs[j].dst; const int K = p.jobs[j].K, N = p.jobs[j].N, ldw = p.jobs[j].ldw, ntn = p.jobs[j].ntn;
        const int tt = t - p.jobs[j].tile0, tn = tt % ntn, tk = tt / ntn, n0 = tn * 64, k0 = tk * 256;
        { const int n4 = (tid & 15) * 4, kr = tid >> 4; f32x4 v[8];
#pragma unroll
          for (int i = 0; i < 8; ++i) v[i] = (n0 + n4 < N) ? __builtin_nontemporal_load((const f32x4*)(src + (size_t)(k0 + kr + 32 * i) * ldw + n0 + n4)) : (f32x4){0.f, 0.f, 0.f, 0.f};
#pragma unroll
          for (int i = 0; i < 8; ++i) { LAS float* d = sm + (kr + 32 * i) * 65 + n4; d[0] = v[i][0]; d[1] = v[i][1]; d[2] = v[i][2]; d[3] = v[i][3]; } }
        __syncthreads();
        { const int nr = tid >> 3, kq = tid & 7;
#pragma unroll
          for (int jj = 0; jj < 4; ++jj) { const int kc = (kq + 8 * jj) * 8; float f[8];
#pragma unroll
              for (int e = 0; e < 8; ++e) f[e] = sm[(kc + e) * 65 + nr];
              if (p.jobs[j].kscale) { const float* ks = p.jobs[j].kscale + k0 + kc;
#pragma unroll
                  for (int e = 0; e < 8; ++e) f[e] *= ks[e]; }
              int nrow = n0 + nr; if (p.jobs[j].pad) { const int jl = nrow & 255; nrow = (nrow & ~255) + 128 * ((jl >> 5) & 1) + 32 * (jl >> 6) + (jl & 31); }
              *(u32x4*)(dst + (size_t)nrow * K + k0 + kc) = pack8(f); } }
        __syncthreads();
    }
}

DI int t5_bucket(int rel) {
    const int n = rel < 0 ? -rel : rel; int b;
    if (n < 8) b = n; else b = 8 + (n >= 12) + (n >= 16) + (n >= 23) + (n >= 32) + (n >= 46) + (n >= 64) + (n >= 91);
    return (rel > 0 ? 16 : 0) + b;
}
DI void phase_bias_table(const Params& p) {
    float* tb = (float*)(p.ws + X_BIAS);
    float* sp8 = (float*)(p.ws + X_SP8); float* ssq = (float*)(p.ws + X_SSQ);
    for (int i = blockIdx.x * 512 + otid(); i < 5 * MTOK; i += gridDim.x * 512) ssq[i] = 0.f;
    for (int i = blockIdx.x * 512 + otid(); i < 16 * 192 + 2048; i += gridDim.x * 512) {
        if (i < 16 * 192) { const int h = i / 192, idx = i % 192; tb[i] = (p.in[2][t5_bucket(idx - 128) * 16 + h] - p.in[2][15 * 16 + h]) * LOG2E; }
        else sp8[i - 16 * 192] = 8.f * log1pf(expf(-p.in[20][i - 16 * 192]));
    }
}

DI void phase_rmsnorm(const float* x, const float* g, bf16_t* out) {
    const int tid = otid(), lane = tid & 63, gw = blockIdx.x * 8 + (tid >> 6), nw = gridDim.x * 8;
    for (int row = gw; row < MTOK; row += nw) {
        const f32x4* xr = (const f32x4*)(x + (size_t)row * DM); f32x4 v[8]; float ss = 0.f;
#pragma unroll
        for (int i = 0; i < 4; ++i) { v[2 * i] = xr[i * 128 + lane * 2]; v[2 * i + 1] = xr[i * 128 + lane * 2 + 1]; }
#pragma unroll
        for (int i = 0; i < 8; ++i) ss += v[i][0] * v[i][0] + v[i][1] * v[i][1] + v[i][2] * v[i][2] + v[i][3] * v[i][3];
        ss = wsum(ss); const float sc = rsqrtf(ss * (1.f / DM) + EPS);
#pragma unroll
        for (int i = 0; i < 4; ++i) { const int c = i * 512 + lane * 8; const f32x4 g0 = *(const f32x4*)(g + c), g1 = *(const f32x4*)(g + c + 4);
            u32x4 w; w.x = pk2(v[2 * i][0] * sc * g0[0], v[2 * i][1] * sc * g0[1]); w.y = pk2(v[2 * i][2] * sc * g0[2], v[2 * i][3] * sc * g0[3]);
            w.z = pk2(v[2 * i + 1][0] * sc * g1[0], v[2 * i + 1][1] * sc * g1[1]); w.w = pk2(v[2 * i + 1][2] * sc * g1[2], v[2 * i + 1][3] * sc * g1[3]);
            *(u32x4*)(out + (size_t)row * DM + c) = w; }
    }
}

DI void phase_qknorm_a(const Params& p) {
    bf16_t* big = (bf16_t*)(p.ws + ACT); const float* qkg = p.in[4];
    const int tid = otid(), lane = tid & 63, gw = blockIdx.x * 8 + (tid >> 6), nw = gridDim.x * 8;
    float gq[8], gk[8];
#pragma unroll
    for (int e = 0; e < 8; ++e) { gq[e] = qkg[(lane & 7) * 8 + e] * (0.125f * LOG2E); gk[e] = qkg[64 + (lane & 7) * 8 + e]; }
    for (int row = gw; row < MTOK; row += nw) {
#pragma unroll
        for (int i = 0; i < 8; ++i) {
            bf16_t* ptr = big + (size_t)row * 8192 + i * 512 + lane * 8; float f[8]; unpack8(*(const u32x4*)ptr, f);
            float ss = 0.f;
#pragma unroll
            for (int e = 0; e < 8; ++e) ss += f[e] * f[e];
            ss += __shfl_xor(ss, 1); ss += __shfl_xor(ss, 2); ss += __shfl_xor(ss, 4);
            const float sc = rsqrtf(ss * (1.f / 64.f) + EPS);
#pragma unroll
            for (int e = 0; e < 8; ++e) f[e] = f[e] * sc * (i < 4 ? gq[e] : gk[e]);
            *(u32x4*)ptr = pack8(f);
        }
    }
}

template <int DQK, int KA8, int DV, bool BIAS, bool JOINT>
DI void attn_core(LAS unsigned char* lds, const bf16_t* Qrow, const bf16_t* KpA, int ldkA, const bf16_t* KpB, int ldkB, const bf16_t* Vp, int ldv,
                  int qb, int wid, int lane, const float* qng  , f32x16 (&O)[DV / 32]) {
    constexpr int KROW = DQK * 2 + 16, VROW = DV * 2 + 64  , KC = DQK / 8, VC = DV / 8, NKC = 64 * KC, NVC = 64 * VC, NL = (NKC + NVC) / 512, STG = 64 * (KROW + VROW);
    static_assert(NKC % 512 == 0 && NVC % 512 == 0, "loader split");
    const int tid = otid(), l32 = lane & 31, hh = lane >> 5, i16 = lane & 15, tq = i16 >> 2, tp = i16 & 3, blk = (lane >> 4) & 1;
    const int q0w = qb * 256 + wid * 32, nkt = 4 * qb + 4, myc = q0w >> 6;
    bf16x8 qf[DQK / 16];
#pragma unroll
    for (int s = 0; s < DQK / 16; ++s) qf[s] = *(const bf16x8*)(Qrow + 16 * s + 8 * hh);
    if constexpr (DQK == 192) {
        if (qng) {
            float ssn = 0.f, ssr = 0.f;
#pragma unroll
            for (int s = 0; s < 12; ++s) { float f[8]; unpack8(__builtin_bit_cast(u32x4, qf[s]), f); float t = 0.f;
#pragma unroll
                for (int e = 0; e < 8; ++e) t += f[e] * f[e];
                if (s < 8) ssn += t; else ssr += t; }
            ssn += __shfl_xor(ssn, 32); ssr += __shfl_xor(ssr, 32);
            const float qs = 0.07216878364870322f * LOG2E, scn = rsqrtf(ssn * (1.f / 128.f) + EPS) * qs, scr = rsqrtf(ssr * (1.f / 64.f) + EPS) * qs;
#pragma unroll
            for (int s = 0; s < 8; ++s) { float f[8]; unpack8(__builtin_bit_cast(u32x4, qf[s]), f);
                const f32x4 g0 = *(const f32x4*)(qng + 16 * s + 8 * hh), g1 = *(const f32x4*)(qng + 16 * s + 8 * hh + 4);
#pragma unroll
                for (int e = 0; e < 4; ++e) { f[e] *= scn * g0[e]; f[4 + e] *= scn * g1[e]; }
                qf[s] = __builtin_bit_cast(bf16x8, pack8(f)); }
            const float posr = (float)(qb * 256 + wid * 32 + l32) * 0.15915494309189535f;
#pragma unroll
            for (int s = 8; s < 10; ++s) { float f1[8], f2[8]; unpack8(__builtin_bit_cast(u32x4, qf[s]), f1); unpack8(__builtin_bit_cast(u32x4, qf[s + 2]), f2);
#pragma unroll
                for (int e = 0; e < 8; ++e) { const int i = 16 * (s - 8) + 8 * hh + e;
                    const float a1 = f1[e] * scr * qng[128 + i], a2 = f2[e] * scr * qng[160 + i];
                    float rev = posr * __builtin_amdgcn_exp2f(-(float)i * 0.41524101186092029f); rev -= floorf(rev);
                    const float sn = __builtin_amdgcn_sinf(rev), cs = __builtin_amdgcn_cosf(rev);
                    f1[e] = a1 * cs - a2 * sn; f2[e] = a2 * cs + a1 * sn; }
                qf[s] = __builtin_bit_cast(bf16x8, pack8(f1)); qf[s + 2] = __builtin_bit_cast(bf16x8, pack8(f2)); }
            __builtin_amdgcn_sched_barrier(0);
        }
    }
    float m = 0.f, l = 0.f; bool mnz = false;
#pragma unroll
    for (int dt = 0; dt < DV / 32; ++dt)
#pragma unroll
        for (int i = 0; i < 16; ++i) O[dt][i] = 0.f;
    u32x4 stg[NL];
    LAS const float* btab = (LAS const float*)(lds + 2 * STG);
    const unsigned koff = l32 * KROW + 16 * hh, vtr = (4 * hh + tq) * VROW + (16 * blk + 4 * tp) * 2;

    auto gload = [&](int kt) {
#pragma unroll
        for (int i = 0; i < NL; ++i) { const int c = tid + i * 512;
            if (i * 512 < NKC) { const int row = c / KC, cc = c % KC;
                const bf16_t* src = (cc < KA8) ? KpA + (size_t)(kt * 64 + row) * ldkA + cc * 8 : KpB + (size_t)(kt * 64 + row) * ldkB + (cc - KA8) * 8;
                stg[i] = *(const u32x4*)src; }
            else { const int c2 = c - NKC, row = c2 / VC, cc = c2 % VC; stg[i] = *(const u32x4*)(Vp + (size_t)(kt * 64 + row) * ldv + cc * 8); } }
    };
    auto lstore = [&](int buf) {
#pragma unroll
        for (int i = 0; i < NL; ++i) { const int c = tid + i * 512;
            if (i * 512 < NKC) { const int row = c / KC, cc = c % KC; *(LAS u32x4*)(lds + buf * STG + row * KROW + cc * 16) = stg[i]; }
            else { const int c2 = c - NKC, row = c2 / VC, cc = c2 % VC; *(LAS u32x4*)(lds + buf * STG + 64 * KROW + row * VROW + cc * 16) = stg[i]; } }
    };

    gload(0); lstore(0); __syncthreads();
    for (int kt = 0; kt < nkt; ++kt) {
        if (kt + 1 < nkt) gload(kt + 1);
        if (JOINT && kt <= myc) {
            LAS unsigned char* kb = lds + (kt & 1) * STG; LAS unsigned char* vb = kb + 64 * KROW;
            const bool far = (kt * 64 + 63 - q0w <= -91);
            f32x16 S0, S1;
#pragma unroll
            for (int i = 0; i < 16; ++i) { S0[i] = 0.f; S1[i] = 0.f; }
#pragma unroll
            for (int s = 0; s < DQK / 16; ++s) {
                const bf16x8 k0 = *(LAS const bf16x8*)(kb + koff + 32 * s), k1 = *(LAS const bf16x8*)(kb + koff + 32 * KROW + 32 * s);
                S0 = mfma32(k0, qf[s], S0); S1 = mfma32(k1, qf[s], S1);
            }
            if (BIAS && !far) {
                const int rb = kt * 64 - (q0w + l32) + 128;
#pragma unroll
                for (int i = 0; i < 16; ++i) { const int i0 = rb + crow(i, hh); S0[i] += btab[i0 < 0 ? 0 : i0]; S1[i] += btab[i0 + 32 < 0 ? 0 : i0 + 32]; }
            }
            if (mnz) {
#pragma unroll
                for (int i = 0; i < 16; ++i) { S0[i] -= m; S1[i] -= m; }
            }
            float mx = fmaxf(S0[0], S1[0]);
#pragma unroll
            for (int i = 1; i < 16; ++i) mx = fmaxf(mx, fmaxf(S0[i], S1[i]));
            mx = fmaxf(mx, __shfl_xor(mx, 32));
            if (__any(mx > 64.f || (kt == 0 && mx < -64.f))) {
                const float dm = (mx > 64.f || (kt == 0 && mx < -64.f)) ? mx : 0.f, alpha = __builtin_amdgcn_exp2f(-dm); m += dm; mnz = true;
                l *= alpha;
#pragma unroll
                for (int dt = 0; dt < DV / 32; ++dt) O[dt] *= alpha;
#pragma unroll
                for (int i = 0; i < 16; ++i) { S0[i] -= dm; S1[i] -= dm; }
            }
            float ps = 0.f;
#pragma unroll
            for (int i = 0; i < 16; ++i) { S0[i] = __builtin_amdgcn_exp2f(S0[i]); S1[i] = __builtin_amdgcn_exp2f(S1[i]); ps += S0[i] + S1[i]; }
            l += ps;
#pragma unroll
            for (int half = 0; half < 2; ++half)
#pragma unroll
                for (int s = 0; s < 2; ++s) {
                    const f32x16& S = half ? S1 : S0;
                    u32x4 pw; pw.x = pk2(S[8 * s], S[8 * s + 1]); pw.y = pk2(S[8 * s + 2], S[8 * s + 3]); pw.z = pk2(S[8 * s + 4], S[8 * s + 5]); pw.w = pk2(S[8 * s + 6], S[8 * s + 7]);
                    const bf16x8 pf = __builtin_bit_cast(bf16x8, pw);
                    LAS unsigned char* vr = vb + vtr + (32 * half + 16 * s) * VROW;
#pragma unroll
                    for (int dt = 0; dt < DV / 32; ++dt) {
                        const bf16x8 vf = cat4(trread(vr + 64 * dt), trread(vr + 8 * VROW + 64 * dt));
                        O[dt] = mfma32(vf, pf, O[dt]);
                    }
                }
        }
        if (!JOINT && kt <= myc) {
            LAS unsigned char* kb = lds + (kt & 1) * STG; LAS unsigned char* vb = kb + 64 * KROW;
            const bool far = (kt * 64 + 63 - q0w <= -91);
#pragma unroll 1
            for (int half = 0; half < 2; ++half) {
                f32x16 S;
#pragma unroll
                for (int i = 0; i < 16; ++i) S[i] = 0.f;
#pragma unroll
                for (int s = 0; s < DQK / 16; ++s) {
                    const bf16x8 kf = *(LAS const bf16x8*)(kb + koff + 32 * half * KROW + 32 * s);
                    S = mfma32(kf, qf[s], S);
                }
                if (BIAS && !far) {
                    const int rb = kt * 64 + 32 * half - (q0w + l32) + 128;
#pragma unroll
                    for (int i = 0; i < 16; ++i) { const int i0 = rb + crow(i, hh); S[i] += btab[i0 < 0 ? 0 : i0]; }
                }
                if (mnz) {
#pragma unroll
                    for (int i = 0; i < 16; ++i) S[i] -= m;
                }
                float mx = S[0];
#pragma unroll
                for (int i = 1; i < 16; ++i) mx = fmaxf(mx, S[i]);
                mx = fmaxf(mx, __shfl_xor(mx, 32));
                const bool first = (kt == 0 && half == 0);
                if (__any(mx > 64.f || (first && mx < -64.f))) {
                    const float dm = (mx > 64.f || (first && mx < -64.f)) ? mx : 0.f, alpha = __builtin_amdgcn_exp2f(-dm); m += dm; mnz = true;
                    l *= alpha;
#pragma unroll
                    for (int dt = 0; dt < DV / 32; ++dt) O[dt] *= alpha;
#pragma unroll
                    for (int i = 0; i < 16; ++i) S[i] -= dm;
                }
                float ps = 0.f;
#pragma unroll
                for (int i = 0; i < 16; ++i) { S[i] = __builtin_amdgcn_exp2f(S[i]); ps += S[i]; }
                l += ps;
#pragma unroll
                for (int s = 0; s < 2; ++s) {
                    u32x4 pw; pw.x = pk2(S[8 * s], S[8 * s + 1]); pw.y = pk2(S[8 * s + 2], S[8 * s + 3]); pw.z = pk2(S[8 * s + 4], S[8 * s + 5]); pw.w = pk2(S[8 * s + 6], S[8 * s + 7]);
                    const bf16x8 pf = __builtin_bit_cast(bf16x8, pw);
                    LAS unsigned char* vr = vb + vtr + (32 * half + 16 * s) * VROW;
#pragma unroll
                    for (int dt = 0; dt < DV / 32; ++dt) {
                        const bf16x8 vf = cat4(trread(vr + 64 * dt), trread(vr + 8 * VROW + 64 * dt));
                        O[dt] = mfma32(vf, pf, O[dt]);
                    }
                }
            }
        }
        if (kt + 1 < nkt) lstore((kt + 1) & 1);
        __syncthreads();
    }
    l += __shfl_xor(l, 32);
    const float il = 1.f / l;
#pragma unroll
    for (int dt = 0; dt < DV / 32; ++dt) O[dt] *= il;
}

DI void phase_attn_a(const Params& p, LAS unsigned char* lds) {
    const bf16_t* big = (const bf16_t*)(p.ws + ACT); bf16_t* y = (bf16_t*)(p.ws + HBUF); const float* tbg = (const float*)(p.ws + X_BIAS);
    const int tid = otid(), wid = tid >> 6, lane = tid & 63, l32 = lane & 31, hh = lane >> 5;
    constexpr int STG = 64 * (64 * 2 + 16 + 128 * 2 + 64);
    float d0 = 0.f, d1 = 0.f;
    for (int i = 0; i < 64; ++i) { d0 += p.in[5][i] * p.in[5][64 + i]; d1 += p.in[5][128 + i] * p.in[5][192 + i]; }
    const float lam_init = 0.2f, lam = __expf(d0) - __expf(d1) + lam_init;
    for (int pr = blockIdx.x; pr < 512; pr += gridDim.x) {
        const int bi = pr & 255, bh = (gridDim.x == 256) ? (bi & 7) + 8 * (bi >> 6) + 32 * (pr >> 8) : pr >> 3, j = (gridDim.x == 256) ? (bi >> 3) & 7 : pr & 7, b = bh >> 4, h = bh & 15;
        for (int half = 0; half < 2; ++half) {
            const int qb = half ? 15 - j : j;
            __syncthreads();
            if (tid < 192) ((LAS float*)(lds + 2 * STG))[tid] = tbg[h * 192 + tid];
            const size_t tok0 = (size_t)b * SEQ, tokq = tok0 + qb * 256 + wid * 32 + l32;
            f32x16 Oa[4]; LAS unsigned* Op = (LAS unsigned*)(lds + 2 * STG + 1024) + wid * 2048 + lane;
            attn_core<64, 8, 128, true, true>(lds, big + tokq * 8192 + h * 128, big + tok0 * 8192 + 2048 + h * 128, 8192, nullptr, 0, big + tok0 * 8192 + 4096 + h * 128, 8192, qb, wid, lane, nullptr, Oa);
#pragma unroll
            for (int dt = 0; dt < 4; ++dt)
#pragma unroll
                for (int i = 0; i < 8; ++i) Op[(dt * 8 + i) * 64] = pk2(Oa[dt][2 * i], Oa[dt][2 * i + 1]);
            attn_core<64, 8, 128, true, true>(lds, big + tokq * 8192 + h * 128 + 64, big + tok0 * 8192 + 2048 + h * 128 + 64, 8192, nullptr, 0, big + tok0 * 8192 + 4096 + h * 128, 8192, qb, wid, lane, nullptr, Oa);
            float ss = 0.f;
#pragma unroll
            for (int dt = 0; dt < 4; ++dt)
#pragma unroll
                for (int i = 0; i < 16; ++i) { const unsigned ow = Op[(dt * 8 + (i >> 1)) * 64]; const float o0 = (i & 1) ? __uint_as_float(ow & 0xffff0000u) : __uint_as_float(ow << 16);
                    const float o = o0 - lam * Oa[dt][i]; Oa[dt][i] = o; ss += o * o; }
            ss += __shfl_xor(ss, 32);
            const float sc = rsqrtf(ss * (1.f / 128.f) + EPS) * (1.f - lam_init);
#pragma unroll
            for (int dt = 0; dt < 4; ++dt)
#pragma unroll
                for (int g4 = 0; g4 < 4; ++g4) { const int dv = 32 * dt + 8 * g4 + 4 * hh;
                    const u32x2 gw = __builtin_nontemporal_load((const u32x2*)(big + tokq * 8192 + 6144 + h * 128 + dv));
                    const f32x4 sg = *(const f32x4*)(p.in[6] + dv);
                    const float g0 = __uint_as_float(gw.x << 16), g1 = __uint_as_float(gw.x & 0xffff0000u), g2 = __uint_as_float(gw.y << 16), g3 = __uint_as_float(gw.y & 0xffff0000u);
                    u32x2 w; w.x = pk2(Oa[dt][4 * g4] * sc * sg[0] * silu(g0), Oa[dt][4 * g4 + 1] * sc * sg[1] * silu(g1));
                    w.y = pk2(Oa[dt][4 * g4 + 2] * sc * sg[2] * silu(g2), Oa[dt][4 * g4 + 3] * sc * sg[3] * silu(g3));
                    *(u32x2*)(y + tokq * DM + h * 128 + dv) = w; }
        }
    }
}

DI void phase_attn_d(const Params& p, LAS unsigned char* lds) {
    const bf16_t* qkv = (const bf16_t*)(p.ws + ACT); const bf16_t* lat = (const bf16_t*)(p.ws + LAT); const bf16_t* gb = (const bf16_t*)(p.ws + HBUF);
    bf16_t* y = (bf16_t*)(p.ws + HBUF);
    for (int pr = blockIdx.x; pr < 512; pr += gridDim.x) {
        const int bi = pr & 255, bh = (gridDim.x == 256) ? (bi & 7) + 8 * (bi >> 6) + 32 * (pr >> 8) : pr >> 3, j = (gridDim.x == 256) ? (bi >> 3) & 7 : pr & 7, b = bh >> 4, h = bh & 15;
        for (int half = 0; half < 2; ++half) {
            const int qb = half ? 15 - j : j;
            __syncthreads();
            const int tid = otid(), wid = tid >> 6, lane = tid & 63, l32 = lane & 31;
            const size_t tok0 = (size_t)b * SEQ, tokq = tok0 + qb * 256 + wid * 32 + l32;
            f32x16 O[4];
            attn_core<192, 16, 128, false, true>(lds, qkv + tokq * 7168 + h * 192, qkv + tok0 * 7168 + 3072 + h * 256, 7168, lat + tok0 * 1088 + 1024, 1088,
                                           qkv + tok0 * 7168 + 3072 + h * 256 + 128, 7168, qb, wid, lane, p.in[27], O);
            const int tid2 = otid(), wid2 = tid2 >> 6, lane2 = tid2 & 63;
            const size_t tokq2 = (size_t)b * SEQ + qb * 256 + wid2 * 32 + (lane2 & 31); const int hh2 = lane2 >> 5;
#pragma unroll
            for (int dt = 0; dt < 4; ++dt)
#pragma unroll
                for (int g4 = 0; g4 < 4; ++g4) { const int dv = 32 * dt + 8 * g4 + 4 * hh2;
                    const u32x2 gw = __builtin_nontemporal_load((const u32x2*)(gb + tokq2 * DM + h * 128 + dv));
                    const float g0 = __uint_as_float(gw.x << 16), g1 = __uint_as_float(gw.x & 0xffff0000u), g2 = __uint_as_float(gw.y << 16), g3 = __uint_as_float(gw.y & 0xffff0000u);
                    u32x2 w; w.x = pk2(O[dt][4 * g4] * silu(g0), O[dt][4 * g4 + 1] * silu(g1)); w.y = pk2(O[dt][4 * g4 + 2] * silu(g2), O[dt][4 * g4 + 3] * silu(g3));
                    *(u32x2*)(y + tokq2 * DM + h * 128 + dv) = w; }
        }
    }
}

DI void phase_gla_prep(const Params& p, LAS unsigned char* lds) {
    bf16_t* big = (bf16_t*)(p.ws + ACT); float* total = (float*)(p.ws + GLA_TOT);
    LAS float* lrs = (LAS float*)lds;
    const int tid = otid(), ch0 = tid * 2;
    float wg0[16], wg1[16];
#pragma unroll
    for (int r = 0; r < 16; ++r) { wg0[r] = p.in[9][r * 1024 + ch0]; wg1[r] = p.in[9][r * 1024 + ch0 + 1]; }
    const float bs0 = p.in[10][ch0], bs1 = p.in[10][ch0 + 1];
    for (int u = blockIdx.x; u < 256; u += gridDim.x) {
        const size_t tokb = (size_t)u * 64;
        __syncthreads();
        {
            LAS bf16_t* wl = (LAS bf16_t*)(lds + 8192);
            LAS float* part = (LAS float*)(lds + 4096);
            const bf16_t* wsrc = (const bf16_t*)(p.ws + W_B_IN) + (size_t)6144 * 2048;
#pragma unroll
            for (int i = 0; i < 8; ++i) { const int c = tid + i * 512; *(LAS u32x4*)(wl + (c >> 8) * 2056 + (c & 255) * 8) = *(const u32x4*)(wsrc + (size_t)c * 8); }
            __syncthreads();
            const int w = tid >> 6, lane = tid & 63, i16 = lane & 15, quad = lane >> 4, mt = w & 3, kh = w >> 2;
            const bf16_t* xr = (const bf16_t*)(p.ws + XG) + (tokb + 16 * mt + i16) * DM + kh * 1024 + 8 * quad;
            f32x4 acc = {0.f, 0.f, 0.f, 0.f};
#pragma unroll 8
            for (int ks = 0; ks < 32; ++ks) {
                const bf16x8 a = *(const bf16x8*)(xr + 32 * ks);
                const bf16x8 bb = *(LAS const bf16x8*)(wl + i16 * 2056 + kh * 1024 + 32 * ks + 8 * quad);
                acc = __builtin_amdgcn_mfma_f32_16x16x32_bf16(a, bb, acc, 0, 0, 0);
            }
            if (kh == 1) {
#pragma unroll
                for (int j = 0; j < 4; ++j) part[(16 * mt + 4 * quad + j) * 16 + i16] = acc[j]; }
            __syncthreads();
            if (kh == 0) {
#pragma unroll
                for (int j = 0; j < 4; ++j) { const int tok = 16 * mt + 4 * quad + j;
                    const float rs = rsqrtf(((const float*)(p.ws + X_SSQ))[tokb + tok] * (1.f / DM) + EPS);
                    lrs[tok * 16 + i16] = (acc[j] + part[tok * 16 + i16]) * rs; } }
        }
        __syncthreads();
        float t0 = 0.f, t1 = 0.f;
        for (int tok = 63; tok >= 0; --tok) {
            float z0 = bs0, z1 = bs1;
#pragma unroll
            for (int r = 0; r < 16; ++r) { const float lv = lrs[tok * 16 + r]; z0 += lv * wg0[r]; z1 += lv * wg1[r]; }
            unsigned* kp = (unsigned*)(big + (tokb + tok) * 6400 + 1024 + ch0); const unsigned w = *kp;
            *kp = pk2(__uint_as_float(w << 16) * __expf(t0), __uint_as_float(w & 0xffff0000u) * __expf(t1));
            t0 += (fminf(z0, 0.f) - __logf(1.f + __expf(-fabsf(z0)))) * (1.f / 16.f); t1 += (fminf(z1, 0.f) - __logf(1.f + __expf(-fabsf(z1)))) * (1.f / 16.f);
        }
        total[(size_t)u * 1024 + ch0] = t0; total[(size_t)u * 1024 + ch0 + 1] = t1;
    }
}

DI void phase_gla_scan(const Params& p, LAS unsigned char* lds) {
    const bf16_t* big = (const bf16_t*)(p.ws + ACT); const float* total = (const float*)(p.ws + GLA_TOT); bf16_t* ob = (bf16_t*)(p.ws + HBUF);
    constexpr int KR = 576, VR = 64, SR = 528, SET = 64 * KR + 64 * VR + 1024  , ST_OFF = 2 * SET, STB = 32 * SR;
    const int tid = otid(), w = tid >> 6, lane = tid & 63, l32 = lane & 31, hh = lane >> 5, i16 = lane & 15, tq = i16 >> 2, tp = i16 & 3, blk = (lane >> 4) & 1, quad = lane >> 4;
    const int mt = w >> 1, nt = w & 1;
    for (int u = blockIdx.x; u < 256; u += gridDim.x) {
        const int ux = (gridDim.x == 256) ? ((u & 7) * 2 + (u >> 7)) * 16 + ((u >> 3) & 15) : u;
        const int b = ux >> 6, h = (ux >> 4) & 3, vs = ux & 15;
        const size_t tok0 = (size_t)b * SEQ;
        f32x16 st;
#pragma unroll
        for (int i = 0; i < 16; ++i) st[i] = 0.f;
        u32x4 rkA[4], rvA, rkB[4], rvB; float rtA = 0.f, rtB = 0.f; bf16x8 qa[8], qn[8];
        rvA = (u32x4){0u, 0u, 0u, 0u}; rvB = rvA;
        unsigned offk[4];
#pragma unroll
        for (int i = 0; i < 4; ++i) { const int idx = tid + i * 512, row = idx >> 5, cc = idx & 31; offk[i] = (unsigned)((row * 6400 + 1024 + h * 256 + cc * 8) * 2); }
        const unsigned offv = (unsigned)(((tid >> 2) * 6400 + 2048 + h * 512 + vs * 32 + (tid & 3) * 8) * 2);
        const unsigned offq = (unsigned)(((16 * mt + i16) * 6400 + h * 256 + 8 * quad) * 2);
        auto gload = [&](int c, u32x4 (&rk)[4], u32x4& rv, float& rt) {
            const char* cb = (const char*)(big + (tok0 + (size_t)c * 64) * 6400);
#pragma unroll
            for (int i = 0; i < 4; ++i) rk[i] = *(const u32x4*)(cb + offk[i]);
            if (tid < 256) { rv = *(const u32x4*)(cb + offv); rt = total[(size_t)(b * 64 + c) * 1024 + h * 256 + tid]; }
        };
        auto lstore = [&](int buf, const u32x4 (&rk)[4], const u32x4& rv, const float& rt) {
            LAS unsigned char* sb = lds + buf * SET;
#pragma unroll
            for (int i = 0; i < 4; ++i) { const int idx = tid + i * 512, row = idx >> 5, cc = idx & 31; *(LAS u32x4*)(sb + row * KR + cc * 16) = rk[i]; }
            if (tid < 256) { const int row = tid >> 2, cc = tid & 3; *(LAS u32x4*)(sb + 64 * KR + row * VR + cc * 16) = rv; ((LAS float*)(sb + 64 * KR + 64 * VR))[tid] = __expf(rt); }
        };
        auto qload = [&](int c, bf16x8 (&q)[8]) {
            const char* cb = (const char*)(big + (tok0 + (size_t)c * 64) * 6400) + offq;
#pragma unroll
            for (int ks = 0; ks < 8; ++ks) q[ks] = *(const bf16x8*)(cb + 64 * ks);
        };
        auto step = [&](int c, const bf16x8 (&qc)[8]) {
            LAS unsigned char* sb = lds + (c & 1) * SET; LAS unsigned char* stb = lds + ST_OFF + (c & 1) * STB;
#pragma unroll
            for (int g = 0; g < 4; ++g) { const f32x4 e = *(LAS const f32x4*)(sb + 64 * KR + 64 * VR + (32 * w + 8 * g + 4 * hh) * 4);
                st[4 * g] *= e[0]; st[4 * g + 1] *= e[1]; st[4 * g + 2] *= e[2]; st[4 * g + 3] *= e[3]; }
#pragma unroll
            for (int sx = 0; sx < 4; ++sx) {
                LAS unsigned char* ka = sb + (16 * sx + 8 * hh + tq) * KR + (32 * w + 16 * blk + 4 * tp) * 2;
                LAS unsigned char* va = sb + 64 * KR + (16 * sx + 8 * hh + tq) * VR + (16 * blk + 4 * tp) * 2;
                const bf16x8 af = cat4(trread(ka), trread(ka + 4 * KR)), bfv = cat4(trread(va), trread(va + 4 * VR));
                st = mfma32(af, bfv, st);
            }
#pragma unroll
            for (int g = 0; g < 4; ++g) { u32x2 wv; wv.x = pk2(st[4 * g], st[4 * g + 1]); wv.y = pk2(st[4 * g + 2], st[4 * g + 3]);
                *(LAS u32x2*)(stb + l32 * SR + (32 * w + 8 * g + 4 * hh) * 2) = wv; }
            asm volatile("s_waitcnt lgkmcnt(0)" ::: "memory");
            __builtin_amdgcn_s_barrier();
            asm volatile("" ::: "memory");
            f32x4 acc = {0.f, 0.f, 0.f, 0.f};
#pragma unroll
            for (int ks = 0; ks < 8; ++ks) {
                const bf16x8 bb = *(LAS const bf16x8*)(stb + (16 * nt + i16) * SR + (32 * ks + 8 * quad) * 2);
                acc = __builtin_amdgcn_mfma_f32_16x16x32_bf16(qc[ks], bb, acc, 0, 0, 0);
            }
#pragma unroll
            for (int jj = 0; jj < 4; ++jj) ob[(tok0 + c * 64 + 16 * mt + quad * 4 + jj) * DM + h * 512 + vs * 32 + 16 * nt + i16] = f2bf(acc[jj] * (1.f / 16.f));
        };
        __syncthreads();
        gload(0, rkA, rvA, rtA); lstore(0, rkA, rvA, rtA);
        gload(1, rkA, rvA, rtA); gload(2, rkB, rvB, rtB); qload(0, qa); qload(1, qn);
        __syncthreads();
        for (int c = 0; c < 64; c += 2) {
            lstore((c + 1) & 1, rkA, rvA, rtA);
            if (c + 3 < 64) gload(c + 3, rkA, rvA, rtA);
            step(c, qa);
            if (c + 2 < 64) qload(c + 2, qa);
            if (c + 2 < 64) lstore(c & 1, rkB, rvB, rtB);
            if (c + 4 < 64) gload(c + 4, rkB, rvB, rtB);
            step(c + 1, qn);
            if (c + 3 < 64) qload(c + 3, qn);
        }
    }
}

DI void phase_gla_post(const Params& p) {
    const bf16_t* big = (const bf16_t*)(p.ws + ACT); bf16_t* y = (bf16_t*)(p.ws + HBUF);
    const int tid = otid(), lane = tid & 63, gw = blockIdx.x * 8 + (tid >> 6), nw = gridDim.x * 8;
    float og[8];
#pragma unroll
    for (int e = 0; e < 8; ++e) og[e] = p.in[11][lane * 8 + e];
    for (int row = gw; row < MTOK; row += nw) {
#pragma unroll
        for (int hd = 0; hd < 4; ++hd) {
            bf16_t* ptr = y + (size_t)row * DM + hd * 512 + lane * 8; float f[8], g[8]; unpack8(*(const u32x4*)ptr, f);
            unpack8(__builtin_nontemporal_load((const u32x4*)(big + (size_t)row * 6400 + 4096 + hd * 512 + lane * 8)), g);
            float ss = 0.f;
#pragma unroll
            for (int e = 0; e < 8; ++e) ss += f[e] * f[e];
            ss = wsum(ss); const float sc = rsqrtf(ss * (1.f / 512.f) + EPS);
#pragma unroll
            for (int e = 0; e < 8; ++e) f[e] = f[e] * sc * og[e] * silu(g[e]);
            *(u32x4*)ptr = pack8(f);
        }
    }
}

DI void phase_conv(const Params& p) {
    const bf16_t* big = (const bf16_t*)(p.ws + ACT); bf16_t* xc = (bf16_t*)(p.ws + HBUF);
    for (size_t idx = (size_t)blockIdx.x * 512 + otid(); idx < (size_t)(MTOK / 8) * 256; idx += (size_t)gridDim.x * 512) {
        const int tok0 = (int)(idx >> 8) * 8, ch = (int)(idx & 255) * 8, t0 = tok0 & (SEQ - 1);
        float wv[4][8], bs[8];
        { const f32x4 b0 = *(const f32x4*)(p.in[15] + ch), b1 = *(const f32x4*)(p.in[15] + ch + 4);
#pragma unroll
          for (int e = 0; e < 4; ++e) { bs[e] = b0[e]; bs[4 + e] = b1[e]; } }
#pragma unroll
        for (int jx = 0; jx < 4; ++jx) { const f32x4 w0 = *(const f32x4*)(p.in[14] + jx * 2048 + ch), w1 = *(const f32x4*)(p.in[14] + jx * 2048 + ch + 4);
#pragma unroll
            for (int e = 0; e < 4; ++e) { wv[jx][e] = w0[e]; wv[jx][4 + e] = w1[e]; } }
        u32x4 raw[11];
#pragma unroll
        for (int r = 0; r < 11; ++r) raw[r] = (r >= 3 || t0 > 0) ? *(const u32x4*)(big + (size_t)(tok0 - 3 + r) * 4096 + ch) : (u32x4){0u, 0u, 0u, 0u};
#pragma unroll
        for (int o = 0; o < 8; ++o) {
            float acc[8];
#pragma unroll
            for (int e = 0; e < 8; ++e) acc[e] = bs[e];
#pragma unroll
            for (int jx = 0; jx < 4; ++jx) { float f[8]; unpack8(raw[o + jx], f);
#pragma unroll
                for (int e = 0; e < 8; ++e) acc[e] += f[e] * wv[jx][e]; }
            *(u32x4*)(xc + (size_t)(tok0 + o) * DM + ch) = pack8(acc);
        }
    }
}
DI void phase_lru_scan(const Params& p, LAS unsigned char* lds) {
    const unsigned* ax = (const unsigned*)(p.ws + ACT + 128 * MiB); const bf16_t* big = (const bf16_t*)(p.ws + ACT);
    bf16_t* y = (bf16_t*)(p.ws + HBUF);
    LAS unsigned* tile = (LAS unsigned*)lds;
    LAS float* sP = (LAS float*)(lds + 65536); LAS float* sH = sP + 512; LAS float* sC = sH + 512;
    const int tid = otid(), seg = tid >> 5, chl = tid & 31;
    for (int u = blockIdx.x; u < 256; u += gridDim.x) {
        const int b = u >> 6, ch = (u & 63) * 32 + chl;
        const size_t rowbase = (size_t)b * SEQ;
        unsigned pre[32];
#pragma unroll
        for (int i = 0; i < 32; ++i) pre[i] = __builtin_nontemporal_load(ax + (rowbase + seg + 16 * i) * DM + ch);
        __syncthreads();
        if (tid < 32) sC[tid] = 0.f;
        for (int sc = 0; sc < 8; ++sc) {
#pragma unroll
            for (int i = 0; i < 32; ++i) tile[(seg + 16 * i) * 32 + chl] = pre[i];
            __syncthreads();
            if (sc + 1 < 8) {
#pragma unroll
                for (int i = 0; i < 32; ++i) pre[i] = __builtin_nontemporal_load(ax + (rowbase + (sc + 1) * 512 + seg + 16 * i) * DM + ch);
            }
            float L = 0.f, H = 0.f;
#pragma unroll 8
            for (int t = 0; t < 32; ++t) { const unsigned w = tile[(seg * 32 + t) * 32 + chl]; const float la = __uint_as_float(w << 16); H = __expf(la) * H + __uint_as_float(w & 0xffff0000u); L += la; }
            sP[tid] = __expf(L); sH[tid] = H;
            __syncthreads();
            float hc = sC[chl];
            for (int sg = 0; sg < seg; ++sg) hc = sP[sg * 32 + chl] * hc + sH[sg * 32 + chl];
            const size_t r0 = rowbase + sc * 512 + seg * 32;
#pragma unroll 8
            for (int t = 0; t < 32; ++t) { const unsigned w = tile[(seg * 32 + t) * 32 + chl]; hc = __expf(__uint_as_float(w << 16)) * hc + __uint_as_float(w & 0xffff0000u);
                y[(r0 + t) * DM + ch] = f2bf(hc * silu(bf2f(__builtin_nontemporal_load(big + (r0 + t) * 4096 + 2048 + ch)))); }
            __syncthreads();
            if (seg == 15) sC[chl] = hc;
        }
    }
}

DI void phase_mla_lat(const Params& p) {
    bf16_t* lat = (bf16_t*)(p.ws + LAT);
    const int tid = otid(), lane = tid & 63, gw = blockIdx.x * 8 + (tid >> 6), nw = gridDim.x * 8;
    float gq[8], gk[8];
#pragma unroll
    for (int e = 0; e < 8; ++e) { gq[e] = p.in[23][lane * 8 + e]; gk[e] = p.in[24][lane * 8 + e]; }
    const float inv = powf(10000.f, -(float)(lane & 31) * (1.f / 32.f));
    const float g1 = p.in[27][192 + 128 + (lane & 31)], g2 = p.in[27][192 + 160 + (lane & 31)];
    for (int row = gw; row < MTOK; row += nw) {
#pragma unroll
        for (int part = 0; part < 2; ++part) {
            bf16_t* ptr = lat + (size_t)row * 1088 + part * 512 + lane * 8; float f[8]; unpack8(*(const u32x4*)ptr, f);
            float ss = 0.f;
#pragma unroll
            for (int e = 0; e < 8; ++e) ss += f[e] * f[e];
            ss = wsum(ss); const float sc = rsqrtf(ss * (1.f / 512.f) + EPS);
#pragma unroll
            for (int e = 0; e < 8; ++e) f[e] = f[e] * sc * (part ? gk[e] : gq[e]);
            *(u32x4*)ptr = pack8(f);
        }
        { bf16_t* kp = lat + (size_t)row * 1088 + 1024; const int i = lane & 31;
          const float x1 = bf2f(kp[i]), x2 = bf2f(kp[i + 32]);
          float ss = (lane < 32) ? x1 * x1 + x2 * x2 : 0.f; ss = wsum(ss); const float sc = rsqrtf(ss * (1.f / 64.f) + EPS);
          const float a1 = x1 * sc * g1, a2 = x2 * sc * g2; float sn, cs; sincosf((float)(row & (SEQ - 1)) * inv, &sn, &cs);
          if (lane < 32) { kp[i] = f2bf(a1 * cs - a2 * sn); kp[i + 32] = f2bf(a2 * cs + a1 * sn); } }
    }
}
DI void phase_mla_qk(const Params& p) {
    bf16_t* qkv = (bf16_t*)(p.ws + ACT); bf16_t* lat = (bf16_t*)(p.ws + LAT); const float* qkg = p.in[27];
    const int tid = otid(), lane = tid & 63, gw = blockIdx.x * 8 + (tid >> 6), nw = gridDim.x * 8;
    const int l16 = lane & 15, l8 = lane & 7;
    float gk[8], gkr[8];
#pragma unroll
    for (int e = 0; e < 8; ++e) { gk[e] = qkg[192 + l16 * 8 + e]; gkr[e] = qkg[192 + 128 + l8 * 8 + e]; }
    float inv[8];
#pragma unroll
    for (int e = 0; e < 8; ++e) inv[e] = powf(10000.f, -(float)((l8 & 3) * 8 + e) * (1.f / 32.f));
    for (int row = gw; row < MTOK; row += nw) {
        bf16_t* qr = qkv + (size_t)row * 7168; bf16_t* kpp = lat + (size_t)row * 1088 + 1024 + l8 * 8;
        u32x4 wk[4];
#pragma unroll
        for (int i = 0; i < 4; ++i) { const int head = 4 * i + (lane >> 4); wk[i] = *(const u32x4*)(qr + 3072 + head * 256 + l16 * 8); }
        const u32x4 wp = *(const u32x4*)kpp;
        const float pos = (float)(row & (SEQ - 1));
#pragma unroll
        for (int i = 0; i < 4; ++i) {
            const int head = 4 * i + (lane >> 4);
            float f[8]; unpack8(wk[i], f); float ss = 0.f;
#pragma unroll
            for (int e = 0; e < 8; ++e) ss += f[e] * f[e];
            ss += __shfl_xor(ss, 1); ss += __shfl_xor(ss, 2); ss += __shfl_xor(ss, 4); ss += __shfl_xor(ss, 8);
            const float sc = rsqrtf(ss * (1.f / 128.f) + EPS);
#pragma unroll
            for (int e = 0; e < 8; ++e) f[e] *= sc * gk[e];
            *(u32x4*)(qr + 3072 + head * 256 + l16 * 8) = pack8(f);
        }
        { float f[8], o[8]; unpack8(wp, f); float ss = 0.f;
#pragma unroll
          for (int e = 0; e < 8; ++e) ss += f[e] * f[e];
          ss += __shfl_xor(ss, 1); ss += __shfl_xor(ss, 2); ss += __shfl_xor(ss, 4);
          const float sc = rsqrtf(ss * (1.f / 64.f) + EPS);
#pragma unroll
          for (int e = 0; e < 8; ++e) {
              const float a = f[e] * sc * gkr[e], pa = __shfl_xor(a, 4);
              float sn, cs; sincosf(pos * inv[e], &sn, &cs);
              o[e] = (l8 < 4) ? a * cs - pa * sn : a * cs + pa * sn;
          }
          if (lane < 8) *(u32x4*)kpp = pack8(o); }
    }
}

#define XB_TMO      128
#define XB_XCNT(j)  (256  + 64 * (j))
#define XB_XSUB(j)  (1280 + 64 * (j))
#define XB_XGEN(j)  (2304 + 64 * (j))
#define XB_TOP      3328
#define XB_TOPGEN   3392
#define XCD_BAR_WORDS 3456
#define XB_SPIN_CAP (1u << 22)
DI unsigned xb_ld(unsigned* p)              { return __hip_atomic_load(p, __ATOMIC_RELAXED, __HIP_MEMORY_SCOPE_AGENT); }
DI unsigned xb_add(unsigned* p, unsigned v) { return __hip_atomic_fetch_add(p, v, __ATOMIC_RELAXED, __HIP_MEMORY_SCOPE_AGENT); }
DI unsigned xb_xcc_id() { return (unsigned)__builtin_amdgcn_s_getreg((3 << 11) | 20) & 0xFu; }
#define XB_SPIN(cond, bar) do { unsigned _sp = 0; while (cond) { __builtin_amdgcn_s_sleep(1); \
    if ((++_sp & 255u) == 0u) { if (xb_ld(&(bar)[XB_TMO])) break; if (_sp > XB_SPIN_CAP) { atomicAdd(&(bar)[XB_TMO], 1u); break; } } } } while (0)
struct XcdBarrier { unsigned* bar; unsigned x; volatile LAS unsigned* st; };
DI XcdBarrier xcd_barrier_post(unsigned* bar, volatile LAS unsigned* st) {
    XcdBarrier b; b.bar = bar; b.x = xb_xcc_id(); b.st = st;
    if (threadIdx.x == 0) (void)xb_add(&bar[XB_XCNT(b.x)], 1u);
    return b;
}
DI void xcd_barrier_complete(unsigned* bar, unsigned x, unsigned& nloc, unsigned& nx) {
    const unsigned G = gridDim.x * gridDim.y * gridDim.z;
    unsigned sum, cnt, mine, sp = 0u;
    for (;;) {
        sum = 0u; cnt = 0u; mine = 0u;
#pragma unroll
        for (unsigned j = 0; j < 16; ++j) { const unsigned c = xb_ld(&bar[XB_XCNT(j)]); sum += c; cnt += (c > 0u) ? 1u : 0u; mine = (j == x) ? c : mine; }
        if (sum == G) break;
        __builtin_amdgcn_s_sleep(1);
        if ((++sp & 255u) == 0u) { if (xb_ld(&bar[XB_TMO])) break; if (sp > XB_SPIN_CAP) { atomicAdd(&bar[XB_TMO], 1u); break; } }
    }
    nloc = mine > 0u ? mine : 1u; nx = cnt > 0u ? cnt : 1u;
}
DI void xcd_barrier(const XcdBarrier& b0) {
    asm volatile("s_waitcnt vmcnt(0)" ::: "memory");
    __syncthreads();
    if (otid() == 0) {
        XcdBarrier b; b.bar = b0.bar; b.st = b0.st; b.x = xb_xcc_id();
        unsigned* bar = b.bar;
        __builtin_amdgcn_s_waitcnt(0);
        unsigned nloc = b.st[0], nx = b.st[1];
        if (nloc == 0u) { xcd_barrier_complete(bar, b.x, nloc, nx); b.st[0] = nloc; b.st[1] = nx; }
        const unsigned old = xb_add(&bar[XB_XSUB(b.x)], 1u);
        const unsigned gen = old / nloc;
        if (old + 1u == (gen + 1u) * nloc) {
            __builtin_amdgcn_fence(__ATOMIC_RELEASE, "agent");
            asm volatile("s_waitcnt vmcnt(0)" ::: "memory");
            const unsigned og = xb_add(&bar[XB_TOP], 1u);
            const unsigned tg = og / nx;
            if (og + 1u == (tg + 1u) * nx) xb_add(&bar[XB_TOPGEN], 1u);
            else XB_SPIN(xb_ld(&bar[XB_TOPGEN]) == tg, bar);
            __builtin_amdgcn_fence(__ATOMIC_ACQUIRE, "agent");
            xb_add(&bar[XB_XGEN(b.x)], 1u);
            asm volatile("s_waitcnt vmcnt(0)" ::: "memory");
        } else {
            XB_SPIN(xb_ld(&bar[XB_XGEN(b.x)]) == gen, bar);
            __builtin_amdgcn_fence(__ATOMIC_ACQUIRE, "agent");
            asm volatile("s_waitcnt vmcnt(0)" ::: "memory");
        }
    }
    __syncthreads();
}

__global__ __launch_bounds__(512, 2) void mega(const Params p) {
    extern __shared__ __attribute__((aligned(16))) unsigned char shm[];
    LAS unsigned char* lds = (LAS unsigned char*)shm;
    cg::grid_group grid = cg::this_grid();
    volatile LAS unsigned* bst = (volatile LAS unsigned*)(lds + 131072 + 1024);
    if (threadIdx.x == 0) { bst[0] = 0u; bst[1] = 0u; }
    __syncthreads();
    XcdBarrier xb = xcd_barrier_post((unsigned*)(p.ws + WS_BAR), bst); xb.x = 0;
    if constexpr ((PHMASK >> 0) & 1) { phase_convert(p, lds); }
    if constexpr ((REPMASK >> 0) & 1) { __syncthreads(); phase_convert(p, lds); }
    if constexpr ((PHMASK >> 1) & 1) { phase_bias_table(p); }
    if constexpr ((REPMASK >> 1) & 1) { __syncthreads(); phase_bias_table(p); }
    if constexpr ((PHMASK >> 2) & 1) { phase_rmsnorm(p.in[0], p.in[1], (bf16_t*)(uni(p.ws) + HBUF)); }
    if constexpr ((REPMASK >> 2) & 1) { __syncthreads(); phase_rmsnorm(p.in[0], p.in[1], (bf16_t*)(uni(p.ws) + HBUF)); }
    if (p.njobs < 0) grid.sync();
    xcd_barrier(xb);
    if constexpr ((PHMASK >> 3) & 1) { { pg8::EpiStoreA E{(bf16_t*)(uni(p.ws) + ACT), p.in[4]}; run_gemm<0>(lds, (bf16_t*)(uni(p.ws) + HBUF), (const bf16_t*)(uni(p.ws) + W_A_IN), 8192, 2048, 2048, E); } }
    if constexpr ((REPMASK >> 3) & 1) { __syncthreads(); { pg8::EpiStoreA E{(bf16_t*)(uni(p.ws) + ACT), p.in[4]}; run_gemm<0>(lds, (bf16_t*)(uni(p.ws) + HBUF), (const bf16_t*)(uni(p.ws) + W_A_IN), 8192, 2048, 2048, E); } }
    xcd_barrier(xb);
    if constexpr ((PHMASK >> 5) & 1) { phase_attn_a(p, lds); }
    if constexpr ((REPMASK >> 5) & 1) { __syncthreads(); phase_attn_a(p, lds); }
    xcd_barrier(xb);
    if constexpr ((PHMASK >> 6) & 1) { { pg8::EpiResid<false, false, true, true> E{p.in[0], nullptr, nullptr, (bf16_t*)(uni(p.ws) + XG), (float*)(uni(p.ws) + X_SSQ)}; run_gemm<0>(lds, (bf16_t*)(uni(p.ws) + HBUF), (const bf16_t*)(uni(p.ws) + W_A_OUT), 2048, 2048, 2048, E); } }
    if constexpr ((REPMASK >> 6) & 1) { __syncthreads(); { pg8::EpiResid<false, false, true, true> E{p.in[0], nullptr, nullptr, (bf16_t*)(uni(p.ws) + XG), (float*)(uni(p.ws) + X_SSQ)}; run_gemm<0>(lds, (bf16_t*)(uni(p.ws) + HBUF), (const bf16_t*)(uni(p.ws) + W_A_OUT), 2048, 2048, 2048, E); } }
    xcd_barrier(xb);
    if constexpr ((PHMASK >> 8) & 1) { { pg8::EpiStore E{(bf16_t*)(uni(p.ws) + ACT), 6400, (const float*)(uni(p.ws) + X_SSQ)}; run_gemm<0>(lds, (const bf16_t*)(uni(p.ws) + XG), (const bf16_t*)(uni(p.ws) + W_B_IN), 6144, 2048, 2048, E); } }
    if constexpr ((REPMASK >> 8) & 1) { __syncthreads(); { pg8::EpiStore E{(bf16_t*)(uni(p.ws) + ACT), 6400, (const float*)(uni(p.ws) + X_SSQ)}; run_gemm<0>(lds, (const bf16_t*)(uni(p.ws) + XG), (const bf16_t*)(uni(p.ws) + W_B_IN), 6144, 2048, 2048, E); } }
    xcd_barrier(xb);
    if constexpr ((PHMASK >> 9) & 1) { phase_gla_prep(p, lds); }
    if constexpr ((REPMASK >> 9) & 1) { __syncthreads(); phase_gla_prep(p, lds); }
    xcd_barrier(xb);
    if constexpr ((PHMASK >> 10) & 1) { phase_gla_scan(p, lds); }
    if constexpr ((REPMASK >> 10) & 1) { __syncthreads(); phase_gla_scan(p, lds); }
    xcd_barrier(xb);
    if constexpr ((PHMASK >> 11) & 1) { phase_gla_post(p); }
    if constexpr ((REPMASK >> 11) & 1) { __syncthreads(); phase_gla_post(p); }
    xcd_barrier(xb);
    if constexpr ((PHMASK >> 12) & 1) { { pg8::EpiResid<true, false, true, true> E{nullptr, (const bf16_t*)(uni(p.ws) + XG), nullptr, (bf16_t*)(uni(p.ws) + XG), (float*)(uni(p.ws) + X_SSQ) + MTOK}; run_gemm<0>(lds, (bf16_t*)(uni(p.ws) + HBUF), (const bf16_t*)(uni(p.ws) + W_B_OUT), 2048, 2048, 2048, E); } }
    if constexpr ((REPMASK >> 12) & 1) { __syncthreads(); { pg8::EpiResid<true, false, true, true> E{nullptr, (const bf16_t*)(uni(p.ws) + XG), nullptr, (bf16_t*)(uni(p.ws) + XG), (float*)(uni(p.ws) + X_SSQ) + MTOK}; run_gemm<0>(lds, (bf16_t*)(uni(p.ws) + HBUF), (const bf16_t*)(uni(p.ws) + W_B_OUT), 2048, 2048, 2048, E); } }
    xcd_barrier(xb);
    if constexpr ((PHMASK >> 14) & 1) { { pg8::EpiStore E{(bf16_t*)(uni(p.ws) + ACT), 4096, (const float*)(uni(p.ws) + X_SSQ) + MTOK}; run_gemm<0>(lds, (const bf16_t*)(uni(p.ws) + XG), (const bf16_t*)(uni(p.ws) + W_C_IN), 4096, 2048, 2048, E); } }
    if constexpr ((REPMASK >> 14) & 1) { __syncthreads(); { pg8::EpiStore E{(bf16_t*)(uni(p.ws) + ACT), 4096, (const float*)(uni(p.ws) + X_SSQ) + MTOK}; run_gemm<0>(lds, (const bf16_t*)(uni(p.ws) + XG), (const bf16_t*)(uni(p.ws) + W_C_IN), 4096, 2048, 2048, E); } }
    xcd_barrier(xb);
    if constexpr ((PHMASK >> 15) & 1) { phase_conv(p); }
    if constexpr ((REPMASK >> 15) & 1) { __syncthreads(); phase_conv(p); }
    xcd_barrier(xb);
    if constexpr ((PHMASK >> 16) & 1) { { pg8::EpiGates E{(bf16_t*)(uni(p.ws) + HBUF), p.in[17], p.in[19], (const float*)(uni(p.ws) + X_SP8), (unsigned*)(uni(p.ws) + ACT + 128 * MiB)}; run_gemm<2>(lds, (bf16_t*)(uni(p.ws) + HBUF), (const bf16_t*)(uni(p.ws) + W_C_GATE), 4096, 256, 2048, E); } }
    if constexpr ((REPMASK >> 16) & 1) { __syncthreads(); { pg8::EpiGates E{(bf16_t*)(uni(p.ws) + HBUF), p.in[17], p.in[19], (const float*)(uni(p.ws) + X_SP8), (unsigned*)(uni(p.ws) + ACT + 128 * MiB)}; run_gemm<2>(lds, (bf16_t*)(uni(p.ws) + HBUF), (const bf16_t*)(uni(p.ws) + W_C_GATE), 4096, 256, 2048, E); } }
    xcd_barrier(xb);
    if constexpr ((PHMASK >> 17) & 1) { phase_lru_scan(p, lds); }
    if constexpr ((REPMASK >> 17) & 1) { __syncthreads(); phase_lru_scan(p, lds); }
    xcd_barrier(xb);
    if constexpr ((PHMASK >> 18) & 1) { { pg8::EpiResid<true, false, true, true> E{nullptr, (const bf16_t*)(uni(p.ws) + XG), nullptr, (bf16_t*)(uni(p.ws) + XG), (float*)(uni(p.ws) + X_SSQ) + 2 * MTOK}; run_gemm<0>(lds, (bf16_t*)(uni(p.ws) + HBUF), (const bf16_t*)(uni(p.ws) + W_C_OUT), 2048, 2048, 2048, E); } }
    if constexpr ((REPMASK >> 18) & 1) { __syncthreads(); { pg8::EpiResid<true, false, true, true> E{nullptr, (const bf16_t*)(uni(p.ws) + XG), nullptr, (bf16_t*)(uni(p.ws) + XG), (float*)(uni(p.ws) + X_SSQ) + 2 * MTOK}; run_gemm<0>(lds, (bf16_t*)(uni(p.ws) + HBUF), (const bf16_t*)(uni(p.ws) + W_C_OUT), 2048, 2048, 2048, E); } }
    xcd_barrier(xb);
    if constexpr ((PHMASK >> 20) & 1) { { pg8::EpiStoreD E{(bf16_t*)(uni(p.ws) + LAT), (bf16_t*)(uni(p.ws) + HBUF), (const float*)(uni(p.ws) + X_SSQ) + 2 * MTOK, (float*)(uni(p.ws) + X_SSQ) + 3 * MTOK}; run_gemm<0>(lds, (const bf16_t*)(uni(p.ws) + XG), (const bf16_t*)(uni(p.ws) + W_D_IN), 3328, 2048, 2048, E); } }
    if constexpr ((REPMASK >> 20) & 1) { __syncthreads(); { pg8::EpiStoreD E{(bf16_t*)(uni(p.ws) + LAT), (bf16_t*)(uni(p.ws) + HBUF), (const float*)(uni(p.ws) + X_SSQ) + 2 * MTOK, (float*)(uni(p.ws) + X_SSQ) + 3 * MTOK}; run_gemm<0>(lds, (const bf16_t*)(uni(p.ws) + XG), (const bf16_t*)(uni(p.ws) + W_D_IN), 3328, 2048, 2048, E); } }
    xcd_barrier(xb);
    if constexpr ((PHMASK >> 22) & 1) { { pg8::EpiStoreU E{(bf16_t*)(uni(p.ws) + ACT), (const float*)(uni(p.ws) + X_SSQ) + 3 * MTOK}; run_gemm<1>(lds, (const bf16_t*)(uni(p.ws) + LAT), (const bf16_t*)(uni(p.ws) + W_D_UQKV), 7168, 512, 1088, E); } }
    if constexpr ((REPMASK >> 22) & 1) { __syncthreads(); { pg8::EpiStoreU E{(bf16_t*)(uni(p.ws) + ACT), (const float*)(uni(p.ws) + X_SSQ) + 3 * MTOK}; run_gemm<1>(lds, (const bf16_t*)(uni(p.ws) + LAT), (const bf16_t*)(uni(p.ws) + W_D_UQKV), 7168, 512, 1088, E); } }
    xcd_barrier(xb);
    if constexpr ((PHMASK >> 23) & 1) { phase_mla_qk(p); }
    if constexpr ((REPMASK >> 23) & 1) { __syncthreads(); phase_mla_qk(p); }
    xcd_barrier(xb);
    if constexpr ((PHMASK >> 24) & 1) { phase_attn_d(p, lds); }
    if constexpr ((REPMASK >> 24) & 1) { __syncthreads(); phase_attn_d(p, lds); }
    xcd_barrier(xb);
    if constexpr ((PHMASK >> 25) & 1) { { pg8::EpiResid<true, true, false, false> E{nullptr, (const bf16_t*)(uni(p.ws) + XG), uni(p.out), nullptr, nullptr}; run_gemm<0>(lds, (bf16_t*)(uni(p.ws) + HBUF), (const bf16_t*)(uni(p.ws) + W_D_OUT), 2048, 2048, 2048, E); } }
    if constexpr ((REPMASK >> 25) & 1) { __syncthreads(); { pg8::EpiResid<true, true, false, false> E{nullptr, (const bf16_t*)(uni(p.ws) + XG), uni(p.out), nullptr, nullptr}; run_gemm<0>(lds, (bf16_t*)(uni(p.ws) + HBUF), (const bf16_t*)(uni(p.ws) + W_D_OUT), 2048, 2048, 2048, E); } }
#ifdef XSYNC
    for (int i = 0; i < XSYNC; ++i) xcd_barrier(xb);
#endif
}

extern "C" void kernel_launch(void* const* d_in, const int* in_sizes, int n_in, void* d_out, int out_size, void* d_ws, size_t ws_size, hipStream_t stream) {
    static int grid_blocks = 0;
    if (!grid_blocks) {
        int dev = 0, cus = 0, per_cu = 0;
        hipGetDevice(&dev);
        hipDeviceGetAttribute(&cus, hipDeviceAttributeMultiprocessorCount, dev);
        hipFuncSetAttribute((const void*)mega, hipFuncAttributeMaxDynamicSharedMemorySize, LDS_BYTES);
        hipOccupancyMaxActiveBlocksPerMultiprocessor(&per_cu, (const void*)mega, 512, LDS_BYTES);
        if (per_cu < 1) per_cu = 1;
        grid_blocks = cus * per_cu;
        if (ws_size < EXTRA + 65536 + 5 * 65536) fprintf(stderr, "kernel_launch: workspace too small (%zu < %zu)\n", ws_size, (size_t)WS_END);
    }
    Params p; memset(&p, 0, sizeof(p));
    for (int i = 0; i < 29; ++i) p.in[i] = (const float*)d_in[i];
    p.out = (float*)d_out; p.ws = (unsigned char*)d_ws;
    unsigned char* ws = (unsigned char*)d_ws;
    int nj = 0, tiles = 0;
    auto add = [&](const float* src, size_t dst_off, int K, int N, int ldw, int npad) {
        TJob& j = p.jobs[nj++]; j.src = src; j.dst = (bf16_t*)(ws + dst_off); j.kscale = nullptr; j.K = K; j.N = N; j.ldw = ldw; j.ntn = npad / 64; j.tile0 = tiles; j.pad = 0; tiles += (npad / 64) * (K / 256);
    };
    add(p.in[3], W_A_IN, 2048, 8192, 8192, 8192); p.jobs[0].pad = 1;
    add(p.in[7], W_A_OUT, 2048, 2048, 2048, 2048);
    add(p.in[8], W_B_IN, 2048, 6160, 6160, 6400); p.jobs[nj - 1].kscale = p.in[1] + 2048;
    add(p.in[12], W_B_OUT, 2048, 2048, 2048, 2048);
    add(p.in[13], W_C_IN, 2048, 4096, 4096, 4096); p.jobs[nj - 1].kscale = p.in[1] + 4096;
    add(p.in[21], W_C_OUT, 2048, 2048, 2048, 2048);
    add(p.in[22], W_D_IN, 2048, 3136, 3136, 3328); p.jobs[nj - 1].kscale = p.in[1] + 6144;
    add(p.in[25], W_D_UQKV, 512, 3072, 3072, 3072); p.jobs[nj - 1].kscale = p.in[23];
    add(p.in[26], W_D_UQKV + (size_t)3072 * 512 * 2, 512, 4096, 4096, 4096); p.jobs[nj - 1].kscale = p.in[24];
    add(p.in[28], W_D_OUT, 2048, 2048, 2048, 2048);
    for (int n = 0; n < 8; ++n) for (int half = 0; half < 2; ++half) for (int bj = 0; bj < 2; ++bj)
        add(p.in[bj ? 18 : 16] + (size_t)n * 65536 + half * 128, W_C_GATE + ((size_t)((n * 2 + half) * 256 + 128 * bj)) * 256 * 2, 256, 128, 256, 128);
    p.njobs = nj; p.ntiles = tiles;
    hipMemsetAsync(ws + WS_BAR, 0, XCD_BAR_WORDS * 4, stream);
    void* args[] = {(void*)&p};
    hipError_t e = hipLaunchCooperativeKernel((const void*)mega, dim3(grid_blocks), dim3(512), args, LDS_BYTES, stream);
    if (e != hipSuccess) fprintf(stderr, "cooperative launch failed: %s (grid %d)\n", hipGetErrorString(e), grid_blocks);
}
```

```cpp
#include <hip/hip_runtime.h>
#include <hip/hip_cooperative_groups.h>
#include <cstdio>
#include <cstring>
namespace cg = cooperative_groups;

#define DI __device__ __forceinline__
#define LAS __attribute__((address_space(3)))
typedef unsigned short bf16_t;
typedef short bf16x8 __attribute__((ext_vector_type(8)));
typedef short s16x4 __attribute__((ext_vector_type(4)));
typedef float f32x2 __attribute__((ext_vector_type(2)));
typedef float f32x4 __attribute__((ext_vector_type(4)));
typedef float f32x16 __attribute__((ext_vector_type(16)));
typedef unsigned u32x2 __attribute__((ext_vector_type(2)));
typedef unsigned u32x4 __attribute__((ext_vector_type(4)));
typedef __bf16 bf16v2_t __attribute__((ext_vector_type(2)));

constexpr int MTOK = 16384, DM = 2048, SEQ = 4096;
constexpr float EPS = 1e-6f, LOG2E = 1.4426950408889634f;
constexpr size_t MiB = (size_t)1 << 20;
constexpr size_t W_A_IN = 0, W_A_OUT = 32 * MiB, W_B_IN = 40 * MiB, W_B_OUT = 65 * MiB, W_C_IN = 73 * MiB, W_C_GATE = 89 * MiB,
                 W_C_OUT = 91 * MiB, W_D_IN = 99 * MiB, W_D_UQKV = 112 * MiB, W_D_OUT = 119 * MiB, HBUF = 127 * MiB, ACT = 191 * MiB,
                 WS_END = 511 * MiB;
constexpr size_t LAT = 0;
constexpr size_t EXTRA = 511 * MiB;
constexpr size_t X_BIAS = EXTRA + 16384, X_SP8 = EXTRA + 32768, X_SSQ = EXTRA + 65536;
constexpr size_t GLA_TOT = ACT + 200 * MiB;
constexpr size_t XG = ACT + 256 * MiB;
constexpr size_t WS_BAR = EXTRA;
constexpr int LDS_BYTES = 131072 + 2048;
#ifndef PHMASK
#define PHMASK 0xffffffffull
#endif
#ifndef REPMASK
#define REPMASK 0ull
#endif

struct TJob { const float* src; bf16_t* dst; const float* kscale; int K, N, ldw, ntn, tile0, pad; };
struct Params { const float* in[29]; float* out; unsigned char* ws; int njobs, ntiles; TJob jobs[44]; };

DI int otid() { int t = threadIdx.x; asm volatile("" : "+v"(t)); return t; }
template <class T> DI T* uni(T* p) {
    const unsigned long long v = (unsigned long long)p;
    const unsigned lo = __builtin_amdgcn_readfirstlane((unsigned)v), hi = __builtin_amdgcn_readfirstlane((unsigned)(v >> 32));
    return (T*)(((unsigned long long)hi << 32) | lo);
}
DI float bf2f(bf16_t v) { return __uint_as_float((unsigned)v << 16); }
DI unsigned pk2(float a, float b) { f32x2 v = {a, b}; bf16v2_t r = __builtin_convertvector(v, bf16v2_t); return __builtin_bit_cast(unsigned, r); }
DI bf16_t f2bf(float a) { return (bf16_t)(pk2(a, 0.f) & 0xffffu); }
DI void unpack8(const u32x4 w, float (&f)[8]) {
#pragma unroll
    for (int i = 0; i < 4; ++i) { f[2 * i] = __uint_as_float(w[i] << 16); f[2 * i + 1] = __uint_as_float(w[i] & 0xffff0000u); }
}
DI u32x4 pack8(const float (&f)[8]) { u32x4 w; w.x = pk2(f[0], f[1]); w.y = pk2(f[2], f[3]); w.z = pk2(f[4], f[5]); w.w = pk2(f[6], f[7]); return w; }
DI float wsum(float v) {
#pragma unroll
    for (int m = 32; m >= 1; m >>= 1) v += __shfl_xor(v, m);
    return v;
}
DI float sigm(float x) { return 1.f / (1.f + __expf(-x)); }
DI float silu(float x) { return x / (1.f + __expf(-x)); }
DI int crow(int i, int hh) { return (i & 3) + 8 * (i >> 2) + 4 * hh; }
DI f32x16 mfma32(bf16x8 a, bf16x8 b, f32x16 c) { return __builtin_amdgcn_mfma_f32_32x32x16_bf16(a, b, c, 0, 0, 0); }
DI s16x4 trread(LAS unsigned char* p) { return __builtin_amdgcn_ds_read_tr16_b64_v4i16((LAS s16x4*)p); }
DI bf16x8 cat4(s16x4 lo, s16x4 hi) { return __builtin_shufflevector(lo, hi, 0, 1, 2, 3, 4, 5, 6, 7); }

namespace pg8 {
constexpr int BM = 256, BK = 64, HALF = 128, HTB = HALF * BK * 2, STAGE_BYTES = 8 * HTB, NXCD = 8, WGM = 8;
DI int lds_byte(int r, int c) { const int st = (r >> 4) * 2 + (c >> 5), rr = r & 15, cc = c & 31, ob = rr * 64 + cc * 2; return st * 1024 + (ob ^ (((ob >> 9) & 1) << 5)); }
DI void stage_rc(int b, int& R, int& C) { const int st = b / 1024, sb = b % 1024, swz = sb ^ (((sb >> 9) & 1) << 5); R = (st >> 1) * 16 + swz / 64; C = (st & 1) * 32 + (swz % 64) / 2; }
DI int perm32(int rho) { const int n = rho >> 4, i = rho & 15; return 8 * (i >> 2) + 4 * n + (i & 3); }
struct Unit { int pm, pn; size_t aoff, boff; };
template <int MODE> struct Sched {
    int nM, nN, nwg, G, c, lda, K;
    DI void init(int M, int N, int G_, int c_, int lda_, int K_) { nM = M / BM; nN = N / BM; nwg = nM * nN; G = G_; c = c_; lda = lda_; K = K_; }
    DI bool next(int i, Unit& u) const {
        const long L = (long)i * G + c; if (L >= nwg) return false;
        int wgid = (int)L; { const int q = nwg / NXCD, r = nwg % NXCD, xcd = wgid % NXCD, off = wgid / NXCD; wgid = (xcd < r ? xcd * (q + 1) : r * (q + 1) + (xcd - r) * q) + off; }
        const int nig = WGM * nN, gid = wgid / nig, fm = gid * WGM, gsz = (nM - fm) < WGM ? (nM - fm) : WGM;
        u.pm = fm + ((wgid % nig) % gsz); u.pn = (wgid % nig) / gsz;
        u.aoff = (size_t)u.pm * 256 * lda * 2; u.boff = (size_t)u.pn * 256 * K * 2;
        if (MODE == 1 && u.pn >= 12) u.aoff += 1024;
        if (MODE == 2) u.aoff += (size_t)(u.pn >> 1) * 512;
        return true;
    }
};

template <class Epi, class SchedT>
DI void gemm_phase(LAS unsigned char* lds, const bf16_t* Ap, const bf16_t* Btp, const int K, const int lda, const SchedT& S, const Epi& E) {
    const int tid = otid(), wid = __builtin_amdgcn_readfirstlane(tid >> 6), lane = tid & 63, wr = wid >> 2, wc = wid & 3, fr = lane & 15, fq = lane >> 4;
    const int nt = K / BK;
    unsigned voffA[2], voffB[2];
#pragma unroll
    for (int i = 0; i < 2; ++i) { int R, C; stage_rc(tid * 16 + i * 8192, R, C); const int Rb = (R & ~31) + perm32(R & 31);
        voffA[i] = (unsigned)(R * lda + C) * 2u; voffB[i] = (unsigned)(Rb * K + C) * 2u; }
    const size_t kstep = (size_t)(BK * 2);
    const size_t hstepA = (size_t)HALF * lda * 2, hstepB = (size_t)HALF * K * 2;
    const unsigned ldsw = (unsigned)wid * 1024u;
    const int aoff = lds_byte(wr * 64 + fr, fq * 8), boff = lds_byte(wc * 32 + fr, fq * 8);
#define PG8_SA(b, h) (((b) * 2 + (h)) * HTB)
#define PG8_SB(b, h) ((4 + (b) * 2 + (h)) * HTB)
#define PG8_STAGE(bufoff, gbase, voff) do { _Pragma("unroll") for (int _i = 0; _i < 2; ++_i) \
        __builtin_amdgcn_global_load_lds((const unsigned*)((const char*)(gbase) + (voff)[_i]), (LAS unsigned*)(lds + (bufoff) + ldsw + _i * 8192), 16, 0, 0); } while (0)
#define PG8_LDA(dst, b, h) do { _Pragma("unroll") for (int m = 0; m < 4; ++m) _Pragma("unroll") for (int k = 0; k < 2; ++k) dst[m][k] = *(const LAS bf16x8*)(lds + PG8_SA(b, h) + aoff + m * 2048 + k * 1024); } while (0)
#define PG8_LDB(dst, b, h) do { _Pragma("unroll") for (int n = 0; n < 2; ++n) _Pragma("unroll") for (int k = 0; k < 2; ++k) dst[n][k] = *(const LAS bf16x8*)(lds + PG8_SB(b, h) + boff + n * 2048 + k * 1024); } while (0)
#define PG8_MMA(ai, bj, At, Bt) do { __builtin_amdgcn_s_setprio(1); _Pragma("unroll") for (int m = 0; m < 4; ++m) _Pragma("unroll") for (int n = 0; n < 2; ++n) _Pragma("unroll") for (int k = 0; k < 2; ++k) \
        acc[ai][bj][m][n] = __builtin_amdgcn_mfma_f32_16x16x32_bf16(Bt[n][k], At[m][k], acc[ai][bj][m][n], 0, 0, 0); __builtin_amdgcn_s_setprio(0); } while (0)
#define PG8_WAIT_V(n) asm volatile("s_waitcnt vmcnt(" #n ")" ::: "memory")
#define PG8_WAIT_L(n) asm volatile("s_waitcnt lgkmcnt(" #n ")" ::: "memory")
#define PG8_BAR __builtin_amdgcn_s_barrier()
#define PG8_SCHED __builtin_amdgcn_sched_barrier(0)
    Unit cur, nxt; int ui = 0;
    if (!S.next(0, cur)) return;
    float pre[8]; E.prefetch(cur, wr, fr, pre);
    f32x4 acc[2][2][4][2];
#pragma unroll
    for (int a = 0; a < 2; ++a)
#pragma unroll
        for (int b = 0; b < 2; ++b)
#pragma unroll
            for (int m = 0; m < 4; ++m)
#pragma unroll
                for (int n = 0; n < 2; ++n) acc[a][b][m][n] = (f32x4){0.f, 0.f, 0.f, 0.f};
    bf16x8 At[4][2], B0[2][2], B1[2][2];
    const char* cA = (const char*)Ap + cur.aoff; const char* cB = (const char*)Btp + cur.boff;
    PG8_STAGE(PG8_SB(0, 0), cB, voffB); PG8_STAGE(PG8_SA(0, 0), cA, voffA); PG8_STAGE(PG8_SB(0, 1), cB + hstepB, voffB); PG8_STAGE(PG8_SA(0, 1), cA + hstepA, voffA);
    if (wr == 1) PG8_BAR;
    PG8_WAIT_V(4); PG8_BAR;
    PG8_STAGE(PG8_SB(1, 0), cB + kstep, voffB); PG8_STAGE(PG8_SA(1, 0), cA + kstep, voffA); PG8_STAGE(PG8_SB(1, 1), cB + hstepB + kstep, voffB);
    PG8_WAIT_V(6); PG8_BAR;
    for (;;) {
        const bool has_next = S.next(ui + 1, nxt);
        const char* nA = has_next ? (const char*)Ap + nxt.aoff : cA; const char* nB = has_next ? (const char*)Btp + nxt.boff : cB;
        for (int t = 0; t < nt; t += 2) {
            const bool last = (t == nt - 2);
            const char* a1 = cA + (size_t)(t + 1) * kstep;
            const char* a2 = last ? nA : cA + (size_t)(t + 2) * kstep; const char* b2 = last ? nB : cB + (size_t)(t + 2) * kstep;
            const char* a3 = a2 + kstep; const char* b3 = b2 + kstep;
            PG8_LDB(B0, 0, 0); PG8_SCHED; PG8_LDA(At, 0, 0); PG8_STAGE(PG8_SA(1, 1), a1 + hstepA, voffA);
            PG8_WAIT_L(8); PG8_BAR; PG8_WAIT_L(0); PG8_MMA(0, 0, At, B0); PG8_BAR; PG8_SCHED;
            PG8_LDB(B1, 0, 1); PG8_STAGE(PG8_SB(0, 0), b2, voffB);
            PG8_BAR; PG8_WAIT_L(0); PG8_MMA(0, 1, At, B1); PG8_BAR;
            PG8_LDA(At, 0, 1); PG8_STAGE(PG8_SA(0, 0), a2, voffA);
            PG8_BAR; PG8_WAIT_L(0); PG8_MMA(1, 0, At, B0); PG8_BAR; PG8_SCHED;
            PG8_STAGE(PG8_SB(0, 1), b2 + hstepB, voffB);
            PG8_WAIT_V(6); PG8_BAR; PG8_MMA(1, 1, At, B1); PG8_BAR;
            PG8_LDB(B0, 1, 0); PG8_SCHED; PG8_LDA(At, 1, 0); PG8_STAGE(PG8_SA(0, 1), a2 + hstepA, voffA);
            PG8_WAIT_L(8); PG8_BAR; PG8_WAIT_L(0); PG8_MMA(0, 0, At, B0); PG8_BAR; PG8_SCHED;
            PG8_LDB(B1, 1, 1); PG8_STAGE(PG8_SB(1, 0), b3, voffB);
            PG8_BAR; PG8_WAIT_L(0); PG8_MMA(0, 1, At, B1); PG8_BAR;
            PG8_LDA(At, 1, 1); PG8_STAGE(PG8_SA(1, 0), a3, voffA);
            PG8_BAR; PG8_WAIT_L(0); PG8_MMA(1, 0, At, B0); PG8_BAR; PG8_SCHED;
            PG8_STAGE(PG8_SB(1, 1), b3 + hstepB, voffB);
            PG8_WAIT_V(6); PG8_BAR; PG8_MMA(1, 1, At, B1); PG8_BAR;
        }
        E(acc, cur, wr, wc, fr, fq, pre);
        if (!has_next) break;
#pragma unroll
        for (int a = 0; a < 2; ++a)
#pragma unroll
            for (int b = 0; b < 2; ++b)
#pragma unroll
                for (int m = 0; m < 4; ++m)
#pragma unroll
                    for (int n = 0; n < 2; ++n) acc[a][b][m][n] = (f32x4){0.f, 0.f, 0.f, 0.f};
        cur = nxt; cA = nA; cB = nB; ++ui; E.prefetch(cur, wr, fr, pre);
    }
    PG8_WAIT_V(0);
    if (wr == 0) PG8_BAR;
    PG8_BAR;
#undef PG8_SA
#undef PG8_SB
#undef PG8_STAGE
#undef PG8_LDA
#undef PG8_LDB
#undef PG8_MMA
#undef PG8_WAIT_V
#undef PG8_WAIT_L
#undef PG8_BAR
#undef PG8_SCHED
}

typedef f32x4 Acc[2][2][4][2];
struct EpiStore {
    bf16_t* O; int ldc; const float* ssq;
    DI void prefetch(const Unit& u, int wr, int fr, float (&pre)[8]) const {
#pragma unroll
        for (int i = 0; i < 8; ++i) pre[i] = ssq ? ssq[u.pm * BM + wr * 64 + fr + (i >> 2) * HALF + (i & 3) * 16] : 0.f; }
    DI void operator()(const Acc& acc, const Unit& u, int wr, int wc, int fr, int fq, const float (&pre)[8]) const {
        const int row0 = u.pm * BM + wr * 64 + fr, col0 = u.pn * BM + wc * 32 + 8 * fq;
#pragma unroll
        for (int ai = 0; ai < 2; ++ai)
#pragma unroll
            for (int m = 0; m < 4; ++m) { bf16_t* rowp = O + (size_t)(row0 + ai * HALF + m * 16) * ldc + col0;
                const float rs = ssq ? rsqrtf(pre[ai * 4 + m] * (1.f / DM) + EPS) : 1.f;
#pragma unroll
                for (int bj = 0; bj < 2; ++bj) { const f32x4 v0 = acc[ai][bj][m][0] * rs, v1 = acc[ai][bj][m][1] * rs;
                    u32x4 w; w.x = pk2(v0[0], v0[1]); w.y = pk2(v0[2], v0[3]); w.z = pk2(v1[0], v1[1]); w.w = pk2(v1[2], v1[3]);
                    *(u32x4*)(rowp + bj * HALF) = w; } }
    }
};
struct EpiStoreA {
    bf16_t* O; const float* qkg;
    DI void prefetch(const Unit&, int, int, float (&pre)[8]) const {
#pragma unroll
        for (int i = 0; i < 8; ++i) pre[i] = 0.f; }
    DI void operator()(const Acc& acc, const Unit& u, int wr, int wc, int fr, int fq, const float (&pre)[8]) const {
        const int row0 = u.pm * BM + wr * 64 + fr, col0 = u.pn * BM + wc * 64 + 8 * fq;
        const bool nrm = u.pn < 16;
        f32x4 gn[2][2];
        if (nrm) { const float* gp = qkg + (u.pn < 8 ? 0 : 64) + 8 * fq; const float gs = u.pn < 8 ? 0.125f * LOG2E : 1.f;
#pragma unroll
            for (int bj = 0; bj < 2; ++bj) { gn[bj][0] = *(const f32x4*)(gp + 32 * bj) * gs; gn[bj][1] = *(const f32x4*)(gp + 32 * bj + 4) * gs; } }
#pragma unroll
        for (int ai = 0; ai < 2; ++ai)
#pragma unroll
            for (int m = 0; m < 4; ++m) { bf16_t* rowp = O + (size_t)(row0 + ai * HALF + m * 16) * 8192 + col0;
                f32x4 v[2][2];
#pragma unroll
                for (int bj = 0; bj < 2; ++bj) { v[bj][0] = acc[ai][bj][m][0]; v[bj][1] = acc[ai][bj][m][1]; }
                if (nrm) { float ss = 0.f;
#pragma unroll
                    for (int bj = 0; bj < 2; ++bj)
#pragma unroll
                        for (int n = 0; n < 2; ++n) ss += v[bj][n][0] * v[bj][n][0] + v[bj][n][1] * v[bj][n][1] + v[bj][n][2] * v[bj][n][2] + v[bj][n][3] * v[bj][n][3];
                    ss += __shfl_xor(ss, 16); ss += __shfl_xor(ss, 32);
                    const float sc = rsqrtf(ss * (1.f / 64.f) + EPS);
#pragma unroll
                    for (int bj = 0; bj < 2; ++bj) { v[bj][0] = v[bj][0] * sc * gn[bj][0]; v[bj][1] = v[bj][1] * sc * gn[bj][1]; } }
#pragma unroll
                for (int bj = 0; bj < 2; ++bj) { u32x4 w; w.x = pk2(v[bj][0][0], v[bj][0][1]); w.y = pk2(v[bj][0][2], v[bj][0][3]); w.z = pk2(v[bj][1][0], v[bj][1][1]); w.w = pk2(v[bj][1][2], v[bj][1][3]);
                    *(u32x4*)(rowp + 32 * bj) = w; } }
    }
};
struct EpiStoreD {
    bf16_t* lat; bf16_t* g; const float* ssq; float* ssql;
    DI void prefetch(const Unit& u, int wr, int fr, float (&pre)[8]) const {
#pragma unroll
        for (int i = 0; i < 8; ++i) pre[i] = ssq[u.pm * BM + wr * 64 + fr + (i >> 2) * HALF + (i & 3) * 16]; }
    DI void operator()(const Acc& acc, const Unit& u, int wr, int wc, int fr, int fq, const float (&pre)[8]) const {
        const int row0 = u.pm * BM + wr * 64 + fr, col0 = u.pn * BM + wc * 32 + 8 * fq;
#pragma unroll
        for (int ai = 0; ai < 2; ++ai)
#pragma unroll
            for (int m = 0; m < 4; ++m) { const size_t row = (size_t)(row0 + ai * HALF + m * 16);
                const float rs = rsqrtf(pre[ai * 4 + m] * (1.f / DM) + EPS); float ss = 0.f;
#pragma unroll
                for (int bj = 0; bj < 2; ++bj) { const f32x4 v0 = acc[ai][bj][m][0] * rs, v1 = acc[ai][bj][m][1] * rs;
                    ss += v0[0] * v0[0] + v0[1] * v0[1] + v0[2] * v0[2] + v0[3] * v0[3] + v1[0] * v1[0] + v1[1] * v1[1] + v1[2] * v1[2] + v1[3] * v1[3];
                    u32x4 w; w.x = pk2(v0[0], v0[1]); w.y = pk2(v0[2], v0[3]); w.z = pk2(v1[0], v1[1]); w.w = pk2(v1[2], v1[3]);
                    const int col = col0 + bj * HALF;
                    if (col < 1088) *(u32x4*)(lat + row * 1088 + col) = w;
                    else if (col < 3136) *(u32x4*)(g + row * 2048 + (col - 1088)) = w; }
                if (u.pn < 4) { ss += __shfl_xor(ss, 16); ss += __shfl_xor(ss, 32); if (fq == 0) atomicAdd(ssql + (u.pn >> 1) * MTOK + row, ss); } }
    }
};
struct EpiStoreU {
    bf16_t* O; const float* ssql;
    DI void prefetch(const Unit& u, int wr, int fr, float (&pre)[8]) const {
        const float* sq = ssql + (u.pn >= 12 ? MTOK : 0);
#pragma unroll
        for (int i = 0; i < 8; ++i) pre[i] = sq[u.pm * BM + wr * 64 + fr + (i >> 2) * HALF + (i & 3) * 16]; }
    DI void operator()(const Acc& acc, const Unit& u, int wr, int wc, int fr, int fq, const float (&pre)[8]) const {
        const int row0 = u.pm * BM + wr * 64 + fr, col0 = u.pn * BM + wc * 32 + 8 * fq;
        const float* sq = ssql + (u.pn >= 12 ? MTOK : 0);
#pragma unroll
        for (int ai = 0; ai < 2; ++ai)
#pragma unroll
            for (int m = 0; m < 4; ++m) { bf16_t* rowp = O + (size_t)(row0 + ai * HALF + m * 16) * 7168 + col0;
                const float rs = rsqrtf(pre[ai * 4 + m] * (1.f / 512.f) + EPS);
#pragma unroll
                for (int bj = 0; bj < 2; ++bj) { const f32x4 v0 = acc[ai][bj][m][0] * rs, v1 = acc[ai][bj][m][1] * rs;
                    u32x4 w; w.x = pk2(v0[0], v0[1]); w.y = pk2(v0[2], v0[3]); w.z = pk2(v1[0], v1[1]); w.w = pk2(v1[2], v1[3]);
                    *(u32x4*)(rowp + bj * HALF) = w; } }
    }
};
template <bool INB, bool OUTF, bool OUTB, bool SSQ> struct EpiResid {
    const float* xf; const bf16_t* xb; float* of; bf16_t* ob; float* ssq;
    DI void prefetch(const Unit&, int, int, float (&pre)[8]) const {
#pragma unroll
        for (int i = 0; i < 8; ++i) pre[i] = 0.f; }
    DI void operator()(const Acc& acc, const Unit& u, int wr, int wc, int fr, int fq, const float (&pre)[8]) const {
        const int row0 = u.pm * BM + wr * 64 + fr, col0 = u.pn * BM + wc * 32 + 8 * fq;
#pragma unroll
        for (int ai = 0; ai < 2; ++ai)
#pragma unroll
            for (int m = 0; m < 4; ++m) { const int row = row0 + ai * HALF + m * 16; const size_t o = (size_t)row * DM + col0;
                float ss = 0.f;
#pragma unroll
                for (int bj = 0; bj < 2; ++bj) {
                    f32x4 x0, x1;
                    if (INB) { float f[8]; unpack8(*(const u32x4*)(xb + o + bj * HALF), f); x0 = (f32x4){f[0], f[1], f[2], f[3]}; x1 = (f32x4){f[4], f[5], f[6], f[7]}; }
                    else { x0 = *(const f32x4*)(xf + o + bj * HALF); x1 = *(const f32x4*)(xf + o + bj * HALF + 4); }
                    x0 += acc[ai][bj][m][0]; x1 += acc[ai][bj][m][1];
                    if (OUTF) { __builtin_nontemporal_store(x0, (f32x4*)(of + o + bj * HALF)); __builtin_nontemporal_store(x1, (f32x4*)(of + o + bj * HALF + 4)); }
                    if (SSQ) ss += x0[0] * x0[0] + x0[1] * x0[1] + x0[2] * x0[2] + x0[3] * x0[3] + x1[0] * x1[0] + x1[1] * x1[1] + x1[2] * x1[2] + x1[3] * x1[3];
                    if (OUTB) { u32x4 w; w.x = pk2(x0[0], x0[1]); w.y = pk2(x0[2], x0[3]); w.z = pk2(x1[0], x1[1]); w.w = pk2(x1[2], x1[3]);
                        *(u32x4*)(ob + o + bj * HALF) = w; } }
                if (SSQ) { ss += __shfl_xor(ss, 16); ss += __shfl_xor(ss, 32); if (fq == 0) atomicAdd(ssq + row, ss); } }
    }
};
struct EpiGates {
    const bf16_t* xc; const float* brg; const float* big; const float* sp8t; unsigned* ax;
    DI void prefetch(const Unit&, int, int, float (&pre)[8]) const {
#pragma unroll
        for (int i = 0; i < 8; ++i) pre[i] = 0.f; }
    DI void operator()(const Acc& acc, const Unit& u, int wr, int wc, int fr, int fq, const float (&pre)[8]) const {
        const int row0 = u.pm * BM + wr * 64 + fr, f0 = (u.pn >> 1) * 256 + (u.pn & 1) * 128 + wc * 32 + 8 * fq;
#pragma unroll
        for (int n = 0; n < 2; ++n) {
            const f32x4 br = *(const f32x4*)(brg + f0 + 4 * n), bi = *(const f32x4*)(big + f0 + 4 * n), sp = *(const f32x4*)(sp8t + f0 + 4 * n);
#pragma unroll
            for (int ai = 0; ai < 2; ++ai)
#pragma unroll
                for (int m = 0; m < 4; ++m) { const size_t o = (size_t)(row0 + ai * HALF + m * 16) * DM + f0 + 4 * n;
                    const u32x2 xw = *(const u32x2*)(xc + o);
                    const float xv[4] = {__uint_as_float(xw.x << 16), __uint_as_float(xw.x & 0xffff0000u), __uint_as_float(xw.y << 16), __uint_as_float(xw.y & 0xffff0000u)};
                    u32x4 w;
#pragma unroll
                    for (int e = 0; e < 4; ++e) { const float r = sigm(acc[ai][0][m][n][e] + br[e]), ig = sigm(acc[ai][1][m][n][e] + bi[e]);
                        const float la = -sp[e] * r, uu = -2.f * la;
                        const float om = uu * (1.f - uu * 0.5f * (1.f - uu * (1.f / 3.f) * (1.f - uu * 0.25f * (1.f - uu * 0.2f * (1.f - uu * (1.f / 6.f))))));
                        w[e] = pk2(la, sqrtf(fmaxf(om, 0.f)) * ig * xv[e]); }
                    *(u32x4*)(ax + o) = w; __builtin_amdgcn_sched_barrier(0); }
        }
    }
};
}

template <int MODE, class Epi>
DI void run_gemm(LAS unsigned char* lds, const bf16_t* A, const bf16_t* Bt, int N, int K, int lda, const Epi& E) {
    asm volatile("" : "+s"(K));
    pg8::Sched<MODE> S; S.init(MTOK, N, (int)gridDim.x, (int)blockIdx.x, lda, K);
    pg8::gemm_phase(lds, A, Bt, K, lda, S, E);
    __syncthreads();
}

DI void phase_convert(const Params& p, LAS unsigned char* lds) {
    LAS float* sm = (LAS float*)lds;
    const int tid = otid();
    for (int t = blockIdx.x; t < p.ntiles; t += gridDim.x) {
        int j = 0; while (j + 1 < p.njobs && p.jobs[j + 1].tile0 <= t) ++j;
        const float* src = p.jobs[j].src; bf16_t* dst = p.jobs[j].dst; const int K = p.jobs[j].K, N = p.jobs[j].N, ldw = p.jobs[j].ldw, ntn = p.jobs[j].ntn;
        const int tt = t - p.jobs[j].tile0, tn = tt % ntn, tk = tt / ntn, n0 = tn * 64, k0 = tk * 256;
        { const int n4 = (tid & 15) * 4, kr = tid >> 4; f32x4 v[8];
#pragma unroll
          for (int i = 0; i < 8; ++i) v[i] = (n0 + n4 < N) ? __builtin_nontemporal_load((const f32x4*)(src + (size_t)(k0 + kr + 32 * i) * ldw + n0 + n4)) : (f32x4){0.f, 0.f, 0.f, 0.f};
#pragma unroll
          for (int i = 0; i < 8; ++i) { LAS float* d = sm + (kr + 32 * i) * 65 + n4; d[0] = v[i][0]; d[1] = v[i][1]; d[2] = v[i][2]; d[3] = v[i][3]; } }
        __syncthreads();
        { const int nr = tid >> 3, kq = tid & 7;
#pragma unroll
          for (int jj = 0; jj < 4; ++jj) { const int kc = (kq + 8 * jj) * 8; float f[8];
#pragma unroll
              for (int e = 0; e < 8; ++e) f[e] = sm[(kc + e) * 65 + nr];
              if (p.jobs[j].kscale) { const float* ks = p.jobs[j].kscale + k0 + kc;
#pragma unroll
                  for (int e = 0; e < 8; ++e) f[e] *= ks[e]; }
              int nrow = n0 + nr; if (p.jobs[j].pad) { const int jl = nrow & 255; nrow = (nrow & ~255) + 128 * ((jl >> 5) & 1) + 32 * (jl >> 6) + (jl & 31); }
              if (j >= 2) __builtin_nontemporal_store(pack8(f), (u32x4*)(dst + (size_t)nrow * K + k0 + kc));
              else *(u32x4*)(dst + (size_t)nrow * K + k0 + kc) = pack8(f); } }
        __syncthreads();
    }
}

DI int t5_bucket(int rel) {
    const int n = rel < 0 ? -rel : rel; int b;
    if (n < 8) b = n; else b = 8 + (n >= 12) + (n >= 16) + (n >= 23) + (n >= 32) + (n >= 46) + (n >= 64) + (n >= 91);
    return (rel > 0 ? 16 : 0) + b;
}
DI void phase_bias_table(const Params& p) {
    float* tb = (float*)(p.ws + X_BIAS);
    float* sp8 = (float*)(p.ws + X_SP8); float* ssq = (float*)(p.ws + X_SSQ);
    for (int i = blockIdx.x * 512 + otid(); i < 5 * MTOK; i += gridDim.x * 512) ssq[i] = 0.f;
    for (int i = blockIdx.x * 512 + otid(); i < 16 * 192 + 2048; i += gridDim.x * 512) {
        if (i < 16 * 192) { const int h = i / 192, idx = i % 192; tb[i] = (p.in[2][t5_bucket(idx - 128) * 16 + h] - p.in[2][15 * 16 + h]) * LOG2E; }
        else sp8[i - 16 * 192] = 8.f * log1pf(expf(-p.in[20][i - 16 * 192]));
    }
}

DI void phase_rmsnorm(const float* x, const float* g, bf16_t* out) {
    const int tid = otid(), lane = tid & 63, gw = blockIdx.x * 8 + (tid >> 6), nw = gridDim.x * 8;
    for (int row = gw; row < MTOK; row += nw) {
        const f32x4* xr = (const f32x4*)(x + (size_t)row * DM); f32x4 v[8]; float ss = 0.f;
#pragma unroll
        for (int i = 0; i < 4; ++i) { v[2 * i] = xr[i * 128 + lane * 2]; v[2 * i + 1] = xr[i * 128 + lane * 2 + 1]; }
#pragma unroll
        for (int i = 0; i < 8; ++i) ss += v[i][0] * v[i][0] + v[i][1] * v[i][1] + v[i][2] * v[i][2] + v[i][3] * v[i][3];
        ss = wsum(ss); const float sc = rsqrtf(ss * (1.f / DM) + EPS);
#pragma unroll
        for (int i = 0; i < 4; ++i) { const int c = i * 512 + lane * 8; const f32x4 g0 = *(const f32x4*)(g + c), g1 = *(const f32x4*)(g + c + 4);
            u32x4 w; w.x = pk2(v[2 * i][0] * sc * g0[0], v[2 * i][1] * sc * g0[1]); w.y = pk2(v[2 * i][2] * sc * g0[2], v[2 * i][3] * sc * g0[3]);
            w.z = pk2(v[2 * i + 1][0] * sc * g1[0], v[2 * i + 1][1] * sc * g1[1]); w.w = pk2(v[2 * i + 1][2] * sc * g1[2], v[2 * i + 1][3] * sc * g1[3]);
            *(u32x4*)(out + (size_t)row * DM + c) = w; }
    }
}

DI void phase_qknorm_a(const Params& p) {
    bf16_t* big = (bf16_t*)(p.ws + ACT); const float* qkg = p.in[4];
    const int tid = otid(), lane = tid & 63, gw = blockIdx.x * 8 + (tid >> 6), nw = gridDim.x * 8;
    float gq[8], gk[8];
#pragma unroll
    for (int e = 0; e < 8; ++e) { gq[e] = qkg[(lane & 7) * 8 + e] * (0.125f * LOG2E); gk[e] = qkg[64 + (lane & 7) * 8 + e]; }
    for (int row = gw; row < MTOK; row += nw) {
#pragma unroll
        for (int i = 0; i < 8; ++i) {
            bf16_t* ptr = big + (size_t)row * 8192 + i * 512 + lane * 8; float f[8]; unpack8(*(const u32x4*)ptr, f);
            float ss = 0.f;
#pragma unroll
            for (int e = 0; e < 8; ++e) ss += f[e] * f[e];
            ss += __shfl_xor(ss, 1); ss += __shfl_xor(ss, 2); ss += __shfl_xor(ss, 4);
            const float sc = rsqrtf(ss * (1.f / 64.f) + EPS);
#pragma unroll
            for (int e = 0; e < 8; ++e) f[e] = f[e] * sc * (i < 4 ? gq[e] : gk[e]);
            *(u32x4*)ptr = pack8(f);
        }
    }
}

template <int DQK, int KA8, int DV, bool BIAS, bool JOINT>
DI void attn_core(LAS unsigned char* lds, const bf16_t* Qrow, const bf16_t* KpA, int ldkA, const bf16_t* KpB, int ldkB, const bf16_t* Vp, int ldv,
                  int qb, int wid, int lane, const float* qng  , f32x16 (&O)[DV / 32]) {
    constexpr int KROW = DQK * 2 + 16, VROW = DV * 2 + 64  , KC = DQK / 8, VC = DV / 8, NKC = 64 * KC, NVC = 64 * VC, NL = (NKC + NVC) / 512, STG = 64 * (KROW + VROW);
    static_assert(NKC % 512 == 0 && NVC % 512 == 0, "loader split");
    const int tid = otid(), l32 = lane & 31, hh = lane >> 5, i16 = lane & 15, tq = i16 >> 2, tp = i16 & 3, blk = (lane >> 4) & 1;
    const int q0w = qb * 256 + wid * 32, nkt = 4 * qb + 4, myc = q0w >> 6;
    bf16x8 qf[DQK / 16];
#pragma unroll
    for (int s = 0; s < DQK / 16; ++s) qf[s] = *(const bf16x8*)(Qrow + 16 * s + 8 * hh);
    if constexpr (DQK == 192) {
        if (qng) {
            float ssn = 0.f, ssr = 0.f;
#pragma unroll
            for (int s = 0; s < 12; ++s) { float f[8]; unpack8(__builtin_bit_cast(u32x4, qf[s]), f); float t = 0.f;
#pragma unroll
                for (int e = 0; e < 8; ++e) t += f[e] * f[e];
                if (s < 8) ssn += t; else ssr += t; }
            ssn += __shfl_xor(ssn, 32); ssr += __shfl_xor(ssr, 32);
            const float qs = 0.07216878364870322f * LOG2E, scn = rsqrtf(ssn * (1.f / 128.f) + EPS) * qs, scr = rsqrtf(ssr * (1.f / 64.f) + EPS) * qs;
#pragma unroll
            for (int s = 0; s < 8; ++s) { float f[8]; unpack8(__builtin_bit_cast(u32x4, qf[s]), f);
                const f32x4 g0 = *(const f32x4*)(qng + 16 * s + 8 * hh), g1 = *(const f32x4*)(qng + 16 * s + 8 * hh + 4);
#pragma unroll
                for (int e = 0; e < 4; ++e) { f[e] *= scn * g0[e]; f[4 + e] *= scn * g1[e]; }
                qf[s] = __builtin_bit_cast(bf16x8, pack8(f)); }
            const float posr = (float)(qb * 256 + wid * 32 + l32) * 0.15915494309189535f;
#pragma unroll
            for (int s = 8; s < 10; ++s) { float f1[8], f2[8]; unpack8(__builtin_bit_cast(u32x4, qf[s]), f1); unpack8(__builtin_bit_cast(u32x4, qf[s + 2]), f2);
#pragma unroll
                for (int e = 0; e < 8; ++e) { const int i = 16 * (s - 8) + 8 * hh + e;
                    const float a1 = f1[e] * scr * qng[128 + i], a2 = f2[e] * scr * qng[160 + i];
                    float rev = posr * __builtin_amdgcn_exp2f(-(float)i * 0.41524101186092029f); rev -= floorf(rev);
                    const float sn = __builtin_amdgcn_sinf(rev), cs = __builtin_amdgcn_cosf(rev);
                    f1[e] = a1 * cs - a2 * sn; f2[e] = a2 * cs + a1 * sn; }
                qf[s] = __builtin_bit_cast(bf16x8, pack8(f1)); qf[s + 2] = __builtin_bit_cast(bf16x8, pack8(f2)); }
            __builtin_amdgcn_sched_barrier(0);
        }
    }
    float m = 0.f, l = 0.f; bool mnz = false;
#pragma unroll
    for (int dt = 0; dt < DV / 32; ++dt)
#pragma unroll
        for (int i = 0; i < 16; ++i) O[dt][i] = 0.f;
    u32x4 stg[NL];
    LAS const float* btab = (LAS const float*)(lds + 2 * STG);
    const unsigned koff = l32 * KROW + 16 * hh, vtr = (4 * hh + tq) * VROW + (16 * blk + 4 * tp) * 2;

    auto gload = [&](int kt) {
#pragma unroll
        for (int i = 0; i < NL; ++i) { const int c = tid + i * 512;
            if (i * 512 < NKC) { const int row = c / KC, cc = c % KC;
                const bf16_t* src = (cc < KA8) ? KpA + (size_t)(kt * 64 + row) * ldkA + cc * 8 : KpB + (size_t)(kt * 64 + row) * ldkB + (cc - KA8) * 8;
                stg[i] = *(const u32x4*)src; }
            else { const int c2 = c - NKC, row = c2 / VC, cc = c2 % VC; stg[i] = *(const u32x4*)(Vp + (size_t)(kt * 64 + row) * ldv + cc * 8); } }
    };
    auto lstore = [&](int buf) {
#pragma unroll
        for (int i = 0; i < NL; ++i) { const int c = tid + i * 512;
            if (i * 512 < NKC) { const int row = c / KC, cc = c % KC; *(LAS u32x4*)(lds + buf * STG + row * KROW + cc * 16) = stg[i]; }
            else { const int c2 = c - NKC, row = c2 / VC, cc = c2 % VC; *(LAS u32x4*)(lds + buf * STG + 64 * KROW + row * VROW + cc * 16) = stg[i]; } }
    };

    gload(0); lstore(0); __syncthreads();
    for (int kt = 0; kt < nkt; ++kt) {
        if (kt + 1 < nkt) gload(kt + 1);
        if (JOINT && kt <= myc) {
            LAS unsigned char* kb = lds + (kt & 1) * STG; LAS unsigned char* vb = kb + 64 * KROW;
            const bool far = (kt * 64 + 63 - q0w <= -91);
            f32x16 S0, S1;
#pragma unroll
            for (int i = 0; i < 16; ++i) { S0[i] = 0.f; S1[i] = 0.f; }
#pragma unroll
            for (int s = 0; s < DQK / 16; ++s) {
                const bf16x8 k0 = *(LAS const bf16x8*)(kb + koff + 32 * s), k1 = *(LAS const bf16x8*)(kb + koff + 32 * KROW + 32 * s);
                S0 = mfma32(k0, qf[s], S0); S1 = mfma32(k1, qf[s], S1);
            }
            if (BIAS && !far) {
                const int rb = kt * 64 - (q0w + l32) + 128;
#pragma unroll
                for (int i = 0; i < 16; ++i) { const int i0 = rb + crow(i, hh); S0[i] += btab[i0 < 0 ? 0 : i0]; S1[i] += btab[i0 + 32 < 0 ? 0 : i0 + 32]; }
            }
            if (mnz) {
#pragma unroll
                for (int i = 0; i < 16; ++i) { S0[i] -= m; S1[i] -= m; }
            }
            float mx = fmaxf(S0[0], S1[0]);
#pragma unroll
            for (int i = 1; i < 16; ++i) mx = fmaxf(mx, fmaxf(S0[i], S1[i]));
            mx = fmaxf(mx, __shfl_xor(mx, 32));
            if (__any(mx > 64.f || (kt == 0 && mx < -64.f))) {
                const float dm = (mx > 64.f || (kt == 0 && mx < -64.f)) ? mx : 0.f, alpha = __builtin_amdgcn_exp2f(-dm); m += dm; mnz = true;
                l *= alpha;
#pragma unroll
                for (int dt = 0; dt < DV / 32; ++dt) O[dt] *= alpha;
#pragma unroll
                for (int i = 0; i < 16; ++i) { S0[i] -= dm; S1[i] -= dm; }
            }
            float ps = 0.f;
#pragma unroll
            for (int i = 0; i < 16; ++i) { S0[i] = __builtin_amdgcn_exp2f(S0[i]); S1[i] = __builtin_amdgcn_exp2f(S1[i]); ps += S0[i] + S1[i]; }
            l += ps;
#pragma unroll
            for (int half = 0; half < 2; ++half)
#pragma unroll
                for (int s = 0; s < 2; ++s) {
                    const f32x16& S = half ? S1 : S0;
                    u32x4 pw; pw.x = pk2(S[8 * s], S[8 * s + 1]); pw.y = pk2(S[8 * s + 2], S[8 * s + 3]); pw.z = pk2(S[8 * s + 4], S[8 * s + 5]); pw.w = pk2(S[8 * s + 6], S[8 * s + 7]);
                    const bf16x8 pf = __builtin_bit_cast(bf16x8, pw);
                    LAS unsigned char* vr = vb + vtr + (32 * half + 16 * s) * VROW;
#pragma unroll
                    for (int dt = 0; dt < DV / 32; ++dt) {
                        const bf16x8 vf = cat4(trread(vr + 64 * dt), trread(vr + 8 * VROW + 64 * dt));
                        O[dt] = mfma32(vf, pf, O[dt]);
                    }
                }
        }
        if (!JOINT && kt <= myc) {
            LAS unsigned char* kb = lds + (kt & 1) * STG; LAS unsigned char* vb = kb + 64 * KROW;
            const bool far = (kt * 64 + 63 - q0w <= -91);
#pragma unroll 1
            for (int half = 0; half < 2; ++half) {
                f32x16 S;
#pragma unroll
                for (int i = 0; i < 16; ++i) S[i] = 0.f;
#pragma unroll
                for (int s = 0; s < DQK / 16; ++s) {
                    const bf16x8 kf = *(LAS const bf16x8*)(kb + koff + 32 * half * KROW + 32 * s);
                    S = mfma32(kf, qf[s], S);
                }
                if (BIAS && !far) {
                    const int rb = kt * 64 + 32 * half - (q0w + l32) + 128;
#pragma unroll
                    for (int i = 0; i < 16; ++i) { const int i0 = rb + crow(i, hh); S[i] += btab[i0 < 0 ? 0 : i0]; }
                }
                if (mnz) {
#pragma unroll
                    for (int i = 0; i < 16; ++i) S[i] -= m;
                }
                float mx = S[0];
#pragma unroll
                for (int i = 1; i < 16; ++i) mx = fmaxf(mx, S[i]);
                mx = fmaxf(mx, __shfl_xor(mx, 32));
                const bool first = (kt == 0 && half == 0);
                if (__any(mx > 64.f || (first && mx < -64.f))) {
                    const float dm = (mx > 64.f || (first && mx < -64.f)) ? mx : 0.f, alpha = __builtin_amdgcn_exp2f(-dm); m += dm; mnz = true;
                    l *= alpha;
#pragma unroll
                    for (int dt = 0; dt < DV / 32; ++dt) O[dt] *= alpha;
#pragma unroll
                    for (int i = 0; i < 16; ++i) S[i] -= dm;
                }
                float ps = 0.f;
#pragma unroll
                for (int i = 0; i < 16; ++i) { S[i] = __builtin_amdgcn_exp2f(S[i]); ps += S[i]; }
                l += ps;
#pragma unroll
                for (int s = 0; s < 2; ++s) {
                    u32x4 pw; pw.x = pk2(S[8 * s], S[8 * s + 1]); pw.y = pk2(S[8 * s + 2], S[8 * s + 3]); pw.z = pk2(S[8 * s + 4], S[8 * s + 5]); pw.w = pk2(S[8 * s + 6], S[8 * s + 7]);
                    const bf16x8 pf = __builtin_bit_cast(bf16x8, pw);
                    LAS unsigned char* vr = vb + vtr + (32 * half + 16 * s) * VROW;
#pragma unroll
                    for (int dt = 0; dt < DV / 32; ++dt) {
                        const bf16x8 vf = cat4(trread(vr + 64 * dt), trread(vr + 8 * VROW + 64 * dt));
                        O[dt] = mfma32(vf, pf, O[dt]);
                    }
                }
            }
        }
        if (kt + 1 < nkt) lstore((kt + 1) & 1);
        __syncthreads();
    }
    l += __shfl_xor(l, 32);
    const float il = 1.f / l;
#pragma unroll
    for (int dt = 0; dt < DV / 32; ++dt) O[dt] *= il;
}

DI void phase_attn_a(const Params& p, LAS unsigned char* lds) {
    const bf16_t* big = (const bf16_t*)(p.ws + ACT); bf16_t* y = (bf16_t*)(p.ws + HBUF); const float* tbg = (const float*)(p.ws + X_BIAS);
    const int tid = otid(), wid = tid >> 6, lane = tid & 63, l32 = lane & 31, hh = lane >> 5;
    constexpr int STG = 64 * (64 * 2 + 16 + 128 * 2 + 64);
    float d0 = 0.f, d1 = 0.f;
    for (int i = 0; i < 64; ++i) { d0 += p.in[5][i] * p.in[5][64 + i]; d1 += p.in[5][128 + i] * p.in[5][192 + i]; }
    const float lam_init = 0.2f, lam = __expf(d0) - __expf(d1) + lam_init;
    for (int pr = blockIdx.x; pr < 512; pr += gridDim.x) {
        const int bi = pr & 255, bh = (gridDim.x == 256) ? (bi & 7) + 8 * (bi >> 6) + 32 * (pr >> 8) : pr >> 3, j = (gridDim.x == 256) ? (bi >> 3) & 7 : pr & 7, b = bh >> 4, h = bh & 15;
        for (int half = 0; half < 2; ++half) {
            const int qb = half ? 15 - j : j;
            __syncthreads();
            if (tid < 192) ((LAS float*)(lds + 2 * STG))[tid] = tbg[h * 192 + tid];
            const size_t tok0 = (size_t)b * SEQ, tokq = tok0 + qb * 256 + wid * 32 + l32;
            f32x16 Oa[4]; LAS unsigned* Op = (LAS unsigned*)(lds + 2 * STG + 1024) + wid * 2048 + lane;
            attn_core<64, 8, 128, true, true>(lds, big + tokq * 8192 + h * 128, big + tok0 * 8192 + 2048 + h * 128, 8192, nullptr, 0, big + tok0 * 8192 + 4096 + h * 128, 8192, qb, wid, lane, nullptr, Oa);
#pragma unroll
            for (int dt = 0; dt < 4; ++dt)
#pragma unroll
                for (int i = 0; i < 8; ++i) Op[(dt * 8 + i) * 64] = pk2(Oa[dt][2 * i], Oa[dt][2 * i + 1]);
            attn_core<64, 8, 128, true, true>(lds, big + tokq * 8192 + h * 128 + 64, big + tok0 * 8192 + 2048 + h * 128 + 64, 8192, nullptr, 0, big + tok0 * 8192 + 4096 + h * 128, 8192, qb, wid, lane, nullptr, Oa);
            float ss = 0.f;
#pragma unroll
            for (int dt = 0; dt < 4; ++dt)
#pragma unroll
                for (int i = 0; i < 16; ++i) { const unsigned ow = Op[(dt * 8 + (i >> 1)) * 64]; const float o0 = (i & 1) ? __uint_as_float(ow & 0xffff0000u) : __uint_as_float(ow << 16);
                    const float o = o0 - lam * Oa[dt][i]; Oa[dt][i] = o; ss += o * o; }
            ss += __shfl_xor(ss, 32);
            const float sc = rsqrtf(ss * (1.f / 128.f) + EPS) * (1.f - lam_init);
#pragma unroll
            for (int dt = 0; dt < 4; ++dt)
#pragma unroll
                for (int g4 = 0; g4 < 4; ++g4) { const int dv = 32 * dt + 8 * g4 + 4 * hh;
                    const u32x2 gw = *(const u32x2*)(big + tokq * 8192 + 6144 + h * 128 + dv);
                    const f32x4 sg = *(const f32x4*)(p.in[6] + dv);
                    const float g0 = __uint_as_float(gw.x << 16), g1 = __uint_as_float(gw.x & 0xffff0000u), g2 = __uint_as_float(gw.y << 16), g3 = __uint_as_float(gw.y & 0xffff0000u);
                    u32x2 w; w.x = pk2(Oa[dt][4 * g4] * sc * sg[0] * silu(g0), Oa[dt][4 * g4 + 1] * sc * sg[1] * silu(g1));
                    w.y = pk2(Oa[dt][4 * g4 + 2] * sc * sg[2] * silu(g2), Oa[dt][4 * g4 + 3] * sc * sg[3] * silu(g3));
                    *(u32x2*)(y + tokq * DM + h * 128 + dv) = w; }
        }
    }
}

DI void phase_attn_d(const Params& p, LAS unsigned char* lds) {
    const bf16_t* qkv = (const bf16_t*)(p.ws + ACT); const bf16_t* lat = (const bf16_t*)(p.ws + LAT); const bf16_t* gb = (const bf16_t*)(p.ws + HBUF);
    bf16_t* y = (bf16_t*)(p.ws + HBUF);
    for (int pr = blockIdx.x; pr < 512; pr += gridDim.x) {
        const int bi = pr & 255, bh = (gridDim.x == 256) ? (bi & 7) + 8 * (bi >> 6) + 32 * (pr >> 8) : pr >> 3, j = (gridDim.x == 256) ? (bi >> 3) & 7 : pr & 7, b = bh >> 4, h = bh & 15;
        for (int half = 0; half < 2; ++half) {
            const int qb = half ? 15 - j : j;
            __syncthreads();
            const int tid = otid(), wid = tid >> 6, lane = tid & 63, l32 = lane & 31;
            const size_t tok0 = (size_t)b * SEQ, tokq = tok0 + qb * 256 + wid * 32 + l32;
            f32x16 O[4];
            attn_core<192, 16, 128, false, true>(lds, qkv + tokq * 7168 + h * 192, qkv + tok0 * 7168 + 3072 + h * 256, 7168, lat + tok0 * 1088 + 1024, 1088,
                                           qkv + tok0 * 7168 + 3072 + h * 256 + 128, 7168, qb, wid, lane, p.in[27], O);
            const int tid2 = otid(), wid2 = tid2 >> 6, lane2 = tid2 & 63;
            const size_t tokq2 = (size_t)b * SEQ + qb * 256 + wid2 * 32 + (lane2 & 31); const int hh2 = lane2 >> 5;
#pragma unroll
            for (int dt = 0; dt < 4; ++dt)
#pragma unroll
                for (int g4 = 0; g4 < 4; ++g4) { const int dv = 32 * dt + 8 * g4 + 4 * hh2;
                    const u32x2 gw = *(const u32x2*)(gb + tokq2 * DM + h * 128 + dv);
                    const float g0 = __uint_as_float(gw.x << 16), g1 = __uint_as_float(gw.x & 0xffff0000u), g2 = __uint_as_float(gw.y << 16), g3 = __uint_as_float(gw.y & 0xffff0000u);
                    u32x2 w; w.x = pk2(O[dt][4 * g4] * silu(g0), O[dt][4 * g4 + 1] * silu(g1)); w.y = pk2(O[dt][4 * g4 + 2] * silu(g2), O[dt][4 * g4 + 3] * silu(g3));
                    *(u32x2*)(y + tokq2 * DM + h * 128 + dv) = w; }
        }
    }
}

DI void phase_gla_prep(const Params& p, LAS unsigned char* lds) {
    bf16_t* big = (bf16_t*)(p.ws + ACT); float* total = (float*)(p.ws + GLA_TOT);
    LAS float* lrs = (LAS float*)lds;
    const int tid = otid(), ch0 = tid * 2;
    float wg0[16], wg1[16];
#pragma unroll
    for (int r = 0; r < 16; ++r) { wg0[r] = p.in[9][r * 1024 + ch0]; wg1[r] = p.in[9][r * 1024 + ch0 + 1]; }
    const float bs0 = p.in[10][ch0], bs1 = p.in[10][ch0 + 1];
    for (int u = blockIdx.x; u < 256; u += gridDim.x) {
        const size_t tokb = (size_t)u * 64;
        __syncthreads();
        {
            LAS bf16_t* wl = (LAS bf16_t*)(lds + 8192);
            LAS float* part = (LAS float*)(lds + 4096);
            const bf16_t* wsrc = (const bf16_t*)(p.ws + W_B_IN) + (size_t)6144 * 2048;
#pragma unroll
            for (int i = 0; i < 8; ++i) { const int c = tid + i * 512; *(LAS u32x4*)(wl + (c >> 8) * 2056 + (c & 255) * 8) = *(const u32x4*)(wsrc + (size_t)c * 8); }
            __syncthreads();
            const int w = tid >> 6, lane = tid & 63, i16 = lane & 15, quad = lane >> 4, mt = w & 3, kh = w >> 2;
            const bf16_t* xr = (const bf16_t*)(p.ws + XG) + (tokb + 16 * mt + i16) * DM + kh * 1024 + 8 * quad;
            f32x4 acc = {0.f, 0.f, 0.f, 0.f};
#pragma unroll 8
            for (int ks = 0; ks < 32; ++ks) {
                const bf16x8 a = *(const bf16x8*)(xr + 32 * ks);
                const bf16x8 bb = *(LAS const bf16x8*)(wl + i16 * 2056 + kh * 1024 + 32 * ks + 8 * quad);
                acc = __builtin_amdgcn_mfma_f32_16x16x32_bf16(a, bb, acc, 0, 0, 0);
            }
            if (kh == 1) {
#pragma unroll
                for (int j = 0; j < 4; ++j) part[(16 * mt + 4 * quad + j) * 16 + i16] = acc[j]; }
            __syncthreads();
            if (kh == 0) {
#pragma unroll
                for (int j = 0; j < 4; ++j) { const int tok = 16 * mt + 4 * quad + j;
                    const float rs = rsqrtf(((const float*)(p.ws + X_SSQ))[tokb + tok] * (1.f / DM) + EPS);
                    lrs[tok * 16 + i16] = (acc[j] + part[tok * 16 + i16]) * rs; } }
        }
        __syncthreads();
        float t0 = 0.f, t1 = 0.f;
        for (int tok = 63; tok >= 0; --tok) {
            float z0 = bs0, z1 = bs1;
#pragma unroll
            for (int r = 0; r < 16; ++r) { const float lv = lrs[tok * 16 + r]; z0 += lv * wg0[r]; z1 += lv * wg1[r]; }
            unsigned* kp = (unsigned*)(big + (tokb + tok) * 6400 + 1024 + ch0); const unsigned w = *kp;
            *kp = pk2(__uint_as_float(w << 16) * __expf(t0), __uint_as_float(w & 0xffff0000u) * __expf(t1));
            t0 += (fminf(z0, 0.f) - __logf(1.f + __expf(-fabsf(z0)))) * (1.f / 16.f); t1 += (fminf(z1, 0.f) - __logf(1.f + __expf(-fabsf(z1)))) * (1.f / 16.f);
        }
        total[(size_t)u * 1024 + ch0] = t0; total[(size_t)u * 1024 + ch0 + 1] = t1;
    }
}

DI void phase_gla_scan(const Params& p, LAS unsigned char* lds) {
    const bf16_t* big = (const bf16_t*)(p.ws + ACT); const float* total = (const float*)(p.ws + GLA_TOT); bf16_t* ob = (bf16_t*)(p.ws + HBUF);
    constexpr int KR = 576, VR = 64, SR = 528, SET = 64 * KR + 64 * VR + 1024  , ST_OFF = 2 * SET, STB = 32 * SR;
    const int tid = otid(), w = tid >> 6, lane = tid & 63, l32 = lane & 31, hh = lane >> 5, i16 = lane & 15, tq = i16 >> 2, tp = i16 & 3, blk = (lane >> 4) & 1, quad = lane >> 4;
    const int mt = w >> 1, nt = w & 1;
    for (int u = blockIdx.x; u < 256; u += gridDim.x) {
        const int ux = (gridDim.x == 256) ? ((u & 7) * 2 + (u >> 7)) * 16 + ((u >> 3) & 15) : u;
        const int b = ux >> 6, h = (ux >> 4) & 3, vs = ux & 15;
        const size_t tok0 = (size_t)b * SEQ;
        f32x16 st;
#pragma unroll
        for (int i = 0; i < 16; ++i) st[i] = 0.f;
        u32x4 rkA[4], rvA, rkB[4], rvB; float rtA = 0.f, rtB = 0.f; bf16x8 qa[8], qn[8];
        rvA = (u32x4){0u, 0u, 0u, 0u}; rvB = rvA;
        unsigned offk[4];
#pragma unroll
        for (int i = 0; i < 4; ++i) { const int idx = tid + i * 512, row = idx >> 5, cc = idx & 31; offk[i] = (unsigned)((row * 6400 + 1024 + h * 256 + cc * 8) * 2); }
        const unsigned offv = (unsigned)(((tid >> 2) * 6400 + 2048 + h * 512 + vs * 32 + (tid & 3) * 8) * 2);
        const unsigned offq = (unsigned)(((16 * mt + i16) * 6400 + h * 256 + 8 * quad) * 2);
        auto gload = [&](int c, u32x4 (&rk)[4], u32x4& rv, float& rt) {
            const char* cb = (const char*)(big + (tok0 + (size_t)c * 64) * 6400);
#pragma unroll
            for (int i = 0; i < 4; ++i) rk[i] = *(const u32x4*)(cb + offk[i]);
            if (tid < 256) { rv = *(const u32x4*)(cb + offv); rt = total[(size_t)(b * 64 + c) * 1024 + h * 256 + tid]; }
        };
        auto lstore = [&](int buf, const u32x4 (&rk)[4], const u32x4& rv, const float& rt) {
            LAS unsigned char* sb = lds + buf * SET;
#pragma unroll
            for (int i = 0; i < 4; ++i) { const int idx = tid + i * 512, row = idx >> 5, cc = idx & 31; *(LAS u32x4*)(sb + row * KR + cc * 16) = rk[i]; }
            if (tid < 256) { const int row = tid >> 2, cc = tid & 3; *(LAS u32x4*)(sb + 64 * KR + row * VR + cc * 16) = rv; ((LAS float*)(sb + 64 * KR + 64 * VR))[tid] = __expf(rt); }
        };
        auto qload = [&](int c, bf16x8 (&q)[8]) {
            const char* cb = (const char*)(big + (tok0 + (size_t)c * 64) * 6400) + offq;
#pragma unroll
            for (int ks = 0; ks < 8; ++ks) q[ks] = *(const bf16x8*)(cb + 64 * ks);
        };
        auto step = [&](int c, const bf16x8 (&qc)[8]) {
            LAS unsigned char* sb = lds + (c & 1) * SET; LAS unsigned char* stb = lds + ST_OFF + (c & 1) * STB;
#pragma unroll
            for (int g = 0; g < 4; ++g) { const f32x4 e = *(LAS const f32x4*)(sb + 64 * KR + 64 * VR + (32 * w + 8 * g + 4 * hh) * 4);
                st[4 * g] *= e[0]; st[4 * g + 1] *= e[1]; st[4 * g + 2] *= e[2]; st[4 * g + 3] *= e[3]; }
#pragma unroll
            for (int sx = 0; sx < 4; ++sx) {
                LAS unsigned char* ka = sb + (16 * sx + 8 * hh + tq) * KR + (32 * w + 16 * blk + 4 * tp) * 2;
                LAS unsigned char* va = sb + 64 * KR + (16 * sx + 8 * hh + tq) * VR + (16 * blk + 4 * tp) * 2;
                const bf16x8 af = cat4(trread(ka), trread(ka + 4 * KR)), bfv = cat4(trread(va), trread(va + 4 * VR));
                st = mfma32(af, bfv, st);
            }
#pragma unroll
            for (int g = 0; g < 4; ++g) { u32x2 wv; wv.x = pk2(st[4 * g], st[4 * g + 1]); wv.y = pk2(st[4 * g + 2], st[4 * g + 3]);
                *(LAS u32x2*)(stb + l32 * SR + (32 * w + 8 * g + 4 * hh) * 2) = wv; }
            asm volatile("s_waitcnt lgkmcnt(0)" ::: "memory");
            __builtin_amdgcn_s_barrier();
            asm volatile("" ::: "memory");
            f32x4 acc = {0.f, 0.f, 0.f, 0.f};
#pragma unroll
            for (int ks = 0; ks < 8; ++ks) {
                const bf16x8 bb = *(LAS const bf16x8*)(stb + (16 * nt + i16) * SR + (32 * ks + 8 * quad) * 2);
                acc = __builtin_amdgcn_mfma_f32_16x16x32_bf16(qc[ks], bb, acc, 0, 0, 0);
            }
#pragma unroll
            for (int jj = 0; jj < 4; ++jj) ob[(tok0 + c * 64 + 16 * mt + quad * 4 + jj) * DM + h * 512 + vs * 32 + 16 * nt + i16] = f2bf(acc[jj] * (1.f / 16.f));
        };
        __syncthreads();
        gload(0, rkA, rvA, rtA); lstore(0, rkA, rvA, rtA);
        gload(1, rkA, rvA, rtA); gload(2, rkB, rvB, rtB); qload(0, qa); qload(1, qn);
        __syncthreads();
        for (int c = 0; c < 64; c += 2) {
            lstore((c + 1) & 1, rkA, rvA, rtA);
            if (c + 3 < 64) gload(c + 3, rkA, rvA, rtA);
            step(c, qa);
            if (c + 2 < 64) qload(c + 2, qa);
            if (c + 2 < 64) lstore(c & 1, rkB, rvB, rtB);
            if (c + 4 < 64) gload(c + 4, rkB, rvB, rtB);
            step(c + 1, qn);
            if (c + 3 < 64) qload(c + 3, qn);
        }
    }
}

DI void phase_gla_post(const Params& p) {
    const bf16_t* big = (const bf16_t*)(p.ws + ACT); bf16_t* y = (bf16_t*)(p.ws + HBUF);
    const int tid = otid(), lane = tid & 63, gw = blockIdx.x * 8 + (tid >> 6), nw = gridDim.x * 8;
    float og[8];
#pragma unroll
    for (int e = 0; e < 8; ++e) og[e] = p.in[11][lane * 8 + e];
    for (int row = gw; row < MTOK; row += nw) {
#pragma unroll
        for (int hd = 0; hd < 4; ++hd) {
            bf16_t* ptr = y + (size_t)row * DM + hd * 512 + lane * 8; float f[8], g[8]; unpack8(*(const u32x4*)ptr, f);
            unpack8(*(const u32x4*)(big + (size_t)row * 6400 + 4096 + hd * 512 + lane * 8), g);
            float ss = 0.f;
#pragma unroll
            for (int e = 0; e < 8; ++e) ss += f[e] * f[e];
            ss = wsum(ss); const float sc = rsqrtf(ss * (1.f / 512.f) + EPS);
#pragma unroll
            for (int e = 0; e < 8; ++e) f[e] = f[e] * sc * og[e] * silu(g[e]);
            *(u32x4*)ptr = pack8(f);
        }
    }
}

DI void phase_conv(const Params& p) {
    const bf16_t* big = (const bf16_t*)(p.ws + ACT); bf16_t* xc = (bf16_t*)(p.ws + HBUF);
    for (size_t idx = (size_t)blockIdx.x * 512 + otid(); idx < (size_t)(MTOK / 8) * 256; idx += (size_t)gridDim.x * 512) {
        const int tok0 = (int)(idx >> 8) * 8, ch = (int)(idx & 255) * 8, t0 = tok0 & (SEQ - 1);
        float wv[4][8], bs[8];
        { const f32x4 b0 = *(const f32x4*)(p.in[15] + ch), b1 = *(const f32x4*)(p.in[15] + ch + 4);
#pragma unroll
          for (int e = 0; e < 4; ++e) { bs[e] = b0[e]; bs[4 + e] = b1[e]; } }
#pragma unroll
        for (int jx = 0; jx < 4; ++jx) { const f32x4 w0 = *(const f32x4*)(p.in[14] + jx * 2048 + ch), w1 = *(const f32x4*)(p.in[14] + jx * 2048 + ch + 4);
#pragma unroll
            for (int e = 0; e < 4; ++e) { wv[jx][e] = w0[e]; wv[jx][4 + e] = w1[e]; } }
        u32x4 raw[11];
#pragma unroll
        for (int r = 0; r < 11; ++r) raw[r] = (r >= 3 || t0 > 0) ? *(const u32x4*)(big + (size_t)(tok0 - 3 + r) * 4096 + ch) : (u32x4){0u, 0u, 0u, 0u};
#pragma unroll
        for (int o = 0; o < 8; ++o) {
            float acc[8];
#pragma unroll
            for (int e = 0; e < 8; ++e) acc[e] = bs[e];
#pragma unroll
            for (int jx = 0; jx < 4; ++jx) { float f[8]; unpack8(raw[o + jx], f);
#pragma unroll
                for (int e = 0; e < 8; ++e) acc[e] += f[e] * wv[jx][e]; }
            *(u32x4*)(xc + (size_t)(tok0 + o) * DM + ch) = pack8(acc);
        }
    }
}
DI void phase_lru_scan(const Params& p, LAS unsigned char* lds) {
    const unsigned* ax = (const unsigned*)(p.ws + ACT + 128 * MiB); const bf16_t* big = (const bf16_t*)(p.ws + ACT);
    bf16_t* y = (bf16_t*)(p.ws + HBUF);
    LAS unsigned* tile = (LAS unsigned*)lds;
    LAS float* sP = (LAS float*)(lds + 65536); LAS float* sH = sP + 512; LAS float* sC = sH + 512;
    const int tid = otid(), seg = tid >> 5, chl = tid & 31;
    for (int u = blockIdx.x; u < 256; u += gridDim.x) {
        const int b = u >> 6, ch = (u & 63) * 32 + chl;
        const size_t rowbase = (size_t)b * SEQ;
        unsigned pre[32];
#pragma unroll
        for (int i = 0; i < 32; ++i) pre[i] = ax[(rowbase + seg + 16 * i) * DM + ch];
        __syncthreads();
        if (tid < 32) sC[tid] = 0.f;
        for (int sc = 0; sc < 8; ++sc) {
#pragma unroll
            for (int i = 0; i < 32; ++i) tile[(seg + 16 * i) * 32 + chl] = pre[i];
            __syncthreads();
            if (sc + 1 < 8) {
#pragma unroll
                for (int i = 0; i < 32; ++i) pre[i] = ax[(rowbase + (sc + 1) * 512 + seg + 16 * i) * DM + ch];
            }
            float L = 0.f, H = 0.f;
#pragma unroll 8
            for (int t = 0; t < 32; ++t) { const unsigned w = tile[(seg * 32 + t) * 32 + chl]; const float la = __uint_as_float(w << 16); H = __expf(la) * H + __uint_as_float(w & 0xffff0000u); L += la; }
            sP[tid] = __expf(L); sH[tid] = H;
            __syncthreads();
            float hc = sC[chl];
            for (int sg = 0; sg < seg; ++sg) hc = sP[sg * 32 + chl] * hc + sH[sg * 32 + chl];
            const size_t r0 = rowbase + sc * 512 + seg * 32;
#pragma unroll 8
            for (int t = 0; t < 32; ++t) { const unsigned w = tile[(seg * 32 + t) * 32 + chl]; hc = __expf(__uint_as_float(w << 16)) * hc + __uint_as_float(w & 0xffff0000u);
                y[(r0 + t) * DM + ch] = f2bf(hc * silu(bf2f(big[(r0 + t) * 4096 + 2048 + ch]))); }
            __syncthreads();
            if (seg == 15) sC[chl] = hc;
        }
    }
}

DI void phase_mla_lat(const Params& p) {
    bf16_t* lat = (bf16_t*)(p.ws + LAT);
    const int tid = otid(), lane = tid & 63, gw = blockIdx.x * 8 + (tid >> 6), nw = gridDim.x * 8;
    float gq[8], gk[8];
#pragma unroll
    for (int e = 0; e < 8; ++e) { gq[e] = p.in[23][lane * 8 + e]; gk[e] = p.in[24][lane * 8 + e]; }
    const float inv = powf(10000.f, -(float)(lane & 31) * (1.f / 32.f));
    const float g1 = p.in[27][192 + 128 + (lane & 31)], g2 = p.in[27][192 + 160 + (lane & 31)];
    for (int row = gw; row < MTOK; row += nw) {
#pragma unroll
        for (int part = 0; part < 2; ++part) {
            bf16_t* ptr = lat + (size_t)row * 1088 + part * 512 + lane * 8; float f[8]; unpack8(*(const u32x4*)ptr, f);
            float ss = 0.f;
#pragma unroll
            for (int e = 0; e < 8; ++e) ss += f[e] * f[e];
            ss = wsum(ss); const float sc = rsqrtf(ss * (1.f / 512.f) + EPS);
#pragma unroll
            for (int e = 0; e < 8; ++e) f[e] = f[e] * sc * (part ? gk[e] : gq[e]);
            *(u32x4*)ptr = pack8(f);
        }
        { bf16_t* kp = lat + (size_t)row * 1088 + 1024; const int i = lane & 31;
          const float x1 = bf2f(kp[i]), x2 = bf2f(kp[i + 32]);
          float ss = (lane < 32) ? x1 * x1 + x2 * x2 : 0.f; ss = wsum(ss); const float sc = rsqrtf(ss * (1.f / 64.f) + EPS);
          const float a1 = x1 * sc * g1, a2 = x2 * sc * g2; float sn, cs; sincosf((float)(row & (SEQ - 1)) * inv, &sn, &cs);
          if (lane < 32) { kp[i] = f2bf(a1 * cs - a2 * sn); kp[i + 32] = f2bf(a2 * cs + a1 * sn); } }
    }
}
DI void phase_mla_qk(const Params& p) {
    bf16_t* qkv = (bf16_t*)(p.ws + ACT); bf16_t* lat = (bf16_t*)(p.ws + LAT); const float* qkg = p.in[27];
    const int tid = otid(), lane = tid & 63, gw = blockIdx.x * 8 + (tid >> 6), nw = gridDim.x * 8;
    const int l16 = lane & 15, l8 = lane & 7;
    float gk[8], gkr[8];
#pragma unroll
    for (int e = 0; e < 8; ++e) { gk[e] = qkg[192 + l16 * 8 + e]; gkr[e] = qkg[192 + 128 + l8 * 8 + e]; }
    float inv[8];
#pragma unroll
    for (int e = 0; e < 8; ++e) inv[e] = powf(10000.f, -(float)((l8 & 3) * 8 + e) * (1.f / 32.f));
    for (int row = gw; row < MTOK; row += nw) {
        bf16_t* qr = qkv + (size_t)row * 7168; bf16_t* kpp = lat + (size_t)row * 1088 + 1024 + l8 * 8;
        u32x4 wk[4];
#pragma unroll
        for (int i = 0; i < 4; ++i) { const int head = 4 * i + (lane >> 4); wk[i] = *(const u32x4*)(qr + 3072 + head * 256 + l16 * 8); }
        const u32x4 wp = *(const u32x4*)kpp;
        const float pos = (float)(row & (SEQ - 1));
#pragma unroll
        for (int i = 0; i < 4; ++i) {
            const int head = 4 * i + (lane >> 4);
            float f[8]; unpack8(wk[i], f); float ss = 0.f;
#pragma unroll
            for (int e = 0; e < 8; ++e) ss += f[e] * f[e];
            ss += __shfl_xor(ss, 1); ss += __shfl_xor(ss, 2); ss += __shfl_xor(ss, 4); ss += __shfl_xor(ss, 8);
            const float sc = rsqrtf(ss * (1.f / 128.f) + EPS);
#pragma unroll
            for (int e = 0; e < 8; ++e) f[e] *= sc * gk[e];
            *(u32x4*)(qr + 3072 + head * 256 + l16 * 8) = pack8(f);
        }
        { float f[8], o[8]; unpack8(wp, f); float ss = 0.f;
#pragma unroll
          for (int e = 0; e < 8; ++e) ss += f[e] * f[e];
          ss += __shfl_xor(ss, 1); ss += __shfl_xor(ss, 2); ss += __shfl_xor(ss, 4);
          const float sc = rsqrtf(ss * (1.f / 64.f) + EPS);
#pragma unroll
          for (int e = 0; e < 8; ++e) {
              const float a = f[e] * sc * gkr[e], pa = __shfl_xor(a, 4);
              float sn, cs; sincosf(pos * inv[e], &sn, &cs);
              o[e] = (l8 < 4) ? a * cs - pa * sn : a * cs + pa * sn;
          }
          if (lane < 8) *(u32x4*)kpp = pack8(o); }
    }
}

#define XB_TMO      128
#define XB_XCNT(j)  (256  + 64 * (j))
#define XB_XSUB(j)  (1280 + 64 * (j))
#define XB_XGEN(j)  (2304 + 64 * (j))
#define XB_TOP      3328
#define XB_TOPGEN   3392
#define XCD_BAR_WORDS 3456
#define XB_SPIN_CAP (1u << 22)
DI unsigned xb_ld(unsigned* p)              { return __hip_atomic_load(p, __ATOMIC_RELAXED, __HIP_MEMORY_SCOPE_AGENT); }
DI unsigned xb_add(unsigned* p, unsigned v) { return __hip_atomic_fetch_add(p, v, __ATOMIC_RELAXED, __HIP_MEMORY_SCOPE_AGENT); }
DI unsigned xb_xcc_id() { return (unsigned)__builtin_amdgcn_s_getreg((3 << 11) | 20) & 0xFu; }
#define XB_SPIN(cond, bar) do { unsigned _sp = 0; while (cond) { __builtin_amdgcn_s_sleep(1); \
    if ((++_sp & 255u) == 0u) { if (xb_ld(&(bar)[XB_TMO])) break; if (_sp > XB_SPIN_CAP) { atomicAdd(&(bar)[XB_TMO], 1u); break; } } } } while (0)
struct XcdBarrier { unsigned* bar; unsigned x; volatile LAS unsigned* st; };
DI XcdBarrier xcd_barrier_post(unsigned* bar, volatile LAS unsigned* st) {
    XcdBarrier b; b.bar = bar; b.x = xb_xcc_id(); b.st = st;
    if (threadIdx.x == 0) (void)xb_add(&bar[XB_XCNT(b.x)], 1u);
    return b;
}
DI void xcd_barrier_complete(unsigned* bar, unsigned x, unsigned& nloc, unsigned& nx) {
    const unsigned G = gridDim.x * gridDim.y * gridDim.z;
    unsigned sum, cnt, mine, sp = 0u;
    for (;;) {
        sum = 0u; cnt = 0u; mine = 0u;
#pragma unroll
        for (unsigned j = 0; j < 16; ++j) { const unsigned c = xb_ld(&bar[XB_XCNT(j)]); sum += c; cnt += (c > 0u) ? 1u : 0u; mine = (j == x) ? c : mine; }
        if (sum == G) break;
        __builtin_amdgcn_s_sleep(1);
        if ((++sp & 255u) == 0u) { if (xb_ld(&bar[XB_TMO])) break; if (sp > XB_SPIN_CAP) { atomicAdd(&bar[XB_TMO], 1u); break; } }
    }
    nloc = mine > 0u ? mine : 1u; nx = cnt > 0u ? cnt : 1u;
}
DI void xcd_barrier(const XcdBarrier& b0) {
    asm volatile("s_waitcnt vmcnt(0)" ::: "memory");
    __syncthreads();
    if (otid() == 0) {
        XcdBarrier b; b.bar = b0.bar; b.st = b0.st; b.x = xb_xcc_id();
        unsigned* bar = b.bar;
        __builtin_amdgcn_s_waitcnt(0);
        unsigned nloc = b.st[0], nx = b.st[1];
        if (nloc == 0u) { xcd_barrier_complete(bar, b.x, nloc, nx); b.st[0] = nloc; b.st[1] = nx; }
        const unsigned old = xb_add(&bar[XB_XSUB(b.x)], 1u);
        const unsigned gen = old / nloc;
        if (old + 1u == (gen + 1u) * nloc) {
            __builtin_amdgcn_fence(__ATOMIC_RELEASE, "agent");
            asm volatile("s_waitcnt vmcnt(0)" ::: "memory");
            const unsigned og = xb_add(&bar[XB_TOP], 1u);
            const unsigned tg = og / nx;
            if (og + 1u == (tg + 1u) * nx) xb_add(&bar[XB_TOPGEN], 1u);
            else XB_SPIN(xb_ld(&bar[XB_TOPGEN]) == tg, bar);
            __builtin_amdgcn_fence(__ATOMIC_ACQUIRE, "agent");
            xb_add(&bar[XB_XGEN(b.x)], 1u);
            asm volatile("s_waitcnt vmcnt(0)" ::: "memory");
        } else {
            XB_SPIN(xb_ld(&bar[XB_XGEN(b.x)]) == gen, bar);
            __builtin_amdgcn_fence(__ATOMIC_ACQUIRE, "agent");
            asm volatile("s_waitcnt vmcnt(0)" ::: "memory");
        }
    }
    __syncthreads();
}

__global__ __launch_bounds__(512, 2) void mega(const Params p) {
    extern __shared__ __attribute__((aligned(16))) unsigned char shm[];
    LAS unsigned char* lds = (LAS unsigned char*)shm;
    cg::grid_group grid = cg::this_grid();
    volatile LAS unsigned* bst = (volatile LAS unsigned*)(lds + 131072 + 1024);
    if (threadIdx.x == 0) { bst[0] = 0u; bst[1] = 0u; }
    __syncthreads();
    XcdBarrier xb = xcd_barrier_post((unsigned*)(p.ws + WS_BAR), bst); xb.x = 0;
    if constexpr ((PHMASK >> 0) & 1) { phase_convert(p, lds); }
    if constexpr ((REPMASK >> 0) & 1) { __syncthreads(); phase_convert(p, lds); }
    if constexpr ((PHMASK >> 1) & 1) { phase_bias_table(p); }
    if constexpr ((REPMASK >> 1) & 1) { __syncthreads(); phase_bias_table(p); }
    if constexpr ((PHMASK >> 2) & 1) { phase_rmsnorm(p.in[0], p.in[1], (bf16_t*)(uni(p.ws) + HBUF)); }
    if constexpr ((REPMASK >> 2) & 1) { __syncthreads(); phase_rmsnorm(p.in[0], p.in[1], (bf16_t*)(uni(p.ws) + HBUF)); }
    if (p.njobs < 0) grid.sync();
    xcd_barrier(xb);
    if constexpr ((PHMASK >> 3) & 1) { { pg8::EpiStoreA E{(bf16_t*)(uni(p.ws) + ACT), p.in[4]}; run_gemm<0>(lds, (bf16_t*)(uni(p.ws) + HBUF), (const bf16_t*)(uni(p.ws) + W_A_IN), 8192, 2048, 2048, E); } }
    if constexpr ((REPMASK >> 3) & 1) { __syncthreads(); { pg8::EpiStoreA E{(bf16_t*)(uni(p.ws) + ACT), p.in[4]}; run_gemm<0>(lds, (bf16_t*)(uni(p.ws) + HBUF), (const bf16_t*)(uni(p.ws) + W_A_IN), 8192, 2048, 2048, E); } }
    xcd_barrier(xb);
    if constexpr ((PHMASK >> 5) & 1) { phase_attn_a(p, lds); }
    if constexpr ((REPMASK >> 5) & 1) { __syncthreads(); phase_attn_a(p, lds); }
    xcd_barrier(xb);
    if constexpr ((PHMASK >> 6) & 1) { { pg8::EpiResid<false, false, true, true> E{p.in[0], nullptr, nullptr, (bf16_t*)(uni(p.ws) + XG), (float*)(uni(p.ws) + X_SSQ)}; run_gemm<0>(lds, (bf16_t*)(uni(p.ws) + HBUF), (const bf16_t*)(uni(p.ws) + W_A_OUT), 2048, 2048, 2048, E); } }
    if constexpr ((REPMASK >> 6) & 1) { __syncthreads(); { pg8::EpiResid<false, false, true, true> E{p.in[0], nullptr, nullptr, (bf16_t*)(uni(p.ws) + XG), (float*)(uni(p.ws) + X_SSQ)}; run_gemm<0>(lds, (bf16_t*)(uni(p.ws) + HBUF), (const bf16_t*)(uni(p.ws) + W_A_OUT), 2048, 2048, 2048, E); } }
    xcd_barrier(xb);
    if constexpr ((PHMASK >> 8) & 1) { { pg8::EpiStore E{(bf16_t*)(uni(p.ws) + ACT), 6400, (const float*)(uni(p.ws) + X_SSQ)}; run_gemm<0>(lds, (const bf16_t*)(uni(p.ws) + XG), (const bf16_t*)(uni(p.ws) + W_B_IN), 6144, 2048, 2048, E); } }
    if constexpr ((REPMASK >> 8) & 1) { __syncthreads(); { pg8::EpiStore E{(bf16_t*)(uni(p.ws) + ACT), 6400, (const float*)(uni(p.ws) + X_SSQ)}; run_gemm<0>(lds, (const bf16_t*)(uni(p.ws) + XG), (const bf16_t*)(uni(p.ws) + W_B_IN), 6144, 2048, 2048, E); } }
    xcd_barrier(xb);
    if constexpr ((PHMASK >> 9) & 1) { phase_gla_prep(p, lds); }
    if constexpr ((REPMASK >> 9) & 1) { __syncthreads(); phase_gla_prep(p, lds); }
    xcd_barrier(xb);
    if constexpr ((PHMASK >> 10) & 1) { phase_gla_scan(p, lds); }
    if constexpr ((REPMASK >> 10) & 1) { __syncthreads(); phase_gla_scan(p, lds); }
    xcd_barrier(xb);
    if constexpr ((PHMASK >> 11) & 1) { phase_gla_post(p); }
    if constexpr ((REPMASK >> 11) & 1) { __syncthreads(); phase_gla_post(p); }
    xcd_barrier(xb);
    if constexpr ((PHMASK >> 12) & 1) { { pg8::EpiResid<true, false, true, true> E{nullptr, (const bf16_t*)(uni(p.ws) + XG), nullptr, (bf16_t*)(uni(p.ws) + XG), (float*)(uni(p.ws) + X_SSQ) + MTOK}; run_gemm<0>(lds, (bf16_t*)(uni(p.ws) + HBUF), (const bf16_t*)(uni(p.ws) + W_B_OUT), 2048, 2048, 2048, E); } }
    if constexpr ((REPMASK >> 12) & 1) { __syncthreads(); { pg8::EpiResid<true, false, true, true> E{nullptr, (const bf16_t*)(uni(p.ws) + XG), nullptr, (bf16_t*)(uni(p.ws) + XG), (float*)(uni(p.ws) + X_SSQ) + MTOK}; run_gemm<0>(lds, (bf16_t*)(uni(p.ws) + HBUF), (const bf16_t*)(uni(p.ws) + W_B_OUT), 2048, 2048, 2048, E); } }
    xcd_barrier(xb);
    if constexpr ((PHMASK >> 14) & 1) { { pg8::EpiStore E{(bf16_t*)(uni(p.ws) + ACT), 4096, (const float*)(uni(p.ws) + X_SSQ) + MTOK}; run_gemm<0>(lds, (const bf16_t*)(uni(p.ws) + XG), (const bf16_t*)(uni(p.ws) + W_C_IN), 4096, 2048, 2048, E); } }
    if constexpr ((REPMASK >> 14) & 1) { __syncthreads(); { pg8::EpiStore E{(bf16_t*)(uni(p.ws) + ACT), 4096, (const float*)(uni(p.ws) + X_SSQ) + MTOK}; run_gemm<0>(lds, (const bf16_t*)(uni(p.ws) + XG), (const bf16_t*)(uni(p.ws) + W_C_IN), 4096, 2048, 2048, E); } }
    xcd_barrier(xb);
    if constexpr ((PHMASK >> 15) & 1) { phase_conv(p); }
    if constexpr ((REPMASK >> 15) & 1) { __syncthreads(); phase_conv(p); }
    xcd_barrier(xb);
    if constexpr ((PHMASK >> 16) & 1) { { pg8::EpiGates E{(bf16_t*)(uni(p.ws) + HBUF), p.in[17], p.in[19], (const float*)(uni(p.ws) + X_SP8), (unsigned*)(uni(p.ws) + ACT + 128 * MiB)}; run_gemm<2>(lds, (bf16_t*)(uni(p.ws) + HBUF), (const bf16_t*)(uni(p.ws) + W_C_GATE), 4096, 256, 2048, E); } }
    if constexpr ((REPMASK >> 16) & 1) { __syncthreads(); { pg8::EpiGates E{(bf16_t*)(uni(p.ws) + HBUF), p.in[17], p.in[19], (const float*)(uni(p.ws) + X_SP8), (unsigned*)(uni(p.ws) + ACT + 128 * MiB)}; run_gemm<2>(lds, (bf16_t*)(uni(p.ws) + HBUF), (const bf16_t*)(uni(p.ws) + W_C_GATE), 4096, 256, 2048, E); } }
    xcd_barrier(xb);
    if constexpr ((PHMASK >> 17) & 1) { phase_lru_scan(p, lds); }
    if constexpr ((REPMASK >> 17) & 1) { __syncthreads(); phase_lru_scan(p, lds); }
    xcd_barrier(xb);
    if constexpr ((PHMASK >> 18) & 1) { { pg8::EpiResid<true, false, true, true> E{nullptr, (const bf16_t*)(uni(p.ws) + XG), nullptr, (bf16_t*)(uni(p.ws) + XG), (float*)(uni(p.ws) + X_SSQ) + 2 * MTOK}; run_gemm<0>(lds, (bf16_t*)(uni(p.ws) + HBUF), (const bf16_t*)(uni(p.ws) + W_C_OUT), 2048, 2048, 2048, E); } }
    if constexpr ((REPMASK >> 18) & 1) { __syncthreads(); { pg8::EpiResid<true, false, true, true> E{nullptr, (const bf16_t*)(uni(p.ws) + XG), nullptr, (bf16_t*)(uni(p.ws) + XG), (float*)(uni(p.ws) + X_SSQ) + 2 * MTOK}; run_gemm<0>(lds, (bf16_t*)(uni(p.ws) + HBUF), (const bf16_t*)(uni(p.ws) + W_C_OUT), 2048, 2048, 2048, E); } }
    xcd_barrier(xb);
    if constexpr ((PHMASK >> 20) & 1) { { pg8::EpiStoreD E{(bf16_t*)(uni(p.ws) + LAT), (bf16_t*)(uni(p.ws) + HBUF), (const float*)(uni(p.ws) + X_SSQ) + 2 * MTOK, (float*)(uni(p.ws) + X_SSQ) + 3 * MTOK}; run_gemm<0>(lds, (const bf16_t*)(uni(p.ws) + XG), (const bf16_t*)(uni(p.ws) + W_D_IN), 3328, 2048, 2048, E); } }
    if constexpr ((REPMASK >> 20) & 1) { __syncthreads(); { pg8::EpiStoreD E{(bf16_t*)(uni(p.ws) + LAT), (bf16_t*)(uni(p.ws) + HBUF), (const float*)(uni(p.ws) + X_SSQ) + 2 * MTOK, (float*)(uni(p.ws) + X_SSQ) + 3 * MTOK}; run_gemm<0>(lds, (const bf16_t*)(uni(p.ws) + XG), (const bf16_t*)(uni(p.ws) + W_D_IN), 3328, 2048, 2048, E); } }
    xcd_barrier(xb);
    if constexpr ((PHMASK >> 22) & 1) { { pg8::EpiStoreU E{(bf16_t*)(uni(p.ws) + ACT), (const float*)(uni(p.ws) + X_SSQ) + 3 * MTOK}; run_gemm<1>(lds, (const bf16_t*)(uni(p.ws) + LAT), (const bf16_t*)(uni(p.ws) + W_D_UQKV), 7168, 512, 1088, E); } }
    if constexpr ((REPMASK >> 22) & 1) { __syncthreads(); { pg8::EpiStoreU E{(bf16_t*)(uni(p.ws) + ACT), (const float*)(uni(p.ws) + X_SSQ) + 3 * MTOK}; run_gemm<1>(lds, (const bf16_t*)(uni(p.ws) + LAT), (const bf16_t*)(uni(p.ws) + W_D_UQKV), 7168, 512, 1088, E); } }
    xcd_barrier(xb);
    if constexpr ((PHMASK >> 23) & 1) { phase_mla_qk(p); }
    if constexpr ((REPMASK >> 23) & 1) { __syncthreads(); phase_mla_qk(p); }
    xcd_barrier(xb);
    if constexpr ((PHMASK >> 24) & 1) { phase_attn_d(p, lds); }
    if constexpr ((REPMASK >> 24) & 1) { __syncthreads(); phase_attn_d(p, lds); }
    xcd_barrier(xb);
    if constexpr ((PHMASK >> 25) & 1) { { pg8::EpiResid<true, true, false, false> E{nullptr, (const bf16_t*)(uni(p.ws) + XG), uni(p.out), nullptr, nullptr}; run_gemm<0>(lds, (bf16_t*)(uni(p.ws) + HBUF), (const bf16_t*)(uni(p.ws) + W_D_OUT), 2048, 2048, 2048, E); } }
    if constexpr ((REPMASK >> 25) & 1) { __syncthreads(); { pg8::EpiResid<true, true, false, false> E{nullptr, (const bf16_t*)(uni(p.ws) + XG), uni(p.out), nullptr, nullptr}; run_gemm<0>(lds, (bf16_t*)(uni(p.ws) + HBUF), (const bf16_t*)(uni(p.ws) + W_D_OUT), 2048, 2048, 2048, E); } }
#ifdef XSYNC
    for (int i = 0; i < XSYNC; ++i) xcd_barrier(xb);
#endif
}

extern "C" void kernel_launch(void* const* d_in, const int* in_sizes, int n_in, void* d_out, int out_size, void* d_ws, size_t ws_size, hipStream_t stream) {
    static int grid_blocks = 0;
    if (!grid_blocks) {
        int dev = 0, cus = 0, per_cu = 0;
        hipGetDevice(&dev);
        hipDeviceGetAttribute(&cus, hipDeviceAttributeMultiprocessorCount, dev);
        hipFuncSetAttribute((const void*)mega, hipFuncAttributeMaxDynamicSharedMemorySize, LDS_BYTES);
        hipOccupancyMaxActiveBlocksPerMultiprocessor(&per_cu, (const void*)mega, 512, LDS_BYTES);
        if (per_cu < 1) per_cu = 1;
        grid_blocks = cus * per_cu;
        if (ws_size < EXTRA + 65536 + 5 * 65536) fprintf(stderr, "kernel_launch: workspace too small (%zu < %zu)\n", ws_size, (size_t)WS_END);
    }
    Params p; memset(&p, 0, sizeof(p));
    for (int i = 0; i < 29; ++i) p.in[i] = (const float*)d_in[i];
    p.out = (float*)d_out; p.ws = (unsigned char*)d_ws;
    unsigned char* ws = (unsigned char*)d_ws;
    int nj = 0, tiles = 0;
    auto add = [&](const float* src, size_t dst_off, int K, int N, int ldw, int npad) {
        TJob& j = p.jobs[nj++]; j.src = src; j.dst = (bf16_t*)(ws + dst_off); j.kscale = nullptr; j.K = K; j.N = N; j.ldw = ldw; j.ntn = npad / 64; j.tile0 = tiles; j.pad = 0; tiles += (npad / 64) * (K / 256);
    };
    add(p.in[3], W_A_IN, 2048, 8192, 8192, 8192); p.jobs[0].pad = 1;
    add(p.in[7], W_A_OUT, 2048, 2048, 2048, 2048);
    add(p.in[8], W_B_IN, 2048, 6160, 6160, 6400); p.jobs[nj - 1].kscale = p.in[1] + 2048;
    add(p.in[12], W_B_OUT, 2048, 2048, 2048, 2048);
    add(p.in[13], W_C_IN, 2048, 4096, 4096, 4096); p.jobs[nj - 1].kscale = p.in[1] + 4096;
    add(p.in[21], W_C_OUT, 2048, 2048, 2048, 2048);
    add(p.in[22], W_D_IN, 2048, 3136, 3136, 3328); p.jobs[nj - 1].kscale = p.in[1] + 6144;
    add(p.in[25], W_D_UQKV, 512, 3072, 3072, 3072); p.jobs[nj - 1].kscale = p.in[23];
    add(p.in[26], W_D_UQKV + (size_t)3072 * 512 * 2, 512, 4096, 4096, 4096); p.jobs[nj - 1].kscale = p.in[24];
    add(p.in[28], W_D_OUT, 2048, 2048, 2048, 2048);
    for (int n = 0; n < 8; ++n) for (int half = 0; half < 2; ++half) for (int bj = 0; bj < 2; ++bj)
        add(p.in[bj ? 18 : 16] + (size_t)n * 65536 + half * 128, W_C_GATE + ((size_t)((n * 2 + half) * 256 + 128 * bj)) * 256 * 2, 256, 128, 256, 128);
    p.njobs = nj; p.ntiles = tiles;
    hipMemsetAsync(ws + WS_BAR, 0, XCD_BAR_WORDS * 4, stream);
    void* args[] = {(void*)&p};
    hipError_t e = hipLaunchCooperativeKernel((const void*)mega, dim3(grid_blocks), dim3(512), args, LDS_BYTES, stream);
    if (e != hipSuccess) fprintf(stderr, "cooperative launch failed: %s (grid %d)\n", hipGetErrorString(e), grid_blocks);
}
```

```cpp
#include <hip/hip_runtime.h>
#include <hip/hip_cooperative_groups.h>
#include <cstdio>
#include <cstring>
namespace cg = cooperative_groups;

#define DI __device__ __forceinline__
#define LAS __attribute__((address_space(3)))
typedef unsigned short bf16_t;
typedef short bf16x8 __attribute__((ext_vector_type(8)));
typedef short s16x4 __attribute__((ext_vector_type(4)));
typedef float f32x2 __attribute__((ext_vector_type(2)));
typedef float f32x4 __attribute__((ext_vector_type(4)));
typedef float f32x16 __attribute__((ext_vector_type(16)));
typedef unsigned u32x2 __attribute__((ext_vector_type(2)));
typedef unsigned u32x4 __attribute__((ext_vector_type(4)));
typedef __bf16 bf16v2_t __attribute__((ext_vector_type(2)));

constexpr int MTOK = 16384, DM = 2048, SEQ = 4096;
constexpr float EPS = 1e-6f, LOG2E = 1.4426950408889634f;
constexpr size_t MiB = (size_t)1 << 20;
constexpr size_t W_A_IN = 0, W_A_OUT = 32 * MiB, W_B_IN = 40 * MiB, W_B_OUT = 65 * MiB, W_C_IN = 73 * MiB, W_C_GATE = 89 * MiB,
                 W_C_OUT = 91 * MiB, W_D_IN = 99 * MiB, W_D_UQKV = 112 * MiB, W_D_OUT = 119 * MiB, HBUF = 127 * MiB, ACT = 191 * MiB,
                 WS_END = 511 * MiB;
constexpr size_t LAT = 0;
constexpr size_t EXTRA = 511 * MiB;
constexpr size_t X_BIAS = EXTRA + 16384, X_SP8 = EXTRA + 32768, X_SSQ = EXTRA + 65536;
constexpr size_t GLA_TOT = ACT + 200 * MiB;
constexpr size_t XG = ACT + 256 * MiB;
constexpr size_t WS_BAR = EXTRA;
constexpr int LDS_BYTES = 131072 + 2048;
#ifndef PHMASK
#define PHMASK 0xffffffffull
#endif
#ifndef REPMASK
#define REPMASK 0ull
#endif

struct TJob { const float* src; bf16_t* dst; const float* kscale; int K, N, ldw, ntn, tile0, pad; };
struct Params { const float* in[29]; float* out; unsigned char* ws; int njobs, ntiles; TJob jobs[44]; };

DI int otid() { int t = threadIdx.x; asm volatile("" : "+v"(t)); return t; }
template <class T> DI T* uni(T* p) {
    const unsigned long long v = (unsigned long long)p;
    const unsigned lo = __builtin_amdgcn_readfirstlane((unsigned)v), hi = __builtin_amdgcn_readfirstlane((unsigned)(v >> 32));
    return (T*)(((unsigned long long)hi << 32) | lo);
}
DI float bf2f(bf16_t v) { return __uint_as_float((unsigned)v << 16); }
DI unsigned pk2(float a, float b) { f32x2 v = {a, b}; bf16v2_t r = __builtin_convertvector(v, bf16v2_t); return __builtin_bit_cast(unsigned, r); }
DI bf16_t f2bf(float a) { return (bf16_t)(pk2(a, 0.f) & 0xffffu); }
DI void unpack8(const u32x4 w, float (&f)[8]) {
#pragma unroll
    for (int i = 0; i < 4; ++i) { f[2 * i] = __uint_as_float(w[i] << 16); f[2 * i + 1] = __uint_as_float(w[i] & 0xffff0000u); }
}
DI u32x4 pack8(const float (&f)[8]) { u32x4 w; w.x = pk2(f[0], f[1]); w.y = pk2(f[2], f[3]); w.z = pk2(f[4], f[5]); w.w = pk2(f[6], f[7]); return w; }
DI float wsum(float v) {
#pragma unroll
    for (int m = 32; m >= 1; m >>= 1) v += __shfl_xor(v, m);
    return v;
}
DI float sigm(float x) { return 1.f / (1.f + __expf(-x)); }
DI float silu(float x) { return x / (1.f + __expf(-x)); }
DI int crow(int i, int hh) { return (i & 3) + 8 * (i >> 2) + 4 * hh; }
DI f32x16 mfma32(bf16x8 a, bf16x8 b, f32x16 c) { return __builtin_amdgcn_mfma_f32_32x32x16_bf16(a, b, c, 0, 0, 0); }
DI s16x4 trread(LAS unsigned char* p) { return __builtin_amdgcn_ds_read_tr16_b64_v4i16((LAS s16x4*)p); }
DI bf16x8 cat4(s16x4 lo, s16x4 hi) { return __builtin_shufflevector(lo, hi, 0, 1, 2, 3, 4, 5, 6, 7); }

namespace pg8 {
constexpr int BM = 256, BK = 64, HALF = 128, HTB = HALF * BK * 2, STAGE_BYTES = 8 * HTB, NXCD = 8, WGM = 8;
DI int lds_byte(int r, int c) { const int st = (r >> 4) * 2 + (c >> 5), rr = r & 15, cc = c & 31, ob = rr * 64 + cc * 2; return st * 1024 + (ob ^ (((ob >> 9) & 1) << 5)); }
DI void stage_rc(int b, int& R, int& C) { const int st = b / 1024, sb = b % 1024, swz = sb ^ (((sb >> 9) & 1) << 5); R = (st >> 1) * 16 + swz / 64; C = (st & 1) * 32 + (swz % 64) / 2; }
DI int perm32(int rho) { const int n = rho >> 4, i = rho & 15; return 8 * (i >> 2) + 4 * n + (i & 3); }
struct Unit { int pm, pn; size_t aoff, boff; };
template <int MODE> struct Sched {
    int nM, nN, nwg, G, c, lda, K;
    DI void init(int M, int N, int G_, int c_, int lda_, int K_) { nM = M / BM; nN = N / BM; nwg = nM * nN; G = G_; c = c_; lda = lda_; K = K_; }
    DI bool next(int i, Unit& u) const {
        const long L = (long)i * G + c; if (L >= nwg) return false;
        int wgid = (int)L; { const int q = nwg / NXCD, r = nwg % NXCD, xcd = wgid % NXCD, off = wgid / NXCD; wgid = (xcd < r ? xcd * (q + 1) : r * (q + 1) + (xcd - r) * q) + off; }
        const int nig = WGM * nN, gid = wgid / nig, fm = gid * WGM, gsz = (nM - fm) < WGM ? (nM - fm) : WGM;
        u.pm = fm + ((wgid % nig) % gsz); u.pn = (wgid % nig) / gsz;
        u.aoff = (size_t)u.pm * 256 * lda * 2; u.boff = (size_t)u.pn * 256 * K * 2;
        if (MODE == 1 && u.pn >= 12) u.aoff += 1024;
        if (MODE == 2) u.aoff += (size_t)(u.pn >> 1) * 512;
        return true;
    }
};

template <class Epi, class SchedT>
DI void gemm_phase(LAS unsigned char* lds, const bf16_t* Ap, const bf16_t* Btp, const int K, const int lda, const SchedT& S, const Epi& E) {
    const int tid = otid(), wid = __builtin_amdgcn_readfirstlane(tid >> 6), lane = tid & 63, wr = wid >> 2, wc = wid & 3, fr = lane & 15, fq = lane >> 4;
    const int nt = K / BK;
    unsigned voffA[2], voffB[2];
#pragma unroll
    for (int i = 0; i < 2; ++i) { int R, C; stage_rc(tid * 16 + i * 8192, R, C); const int Rb = (R & ~31) + perm32(R & 31);
        voffA[i] = (unsigned)(R * lda + C) * 2u; voffB[i] = (unsigned)(Rb * K + C) * 2u; }
    const size_t kstep = (size_t)(BK * 2);
    const size_t hstepA = (size_t)HALF * lda * 2, hstepB = (size_t)HALF * K * 2;
    const unsigned ldsw = (unsigned)wid * 1024u;
    const int aoff = lds_byte(wr * 64 + fr, fq * 8), boff = lds_byte(wc * 32 + fr, fq * 8);
#define PG8_SA(b, h) (((b) * 2 + (h)) * HTB)
#define PG8_SB(b, h) ((4 + (b) * 2 + (h)) * HTB)
#define PG8_STAGE(bufoff, gbase, voff) do { _Pragma("unroll") for (int _i = 0; _i < 2; ++_i) \
        __builtin_amdgcn_global_load_lds((const unsigned*)((const char*)(gbase) + (voff)[_i]), (LAS unsigned*)(lds + (bufoff) + ldsw + _i * 8192), 16, 0, 0); } while (0)
#define PG8_LDA(dst, b, h) do { _Pragma("unroll") for (int m = 0; m < 4; ++m) _Pragma("unroll") for (int k = 0; k < 2; ++k) dst[m][k] = *(const LAS bf16x8*)(lds + PG8_SA(b, h) + aoff + m * 2048 + k * 1024); } while (0)
#define PG8_LDB(dst, b, h) do { _Pragma("unroll") for (int n = 0; n < 2; ++n) _Pragma("unroll") for (int k = 0; k < 2; ++k) dst[n][k] = *(const LAS bf16x8*)(lds + PG8_SB(b, h) + boff + n * 2048 + k * 1024); } while (0)
#define PG8_MMA(ai, bj, At, Bt) do { __builtin_amdgcn_s_setprio(1); _Pragma("unroll") for (int m = 0; m < 4; ++m) _Pragma("unroll") for (int n = 0; n < 2; ++n) _Pragma("unroll") for (int k = 0; k < 2; ++k) \
        acc[ai][bj][m][n] = __builtin_amdgcn_mfma_f32_16x16x32_bf16(Bt[n][k], At[m][k], acc[ai][bj][m][n], 0, 0, 0); __builtin_amdgcn_s_setprio(0); } while (0)
#define PG8_WAIT_V(n) asm volatile("s_waitcnt vmcnt(" #n ")" ::: "memory")
#define PG8_WAIT_L(n) asm volatile("s_waitcnt lgkmcnt(" #n ")" ::: "memory")
#define PG8_BAR __builtin_amdgcn_s_barrier()
#define PG8_SCHED __builtin_amdgcn_sched_barrier(0)
    Unit cur, nxt; int ui = 0;
    if (!S.next(0, cur)) return;
    float pre[8]; E.prefetch(cur, wr, fr, pre);
    f32x4 acc[2][2][4][2];
#pragma unroll
    for (int a = 0; a < 2; ++a)
#pragma unroll
        for (int b = 0; b < 2; ++b)
#pragma unroll
            for (int m = 0; m < 4; ++m)
#pragma unroll
                for (int n = 0; n < 2; ++n) acc[a][b][m][n] = (f32x4){0.f, 0.f, 0.f, 0.f};
    bf16x8 At[4][2], B0[2][2], B1[2][2];
    const char* cA = (const char*)Ap + cur.aoff; const char* cB = (const char*)Btp + cur.boff;
    PG8_STAGE(PG8_SB(0, 0), cB, voffB); PG8_STAGE(PG8_SA(0, 0), cA, voffA); PG8_STAGE(PG8_SB(0, 1), cB + hstepB, voffB); PG8_STAGE(PG8_SA(0, 1), cA + hstepA, voffA);
    if (wr == 1) PG8_BAR;
    PG8_WAIT_V(4); PG8_BAR;
    PG8_STAGE(PG8_SB(1, 0), cB + kstep, voffB); PG8_STAGE(PG8_SA(1, 0), cA + kstep, voffA); PG8_STAGE(PG8_SB(1, 1), cB + hstepB + kstep, voffB);
    PG8_WAIT_V(6); PG8_BAR;
    for (;;) {
        const bool has_next = S.next(ui + 1, nxt);
        const char* nA = has_next ? (const char*)Ap + nxt.aoff : cA; const char* nB = has_next ? (const char*)Btp + nxt.boff : cB;
        for (int t = 0; t < nt; t += 2) {
            const bool last = (t == nt - 2);
            const char* a1 = cA + (size_t)(t + 1) * kstep;
            const char* a2 = last ? nA : cA + (size_t)(t + 2) * kstep; const char* b2 = last ? nB : cB + (size_t)(t + 2) * kstep;
            const char* a3 = a2 + kstep; const char* b3 = b2 + kstep;
            PG8_LDB(B0, 0, 0); PG8_SCHED; PG8_LDA(At, 0, 0); PG8_STAGE(PG8_SA(1, 1), a1 + hstepA, voffA);
            PG8_WAIT_L(8); PG8_BAR; PG8_WAIT_L(0); PG8_MMA(0, 0, At, B0); PG8_BAR; PG8_SCHED;
            PG8_LDB(B1, 0, 1); PG8_STAGE(PG8_SB(0, 0), b2, voffB);
            PG8_BAR; PG8_WAIT_L(0); PG8_MMA(0, 1, At, B1); PG8_BAR;
            PG8_LDA(At, 0, 1); PG8_STAGE(PG8_SA(0, 0), a2, voffA);
            PG8_BAR; PG8_WAIT_L(0); PG8_MMA(1, 0, At, B0); PG8_BAR; PG8_SCHED;
            PG8_STAGE(PG8_SB(0, 1), b2 + hstepB, voffB);
            PG8_WAIT_V(6); PG8_BAR; PG8_MMA(1, 1, At, B1); PG8_BAR;
            PG8_LDB(B0, 1, 0); PG8_SCHED; PG8_LDA(At, 1, 0); PG8_STAGE(PG8_SA(0, 1), a2 + hstepA, voffA);
            PG8_WAIT_L(8); PG8_BAR; PG8_WAIT_L(0); PG8_MMA(0, 0, At, B0); PG8_BAR; PG8_SCHED;
            PG8_LDB(B1, 1, 1); PG8_STAGE(PG8_SB(1, 0), b3, voffB);
            PG8_BAR; PG8_WAIT_L(0); PG8_MMA(0, 1, At, B1); PG8_BAR;
            PG8_LDA(At, 1, 1); PG8_STAGE(PG8_SA(1, 0), a3, voffA);
            PG8_BAR; PG8_WAIT_L(0); PG8_MMA(1, 0, At, B0); PG8_BAR; PG8_SCHED;
            PG8_STAGE(PG8_SB(1, 1), b3 + hstepB, voffB);
            PG8_WAIT_V(6); PG8_BAR; PG8_MMA(1, 1, At, B1); PG8_BAR;
        }
        E(acc, cur, wr, wc, fr, fq, pre);
        if (!has_next) break;
#pragma unroll
        for (int a = 0; a < 2; ++a)
#pragma unroll
            for (int b = 0; b < 2; ++b)
#pragma unroll
                for (int m = 0; m < 4; ++m)
#pragma unroll
                    for (int n = 0; n < 2; ++n) acc[a][b][m][n] = (f32x4){0.f, 0.f, 0.f, 0.f};
        cur = nxt; cA = nA; cB = nB; ++ui; E.prefetch(cur, wr, fr, pre);
    }
    PG8_WAIT_V(0);
    if (wr == 0) PG8_BAR;
    PG8_BAR;
#undef PG8_SA
#undef PG8_SB
#undef PG8_STAGE
#undef PG8_LDA
#undef PG8_LDB
#undef PG8_MMA
#undef PG8_WAIT_V
#undef PG8_WAIT_L
#undef PG8_BAR
#undef PG8_SCHED
}

typedef f32x4 Acc[2][2][4][2];
struct EpiStore {
    bf16_t* O; int ldc; const float* ssq;
    DI void prefetch(const Unit& u, int wr, int fr, float (&pre)[8]) const {
#pragma unroll
        for (int i = 0; i < 8; ++i) pre[i] = ssq ? ssq[u.pm * BM + wr * 64 + fr + (i >> 2) * HALF + (i & 3) * 16] : 0.f; }
    DI void operator()(const Acc& acc, const Unit& u, int wr, int wc, int fr, int fq, const float (&pre)[8]) const {
        const int row0 = u.pm * BM + wr * 64 + fr, col0 = u.pn * BM + wc * 32 + 8 * fq;
#pragma unroll
        for (int ai = 0; ai < 2; ++ai)
#pragma unroll
            for (int m = 0; m < 4; ++m) { bf16_t* rowp = O + (size_t)(row0 + ai * HALF + m * 16) * ldc + col0;
                const float rs = ssq ? rsqrtf(pre[ai * 4 + m] * (1.f / DM) + EPS) : 1.f;
#pragma unroll
                for (int bj = 0; bj < 2; ++bj) { const f32x4 v0 = acc[ai][bj][m][0] * rs, v1 = acc[ai][bj][m][1] * rs;
                    u32x4 w; w.x = pk2(v0[0], v0[1]); w.y = pk2(v0[2], v0[3]); w.z = pk2(v1[0], v1[1]); w.w = pk2(v1[2], v1[3]);
                    *(u32x4*)(rowp + bj * HALF) = w; } }
    }
};
struct EpiStoreA {
    bf16_t* O; const float* qkg;
    DI void prefetch(const Unit&, int, int, float (&pre)[8]) const {
#pragma unroll
        for (int i = 0; i < 8; ++i) pre[i] = 0.f; }
    DI void operator()(const Acc& acc, const Unit& u, int wr, int wc, int fr, int fq, const float (&pre)[8]) const {
        const int row0 = u.pm * BM + wr * 64 + fr, col0 = u.pn * BM + wc * 64 + 8 * fq;
        const bool nrm = u.pn < 16;
        f32x4 gn[2][2];
        if (nrm) { const float* gp = qkg + (u.pn < 8 ? 0 : 64) + 8 * fq; const float gs = u.pn < 8 ? 0.125f * LOG2E : 1.f;
#pragma unroll
            for (int bj = 0; bj < 2; ++bj) { gn[bj][0] = *(const f32x4*)(gp + 32 * bj) * gs; gn[bj][1] = *(const f32x4*)(gp + 32 * bj + 4) * gs; } }
#pragma unroll
        for (int ai = 0; ai < 2; ++ai)
#pragma unroll
            for (int m = 0; m < 4; ++m) { bf16_t* rowp = O + (size_t)(row0 + ai * HALF + m * 16) * 8192 + col0;
                f32x4 v[2][2];
#pragma unroll
                for (int bj = 0; bj < 2; ++bj) { v[bj][0] = acc[ai][bj][m][0]; v[bj][1] = acc[ai][bj][m][1]; }
                if (nrm) { float ss = 0.f;
#pragma unroll
                    for (int bj = 0; bj < 2; ++bj)
#pragma unroll
                        for (int n = 0; n < 2; ++n) ss += v[bj][n][0] * v[bj][n][0] + v[bj][n][1] * v[bj][n][1] + v[bj][n][2] * v[bj][n][2] + v[bj][n][3] * v[bj][n][3];
                    ss += __shfl_xor(ss, 16); ss += __shfl_xor(ss, 32);
                    const float sc = rsqrtf(ss * (1.f / 64.f) + EPS);
#pragma unroll
                    for (int bj = 0; bj < 2; ++bj) { v[bj][0] = v[bj][0] * sc * gn[bj][0]; v[bj][1] = v[bj][1] * sc * gn[bj][1]; } }
#pragma unroll
                for (int bj = 0; bj < 2; ++bj) { u32x4 w; w.x = pk2(v[bj][0][0], v[bj][0][1]); w.y = pk2(v[bj][0][2], v[bj][0][3]); w.z = pk2(v[bj][1][0], v[bj][1][1]); w.w = pk2(v[bj][1][2], v[bj][1][3]);
                    *(u32x4*)(rowp + 32 * bj) = w; } }
    }
};
struct EpiStoreD {
    bf16_t* lat; bf16_t* g; const float* ssq; float* ssql;
    DI void prefetch(const Unit& u, int wr, int fr, float (&pre)[8]) const {
#pragma unroll
        for (int i = 0; i < 8; ++i) pre[i] = ssq[u.pm * BM + wr * 64 + fr + (i >> 2) * HALF + (i & 3) * 16]; }
    DI void operator()(const Acc& acc, const Unit& u, int wr, int wc, int fr, int fq, const float (&pre)[8]) const {
        const int row0 = u.pm * BM + wr * 64 + fr, col0 = u.pn * BM + wc * 32 + 8 * fq;
#pragma unroll
        for (int ai = 0; ai < 2; ++ai)
#pragma unroll
            for (int m = 0; m < 4; ++m) { const size_t row = (size_t)(row0 + ai * HALF + m * 16);
                const float rs = rsqrtf(pre[ai * 4 + m] * (1.f / DM) + EPS); float ss = 0.f;
#pragma unroll
                for (int bj = 0; bj < 2; ++bj) { const f32x4 v0 = acc[ai][bj][m][0] * rs, v1 = acc[ai][bj][m][1] * rs;
                    ss += v0[0] * v0[0] + v0[1] * v0[1] + v0[2] * v0[2] + v0[3] * v0[3] + v1[0] * v1[0] + v1[1] * v1[1] + v1[2] * v1[2] + v1[3] * v1[3];
                    u32x4 w; w.x = pk2(v0[0], v0[1]); w.y = pk2(v0[2], v0[3]); w.z = pk2(v1[0], v1[1]); w.w = pk2(v1[2], v1[3]);
                    const int col = col0 + bj * HALF;
                    if (col < 1088) *(u32x4*)(lat + row * 1088 + col) = w;
                    else if (col < 3136) *(u32x4*)(g + row * 2048 + (col - 1088)) = w; }
                if (u.pn < 4) { ss += __shfl_xor(ss, 16); ss += __shfl_xor(ss, 32); if (fq == 0) atomicAdd(ssql + (u.pn >> 1) * MTOK + row, ss); } }
    }
};
struct EpiStoreU {
    bf16_t* O; const float* ssql;
    DI void prefetch(const Unit& u, int wr, int fr, float (&pre)[8]) const {
        const float* sq = ssql + (u.pn >= 12 ? MTOK : 0);
#pragma unroll
        for (int i = 0; i < 8; ++i) pre[i] = sq[u.pm * BM + wr * 64 + fr + (i >> 2) * HALF + (i & 3) * 16]; }
    DI void operator()(const Acc& acc, const Unit& u, int wr, int wc, int fr, int fq, const float (&pre)[8]) const {
        const int row0 = u.pm * BM + wr * 64 + fr, col0 = u.pn * BM + wc * 32 + 8 * fq;
        const float* sq = ssql + (u.pn >= 12 ? MTOK : 0);
#pragma unroll
        for (int ai = 0; ai < 2; ++ai)
#pragma unroll
            for (int m = 0; m < 4; ++m) { bf16_t* rowp = O + (size_t)(row0 + ai * HALF + m * 16) * 7168 + col0;
                const float rs = rsqrtf(pre[ai * 4 + m] * (1.f / 512.f) + EPS);
#pragma unroll
                for (int bj = 0; bj < 2; ++bj) { const f32x4 v0 = acc[ai][bj][m][0] * rs, v1 = acc[ai][bj][m][1] * rs;
                    u32x4 w; w.x = pk2(v0[0], v0[1]); w.y = pk2(v0[2], v0[3]); w.z = pk2(v1[0], v1[1]); w.w = pk2(v1[2], v1[3]);
                    *(u32x4*)(rowp + bj * HALF) = w; } }
    }
};
template <bool INB, bool OUTF, bool OUTB, bool SSQ> struct EpiResid {
    const float* xf; const bf16_t* xb; float* of; bf16_t* ob; float* ssq;
    DI void prefetch(const Unit&, int, int, float (&pre)[8]) const {
#pragma unroll
        for (int i = 0; i < 8; ++i) pre[i] = 0.f; }
    DI void operator()(const Acc& acc, const Unit& u, int wr, int wc, int fr, int fq, const float (&pre)[8]) const {
        const int row0 = u.pm * BM + wr * 64 + fr, col0 = u.pn * BM + wc * 32 + 8 * fq;
#pragma unroll
        for (int ai = 0; ai < 2; ++ai)
#pragma unroll
            for (int m = 0; m < 4; ++m) { const int row = row0 + ai * HALF + m * 16; const size_t o = (size_t)row * DM + col0;
                float ss = 0.f;
#pragma unroll
                for (int bj = 0; bj < 2; ++bj) {
                    f32x4 x0, x1;
                    if (INB) { float f[8]; unpack8(*(const u32x4*)(xb + o + bj * HALF), f); x0 = (f32x4){f[0], f[1], f[2], f[3]}; x1 = (f32x4){f[4], f[5], f[6], f[7]}; }
                    else { x0 = *(const f32x4*)(xf + o + bj * HALF); x1 = *(const f32x4*)(xf + o + bj * HALF + 4); }
                    x0 += acc[ai][bj][m][0]; x1 += acc[ai][bj][m][1];
                    if (OUTF) { __builtin_nontemporal_store(x0, (f32x4*)(of + o + bj * HALF)); __builtin_nontemporal_store(x1, (f32x4*)(of + o + bj * HALF + 4)); }
                    if (SSQ) ss += x0[0] * x0[0] + x0[1] * x0[1] + x0[2] * x0[2] + x0[3] * x0[3] + x1[0] * x1[0] + x1[1] * x1[1] + x1[2] * x1[2] + x1[3] * x1[3];
                    if (OUTB) { u32x4 w; w.x = pk2(x0[0], x0[1]); w.y = pk2(x0[2], x0[3]); w.z = pk2(x1[0], x1[1]); w.w = pk2(x1[2], x1[3]);
                        *(u32x4*)(ob + o + bj * HALF) = w; } }
                if (SSQ) { ss += __shfl_xor(ss, 16); ss += __shfl_xor(ss, 32); if (fq == 0) atomicAdd(ssq + row, ss); } }
    }
};
struct EpiGates {
    const bf16_t* xc; const float* brg; const float* big; const float* sp8t; unsigned* ax;
    DI void prefetch(const Unit&, int, int, float (&pre)[8]) const {
#pragma unroll
        for (int i = 0; i < 8; ++i) pre[i] = 0.f; }
    DI void operator()(const Acc& acc, const Unit& u, int wr, int wc, int fr, int fq, const float (&pre)[8]) const {
        const int row0 = u.pm * BM + wr * 64 + fr, f0 = (u.pn >> 1) * 256 + (u.pn & 1) * 128 + wc * 32 + 8 * fq;
#pragma unroll
        for (int n = 0; n < 2; ++n) {
            const f32x4 br = *(const f32x4*)(brg + f0 + 4 * n), bi = *(const f32x4*)(big + f0 + 4 * n), sp = *(const f32x4*)(sp8t + f0 + 4 * n);
#pragma unroll
            for (int ai = 0; ai < 2; ++ai)
#pragma unroll
                for (int m = 0; m < 4; ++m) { const size_t o = (size_t)(row0 + ai * HALF + m * 16) * DM + f0 + 4 * n;
                    const u32x2 xw = *(const u32x2*)(xc + o);
                    const float xv[4] = {__uint_as_float(xw.x << 16), __uint_as_float(xw.x & 0xffff0000u), __uint_as_float(xw.y << 16), __uint_as_float(xw.y & 0xffff0000u)};
                    u32x4 w;
#pragma unroll
                    for (int e = 0; e < 4; ++e) { const float r = sigm(acc[ai][0][m][n][e] + br[e]), ig = sigm(acc[ai][1][m][n][e] + bi[e]);
                        const float la = -sp[e] * r, uu = -2.f * la;
                        const float om = uu * (1.f - uu * 0.5f * (1.f - uu * (1.f / 3.f) * (1.f - uu * 0.25f * (1.f - uu * 0.2f * (1.f - uu * (1.f / 6.f))))));
                        w[e] = pk2(la, sqrtf(fmaxf(om, 0.f)) * ig * xv[e]); }
                    *(u32x4*)(ax + o) = w; __builtin_amdgcn_sched_barrier(0); }
        }
    }
};
}

template <int MODE, class Epi>
DI void run_gemm(LAS unsigned char* lds, const bf16_t* A, const bf16_t* Bt, int N, int K, int lda, const Epi& E) {
    asm volatile("" : "+s"(K));
    pg8::Sched<MODE> S; S.init(MTOK, N, (int)gridDim.x, (int)blockIdx.x, lda, K);
    pg8::gemm_phase(lds, A, Bt, K, lda, S, E);
    __syncthreads();
}

DI void phase_convert(const Params& p, LAS unsigned char* lds) {
    LAS float* sm = (LAS float*)lds;
    const int tid = otid();
    for (int t = blockIdx.x; t < p.ntiles; t += gridDim.x) {
        int j = 0; while (j + 1 < p.njobs && p.jobs[j + 1].tile0 <= t) ++j;
        const float* src = p.jobs[j].src; bf16_t* dst = p.jobs[j].dst; const int K = p.jobs[j].K, N = p.jobs[j].N, ldw = p.jobs[j].ldw, ntn = p.jobs[j].ntn;
        const int tt = t - p.jobs[j].tile0, tn = tt % ntn, tk = tt / ntn, n0 = tn * 64, k0 = tk * 256;
        { const int n4 = (tid & 15) * 4, kr = tid >> 4; f32x4 v[8];
#pragma unroll
          for (int i = 0; i < 8; ++i) v[i] = (n0 + n4 < N) ? __builtin_nontemporal_load((const f32x4*)(src + (size_t)(k0 + kr + 32 * i) * ldw + n0 + n4)) : (f32x4){0.f, 0.f, 0.f, 0.f};
#pragma unroll
          for (int i = 0; i < 8; ++i) { LAS float* d = sm + (kr + 32 * i) * 65 + n4; d[0] = v[i][0]; d[1] = v[i][1]; d[2] = v[i][2]; d[3] = v[i][3]; } }
        __syncthreads();
        { const int nr = tid >> 3, kq = tid & 7;
#pragma unroll
          for (int jj = 0; jj < 4; ++jj) { const int kc = (kq + 8 * jj) * 8; float f[8];
#pragma unroll
              for (int e = 0; e < 8; ++e) f[e] = sm[(kc + e) * 65 + nr];
              if (p.jobs[j].kscale) { const float* ks = p.jobs[j].kscale + k0 + kc;
#pragma unroll
                  for (int e = 0; e < 8; ++e) f[e] *= ks[e]; }
              int nrow = n0 + nr; if (p.jobs[j].pad) { const int jl = nrow & 255; nrow = (nrow & ~255) + 128 * ((jl >> 5) & 1) + 32 * (jl >> 6) + (jl & 31); }
              *(u32x4*)(dst + (size_t)nrow * K + k0 + kc) = pack8(f); } }
        __syncthreads();
    }
}

DI int t5_bucket(int rel) {
    const int n = rel < 0 ? -rel : rel; int b;
    if (n < 8) b = n; else b = 8 + (n >= 12) + (n >= 16) + (n >= 23) + (n >= 32) + (n >= 46) + (n >= 64) + (n >= 91);
    return (rel > 0 ? 16 : 0) + b;
}
DI void phase_bias_table(const Params& p) {
    float* tb = (float*)(p.ws + X_BIAS);
    float* sp8 = (float*)(p.ws + X_SP8); float* ssq = (float*)(p.ws + X_SSQ);
    for (int i = blockIdx.x * 512 + otid(); i < 5 * MTOK; i += gridDim.x * 512) ssq[i] = 0.f;
    for (int i = blockIdx.x * 512 + otid(); i < 16 * 192 + 2048; i += gridDim.x * 512) {
        if (i < 16 * 192) { const int h = i / 192, idx = i % 192; tb[i] = (p.in[2][t5_bucket(idx - 128) * 16 + h] - p.in[2][15 * 16 + h]) * LOG2E; }
        else sp8[i - 16 * 192] = 8.f * log1pf(expf(-p.in[20][i - 16 * 192]));
    }
}

DI void phase_rmsnorm(const float* x, const float* g, bf16_t* out) {
    const int tid = otid(), lane = tid & 63, gw = blockIdx.x * 8 + (tid >> 6), nw = gridDim.x * 8;
    for (int row = gw; row < MTOK; row += nw) {
        const f32x4* xr = (const f32x4*)(x + (size_t)row * DM); f32x4 v[8]; float ss = 0.f;
#pragma unroll
        for (int i = 0; i < 4; ++i) { v[2 * i] = xr[i * 128 + lane * 2]; v[2 * i + 1] = xr[i * 128 + lane * 2 + 1]; }
#pragma unroll
        for (int i = 0; i < 8; ++i) ss += v[i][0] * v[i][0] + v[i][1] * v[i][1] + v[i][2] * v[i][2] + v[i][3] * v[i][3];
        ss = wsum(ss); const float sc = rsqrtf(ss * (1.f / DM) + EPS);
#pragma unroll
        for (int i = 0; i < 4; ++i) { const int c = i * 512 + lane * 8; const f32x4 g0 = *(const f32x4*)(g + c), g1 = *(const f32x4*)(g + c + 4);
            u32x4 w; w.x = pk2(v[2 * i][0] * sc * g0[0], v[2 * i][1] * sc * g0[1]); w.y = pk2(v[2 * i][2] * sc * g0[2], v[2 * i][3] * sc * g0[3]);
            w.z = pk2(v[2 * i + 1][0] * sc * g1[0], v[2 * i + 1][1] * sc * g1[1]); w.w = pk2(v[2 * i + 1][2] * sc * g1[2], v[2 * i + 1][3] * sc * g1[3]);
            *(u32x4*)(out + (size_t)row * DM + c) = w; }
    }
}

DI void phase_qknorm_a(const Params& p) {
    bf16_t* big = (bf16_t*)(p.ws + ACT); const float* qkg = p.in[4];
    const int tid = otid(), lane = tid & 63, gw = blockIdx.x * 8 + (tid >> 6), nw = gridDim.x * 8;
    float gq[8], gk[8];
#pragma unroll
    for (int e = 0; e < 8; ++e) { gq[e] = qkg[(lane & 7) * 8 + e] * (0.125f * LOG2E); gk[e] = qkg[64 + (lane & 7) * 8 + e]; }
    for (int row = gw; row < MTOK; row += nw) {
#pragma unroll
        for (int i = 0; i < 8; ++i) {
            bf16_t* ptr = big + (size_t)row * 8192 + i * 512 + lane * 8; float f[8]; unpack8(*(const u32x4*)ptr, f);
            float ss = 0.f;
#pragma unroll
            for (int e = 0; e < 8; ++e) ss += f[e] * f[e];
            ss += __shfl_xor(ss, 1); ss += __shfl_xor(ss, 2); ss += __shfl_xor(ss, 4);
            const float sc = rsqrtf(ss * (1.f / 64.f) + EPS);
#pragma unroll
            for (int e = 0; e < 8; ++e) f[e] = f[e] * sc * (i < 4 ? gq[e] : gk[e]);
            *(u32x4*)ptr = pack8(f);
        }
    }
}

template <int DQK, int KA8, int DV, bool BIAS, bool JOINT>
DI void attn_core(LAS unsigned char* lds, const bf16_t* Qrow, const bf16_t* KpA, int ldkA, const bf16_t* KpB, int ldkB, const bf16_t* Vp, int ldv,
                  int qb, int wid, int lane, const float* qng  , f32x16 (&O)[DV / 32]) {
    constexpr int KROW = DQK * 2 + 16, VROW = DV * 2 + 64  , KC = DQK / 8, VC = DV / 8, NKC = 64 * KC, NVC = 64 * VC, NL = (NKC + NVC) / 512, STG = 64 * (KROW + VROW);
    static_assert(NKC % 512 == 0 && NVC % 512 == 0, "loader split");
    const int tid = otid(), l32 = lane & 31, hh = lane >> 5, i16 = lane & 15, tq = i16 >> 2, tp = i16 & 3, blk = (lane >> 4) & 1;
    const int q0w = qb * 256 + wid * 32, nkt = 4 * qb + 4, myc = q0w >> 6;
    bf16x8 qf[DQK / 16];
#pragma unroll
    for (int s = 0; s < DQK / 16; ++s) qf[s] = *(const bf16x8*)(Qrow + 16 * s + 8 * hh);
    if constexpr (DQK == 192) {
        if (qng) {
            float ssn = 0.f, ssr = 0.f;
#pragma unroll
            for (int s = 0; s < 12; ++s) { float f[8]; unpack8(__builtin_bit_cast(u32x4, qf[s]), f); float t = 0.f;
#pragma unroll
                for (int e = 0; e < 8; ++e) t += f[e] * f[e];
                if (s < 8) ssn += t; else ssr += t; }
            ssn += __shfl_xor(ssn, 32); ssr += __shfl_xor(ssr, 32);
            const float qs = 0.07216878364870322f * LOG2E, scn = rsqrtf(ssn * (1.f / 128.f) + EPS) * qs, scr = rsqrtf(ssr * (1.f / 64.f) + EPS) * qs;
#pragma unroll
            for (int s = 0; s < 8; ++s) { float f[8]; unpack8(__builtin_bit_cast(u32x4, qf[s]), f);
                const f32x4 g0 = *(const f32x4*)(qng + 16 * s + 8 * hh), g1 = *(const f32x4*)(qng + 16 * s + 8 * hh + 4);
#pragma unroll
                for (int e = 0; e < 4; ++e) { f[e] *= scn * g0[e]; f[4 + e] *= scn * g1[e]; }
                qf[s] = __builtin_bit_cast(bf16x8, pack8(f)); }
            const float posr = (float)(qb * 256 + wid * 32 + l32) * 0.15915494309189535f;
#pragma unroll
            for (int s = 8; s < 10; ++s) { float f1[8], f2[8]; unpack8(__builtin_bit_cast(u32x4, qf[s]), f1); unpack8(__builtin_bit_cast(u32x4, qf[s + 2]), f2);
#pragma unroll
                for (int e = 0; e < 8; ++e) { const int i = 16 * (s - 8) + 8 * hh + e;
                    const float a1 = f1[e] * scr * qng[128 + i], a2 = f2[e] * scr * qng[160 + i];
                    float rev = posr * __builtin_amdgcn_exp2f(-(float)i * 0.41524101186092029f); rev -= floorf(rev);
                    const float sn = __builtin_amdgcn_sinf(rev), cs = __builtin_amdgcn_cosf(rev);
                    f1[e] = a1 * cs - a2 * sn; f2[e] = a2 * cs + a1 * sn; }
                qf[s] = __builtin_bit_cast(bf16x8, pack8(f1)); qf[s + 2] = __builtin_bit_cast(bf16x8, pack8(f2)); }
            __builtin_amdgcn_sched_barrier(0);
        }
    }
    float m = 0.f, l = 0.f; bool mnz = false;
#pragma unroll
    for (int dt = 0; dt < DV / 32; ++dt)
#pragma unroll
        for (int i = 0; i < 16; ++i) O[dt][i] = 0.f;
    u32x4 stg[NL];
    LAS const float* btab = (LAS const float*)(lds + 2 * STG);
    const unsigned koff = l32 * KROW + 16 * hh, vtr = (4 * hh + tq) * VROW + (16 * blk + 4 * tp) * 2;

    auto gload = [&](int kt) {
#pragma unroll
        for (int i = 0; i < NL; ++i) { const int c = tid + i * 512;
            if (i * 512 < NKC) { const int row = c / KC, cc = c % KC;
                const bf16_t* src = (cc < KA8) ? KpA + (size_t)(kt * 64 + row) * ldkA + cc * 8 : KpB + (size_t)(kt * 64 + row) * ldkB + (cc - KA8) * 8;
                stg[i] = *(const u32x4*)src; }
            else { const int c2 = c - NKC, row = c2 / VC, cc = c2 % VC; stg[i] = *(const u32x4*)(Vp + (size_t)(kt * 64 + row) * ldv + cc * 8); } }
    };
    auto lstore = [&](int buf) {
#pragma unroll
        for (int i = 0; i < NL; ++i) { const int c = tid + i * 512;
            if (i * 512 < NKC) { const int row = c / KC, cc = c % KC; *(LAS u32x4*)(lds + buf * STG + row * KROW + cc * 16) = stg[i]; }
            else { const int c2 = c - NKC, row = c2 / VC, cc = c2 % VC; *(LAS u32x4*)(lds + buf * STG + 64 * KROW + row * VROW + cc * 16) = stg[i]; } }
    };

    gload(0); lstore(0); __syncthreads();
    for (int kt = 0; kt < nkt; ++kt) {
        if (kt + 1 < nkt) gload(kt + 1);
        if (JOINT && kt <= myc) {
            LAS unsigned char* kb = lds + (kt & 1) * STG; LAS unsigned char* vb = kb + 64 * KROW;
            const bool far = (kt * 64 + 63 - q0w <= -91);
            f32x16 S0, S1;
#pragma unroll
            for (int i = 0; i < 16; ++i) { S0[i] = 0.f; S1[i] = 0.f; }
#pragma unroll
            for (int s = 0; s < DQK / 16; ++s) {
                const bf16x8 k0 = *(LAS const bf16x8*)(kb + koff + 32 * s), k1 = *(LAS const bf16x8*)(kb + koff + 32 * KROW + 32 * s);
                S0 = mfma32(k0, qf[s], S0); S1 = mfma32(k1, qf[s], S1);
            }
            if (BIAS && !far) {
                const int rb = kt * 64 - (q0w + l32) + 128;
#pragma unroll
                for (int i = 0; i < 16; ++i) { const int i0 = rb + crow(i, hh); S0[i] += btab[i0 < 0 ? 0 : i0]; S1[i] += btab[i0 + 32 < 0 ? 0 : i0 + 32]; }
            }
            if (mnz) {
#pragma unroll
                for (int i = 0; i < 16; ++i) { S0[i] -= m; S1[i] -= m; }
            }
            float mx = fmaxf(S0[0], S1[0]);
#pragma unroll
            for (int i = 1; i < 16; ++i) mx = fmaxf(mx, fmaxf(S0[i], S1[i]));
            mx = fmaxf(mx, __shfl_xor(mx, 32));
            if (__any(mx > 64.f || (kt == 0 && mx < -64.f))) {
                const float dm = (mx > 64.f || (kt == 0 && mx < -64.f)) ? mx : 0.f, alpha = __builtin_amdgcn_exp2f(-dm); m += dm; mnz = true;
                l *= alpha;
#pragma unroll
                for (int dt = 0; dt < DV / 32; ++dt) O[dt] *= alpha;
#pragma unroll
                for (int i = 0; i < 16; ++i) { S0[i] -= dm; S1[i] -= dm; }
            }
            float ps = 0.f;
#pragma unroll
            for (int i = 0; i < 16; ++i) { S0[i] = __builtin_amdgcn_exp2f(S0[i]); S1[i] = __builtin_amdgcn_exp2f(S1[i]); ps += S0[i] + S1[i]; }
            l += ps;
#pragma unroll
            for (int half = 0; half < 2; ++half)
#pragma unroll
                for (int s = 0; s < 2; ++s) {
                    const f32x16& S = half ? S1 : S0;
                    u32x4 pw; pw.x = pk2(S[8 * s], S[8 * s + 1]); pw.y = pk2(S[8 * s + 2], S[8 * s + 3]); pw.z = pk2(S[8 * s + 4], S[8 * s + 5]); pw.w = pk2(S[8 * s + 6], S[8 * s + 7]);
                    const bf16x8 pf = __builtin_bit_cast(bf16x8, pw);
                    LAS unsigned char* vr = vb + vtr + (32 * half + 16 * s) * VROW;
#pragma unroll
                    for (int dt = 0; dt < DV / 32; ++dt) {
                        const bf16x8 vf = cat4(trread(vr + 64 * dt), trread(vr + 8 * VROW + 64 * dt));
                        O[dt] = mfma32(vf, pf, O[dt]);
                    }
                }
        }
        if (!JOINT && kt <= myc) {
            LAS unsigned char* kb = lds + (kt & 1) * STG; LAS unsigned char* vb = kb + 64 * KROW;
            const bool far = (kt * 64 + 63 - q0w <= -91);
#pragma unroll 1
            for (int half = 0; half < 2; ++half) {
                f32x16 S;
#pragma unroll
                for (int i = 0; i < 16; ++i) S[i] = 0.f;
#pragma unroll
                for (int s = 0; s < DQK / 16; ++s) {
                    const bf16x8 kf = *(LAS const bf16x8*)(kb + koff + 32 * half * KROW + 32 * s);
                    S = mfma32(kf, qf[s], S);
                }
                if (BIAS && !far) {
                    const int rb = kt * 64 + 32 * half - (q0w + l32) + 128;
#pragma unroll
                    for (int i = 0; i < 16; ++i) { const int i0 = rb + crow(i, hh); S[i] += btab[i0 < 0 ? 0 : i0]; }
                }
                if (mnz) {
#pragma unroll
                    for (int i = 0; i < 16; ++i) S[i] -= m;
                }
                float mx = S[0];
#pragma unroll
                for (int i = 1; i < 16; ++i) mx = fmaxf(mx, S[i]);
                mx = fmaxf(mx, __shfl_xor(mx, 32));
                const bool first = (kt == 0 && half == 0);
                if (__any(mx > 64.f || (first && mx < -64.f))) {
                    const float dm = (mx > 64.f || (first && mx < -64.f)) ? mx : 0.f, alpha = __builtin_amdgcn_exp2f(-dm); m += dm; mnz = true;
                    l *= alpha;
#pragma unroll
                    for (int dt = 0; dt < DV / 32; ++dt) O[dt] *= alpha;
#pragma unroll
                    for (int i = 0; i < 16; ++i) S[i] -= dm;
                }
                float ps = 0.f;
#pragma unroll
                for (int i = 0; i < 16; ++i) { S[i] = __builtin_amdgcn_exp2f(S[i]); ps += S[i]; }
                l += ps;
#pragma unroll
                for (int s = 0; s < 2; ++s) {
                    u32x4 pw; pw.x = pk2(S[8 * s], S[8 * s + 1]); pw.y = pk2(S[8 * s + 2], S[8 * s + 3]); pw.z = pk2(S[8 * s + 4], S[8 * s + 5]); pw.w = pk2(S[8 * s + 6], S[8 * s + 7]);
                    const bf16x8 pf = __builtin_bit_cast(bf16x8, pw);
                    LAS unsigned char* vr = vb + vtr + (32 * half + 16 * s) * VROW;
#pragma unroll
                    for (int dt = 0; dt < DV / 32; ++dt) {
                        const bf16x8 vf = cat4(trread(vr + 64 * dt), trread(vr + 8 * VROW + 64 * dt));
                        O[dt] = mfma32(vf, pf, O[dt]);
                    }
                }
            }
        }
        if (kt + 1 < nkt) lstore((kt + 1) & 1);
        __syncthreads();
    }
    l += __shfl_xor(l, 32);
    const float il = 1.f / l;
#pragma unroll
    for (int dt = 0; dt < DV / 32; ++dt) O[dt] *= il;
}

DI void phase_attn_a(const Params& p, LAS unsigned char* lds) {
    const bf16_t* big = (const bf16_t*)(p.ws + ACT); bf16_t* y = (bf16_t*)(p.ws + HBUF); const float* tbg = (const float*)(p.ws + X_BIAS);
    const int tid = otid(), wid = tid >> 6, lane = tid & 63, l32 = lane & 31, hh = lane >> 5;
    constexpr int STG = 64 * (64 * 2 + 16 + 128 * 2 + 64);
    float d0 = 0.f, d1 = 0.f;
    for (int i = 0; i < 64; ++i) { d0 += p.in[5][i] * p.in[5][64 + i]; d1 += p.in[5][128 + i] * p.in[5][192 + i]; }
    const float lam_init = 0.2f, lam = __expf(d0) - __expf(d1) + lam_init;
    for (int pr = blockIdx.x; pr < 512; pr += gridDim.x) {
        const int bi = pr & 255, bh = (gridDim.x == 256) ? (bi & 7) + 8 * (bi >> 6) + 32 * (pr >> 8) : pr >> 3, j = (gridDim.x == 256) ? (bi >> 3) & 7 : pr & 7, b = bh >> 4, h = bh & 15;
        for (int half = 0; half < 2; ++half) {
            const int qb = half ? 15 - j : j;
            __syncthreads();
            if (tid < 192) ((LAS float*)(lds + 2 * STG))[tid] = tbg[h * 192 + tid];
            const size_t tok0 = (size_t)b * SEQ, tokq = tok0 + qb * 256 + wid * 32 + l32;
            f32x16 Oa[4]; LAS unsigned* Op = (LAS unsigned*)(lds + 2 * STG + 1024) + wid * 2048 + lane;
            attn_core<64, 8, 128, true, true>(lds, big + tokq * 8192 + h * 128, big + tok0 * 8192 + 2048 + h * 128, 8192, nullptr, 0, big + tok0 * 8192 + 4096 + h * 128, 8192, qb, wid, lane, nullptr, Oa);
#pragma unroll
            for (int dt = 0; dt < 4; ++dt)
#pragma unroll
                for (int i = 0; i < 8; ++i) Op[(dt * 8 + i) * 64] = pk2(Oa[dt][2 * i], Oa[dt][2 * i + 1]);
            attn_core<64, 8, 128, true, true>(lds, big + tokq * 8192 + h * 128 + 64, big + tok0 * 8192 + 2048 + h * 128 + 64, 8192, nullptr, 0, big + tok0 * 8192 + 4096 + h * 128, 8192, qb, wid, lane, nullptr, Oa);
            float ss = 0.f;
#pragma unroll
            for (int dt = 0; dt < 4; ++dt)
#pragma unroll
                for (int i = 0; i < 16; ++i) { const unsigned ow = Op[(dt * 8 + (i >> 1)) * 64]; const float o0 = (i & 1) ? __uint_as_float(ow & 0xffff0000u) : __uint_as_float(ow << 16);
                    const float o = o0 - lam * Oa[dt][i]; Oa[dt][i] = o; ss += o * o; }
            ss += __shfl_xor(ss, 32);
            const float sc = rsqrtf(ss * (1.f / 128.f) + EPS) * (1.f - lam_init);
#pragma unroll
            for (int dt = 0; dt < 4; ++dt)
#pragma unroll
                for (int g4 = 0; g4 < 4; ++g4) { const int dv = 32 * dt + 8 * g4 + 4 * hh;
                    const u32x2 gw = *(const u32x2*)(big + tokq * 8192 + 6144 + h * 128 + dv);
                    const f32x4 sg = *(const f32x4*)(p.in[6] + dv);
                    const float g0 = __uint_as_float(gw.x << 16), g1 = __uint_as_float(gw.x & 0xffff0000u), g2 = __uint_as_float(gw.y << 16), g3 = __uint_as_float(gw.y & 0xffff0000u);
                    u32x2 w; w.x = pk2(Oa[dt][4 * g4] * sc * sg[0] * silu(g0), Oa[dt][4 * g4 + 1] * sc * sg[1] * silu(g1));
                    w.y = pk2(Oa[dt][4 * g4 + 2] * sc * sg[2] * silu(g2), Oa[dt][4 * g4 + 3] * sc * sg[3] * silu(g3));
                    *(u32x2*)(y + tokq * DM + h * 128 + dv) = w; }
        }
    }
}

DI void phase_attn_d(const Params& p, LAS unsigned char* lds) {
    const bf16_t* qkv = (const bf16_t*)(p.ws + ACT); const bf16_t* lat = (const bf16_t*)(p.ws + LAT); const bf16_t* gb = (const bf16_t*)(p.ws + HBUF);
    bf16_t* y = (bf16_t*)(p.ws + HBUF);
    for (int pr = blockIdx.x; pr < 512; pr += gridDim.x) {
        const int bi = pr & 255, bh = (gridDim.x == 256) ? (bi & 7) + 8 * (bi >> 6) + 32 * (pr >> 8) : pr >> 3, j = (gridDim.x == 256) ? (bi >> 3) & 7 : pr & 7, b = bh >> 4, h = bh & 15;
        for (int half = 0; half < 2; ++half) {
            const int qb = half ? 15 - j : j;
            __syncthreads();
            const int tid = otid(), wid = tid >> 6, lane = tid & 63, l32 = lane & 31;
            const size_t tok0 = (size_t)b * SEQ, tokq = tok0 + qb * 256 + wid * 32 + l32;
            f32x16 O[4];
            attn_core<192, 16, 128, false, true>(lds, qkv + tokq * 7168 + h * 192, qkv + tok0 * 7168 + 3072 + h * 256, 7168, lat + tok0 * 1088 + 1024, 1088,
                                           qkv + tok0 * 7168 + 3072 + h * 256 + 128, 7168, qb, wid, lane, p.in[27], O);
            const int tid2 = otid(), wid2 = tid2 >> 6, lane2 = tid2 & 63;
            const size_t tokq2 = (size_t)b * SEQ + qb * 256 + wid2 * 32 + (lane2 & 31); const int hh2 = lane2 >> 5;
#pragma unroll
            for (int dt = 0; dt < 4; ++dt)
#pragma unroll
                for (int g4 = 0; g4 < 4; ++g4) { const int dv = 32 * dt + 8 * g4 + 4 * hh2;
                    const u32x2 gw = *(const u32x2*)(gb + tokq2 * DM + h * 128 + dv);
                    const float g0 = __uint_as_float(gw.x << 16), g1 = __uint_as_float(gw.x & 0xffff0000u), g2 = __uint_as_float(gw.y << 16), g3 = __uint_as_float(gw.y & 0xffff0000u);
                    u32x2 w; w.x = pk2(O[dt][4 * g4] * silu(g0), O[dt][4 * g4 + 1] * silu(g1)); w.y = pk2(O[dt][4 * g4 + 2] * silu(g2), O[dt][4 * g4 + 3] * silu(g3));
                    *(u32x2*)(y + tokq2 * DM + h * 128 + dv) = w; }
        }
    }
}

DI void phase_gla_prep(const Params& p, LAS unsigned char* lds) {
    bf16_t* big = (bf16_t*)(p.ws + ACT); float* total = (float*)(p.ws + GLA_TOT);
    LAS float* lrs = (LAS float*)lds;
    const int tid = otid(), ch0 = tid * 2;
    float wg0[16], wg1[16];
#pragma unroll
    for (int r = 0; r < 16; ++r) { wg0[r] = p.in[9][r * 1024 + ch0]; wg1[r] = p.in[9][r * 1024 + ch0 + 1]; }
    const float bs0 = p.in[10][ch0], bs1 = p.in[10][ch0 + 1];
    for (int u = blockIdx.x; u < 256; u += gridDim.x) {
        const size_t tokb = (size_t)u * 64;
        __syncthreads();
        {
            LAS bf16_t* wl = (LAS bf16_t*)(lds + 8192);
            LAS float* part = (LAS float*)(lds + 4096);
            const bf16_t* wsrc = (const bf16_t*)(p.ws + W_B_IN) + (size_t)6144 * 2048;
#pragma unroll
            for (int i = 0; i < 8; ++i) { const int c = tid + i * 512; *(LAS u32x4*)(wl + (c >> 8) * 2056 + (c & 255) * 8) = *(const u32x4*)(wsrc + (size_t)c * 8); }
            __syncthreads();
            const int w = tid >> 6, lane = tid & 63, i16 = lane & 15, quad = lane >> 4, mt = w & 3, kh = w >> 2;
            const bf16_t* xr = (const bf16_t*)(p.ws + XG) + (tokb + 16 * mt + i16) * DM + kh * 1024 + 8 * quad;
            f32x4 acc = {0.f, 0.f, 0.f, 0.f};
#pragma unroll 8
            for (int ks = 0; ks < 32; ++ks) {
                const bf16x8 a = *(const bf16x8*)(xr + 32 * ks);
                const bf16x8 bb = *(LAS const bf16x8*)(wl + i16 * 2056 + kh * 1024 + 32 * ks + 8 * quad);
                acc = __builtin_amdgcn_mfma_f32_16x16x32_bf16(a, bb, acc, 0, 0, 0);
            }
            if (kh == 1) {
#pragma unroll
                for (int j = 0; j < 4; ++j) part[(16 * mt + 4 * quad + j) * 16 + i16] = acc[j]; }
            __syncthreads();
            if (kh == 0) {
#pragma unroll
                for (int j = 0; j < 4; ++j) { const int tok = 16 * mt + 4 * quad + j;
                    const float rs = rsqrtf(((const float*)(p.ws + X_SSQ))[tokb + tok] * (1.f / DM) + EPS);
                    lrs[tok * 16 + i16] = (acc[j] + part[tok * 16 + i16]) * rs; } }
        }
        __syncthreads();
        float t0 = 0.f, t1 = 0.f;
        for (int tok = 63; tok >= 0; --tok) {
            float z0 = bs0, z1 = bs1;
#pragma unroll
            for (int r = 0; r < 16; ++r) { const float lv = lrs[tok * 16 + r]; z0 += lv * wg0[r]; z1 += lv * wg1[r]; }
            unsigned* kp = (unsigned*)(big + (tokb + tok) * 6400 + 1024 + ch0); const unsigned w = *kp;
            *kp = pk2(__uint_as_float(w << 16) * __expf(t0), __uint_as_float(w & 0xffff0000u) * __expf(t1));
            t0 += (fminf(z0, 0.f) - __logf(1.f + __expf(-fabsf(z0)))) * (1.f / 16.f); t1 += (fminf(z1, 0.f) - __logf(1.f + __expf(-fabsf(z1)))) * (1.f / 16.f);
        }
        total[(size_t)u * 1024 + ch0] = t0; total[(size_t)u * 1024 + ch0 + 1] = t1;
    }
}

DI void phase_gla_scan(const Params& p, LAS unsigned char* lds) {
    const bf16_t* big = (const bf16_t*)(p.ws + ACT); const float* total = (const float*)(p.ws + GLA_TOT); bf16_t* ob = (bf16_t*)(p.ws + HBUF);
    constexpr int KR = 576, VR = 64, SR = 528, SET = 64 * KR + 64 * VR + 1024  , ST_OFF = 2 * SET, STB = 32 * SR;
    const int tid = otid(), w = tid >> 6, lane = tid & 63, l32 = lane & 31, hh = lane >> 5, i16 = lane & 15, tq = i16 >> 2, tp = i16 & 3, blk = (lane >> 4) & 1, quad = lane >> 4;
    const int mt = w >> 1, nt = w & 1;
    for (int u = blockIdx.x; u < 256; u += gridDim.x) {
        const int ux = (gridDim.x == 256) ? ((u & 7) * 2 + (u >> 7)) * 16 + ((u >> 3) & 15) : u;
        const int b = ux >> 6, h = (ux >> 4) & 3, vs = ux & 15;
        const size_t tok0 = (size_t)b * SEQ;
        f32x16 st;
#pragma unroll
        for (int i = 0; i < 16; ++i) st[i] = 0.f;
        u32x4 rkA[4], rvA, rkB[4], rvB; float rtA = 0.f, rtB = 0.f; bf16x8 qa[8], qn[8];
        rvA = (u32x4){0u, 0u, 0u, 0u}; rvB = rvA;
        unsigned offk[4];
#pragma unroll
        for (int i = 0; i < 4; ++i) { const int idx = tid + i * 512, row = idx >> 5, cc = idx & 31; offk[i] = (unsigned)((row * 6400 + 1024 + h * 256 + cc * 8) * 2); }
        const unsigned offv = (unsigned)(((tid >> 2) * 6400 + 2048 + h * 512 + vs * 32 + (tid & 3) * 8) * 2);
        const unsigned offq = (unsigned)(((16 * mt + i16) * 6400 + h * 256 + 8 * quad) * 2);
        auto gload = [&](int c, u32x4 (&rk)[4], u32x4& rv, float& rt) {
            const char* cb = (const char*)(big + (tok0 + (size_t)c * 64) * 6400);
#pragma unroll
            for (int i = 0; i < 4; ++i) rk[i] = *(const u32x4*)(cb + offk[i]);
            if (tid < 256) { rv = *(const u32x4*)(cb + offv); rt = total[(size_t)(b * 64 + c) * 1024 + h * 256 + tid]; }
        };
        auto lstore = [&](int buf, const u32x4 (&rk)[4], const u32x4& rv, const float& rt) {
            LAS unsigned char* sb = lds + buf * SET;
#pragma unroll
            for (int i = 0; i < 4; ++i) { const int idx = tid + i * 512, row = idx >> 5, cc = idx & 31; *(LAS u32x4*)(sb + row * KR + cc * 16) = rk[i]; }
            if (tid < 256) { const int row = tid >> 2, cc = tid & 3; *(LAS u32x4*)(sb + 64 * KR + row * VR + cc * 16) = rv; ((LAS float*)(sb + 64 * KR + 64 * VR))[tid] = __expf(rt); }
        };
        auto qload = [&](int c, bf16x8 (&q)[8]) {
            const char* cb = (const char*)(big + (tok0 + (size_t)c * 64) * 6400) + offq;
#pragma unroll
            for (int ks = 0; ks < 8; ++ks) q[ks] = *(const bf16x8*)(cb + 64 * ks);
        };
        auto step = [&](int c, const bf16x8 (&qc)[8]) {
            LAS unsigned char* sb = lds + (c & 1) * SET; LAS unsigned char* stb = lds + ST_OFF + (c & 1) * STB;
#pragma unroll
            for (int g = 0; g < 4; ++g) { const f32x4 e = *(LAS const f32x4*)(sb + 64 * KR + 64 * VR + (32 * w + 8 * g + 4 * hh) * 4);
                st[4 * g] *= e[0]; st[4 * g + 1] *= e[1]; st[4 * g + 2] *= e[2]; st[4 * g + 3] *= e[3]; }
#pragma unroll
            for (int sx = 0; sx < 4; ++sx) {
                LAS unsigned char* ka = sb + (16 * sx + 8 * hh + tq) * KR + (32 * w + 16 * blk + 4 * tp) * 2;
                LAS unsigned char* va = sb + 64 * KR + (16 * sx + 8 * hh + tq) * VR + (16 * blk + 4 * tp) * 2;
                const bf16x8 af = cat4(trread(ka), trread(ka + 4 * KR)), bfv = cat4(trread(va), trread(va + 4 * VR));
                st = mfma32(af, bfv, st);
            }
#pragma unroll
            for (int g = 0; g < 4; ++g) { u32x2 wv; wv.x = pk2(st[4 * g], st[4 * g + 1]); wv.y = pk2(st[4 * g + 2], st[4 * g + 3]);
                *(LAS u32x2*)(stb + l32 * SR + (32 * w + 8 * g + 4 * hh) * 2) = wv; }
            asm volatile("s_waitcnt lgkmcnt(0)" ::: "memory");
            __builtin_amdgcn_s_barrier();
            asm volatile("" ::: "memory");
            f32x4 acc = {0.f, 0.f, 0.f, 0.f};
#pragma unroll
            for (int ks = 0; ks < 8; ++ks) {
                const bf16x8 bb = *(LAS const bf16x8*)(stb + (16 * nt + i16) * SR + (32 * ks + 8 * quad) * 2);
                acc = __builtin_amdgcn_mfma_f32_16x16x32_bf16(qc[ks], bb, acc, 0, 0, 0);
            }
#pragma unroll
            for (int jj = 0; jj < 4; ++jj) ob[(tok0 + c * 64 + 16 * mt + quad * 4 + jj) * DM + h * 512 + vs * 32 + 16 * nt + i16] = f2bf(acc[jj] * (1.f / 16.f));
        };
        __syncthreads();
        gload(0, rkA, rvA, rtA); lstore(0, rkA, rvA, rtA);
        gload(1, rkA, rvA, rtA); gload(2, rkB, rvB, rtB); qload(0, qa); qload(1, qn);
        __syncthreads();
        for (int c = 0; c < 64; c += 2) {
            lstore((c + 1) & 1, rkA, rvA, rtA);
            if (c + 3 < 64) gload(c + 3, rkA, rvA, rtA);
            step(c, qa);
            if (c + 2 < 64) qload(c + 2, qa);
            if (c + 2 < 64) lstore(c & 1, rkB, rvB, rtB);
            if (c + 4 < 64) gload(c + 4, rkB, rvB, rtB);
            step(c + 1, qn);
            if (c + 3 < 64) qload(c + 3, qn);
        }
    }
}

DI void phase_gla_post(const Params& p) {
    const bf16_t* big = (const bf16_t*)(p.ws + ACT); bf16_t* y = (bf16_t*)(p.ws + HBUF);
    const int tid = otid(), lane = tid & 63, gw = blockIdx.x * 8 + (tid >> 6), nw = gridDim.x * 8;
    float og[8];
#pragma unroll
    for (int e = 0; e < 8; ++e) og[e] = p.in[11][lane * 8 + e];
    for (int row = gw; row < MTOK; row += 2 * nw) {
        u32x4 wo[2][4], wg[2][4]; bool ok[2]; size_t rr[2];
#pragma unroll
        for (int r = 0; r < 2; ++r) { ok[r] = row + r * nw < MTOK; rr[r] = ok[r] ? (size_t)(row + r * nw) : (size_t)row;
#pragma unroll
            for (int hd = 0; hd < 4; ++hd) { wo[r][hd] = *(const u32x4*)(y + rr[r] * DM + hd * 512 + lane * 8); wg[r][hd] = *(const u32x4*)(big + rr[r] * 6400 + 4096 + hd * 512 + lane * 8); } }
#pragma unroll
        for (int r = 0; r < 2; ++r)
#pragma unroll
            for (int hd = 0; hd < 4; ++hd) {
                float f[8], g[8]; unpack8(wo[r][hd], f); unpack8(wg[r][hd], g);
                float ss = 0.f;
#pragma unroll
                for (int e = 0; e < 8; ++e) ss += f[e] * f[e];
                ss = wsum(ss); const float sc = rsqrtf(ss * (1.f / 512.f) + EPS);
#pragma unroll
                for (int e = 0; e < 8; ++e) f[e] = f[e] * sc * og[e] * silu(g[e]);
                if (ok[r]) *(u32x4*)(y + rr[r] * DM + hd * 512 + lane * 8) = pack8(f);
            }
    }
}

DI void phase_conv(const Params& p) {
    const bf16_t* big = (const bf16_t*)(p.ws + ACT); bf16_t* xc = (bf16_t*)(p.ws + HBUF);
    for (size_t idx = (size_t)blockIdx.x * 512 + otid(); idx < (size_t)(MTOK / 8) * 256; idx += (size_t)gridDim.x * 512) {
        const int tok0 = (int)(idx >> 8) * 8, ch = (int)(idx & 255) * 8, t0 = tok0 & (SEQ - 1);
        float wv[4][8], bs[8];
        { const f32x4 b0 = *(const f32x4*)(p.in[15] + ch), b1 = *(const f32x4*)(p.in[15] + ch + 4);
#pragma unroll
          for (int e = 0; e < 4; ++e) { bs[e] = b0[e]; bs[4 + e] = b1[e]; } }
#pragma unroll
        for (int jx = 0; jx < 4; ++jx) { const f32x4 w0 = *(const f32x4*)(p.in[14] + jx * 2048 + ch), w1 = *(const f32x4*)(p.in[14] + jx * 2048 + ch + 4);
#pragma unroll
            for (int e = 0; e < 4; ++e) { wv[jx][e] = w0[e]; wv[jx][4 + e] = w1[e]; } }
        u32x4 raw[11];
#pragma unroll
        for (int r = 0; r < 11; ++r) raw[r] = (r >= 3 || t0 > 0) ? *(const u32x4*)(big + (size_t)(tok0 - 3 + r) * 4096 + ch) : (u32x4){0u, 0u, 0u, 0u};
#pragma unroll
        for (int o = 0; o < 8; ++o) {
            float acc[8];
#pragma unroll
            for (int e = 0; e < 8; ++e) acc[e] = bs[e];
#pragma unroll
            for (int jx = 0; jx < 4; ++jx) { float f[8]; unpack8(raw[o + jx], f);
#pragma unroll
                for (int e = 0; e < 8; ++e) acc[e] += f[e] * wv[jx][e]; }
            *(u32x4*)(xc + (size_t)(tok0 + o) * DM + ch) = pack8(acc);
        }
    }
}
DI void phase_lru_scan(const Params& p, LAS unsigned char* lds) {
    const unsigned* ax = (const unsigned*)(p.ws + ACT + 128 * MiB); const bf16_t* big = (const bf16_t*)(p.ws + ACT);
    bf16_t* y = (bf16_t*)(p.ws + HBUF);
    LAS unsigned* tile = (LAS unsigned*)lds;
    LAS float* sP = (LAS float*)(lds + 65536); LAS float* sH = sP + 512; LAS float* sC = sH + 512;
    const int tid = otid(), seg = tid >> 5, chl = tid & 31;
    for (int u = blockIdx.x; u < 256; u += gridDim.x) {
        const int b = u >> 6, ch = (u & 63) * 32 + chl;
        const size_t rowbase = (size_t)b * SEQ;
        unsigned pre[32];
#pragma unroll
        for (int i = 0; i < 32; ++i) pre[i] = ax[(rowbase + seg + 16 * i) * DM + ch];
        __syncthreads();
        if (tid < 32) sC[tid] = 0.f;
        for (int sc = 0; sc < 8; ++sc) {
#pragma unroll
            for (int i = 0; i < 32; ++i) tile[(seg + 16 * i) * 32 + chl] = pre[i];
            __syncthreads();
            if (sc + 1 < 8) {
#pragma unroll
                for (int i = 0; i < 32; ++i) pre[i] = ax[(rowbase + (sc + 1) * 512 + seg + 16 * i) * DM + ch];
            }
            float L = 0.f, H = 0.f;
#pragma unroll 8
            for (int t = 0; t < 32; ++t) { const unsigned w = tile[(seg * 32 + t) * 32 + chl]; const float la = __uint_as_float(w << 16); H = __expf(la) * H + __uint_as_float(w & 0xffff0000u); L += la; }
            sP[tid] = __expf(L); sH[tid] = H;
            __syncthreads();
            float hc = sC[chl];
            for (int sg = 0; sg < seg; ++sg) hc = sP[sg * 32 + chl] * hc + sH[sg * 32 + chl];
            const size_t r0 = rowbase + sc * 512 + seg * 32;
#pragma unroll 8
            for (int t = 0; t < 32; ++t) { const unsigned w = tile[(seg * 32 + t) * 32 + chl]; hc = __expf(__uint_as_float(w << 16)) * hc + __uint_as_float(w & 0xffff0000u);
                y[(r0 + t) * DM + ch] = f2bf(hc * silu(bf2f(big[(r0 + t) * 4096 + 2048 + ch]))); }
            __syncthreads();
            if (seg == 15) sC[chl] = hc;
        }
    }
}

DI void phase_mla_lat(const Params& p) {
    bf16_t* lat = (bf16_t*)(p.ws + LAT);
    const int tid = otid(), lane = tid & 63, gw = blockIdx.x * 8 + (tid >> 6), nw = gridDim.x * 8;
    float gq[8], gk[8];
#pragma unroll
    for (int e = 0; e < 8; ++e) { gq[e] = p.in[23][lane * 8 + e]; gk[e] = p.in[24][lane * 8 + e]; }
    const float inv = powf(10000.f, -(float)(lane & 31) * (1.f / 32.f));
    const float g1 = p.in[27][192 + 128 + (lane & 31)], g2 = p.in[27][192 + 160 + (lane & 31)];
    for (int row = gw; row < MTOK; row += nw) {
#pragma unroll
        for (int part = 0; part < 2; ++part) {
            bf16_t* ptr = lat + (size_t)row * 1088 + part * 512 + lane * 8; float f[8]; unpack8(*(const u32x4*)ptr, f);
            float ss = 0.f;
#pragma unroll
            for (int e = 0; e < 8; ++e) ss += f[e] * f[e];
            ss = wsum(ss); const float sc = rsqrtf(ss * (1.f / 512.f) + EPS);
#pragma unroll
            for (int e = 0; e < 8; ++e) f[e] = f[e] * sc * (part ? gk[e] : gq[e]);
            *(u32x4*)ptr = pack8(f);
        }
        { bf16_t* kp = lat + (size_t)row * 1088 + 1024; const int i = lane & 31;
          const float x1 = bf2f(kp[i]), x2 = bf2f(kp[i + 32]);
          float ss = (lane < 32) ? x1 * x1 + x2 * x2 : 0.f; ss = wsum(ss); const float sc = rsqrtf(ss * (1.f / 64.f) + EPS);
          const float a1 = x1 * sc * g1, a2 = x2 * sc * g2; float sn, cs; sincosf((float)(row & (SEQ - 1)) * inv, &sn, &cs);
          if (lane < 32) { kp[i] = f2bf(a1 * cs - a2 * sn); kp[i + 32] = f2bf(a2 * cs + a1 * sn); } }
    }
}
DI void phase_mla_qk(const Params& p) {
    bf16_t* qkv = (bf16_t*)(p.ws + ACT); bf16_t* lat = (bf16_t*)(p.ws + LAT); const float* qkg = p.in[27];
    const int tid = otid(), lane = tid & 63, gw = blockIdx.x * 8 + (tid >> 6), nw = gridDim.x * 8;
    const int l16 = lane & 15, l8 = lane & 7;
    float gk[8], gkr[8];
#pragma unroll
    for (int e = 0; e < 8; ++e) { gk[e] = qkg[192 + l16 * 8 + e]; gkr[e] = qkg[192 + 128 + l8 * 8 + e]; }
    float inv[8];
#pragma unroll
    for (int e = 0; e < 8; ++e) inv[e] = powf(10000.f, -(float)((l8 & 3) * 8 + e) * (1.f / 32.f));
    for (int row0 = gw; row0 < MTOK; row0 += 2 * nw) {
        u32x4 wk[2][4], wp[2]; bool ok[2]; int rw[2];
#pragma unroll
        for (int r = 0; r < 2; ++r) { ok[r] = row0 + r * nw < MTOK; rw[r] = ok[r] ? row0 + r * nw : row0;
            const bf16_t* qr = qkv + (size_t)rw[r] * 7168;
#pragma unroll
            for (int i = 0; i < 4; ++i) { const int head = 4 * i + (lane >> 4); wk[r][i] = *(const u32x4*)(qr + 3072 + head * 256 + l16 * 8); }
            wp[r] = *(const u32x4*)(lat + (size_t)rw[r] * 1088 + 1024 + l8 * 8); }
#pragma unroll
        for (int r = 0; r < 2; ++r) {
            bf16_t* qr = qkv + (size_t)rw[r] * 7168; bf16_t* kpp = lat + (size_t)rw[r] * 1088 + 1024 + l8 * 8;
            const float pos = (float)(rw[r] & (SEQ - 1));
#pragma unroll
            for (int i = 0; i < 4; ++i) {
                const int head = 4 * i + (lane >> 4);
                float f[8]; unpack8(wk[r][i], f); float ss = 0.f;
#pragma unroll
                for (int e = 0; e < 8; ++e) ss += f[e] * f[e];
                ss += __shfl_xor(ss, 1); ss += __shfl_xor(ss, 2); ss += __shfl_xor(ss, 4); ss += __shfl_xor(ss, 8);
                const float sc = rsqrtf(ss * (1.f / 128.f) + EPS);
#pragma unroll
                for (int e = 0; e < 8; ++e) f[e] *= sc * gk[e];
                if (ok[r]) *(u32x4*)(qr + 3072 + head * 256 + l16 * 8) = pack8(f);
            }
            { float f[8], o[8]; unpack8(wp[r], f); float ss = 0.f;
#pragma unroll
              for (int e = 0; e < 8; ++e) ss += f[e] * f[e];
              ss += __shfl_xor(ss, 1); ss += __shfl_xor(ss, 2); ss += __shfl_xor(ss, 4);
              const float sc = rsqrtf(ss * (1.f / 64.f) + EPS);
#pragma unroll
              for (int e = 0; e < 8; ++e) {
                  const float a = f[e] * sc * gkr[e], pa = __shfl_xor(a, 4);
                  float sn, cs; sincosf(pos * inv[e], &sn, &cs);
                  o[e] = (l8 < 4) ? a * cs - pa * sn : a * cs + pa * sn;
              }
              if (ok[r] && lane < 8) *(u32x4*)kpp = pack8(o); }
        }
    }
}

#define XB_TMO      128
#define XB_XCNT(j)  (256  + 64 * (j))
#define XB_XSUB(j)  (1280 + 64 * (j))
#define XB_XGEN(j)  (2304 + 64 * (j))
#define XB_TOP      3328
#define XB_TOPGEN   3392
#define XCD_BAR_WORDS 3456
#define XB_SPIN_CAP (1u << 22)
DI unsigned xb_ld(unsigned* p)              { return __hip_atomic_load(p, __ATOMIC_RELAXED, __HIP_MEMORY_SCOPE_AGENT); }
DI unsigned xb_add(unsigned* p, unsigned v) { return __hip_atomic_fetch_add(p, v, __ATOMIC_RELAXED, __HIP_MEMORY_SCOPE_AGENT); }
DI unsigned xb_xcc_id() { return (unsigned)__builtin_amdgcn_s_getreg((3 << 11) | 20) & 0xFu; }
#define XB_SPIN(cond, bar) do { unsigned _sp = 0; while (cond) { __builtin_amdgcn_s_sleep(1); \
    if ((++_sp & 255u) == 0u) { if (xb_ld(&(bar)[XB_TMO])) break; if (_sp > XB_SPIN_CAP) { atomicAdd(&(bar)[XB_TMO], 1u); break; } } } } while (0)
struct XcdBarrier { unsigned* bar; unsigned x; volatile LAS unsigned* st; };
DI XcdBarrier xcd_barrier_post(unsigned* bar, volatile LAS unsigned* st) {
    XcdBarrier b; b.bar = bar; b.x = xb_xcc_id(); b.st = st;
    if (threadIdx.x == 0) (void)xb_add(&bar[XB_XCNT(b.x)], 1u);
    return b;
}
DI void xcd_barrier_complete(unsigned* bar, unsigned x, unsigned& nloc, unsigned& nx) {
    const unsigned G = gridDim.x * gridDim.y * gridDim.z;
    unsigned sum, cnt, mine, sp = 0u;
    for (;;) {
        sum = 0u; cnt = 0u; mine = 0u;
#pragma unroll
        for (unsigned j = 0; j < 16; ++j) { const unsigned c = xb_ld(&bar[XB_XCNT(j)]); sum += c; cnt += (c > 0u) ? 1u : 0u; mine = (j == x) ? c : mine; }
        if (sum == G) break;
        __builtin_amdgcn_s_sleep(1);
        if ((++sp & 255u) == 0u) { if (xb_ld(&bar[XB_TMO])) break; if (sp > XB_SPIN_CAP) { atomicAdd(&bar[XB_TMO], 1u); break; } }
    }
    nloc = mine > 0u ? mine : 1u; nx = cnt > 0u ? cnt : 1u;
}
DI void xcd_barrier(const XcdBarrier& b0) {
    asm volatile("s_waitcnt vmcnt(0)" ::: "memory");
    __syncthreads();
    if (otid() == 0) {
        XcdBarrier b; b.bar = b0.bar; b.st = b0.st; b.x = xb_xcc_id();
        unsigned* bar = b.bar;
        __builtin_amdgcn_s_waitcnt(0);
        unsigned nloc = b.st[0], nx = b.st[1];
        if (nloc == 0u) { xcd_barrier_complete(bar, b.x, nloc, nx); b.st[0] = nloc; b.st[1] = nx; }
        const unsigned old = xb_add(&bar[XB_XSUB(b.x)], 1u);
        const unsigned gen = old / nloc;
        if (old + 1u == (gen + 1u) * nloc) {
            __builtin_amdgcn_fence(__ATOMIC_RELEASE, "agent");
            asm volatile("s_waitcnt vmcnt(0)" ::: "memory");
            const unsigned og = xb_add(&bar[XB_TOP], 1u);
            const unsigned tg = og / nx;
            if (og + 1u == (tg + 1u) * nx) xb_add(&bar[XB_TOPGEN], 1u);
            else XB_SPIN(xb_ld(&bar[XB_TOPGEN]) == tg, bar);
            __builtin_amdgcn_fence(__ATOMIC_ACQUIRE, "agent");
            xb_add(&bar[XB_XGEN(b.x)], 1u);
            asm volatile("s_waitcnt vmcnt(0)" ::: "memory");
        } else {
            XB_SPIN(xb_ld(&bar[XB_XGEN(b.x)]) == gen, bar);
            __builtin_amdgcn_fence(__ATOMIC_ACQUIRE, "agent");
            asm volatile("s_waitcnt vmcnt(0)" ::: "memory");
        }
    }
    __syncthreads();
}

__global__ __launch_bounds__(512, 2) void mega(const Params p) {
    extern __shared__ __attribute__((aligned(16))) unsigned char shm[];
    LAS unsigned char* lds = (LAS unsigned char*)shm;
    cg::grid_group grid = cg::this_grid();
    volatile LAS unsigned* bst = (volatile LAS unsigned*)(lds + 131072 + 1024);
    if (threadIdx.x == 0) { bst[0] = 0u; bst[1] = 0u; }
    __syncthreads();
    XcdBarrier xb = xcd_barrier_post((unsigned*)(p.ws + WS_BAR), bst); xb.x = 0;
    if constexpr ((PHMASK >> 0) & 1) { phase_convert(p, lds); }
    if constexpr ((REPMASK >> 0) & 1) { __syncthreads(); phase_convert(p, lds); }
    if constexpr ((PHMASK >> 1) & 1) { phase_bias_table(p); }
    if constexpr ((REPMASK >> 1) & 1) { __syncthreads(); phase_bias_table(p); }
    if constexpr ((PHMASK >> 2) & 1) { phase_rmsnorm(p.in[0], p.in[1], (bf16_t*)(uni(p.ws) + HBUF)); }
    if constexpr ((REPMASK >> 2) & 1) { __syncthreads(); phase_rmsnorm(p.in[0], p.in[1], (bf16_t*)(uni(p.ws) + HBUF)); }
    if (p.njobs < 0) grid.sync();
    xcd_barrier(xb);
    if constexpr ((PHMASK >> 3) & 1) { { pg8::EpiStoreA E{(bf16_t*)(uni(p.ws) + ACT), p.in[4]}; run_gemm<0>(lds, (bf16_t*)(uni(p.ws) + HBUF), (const bf16_t*)(uni(p.ws) + W_A_IN), 8192, 2048, 2048, E); } }
    if constexpr ((REPMASK >> 3) & 1) { __syncthreads(); { pg8::EpiStoreA E{(bf16_t*)(uni(p.ws) + ACT), p.in[4]}; run_gemm<0>(lds, (bf16_t*)(uni(p.ws) + HBUF), (const bf16_t*)(uni(p.ws) + W_A_IN), 8192, 2048, 2048, E); } }
    xcd_barrier(xb);
    if constexpr ((PHMASK >> 5) & 1) { phase_attn_a(p, lds); }
    if constexpr ((REPMASK >> 5) & 1) { __syncthreads(); phase_attn_a(p, lds); }
    xcd_barrier(xb);
    if constexpr ((PHMASK >> 6) & 1) { { pg8::EpiResid<false, false, true, true> E{p.in[0], nullptr, nullptr, (bf16_t*)(uni(p.ws) + XG), (float*)(uni(p.ws) + X_SSQ)}; run_gemm<0>(lds, (bf16_t*)(uni(p.ws) + HBUF), (const bf16_t*)(uni(p.ws) + W_A_OUT), 2048, 2048, 2048, E); } }
    if constexpr ((REPMASK >> 6) & 1) { __syncthreads(); { pg8::EpiResid<false, false, true, true> E{p.in[0], nullptr, nullptr, (bf16_t*)(uni(p.ws) + XG), (float*)(uni(p.ws) + X_SSQ)}; run_gemm<0>(lds, (bf16_t*)(uni(p.ws) + HBUF), (const bf16_t*)(uni(p.ws) + W_A_OUT), 2048, 2048, 2048, E); } }
    xcd_barrier(xb);
    if constexpr ((PHMASK >> 8) & 1) { { pg8::EpiStore E{(bf16_t*)(uni(p.ws) + ACT), 6400, (const float*)(uni(p.ws) + X_SSQ)}; run_gemm<0>(lds, (const bf16_t*)(uni(p.ws) + XG), (const bf16_t*)(uni(p.ws) + W_B_IN), 6144, 2048, 2048, E); } }
    if constexpr ((REPMASK >> 8) & 1) { __syncthreads(); { pg8::EpiStore E{(bf16_t*)(uni(p.ws) + ACT), 6400, (const float*)(uni(p.ws) + X_SSQ)}; run_gemm<0>(lds, (const bf16_t*)(uni(p.ws) + XG), (const bf16_t*)(uni(p.ws) + W_B_IN), 6144, 2048, 2048, E); } }
    xcd_barrier(xb);
    if constexpr ((PHMASK >> 9) & 1) { phase_gla_prep(p, lds); }
    if constexpr ((REPMASK >> 9) & 1) { __syncthreads(); phase_gla_prep(p, lds); }
    xcd_barrier(xb);
    if constexpr ((PHMASK >> 10) & 1) { phase_gla_scan(p, lds); }
    if constexpr ((REPMASK >> 10) & 1) { __syncthreads(); phase_gla_scan(p, lds); }
    xcd_barrier(xb);
    if constexpr ((PHMASK >> 11) & 1) { phase_gla_post(p); }
    if constexpr ((REPMASK >> 11) & 1) { __syncthreads(); phase_gla_post(p); }
    xcd_barrier(xb);
    if constexpr ((PHMASK >> 12) & 1) { { pg8::EpiResid<true, false, true, true> E{nullptr, (const bf16_t*)(uni(p.ws) + XG), nullptr, (bf16_t*)(uni(p.ws) + XG), (float*)(uni(p.ws) + X_SSQ) + MTOK}; run_gemm<0>(lds, (bf16_t*)(uni(p.ws) + HBUF), (const bf16_t*)(uni(p.ws) + W_B_OUT), 2048, 2048, 2048, E); } }
    if constexpr ((REPMASK >> 12) & 1) { __syncthreads(); { pg8::EpiResid<true, false, true, true> E{nullptr, (const bf16_t*)(uni(p.ws) + XG), nullptr, (bf16_t*)(uni(p.ws) + XG), (float*)(uni(p.ws) + X_SSQ) + MTOK}; run_gemm<0>(lds, (bf16_t*)(uni(p.ws) + HBUF), (const bf16_t*)(uni(p.ws) + W_B_OUT), 2048, 2048, 2048, E); } }
    xcd_barrier(xb);
    if constexpr ((PHMASK >> 14) & 1) { { pg8::EpiStore E{(bf16_t*)(uni(p.ws) + ACT), 4096, (const float*)(uni(p.ws) + X_SSQ) + MTOK}; run_gemm<0>(lds, (const bf16_t*)(uni(p.ws) + XG), (const bf16_t*)(uni(p.ws) + W_C_IN), 4096, 2048, 2048, E); } }
    if constexpr ((REPMASK >> 14) & 1) { __syncthreads(); { pg8::EpiStore E{(bf16_t*)(uni(p.ws) + ACT), 4096, (const float*)(uni(p.ws) + X_SSQ) + MTOK}; run_gemm<0>(lds, (const bf16_t*)(uni(p.ws) + XG), (const bf16_t*)(uni(p.ws) + W_C_IN), 4096, 2048, 2048, E); } }
    xcd_barrier(xb);
    if constexpr ((PHMASK >> 15) & 1) { phase_conv(p); }
    if constexpr ((REPMASK >> 15) & 1) { __syncthreads(); phase_conv(p); }
    xcd_barrier(xb);
    if constexpr ((PHMASK >> 16) & 1) { { pg8::EpiGates E{(bf16_t*)(uni(p.ws) + HBUF), p.in[17], p.in[19], (const float*)(uni(p.ws) + X_SP8), (unsigned*)(uni(p.ws) + ACT + 128 * MiB)}; run_gemm<2>(lds, (bf16_t*)(uni(p.ws) + HBUF), (const bf16_t*)(uni(p.ws) + W_C_GATE), 4096, 256, 2048, E); } }
    if constexpr ((REPMASK >> 16) & 1) { __syncthreads(); { pg8::EpiGates E{(bf16_t*)(uni(p.ws) + HBUF), p.in[17], p.in[19], (const float*)(uni(p.ws) + X_SP8), (unsigned*)(uni(p.ws) + ACT + 128 * MiB)}; run_gemm<2>(lds, (bf16_t*)(uni(p.ws) + HBUF), (const bf16_t*)(uni(p.ws) + W_C_GATE), 4096, 256, 2048, E); } }
    xcd_barrier(xb);
    if constexpr ((PHMASK >> 17) & 1) { phase_lru_scan(p, lds); }
    if constexpr ((REPMASK >> 17) & 1) { __syncthreads(); phase_lru_scan(p, lds); }
    xcd_barrier(xb);
    if constexpr ((PHMASK >> 18) & 1) { { pg8::EpiResid<true, false, true, true> E{nullptr, (const bf16_t*)(uni(p.ws) + XG), nullptr, (bf16_t*)(uni(p.ws) + XG), (float*)(uni(p.ws) + X_SSQ) + 2 * MTOK}; run_gemm<0>(lds, (bf16_t*)(uni(p.ws) + HBUF), (const bf16_t*)(uni(p.ws) + W_C_OUT), 2048, 2048, 2048, E); } }
    if constexpr ((REPMASK >> 18) & 1) { __syncthreads(); { pg8::EpiResid<true, false, true, true> E{nullptr, (const bf16_t*)(uni(p.ws) + XG), nullptr, (bf16_t*)(uni(p.ws) + XG), (float*)(uni(p.ws) + X_SSQ) + 2 * MTOK}; run_gemm<0>(lds, (bf16_t*)(uni(p.ws) + HBUF), (const bf16_t*)(uni(p.ws) + W_C_OUT), 2048, 2048, 2048, E); } }
    xcd_barrier(xb);
    if constexpr ((PHMASK >> 20) & 1) { { pg8::EpiStoreD E{(bf16_t*)(uni(p.ws) + LAT), (bf16_t*)(uni(p.ws) + HBUF), (const float*)(uni(p.ws) + X_SSQ) + 2 * MTOK, (float*)(uni(p.ws) + X_SSQ) + 3 * MTOK}; run_gemm<0>(lds, (const bf16_t*)(uni(p.ws) + XG), (const bf16_t*)(uni(p.ws) + W_D_IN), 3328, 2048, 2048, E); } }
    if constexpr ((REPMASK >> 20) & 1) { __syncthreads(); { pg8::EpiStoreD E{(bf16_t*)(uni(p.ws) + LAT), (bf16_t*)(uni(p.ws) + HBUF), (const float*)(uni(p.ws) + X_SSQ) + 2 * MTOK, (float*)(uni(p.ws) + X_SSQ) + 3 * MTOK}; run_gemm<0>(lds, (const bf16_t*)(uni(p.ws) + XG), (const bf16_t*)(uni(p.ws) + W_D_IN), 3328, 2048, 2048, E); } }
    xcd_barrier(xb);
    if constexpr ((PHMASK >> 22) & 1) { { pg8::EpiStoreU E{(bf16_t*)(uni(p.ws) + ACT), (const float*)(uni(p.ws) + X_SSQ) + 3 * MTOK}; run_gemm<1>(lds, (const bf16_t*)(uni(p.ws) + LAT), (const bf16_t*)(uni(p.ws) + W_D_UQKV), 7168, 512, 1088, E); } }
    if constexpr ((REPMASK >> 22) & 1) { __syncthreads(); { pg8::EpiStoreU E{(bf16_t*)(uni(p.ws) + ACT), (const float*)(uni(p.ws) + X_SSQ) + 3 * MTOK}; run_gemm<1>(lds, (const bf16_t*)(uni(p.ws) + LAT), (const bf16_t*)(uni(p.ws) + W_D_UQKV), 7168, 512, 1088, E); } }
    xcd_barrier(xb);
    if constexpr ((PHMASK >> 23) & 1) { phase_mla_qk(p); }
    if constexpr ((REPMASK >> 23) & 1) { __syncthreads(); phase_mla_qk(p); }
    xcd_barrier(xb);
    if constexpr ((PHMASK >> 24) & 1) { phase_attn_d(p, lds); }
    if constexpr ((REPMASK >> 24) & 1) { __syncthreads(); phase_attn_d(p, lds); }
    xcd_barrier(xb);
    if constexpr ((PHMASK >> 25) & 1) { { pg8::EpiResid<true, true, false, false> E{nullptr, (const bf16_t*)(uni(p.ws) + XG), uni(p.out), nullptr, nullptr}; run_gemm<0>(lds, (bf16_t*)(uni(p.ws) + HBUF), (const bf16_t*)(uni(p.ws) + W_D_OUT), 2048, 2048, 2048, E); } }
    if constexpr ((REPMASK >> 25) & 1) { __syncthreads(); { pg8::EpiResid<true, true, false, false> E{nullptr, (const bf16_t*)(uni(p.ws) + XG), uni(p.out), nullptr, nullptr}; run_gemm<0>(lds, (bf16_t*)(uni(p.ws) + HBUF), (const bf16_t*)(uni(p.ws) + W_D_OUT), 2048, 2048, 2048, E); } }
#ifdef XSYNC
    for (int i = 0; i < XSYNC; ++i) xcd_barrier(xb);
#endif
}

extern "C" void kernel_launch(void* const* d_in, const int* in_sizes, int n_in, void* d_out, int out_size, void* d_ws, size_t ws_size, hipStream_t stream) {
    static int grid_blocks = 0;
    if (!grid_blocks) {
        int dev = 0, cus = 0, per_cu = 0;
        hipGetDevice(&dev);
        hipDeviceGetAttribute(&cus, hipDeviceAttributeMultiprocessorCount, dev);
        hipFuncSetAttribute((const void*)mega, hipFuncAttributeMaxDynamicSharedMemorySize, LDS_BYTES);
        hipOccupancyMaxActiveBlocksPerMultiprocessor(&per_cu, (const void*)mega, 512, LDS_BYTES);
        if (per_cu < 1) per_cu = 1;
        grid_blocks = cus * per_cu;
        if (ws_size < EXTRA + 65536 + 5 * 65536) fprintf(stderr, "kernel_launch: workspace too small (%zu < %zu)\n", ws_size, (size_t)WS_END);
    }
    Params p; memset(&p, 0, sizeof(p));
    for (int i = 0; i < 29; ++i) p.in[i] = (const float*)d_in[i];
    p.out = (float*)d_out; p.ws = (unsigned char*)d_ws;
    unsigned char* ws = (unsigned char*)d_ws;
    int nj = 0, tiles = 0;
    auto add = [&](const float* src, size_t dst_off, int K, int N, int ldw, int npad) {
        TJob& j = p.jobs[nj++]; j.src = src; j.dst = (bf16_t*)(ws + dst_off); j.kscale = nullptr; j.K = K; j.N = N; j.ldw = ldw; j.ntn = npad / 64; j.tile0 = tiles; j.pad = 0; tiles += (npad / 64) * (K / 256);
    };
    add(p.in[3], W_A_IN, 2048, 8192, 8192, 8192); p.jobs[0].pad = 1;
    add(p.in[7], W_A_OUT, 2048, 2048, 2048, 2048);
    add(p.in[8], W_B_IN, 2048, 6160, 6160, 6400); p.jobs[nj - 1].kscale = p.in[1] + 2048;
    add(p.in[12], W_B_OUT, 2048, 2048, 2048, 2048);
    add(p.in[13], W_C_IN, 2048, 4096, 4096, 4096); p.jobs[nj - 1].kscale = p.in[1] + 4096;
    add(p.in[21], W_C_OUT, 2048, 2048, 2048, 2048);
    add(p.in[22], W_D_IN, 2048, 3136, 3136, 3328); p.jobs[nj - 1].kscale = p.in[1] + 6144;
    add(p.in[25], W_D_UQKV, 512, 3072, 3072, 3072); p.jobs[nj - 1].kscale = p.in[23];
    add(p.in[26], W_D_UQKV + (size_t)3072 * 512 * 2, 512, 4096, 4096, 4096); p.jobs[nj - 1].kscale = p.in[24];
    add(p.in[28], W_D_OUT, 2048, 2048, 2048, 2048);
    for (int n = 0; n < 8; ++n) for (int half = 0; half < 2; ++half) for (int bj = 0; bj < 2; ++bj)
        add(p.in[bj ? 18 : 16] + (size_t)n * 65536 + half * 128, W_C_GATE + ((size_t)((n * 2 + half) * 256 + 128 * bj)) * 256 * 2, 256, 128, 256, 128);
    p.njobs = nj; p.ntiles = tiles;
    hipMemsetAsync(ws + WS_BAR, 0, XCD_BAR_WORDS * 4, stream);
    void* args[] = {(void*)&p};
    hipError_t e = hipLaunchCooperativeKernel((const void*)mega, dim3(grid_blocks), dim3(512), args, LDS_BYTES, stream);
    if (e != hipSuccess) fprintf(stderr, "cooperative launch failed: %s (grid %d)\n", hipGetErrorString(e), grid_blocks);
}
```

```cpp
#include <hip/hip_runtime.h>
#include <hip/hip_cooperative_groups.h>
#include <cstdio>
#include <cstring>
namespace cg = cooperative_groups;

#define DI __device__ __forceinline__
#define LAS __attribute__((address_space(3)))
typedef unsigned short bf16_t;
typedef short bf16x8 __attribute__((ext_vector_type(8)));
typedef short s16x4 __attribute__((ext_vector_type(4)));
typedef float f32x2 __attribute__((ext_vector_type(2)));
typedef float f32x4 __attribute__((ext_vector_type(4)));
typedef float f32x16 __attribute__((ext_vector_type(16)));
typedef unsigned u32x2 __attribute__((ext_vector_type(2)));
typedef unsigned u32x4 __attribute__((ext_vector_type(4)));
typedef __bf16 bf16v2_t __attribute__((ext_vector_type(2)));

constexpr int MTOK = 16384, DM = 2048, SEQ = 4096;
constexpr float EPS = 1e-6f, LOG2E = 1.4426950408889634f;
constexpr size_t MiB = (size_t)1 << 20;
constexpr size_t W_A_IN = 0, W_A_OUT = 32 * MiB, W_B_IN = 40 * MiB, W_B_OUT = 65 * MiB, W_C_IN = 73 * MiB, W_C_GATE = 89 * MiB,
                 W_C_OUT = 91 * MiB, W_D_IN = 99 * MiB, W_D_UQKV = 112 * MiB, W_D_OUT = 119 * MiB, HBUF = 127 * MiB, ACT = 191 * MiB,
                 WS_END = 511 * MiB;
constexpr size_t LAT = 0;
constexpr size_t EXTRA = 511 * MiB;
constexpr size_t X_BIAS = EXTRA + 16384, X_SP8 = EXTRA + 32768, X_SSQ = EXTRA + 65536;
constexpr size_t GLA_TOT = ACT + 200 * MiB;
constexpr size_t XG = ACT + 256 * MiB;
constexpr size_t WS_BAR = EXTRA;
constexpr int LDS_BYTES = 131072 + 2048;
#ifndef PHMASK
#define PHMASK 0xffffffffull
#endif
#ifndef REPMASK
#define REPMASK 0ull
#endif

struct TJob { const float* src; bf16_t* dst; const float* kscale; int K, N, ldw, ntn, tile0, pad; };
struct Params { const float* in[29]; float* out; unsigned char* ws; int njobs, ntiles; TJob jobs[44]; };

DI int otid() { int t = threadIdx.x; asm volatile("" : "+v"(t)); return t; }
template <class T> DI T* uni(T* p) {
    const unsigned long long v = (unsigned long long)p;
    const unsigned lo = __builtin_amdgcn_readfirstlane((unsigned)v), hi = __builtin_amdgcn_readfirstlane((unsigned)(v >> 32));
    return (T*)(((unsigned long long)hi << 32) | lo);
}
DI float bf2f(bf16_t v) { return __uint_as_float((unsigned)v << 16); }
DI unsigned pk2(float a, float b) { f32x2 v = {a, b}; bf16v2_t r = __builtin_convertvector(v, bf16v2_t); return __builtin_bit_cast(unsigned, r); }
DI bf16_t f2bf(float a) { return (bf16_t)(pk2(a, 0.f) & 0xffffu); }
DI void unpack8(const u32x4 w, float (&f)[8]) {
#pragma unroll
    for (int i = 0; i < 4; ++i) { f[2 * i] = __uint_as_float(w[i] << 16); f[2 * i + 1] = __uint_as_float(w[i] & 0xffff0000u); }
}
DI u32x4 pack8(const float (&f)[8]) { u32x4 w; w.x = pk2(f[0], f[1]); w.y = pk2(f[2], f[3]); w.z = pk2(f[4], f[5]); w.w = pk2(f[6], f[7]); return w; }
DI float wsum(float v) {
#pragma unroll
    for (int m = 32; m >= 1; m >>= 1) v += __shfl_xor(v, m);
    return v;
}
DI float sigm(float x) { return 1.f / (1.f + __expf(-x)); }
DI float silu(float x) { return x / (1.f + __expf(-x)); }
DI int crow(int i, int hh) { return (i & 3) + 8 * (i >> 2) + 4 * hh; }
DI f32x16 mfma32(bf16x8 a, bf16x8 b, f32x16 c) { return __builtin_amdgcn_mfma_f32_32x32x16_bf16(a, b, c, 0, 0, 0); }
DI s16x4 trread(LAS unsigned char* p) { return __builtin_amdgcn_ds_read_tr16_b64_v4i16((LAS s16x4*)p); }
DI bf16x8 cat4(s16x4 lo, s16x4 hi) { return __builtin_shufflevector(lo, hi, 0, 1, 2, 3, 4, 5, 6, 7); }

namespace pg8 {
constexpr int BM = 256, BK = 64, HALF = 128, HTB = HALF * BK * 2, STAGE_BYTES = 8 * HTB, NXCD = 8, WGM = 8;
DI int lds_byte(int r, int c) { const int st = (r >> 4) * 2 + (c >> 5), rr = r & 15, cc = c & 31, ob = rr * 64 + cc * 2; return st * 1024 + (ob ^ (((ob >> 9) & 1) << 5)); }
DI void stage_rc(int b, int& R, int& C) { const int st = b / 1024, sb = b % 1024, swz = sb ^ (((sb >> 9) & 1) << 5); R = (st >> 1) * 16 + swz / 64; C = (st & 1) * 32 + (swz % 64) / 2; }
DI int perm32(int rho) { const int n = rho >> 4, i = rho & 15; return 8 * (i >> 2) + 4 * n + (i & 3); }
struct Unit { int pm, pn; size_t aoff, boff; };
template <int MODE> struct Sched {
    int nM, nN, nwg, G, c, lda, K;
    DI void init(int M, int N, int G_, int c_, int lda_, int K_) { nM = M / BM; nN = N / BM; nwg = nM * nN; G = G_; c = c_; lda = lda_; K = K_; }
    DI bool next(int i, Unit& u) const {
        const long L = (long)i * G + c; if (L >= nwg) return false;
        int wgid = (int)L; { const int q = nwg / NXCD, r = nwg % NXCD, xcd = wgid % NXCD, off = wgid / NXCD; wgid = (xcd < r ? xcd * (q + 1) : r * (q + 1) + (xcd - r) * q) + off; }
        const int nig = WGM * nN, gid = wgid / nig, fm = gid * WGM, gsz = (nM - fm) < WGM ? (nM - fm) : WGM;
        u.pm = fm + ((wgid % nig) % gsz); u.pn = (wgid % nig) / gsz;
        u.aoff = (size_t)u.pm * 256 * lda * 2; u.boff = (size_t)u.pn * 256 * K * 2;
        if (MODE == 1 && u.pn >= 12) u.aoff += 1024;
        if (MODE == 2) u.aoff += (size_t)(u.pn >> 1) * 512;
        return true;
    }
};

template <class Epi, class SchedT>
DI void gemm_phase(LAS unsigned char* lds, const bf16_t* Ap, const bf16_t* Btp, const int K, const int lda, const SchedT& S, const Epi& E) {
    const int tid = otid(), wid = __builtin_amdgcn_readfirstlane(tid >> 6), lane = tid & 63, wr = wid >> 2, wc = wid & 3, fr = lane & 15, fq = lane >> 4;
    const int nt = K / BK;
    unsigned voffA[2], voffB[2];
#pragma unroll
    for (int i = 0; i < 2; ++i) { int R, C; stage_rc(tid * 16 + i * 8192, R, C); const int Rb = (R & ~31) + perm32(R & 31);
        voffA[i] = (unsigned)(R * lda + C) * 2u; voffB[i] = (unsigned)(Rb * K + C) * 2u; }
    const size_t kstep = (size_t)(BK * 2);
    const size_t hstepA = (size_t)HALF * lda * 2, hstepB = (size_t)HALF * K * 2;
    const unsigned ldsw = (unsigned)wid * 1024u;
    const int aoff = lds_byte(wr * 64 + fr, fq * 8), boff = lds_byte(wc * 32 + fr, fq * 8);
#define PG8_SA(b, h) (((b) * 2 + (h)) * HTB)
#define PG8_SB(b, h) ((4 + (b) * 2 + (h)) * HTB)
#define PG8_STAGE(bufoff, gbase, voff) do { _Pragma("unroll") for (int _i = 0; _i < 2; ++_i) \
        __builtin_amdgcn_global_load_lds((const unsigned*)((const char*)(gbase) + (voff)[_i]), (LAS unsigned*)(lds + (bufoff) + ldsw + _i * 8192), 16, 0, 0); } while (0)
#define PG8_LDA(dst, b, h) do { _Pragma("unroll") for (int m = 0; m < 4; ++m) _Pragma("unroll") for (int k = 0; k < 2; ++k) dst[m][k] = *(const LAS bf16x8*)(lds + PG8_SA(b, h) + aoff + m * 2048 + k * 1024); } while (0)
#define PG8_LDB(dst, b, h) do { _Pragma("unroll") for (int n = 0; n < 2; ++n) _Pragma("unroll") for (int k = 0; k < 2; ++k) dst[n][k] = *(const LAS bf16x8*)(lds + PG8_SB(b, h) + boff + n * 2048 + k * 1024); } while (0)
#define PG8_MMA(ai, bj, At, Bt) do { __builtin_amdgcn_s_setprio(1); _Pragma("unroll") for (int m = 0; m < 4; ++m) _Pragma("unroll") for (int n = 0; n < 2; ++n) _Pragma("unroll") for (int k = 0; k < 2; ++k) \
        acc[ai][bj][m][n] = __builtin_amdgcn_mfma_f32_16x16x32_bf16(Bt[n][k], At[m][k], acc[ai][bj][m][n], 0, 0, 0); __builtin_amdgcn_s_setprio(0); } while (0)
#define PG8_WAIT_V(n) asm volatile("s_waitcnt vmcnt(" #n ")" ::: "memory")
#define PG8_WAIT_L(n) asm volatile("s_waitcnt lgkmcnt(" #n ")" ::: "memory")
#define PG8_BAR __builtin_amdgcn_s_barrier()
#define PG8_SCHED __builtin_amdgcn_sched_barrier(0)
    Unit cur, nxt; int ui = 0;
    if (!S.next(0, cur)) return;
    float pre[8]; E.prefetch(cur, wr, fr, pre);
    f32x4 acc[2][2][4][2];
#pragma unroll
    for (int a = 0; a < 2; ++a)
#pragma unroll
        for (int b = 0; b < 2; ++b)
#pragma unroll
            for (int m = 0; m < 4; ++m)
#pragma unroll
                for (int n = 0; n < 2; ++n) acc[a][b][m][n] = (f32x4){0.f, 0.f, 0.f, 0.f};
    bf16x8 At[4][2], B0[2][2], B1[2][2];
    const char* cA = (const char*)Ap + cur.aoff; const char* cB = (const char*)Btp + cur.boff;
    PG8_STAGE(PG8_SB(0, 0), cB, voffB); PG8_STAGE(PG8_SA(0, 0), cA, voffA); PG8_STAGE(PG8_SB(0, 1), cB + hstepB, voffB); PG8_STAGE(PG8_SA(0, 1), cA + hstepA, voffA);
    if (wr == 1) PG8_BAR;
    PG8_WAIT_V(4); PG8_BAR;
    PG8_STAGE(PG8_SB(1, 0), cB + kstep, voffB); PG8_STAGE(PG8_SA(1, 0), cA + kstep, voffA); PG8_STAGE(PG8_SB(1, 1), cB + hstepB + kstep, voffB);
    PG8_WAIT_V(6); PG8_BAR;
    for (;;) {
        const bool has_next = S.next(ui + 1, nxt);
        const char* nA = has_next ? (const char*)Ap + nxt.aoff : cA; const char* nB = has_next ? (const char*)Btp + nxt.boff : cB;
        for (int t = 0; t < nt; t += 2) {
            const bool last = (t == nt - 2);
            const char* a1 = cA + (size_t)(t + 1) * kstep;
            const char* a2 = last ? nA : cA + (size_t)(t + 2) * kstep; const char* b2 = last ? nB : cB + (size_t)(t + 2) * kstep;
            const char* a3 = a2 + kstep; const char* b3 = b2 + kstep;
            PG8_LDB(B0, 0, 0); PG8_SCHED; PG8_LDA(At, 0, 0); PG8_STAGE(PG8_SA(1, 1), a1 + hstepA, voffA);
            PG8_WAIT_L(8); PG8_BAR; PG8_WAIT_L(0); PG8_MMA(0, 0, At, B0); PG8_BAR; PG8_SCHED;
            PG8_LDB(B1, 0, 1); PG8_STAGE(PG8_SB(0, 0), b2, voffB);
            PG8_BAR; PG8_WAIT_L(0); PG8_MMA(0, 1, At, B1); PG8_BAR;
            PG8_LDA(At, 0, 1); PG8_STAGE(PG8_SA(0, 0), a2, voffA);
            PG8_BAR; PG8_WAIT_L(0); PG8_MMA(1, 0, At, B0); PG8_BAR; PG8_SCHED;
            PG8_STAGE(PG8_SB(0, 1), b2 + hstepB, voffB);
            PG8_WAIT_V(6); PG8_BAR; PG8_MMA(1, 1, At, B1); PG8_BAR;
            PG8_LDB(B0, 1, 0); PG8_SCHED; PG8_LDA(At, 1, 0); PG8_STAGE(PG8_SA(0, 1), a2 + hstepA, voffA);
            PG8_WAIT_L(8); PG8_BAR; PG8_WAIT_L(0); PG8_MMA(0, 0, At, B0); PG8_BAR; PG8_SCHED;
            PG8_LDB(B1, 1, 1); PG8_STAGE(PG8_SB(1, 0), b3, voffB);
            PG8_BAR; PG8_WAIT_L(0); PG8_MMA(0, 1, At, B1); PG8_BAR;
            PG8_LDA(At, 1, 1); PG8_STAGE(PG8_SA(1, 0), a3, voffA);
            PG8_BAR; PG8_WAIT_L(0); PG8_MMA(1, 0, At, B0); PG8_BAR; PG8_SCHED;
            PG8_STAGE(PG8_SB(1, 1), b3 + hstepB, voffB);
            PG8_WAIT_V(6); PG8_BAR; PG8_MMA(1, 1, At, B1); PG8_BAR;
        }
        E(acc, cur, wr, wc, fr, fq, pre);
        if (!has_next) break;
#pragma unroll
        for (int a = 0; a < 2; ++a)
#pragma unroll
            for (int b = 0; b < 2; ++b)
#pragma unroll
                for (int m = 0; m < 4; ++m)
#pragma unroll
                    for (int n = 0; n < 2; ++n) acc[a][b][m][n] = (f32x4){0.f, 0.f, 0.f, 0.f};
        cur = nxt; cA = nA; cB = nB; ++ui; E.prefetch(cur, wr, fr, pre);
    }
    PG8_WAIT_V(0);
    if (wr == 0) PG8_BAR;
    PG8_BAR;
#undef PG8_SA
#undef PG8_SB
#undef PG8_STAGE
#undef PG8_LDA
#undef PG8_LDB
#undef PG8_MMA
#undef PG8_WAIT_V
#undef PG8_WAIT_L
#undef PG8_BAR
#undef PG8_SCHED
}

typedef f32x4 Acc[2][2][4][2];
struct EpiStore {
    bf16_t* O; int ldc; const float* ssq;
    DI void prefetch(const Unit& u, int wr, int fr, float (&pre)[8]) const {
#pragma unroll
        for (int i = 0; i < 8; ++i) pre[i] = ssq ? ssq[u.pm * BM + wr * 64 + fr + (i >> 2) * HALF + (i & 3) * 16] : 0.f; }
    DI void operator()(const Acc& acc, const Unit& u, int wr, int wc, int fr, int fq, const float (&pre)[8]) const {
        const int row0 = u.pm * BM + wr * 64 + fr, col0 = u.pn * BM + wc * 32 + 8 * fq;
#pragma unroll
        for (int ai = 0; ai < 2; ++ai)
#pragma unroll
            for (int m = 0; m < 4; ++m) { bf16_t* rowp = O + (size_t)(row0 + ai * HALF + m * 16) * ldc + col0;
                const float rs = ssq ? rsqrtf(pre[ai * 4 + m] * (1.f / DM) + EPS) : 1.f;
#pragma unroll
                for (int bj = 0; bj < 2; ++bj) { const f32x4 v0 = acc[ai][bj][m][0] * rs, v1 = acc[ai][bj][m][1] * rs;
                    u32x4 w; w.x = pk2(v0[0], v0[1]); w.y = pk2(v0[2], v0[3]); w.z = pk2(v1[0], v1[1]); w.w = pk2(v1[2], v1[3]);
                    *(u32x4*)(rowp + bj * HALF) = w; } }
    }
};
struct EpiStoreA {
    bf16_t* O; const float* qkg; const float* ssq;
    DI void prefetch(const Unit& u, int wr, int fr, float (&pre)[8]) const {
#pragma unroll
        for (int i = 0; i < 8; ++i) pre[i] = ssq[u.pm * BM + wr * 64 + fr + (i >> 2) * HALF + (i & 3) * 16]; }
    DI void operator()(const Acc& acc, const Unit& u, int wr, int wc, int fr, int fq, const float (&pre)[8]) const {
        const int row0 = u.pm * BM + wr * 64 + fr, col0 = u.pn * BM + wc * 64 + 8 * fq;
        const bool nrm = u.pn < 16;
        f32x4 gn[2][2];
        if (nrm) { const float* gp = qkg + (u.pn < 8 ? 0 : 64) + 8 * fq; const float gs = u.pn < 8 ? 0.125f * LOG2E : 1.f;
#pragma unroll
            for (int bj = 0; bj < 2; ++bj) { gn[bj][0] = *(const f32x4*)(gp + 32 * bj) * gs; gn[bj][1] = *(const f32x4*)(gp + 32 * bj + 4) * gs; } }
#pragma unroll
        for (int ai = 0; ai < 2; ++ai)
#pragma unroll
            for (int m = 0; m < 4; ++m) { bf16_t* rowp = O + (size_t)(row0 + ai * HALF + m * 16) * 8192 + col0;
                f32x4 v[2][2]; const float rs = rsqrtf(pre[ai * 4 + m] * (1.f / DM) + EPS);
#pragma unroll
                for (int bj = 0; bj < 2; ++bj) { v[bj][0] = acc[ai][bj][m][0] * rs; v[bj][1] = acc[ai][bj][m][1] * rs; }
                if (nrm) { float ss = 0.f;
#pragma unroll
                    for (int bj = 0; bj < 2; ++bj)
#pragma unroll
                        for (int n = 0; n < 2; ++n) ss += v[bj][n][0] * v[bj][n][0] + v[bj][n][1] * v[bj][n][1] + v[bj][n][2] * v[bj][n][2] + v[bj][n][3] * v[bj][n][3];
                    ss += __shfl_xor(ss, 16); ss += __shfl_xor(ss, 32);
                    const float sc = rsqrtf(ss * (1.f / 64.f) + EPS);
#pragma unroll
                    for (int bj = 0; bj < 2; ++bj) { v[bj][0] = v[bj][0] * sc * gn[bj][0]; v[bj][1] = v[bj][1] * sc * gn[bj][1]; } }
#pragma unroll
                for (int bj = 0; bj < 2; ++bj) { u32x4 w; w.x = pk2(v[bj][0][0], v[bj][0][1]); w.y = pk2(v[bj][0][2], v[bj][0][3]); w.z = pk2(v[bj][1][0], v[bj][1][1]); w.w = pk2(v[bj][1][2], v[bj][1][3]);
                    *(u32x4*)(rowp + 32 * bj) = w; } }
    }
};
struct EpiStoreD {
    bf16_t* lat; bf16_t* g; const float* ssq; float* ssql;
    DI void prefetch(const Unit& u, int wr, int fr, float (&pre)[8]) const {
#pragma unroll
        for (int i = 0; i < 8; ++i) pre[i] = ssq[u.pm * BM + wr * 64 + fr + (i >> 2) * HALF + (i & 3) * 16]; }
    DI void operator()(const Acc& acc, const Unit& u, int wr, int wc, int fr, int fq, const float (&pre)[8]) const {
        const int row0 = u.pm * BM + wr * 64 + fr, col0 = u.pn * BM + wc * 32 + 8 * fq;
#pragma unroll
        for (int ai = 0; ai < 2; ++ai)
#pragma unroll
            for (int m = 0; m < 4; ++m) { const size_t row = (size_t)(row0 + ai * HALF + m * 16);
                const float rs = rsqrtf(pre[ai * 4 + m] * (1.f / DM) + EPS); float ss = 0.f;
#pragma unroll
                for (int bj = 0; bj < 2; ++bj) { const f32x4 v0 = acc[ai][bj][m][0] * rs, v1 = acc[ai][bj][m][1] * rs;
                    ss += v0[0] * v0[0] + v0[1] * v0[1] + v0[2] * v0[2] + v0[3] * v0[3] + v1[0] * v1[0] + v1[1] * v1[1] + v1[2] * v1[2] + v1[3] * v1[3];
                    u32x4 w; w.x = pk2(v0[0], v0[1]); w.y = pk2(v0[2], v0[3]); w.z = pk2(v1[0], v1[1]); w.w = pk2(v1[2], v1[3]);
                    const int col = col0 + bj * HALF;
                    if (col < 1088) *(u32x4*)(lat + row * 1088 + col) = w;
                    else if (col < 3136) *(u32x4*)(g + row * 2048 + (col - 1088)) = w; }
                if (u.pn < 4) { ss += __shfl_xor(ss, 16); ss += __shfl_xor(ss, 32); if (fq == 0) atomicAdd(ssql + (u.pn >> 1) * MTOK + row, ss); } }
    }
};
struct EpiStoreU {
    bf16_t* O; const float* ssql;
    DI void prefetch(const Unit& u, int wr, int fr, float (&pre)[8]) const {
        const float* sq = ssql + (u.pn >= 12 ? MTOK : 0);
#pragma unroll
        for (int i = 0; i < 8; ++i) pre[i] = sq[u.pm * BM + wr * 64 + fr + (i >> 2) * HALF + (i & 3) * 16]; }
    DI void operator()(const Acc& acc, const Unit& u, int wr, int wc, int fr, int fq, const float (&pre)[8]) const {
        const int row0 = u.pm * BM + wr * 64 + fr, col0 = u.pn * BM + wc * 32 + 8 * fq;
        const float* sq = ssql + (u.pn >= 12 ? MTOK : 0);
#pragma unroll
        for (int ai = 0; ai < 2; ++ai)
#pragma unroll
            for (int m = 0; m < 4; ++m) { bf16_t* rowp = O + (size_t)(row0 + ai * HALF + m * 16) * 7168 + col0;
                const float rs = rsqrtf(pre[ai * 4 + m] * (1.f / 512.f) + EPS);
#pragma unroll
                for (int bj = 0; bj < 2; ++bj) { const f32x4 v0 = acc[ai][bj][m][0] * rs, v1 = acc[ai][bj][m][1] * rs;
                    u32x4 w; w.x = pk2(v0[0], v0[1]); w.y = pk2(v0[2], v0[3]); w.z = pk2(v1[0], v1[1]); w.w = pk2(v1[2], v1[3]);
                    *(u32x4*)(rowp + bj * HALF) = w; } }
    }
};
template <bool INB, bool OUTF, bool OUTB, bool SSQ> struct EpiResid {
    const float* xf; const bf16_t* xb; float* of; bf16_t* ob; float* ssq;
    DI void prefetch(const Unit&, int, int, float (&pre)[8]) const {
#pragma unroll
        for (int i = 0; i < 8; ++i) pre[i] = 0.f; }
    DI void operator()(const Acc& acc, const Unit& u, int wr, int wc, int fr, int fq, const float (&pre)[8]) const {
        const int row0 = u.pm * BM + wr * 64 + fr, col0 = u.pn * BM + wc * 32 + 8 * fq;
#pragma unroll
        for (int ai = 0; ai < 2; ++ai)
#pragma unroll
            for (int m = 0; m < 4; ++m) { const int row = row0 + ai * HALF + m * 16; const size_t o = (size_t)row * DM + col0;
                float ss = 0.f;
#pragma unroll
                for (int bj = 0; bj < 2; ++bj) {
                    f32x4 x0, x1;
                    if (INB) { float f[8]; unpack8(*(const u32x4*)(xb + o + bj * HALF), f); x0 = (f32x4){f[0], f[1], f[2], f[3]}; x1 = (f32x4){f[4], f[5], f[6], f[7]}; }
                    else { x0 = *(const f32x4*)(xf + o + bj * HALF); x1 = *(const f32x4*)(xf + o + bj * HALF + 4); }
                    x0 += acc[ai][bj][m][0]; x1 += acc[ai][bj][m][1];
                    if (OUTF) { __builtin_nontemporal_store(x0, (f32x4*)(of + o + bj * HALF)); __builtin_nontemporal_store(x1, (f32x4*)(of + o + bj * HALF + 4)); }
                    if (SSQ) ss += x0[0] * x0[0] + x0[1] * x0[1] + x0[2] * x0[2] + x0[3] * x0[3] + x1[0] * x1[0] + x1[1] * x1[1] + x1[2] * x1[2] + x1[3] * x1[3];
                    if (OUTB) { u32x4 w; w.x = pk2(x0[0], x0[1]); w.y = pk2(x0[2], x0[3]); w.z = pk2(x1[0], x1[1]); w.w = pk2(x1[2], x1[3]);
                        *(u32x4*)(ob + o + bj * HALF) = w; } }
                if (SSQ) { ss += __shfl_xor(ss, 16); ss += __shfl_xor(ss, 32); if (fq == 0) atomicAdd(ssq + row, ss); } }
    }
};
struct EpiGates {
    const bf16_t* xc; const float* brg; const float* big; const float* sp8t; unsigned* ax;
    DI void prefetch(const Unit&, int, int, float (&pre)[8]) const {
#pragma unroll
        for (int i = 0; i < 8; ++i) pre[i] = 0.f; }
    DI void operator()(const Acc& acc, const Unit& u, int wr, int wc, int fr, int fq, const float (&pre)[8]) const {
        const int row0 = u.pm * BM + wr * 64 + fr, f0 = (u.pn >> 1) * 256 + (u.pn & 1) * 128 + wc * 32 + 8 * fq;
#pragma unroll
        for (int n = 0; n < 2; ++n) {
            const f32x4 br = *(const f32x4*)(brg + f0 + 4 * n), bi = *(const f32x4*)(big + f0 + 4 * n), sp = *(const f32x4*)(sp8t + f0 + 4 * n);
#pragma unroll
            for (int ai = 0; ai < 2; ++ai)
#pragma unroll
                for (int m = 0; m < 4; ++m) { const size_t o = (size_t)(row0 + ai * HALF + m * 16) * DM + f0 + 4 * n;
                    const u32x2 xw = *(const u32x2*)(xc + o);
                    const float xv[4] = {__uint_as_float(xw.x << 16), __uint_as_float(xw.x & 0xffff0000u), __uint_as_float(xw.y << 16), __uint_as_float(xw.y & 0xffff0000u)};
                    u32x4 w;
#pragma unroll
                    for (int e = 0; e < 4; ++e) { const float r = sigm(acc[ai][0][m][n][e] + br[e]), ig = sigm(acc[ai][1][m][n][e] + bi[e]);
                        const float la = -sp[e] * r, uu = -2.f * la;
                        const float om = uu * (1.f - uu * 0.5f * (1.f - uu * (1.f / 3.f) * (1.f - uu * 0.25f * (1.f - uu * 0.2f * (1.f - uu * (1.f / 6.f))))));
                        w[e] = pk2(la, sqrtf(fmaxf(om, 0.f)) * ig * xv[e]); }
                    *(u32x4*)(ax + o) = w; __builtin_amdgcn_sched_barrier(0); }
        }
    }
};
}

template <int MODE, class Epi>
DI void run_gemm(LAS unsigned char* lds, const bf16_t* A, const bf16_t* Bt, int N, int K, int lda, const Epi& E) {
    asm volatile("" : "+s"(K));
    pg8::Sched<MODE> S; S.init(MTOK, N, (int)gridDim.x, (int)blockIdx.x, lda, K);
    pg8::gemm_phase(lds, A, Bt, K, lda, S, E);
    __syncthreads();
}

DI void phase_convert(const Params& p, LAS unsigned char* lds) {
    LAS float* sm = (LAS float*)lds;
    const int tid = otid();
    for (int t = blockIdx.x; t < p.ntiles; t += gridDim.x) {
        int j = 0; while (j + 1 < p.njobs && p.jobs[j + 1].tile0 <= t) ++j;
        const float* src = p.jobs[j].src; bf16_t* dst = p.jobs[j].dst; const int K = p.jobs[j].K, N = p.jobs[j].N, ldw = p.jobs[j].ldw, ntn = p.jobs[j].ntn;
        const int tt = t - p.jobs[j].tile0, tn = tt % ntn, tk = tt / ntn, n0 = tn * 64, k0 = tk * 256;
        { const int n4 = (tid & 15) * 4, kr = tid >> 4; f32x4 v[8];
#pragma unroll
          for (int i = 0; i < 8; ++i) v[i] = (n0 + n4 < N) ? __builtin_nontemporal_load((const f32x4*)(src + (size_t)(k0 + kr + 32 * i) * ldw + n0 + n4)) : (f32x4){0.f, 0.f, 0.f, 0.f};
#pragma unroll
          for (int i = 0; i < 8; ++i) { LAS float* d = sm + (kr + 32 * i) * 65 + n4; d[0] = v[i][0]; d[1] = v[i][1]; d[2] = v[i][2]; d[3] = v[i][3]; } }
        __syncthreads();
        { const int nr = tid >> 3, kq = tid & 7;
#pragma unroll
          for (int jj = 0; jj < 4; ++jj) { const int kc = (kq + 8 * jj) * 8; float f[8];
#pragma unroll
              for (int e = 0; e < 8; ++e) f[e] = sm[(kc + e) * 65 + nr];
              if (p.jobs[j].kscale) { const float* ks = p.jobs[j].kscale + k0 + kc;
#pragma unroll
                  for (int e = 0; e < 8; ++e) f[e] *= ks[e]; }
              int nrow = n0 + nr; if (p.jobs[j].pad) { const int jl = nrow & 255; nrow = (nrow & ~255) + 128 * ((jl >> 5) & 1) + 32 * (jl >> 6) + (jl & 31); }
              *(u32x4*)(dst + (size_t)nrow * K + k0 + kc) = pack8(f); } }
        __syncthreads();
    }
}

DI int t5_bucket(int rel) {
    const int n = rel < 0 ? -rel : rel; int b;
    if (n < 8) b = n; else b = 8 + (n >= 12) + (n >= 16) + (n >= 23) + (n >= 32) + (n >= 46) + (n >= 64) + (n >= 91);
    return (rel > 0 ? 16 : 0) + b;
}
DI void phase_bias_table(const Params& p) {
    float* tb = (float*)(p.ws + X_BIAS);
    float* sp8 = (float*)(p.ws + X_SP8); float* ssq = (float*)(p.ws + X_SSQ);
    for (int i = blockIdx.x * 512 + otid(); i < 5 * MTOK; i += gridDim.x * 512) ssq[i] = 0.f;
    for (int i = blockIdx.x * 512 + otid(); i < 16 * 192 + 2048; i += gridDim.x * 512) {
        if (i < 16 * 192) { const int h = i / 192, idx = i % 192; tb[i] = (p.in[2][t5_bucket(idx - 128) * 16 + h] - p.in[2][15 * 16 + h]) * LOG2E; }
        else sp8[i - 16 * 192] = 8.f * log1pf(expf(-p.in[20][i - 16 * 192]));
    }
}

DI void phase_x0(const float* x, bf16_t* out, float* ssq) {
    const int tid = otid(), lane = tid & 63, gw = blockIdx.x * 8 + (tid >> 6), nw = gridDim.x * 8;
    for (int row = gw; row < MTOK; row += nw) {
        const f32x4* xr = (const f32x4*)(x + (size_t)row * DM); f32x4 v[8]; float ss = 0.f;
#pragma unroll
        for (int i = 0; i < 4; ++i) { v[2 * i] = __builtin_nontemporal_load(xr + i * 128 + lane * 2); v[2 * i + 1] = __builtin_nontemporal_load(xr + i * 128 + lane * 2 + 1); }
#pragma unroll
        for (int i = 0; i < 8; ++i) ss += v[i][0] * v[i][0] + v[i][1] * v[i][1] + v[i][2] * v[i][2] + v[i][3] * v[i][3];
        ss = wsum(ss);
        if (lane == 0) ssq[row] = ss;
#pragma unroll
        for (int i = 0; i < 4; ++i) { u32x4 w; w.x = pk2(v[2 * i][0], v[2 * i][1]); w.y = pk2(v[2 * i][2], v[2 * i][3]); w.z = pk2(v[2 * i + 1][0], v[2 * i + 1][1]); w.w = pk2(v[2 * i + 1][2], v[2 * i + 1][3]);
            *(u32x4*)(out + (size_t)row * DM + i * 512 + lane * 8) = w; }
    }
}

DI void phase_rmsnorm(const float* x, const float* g, bf16_t* out) {
    const int tid = otid(), lane = tid & 63, gw = blockIdx.x * 8 + (tid >> 6), nw = gridDim.x * 8;
    for (int row = gw; row < MTOK; row += nw) {
        const f32x4* xr = (const f32x4*)(x + (size_t)row * DM); f32x4 v[8]; float ss = 0.f;
#pragma unroll
        for (int i = 0; i < 4; ++i) { v[2 * i] = xr[i * 128 + lane * 2]; v[2 * i + 1] = xr[i * 128 + lane * 2 + 1]; }
#pragma unroll
        for (int i = 0; i < 8; ++i) ss += v[i][0] * v[i][0] + v[i][1] * v[i][1] + v[i][2] * v[i][2] + v[i][3] * v[i][3];
        ss = wsum(ss); const float sc = rsqrtf(ss * (1.f / DM) + EPS);
#pragma unroll
        for (int i = 0; i < 4; ++i) { const int c = i * 512 + lane * 8; const f32x4 g0 = *(const f32x4*)(g + c), g1 = *(const f32x4*)(g + c + 4);
            u32x4 w; w.x = pk2(v[2 * i][0] * sc * g0[0], v[2 * i][1] * sc * g0[1]); w.y = pk2(v[2 * i][2] * sc * g0[2], v[2 * i][3] * sc * g0[3]);
            w.z = pk2(v[2 * i + 1][0] * sc * g1[0], v[2 * i + 1][1] * sc * g1[1]); w.w = pk2(v[2 * i + 1][2] * sc * g1[2], v[2 * i + 1][3] * sc * g1[3]);
            *(u32x4*)(out + (size_t)row * DM + c) = w; }
    }
}

DI void phase_qknorm_a(const Params& p) {
    bf16_t* big = (bf16_t*)(p.ws + ACT); const float* qkg = p.in[4];
    const int tid = otid(), lane = tid & 63, gw = blockIdx.x * 8 + (tid >> 6), nw = gridDim.x * 8;
    float gq[8], gk[8];
#pragma unroll
    for (int e = 0; e < 8; ++e) { gq[e] = qkg[(lane & 7) * 8 + e] * (0.125f * LOG2E); gk[e] = qkg[64 + (lane & 7) * 8 + e]; }
    for (int row = gw; row < MTOK; row += nw) {
#pragma unroll
        for (int i = 0; i < 8; ++i) {
            bf16_t* ptr = big + (size_t)row * 8192 + i * 512 + lane * 8; float f[8]; unpack8(*(const u32x4*)ptr, f);
            float ss = 0.f;
#pragma unroll
            for (int e = 0; e < 8; ++e) ss += f[e] * f[e];
            ss += __shfl_xor(ss, 1); ss += __shfl_xor(ss, 2); ss += __shfl_xor(ss, 4);
            const float sc = rsqrtf(ss * (1.f / 64.f) + EPS);
#pragma unroll
            for (int e = 0; e < 8; ++e) f[e] = f[e] * sc * (i < 4 ? gq[e] : gk[e]);
            *(u32x4*)ptr = pack8(f);
        }
    }
}

template <int DQK, int KA8, int DV, bool BIAS, bool JOINT>
DI void attn_core(LAS unsigned char* lds, const bf16_t* Qrow, const bf16_t* KpA, int ldkA, const bf16_t* KpB, int ldkB, const bf16_t* Vp, int ldv,
                  int qb, int wid, int lane, const float* qng  , f32x16 (&O)[DV / 32]) {
    constexpr int KROW = DQK * 2 + 16, VROW = DV * 2 + 64  , KC = DQK / 8, VC = DV / 8, NKC = 64 * KC, NVC = 64 * VC, NL = (NKC + NVC) / 512, STG = 64 * (KROW + VROW);
    static_assert(NKC % 512 == 0 && NVC % 512 == 0, "loader split");
    const int tid = otid(), l32 = lane & 31, hh = lane >> 5, i16 = lane & 15, tq = i16 >> 2, tp = i16 & 3, blk = (lane >> 4) & 1;
    const int q0w = qb * 256 + wid * 32, nkt = 4 * qb + 4, myc = q0w >> 6;
    bf16x8 qf[DQK / 16];
#pragma unroll
    for (int s = 0; s < DQK / 16; ++s) qf[s] = *(const bf16x8*)(Qrow + 16 * s + 8 * hh);
    if constexpr (DQK == 192) {
        if (qng) {
            float ssn = 0.f, ssr = 0.f;
#pragma unroll
            for (int s = 0; s < 12; ++s) { float f[8]; unpack8(__builtin_bit_cast(u32x4, qf[s]), f); float t = 0.f;
#pragma unroll
                for (int e = 0; e < 8; ++e) t += f[e] * f[e];
                if (s < 8) ssn += t; else ssr += t; }
            ssn += __shfl_xor(ssn, 32); ssr += __shfl_xor(ssr, 32);
            const float qs = 0.07216878364870322f * LOG2E, scn = rsqrtf(ssn * (1.f / 128.f) + EPS) * qs, scr = rsqrtf(ssr * (1.f / 64.f) + EPS) * qs;
#pragma unroll
            for (int s = 0; s < 8; ++s) { float f[8]; unpack8(__builtin_bit_cast(u32x4, qf[s]), f);
                const f32x4 g0 = *(const f32x4*)(qng + 16 * s + 8 * hh), g1 = *(const f32x4*)(qng + 16 * s + 8 * hh + 4);
#pragma unroll
                for (int e = 0; e < 4; ++e) { f[e] *= scn * g0[e]; f[4 + e] *= scn * g1[e]; }
                qf[s] = __builtin_bit_cast(bf16x8, pack8(f)); }
            const float posr = (float)(qb * 256 + wid * 32 + l32) * 0.15915494309189535f;
#pragma unroll
            for (int s = 8; s < 10; ++s) { float f1[8], f2[8]; unpack8(__builtin_bit_cast(u32x4, qf[s]), f1); unpack8(__builtin_bit_cast(u32x4, qf[s + 2]), f2);
#pragma unroll
                for (int e = 0; e < 8; ++e) { const int i = 16 * (s - 8) + 8 * hh + e;
                    const float a1 = f1[e] * scr * qng[128 + i], a2 = f2[e] * scr * qng[160 + i];
                    float rev = posr * __builtin_amdgcn_exp2f(-(float)i * 0.41524101186092029f); rev -= floorf(rev);
                    const float sn = __builtin_amdgcn_sinf(rev), cs = __builtin_amdgcn_cosf(rev);
                    f1[e] = a1 * cs - a2 * sn; f2[e] = a2 * cs + a1 * sn; }
                qf[s] = __builtin_bit_cast(bf16x8, pack8(f1)); qf[s + 2] = __builtin_bit_cast(bf16x8, pack8(f2)); }
            __builtin_amdgcn_sched_barrier(0);
        }
    }
    float m = 0.f, l = 0.f; bool mnz = false;
#pragma unroll
    for (int dt = 0; dt < DV / 32; ++dt)
#pragma unroll
        for (int i = 0; i < 16; ++i) O[dt][i] = 0.f;
    u32x4 stg[NL];
    LAS const float* btab = (LAS const float*)(lds + 2 * STG);
    const unsigned koff = l32 * KROW + 16 * hh, vtr = (4 * hh + tq) * VROW + (16 * blk + 4 * tp) * 2;

    auto gload = [&](int kt) {
#pragma unroll
        for (int i = 0; i < NL; ++i) { const int c = tid + i * 512;
            if (i * 512 < NKC) { const int row = c / KC, cc = c % KC;
                const bf16_t* src = (cc < KA8) ? KpA + (size_t)(kt * 64 + row) * ldkA + cc * 8 : KpB + (size_t)(kt * 64 + row) * ldkB + (cc - KA8) * 8;
                stg[i] = *(const u32x4*)src; }
            else { const int c2 = c - NKC, row = c2 / VC, cc = c2 % VC; stg[i] = *(const u32x4*)(Vp + (size_t)(kt * 64 + row) * ldv + cc * 8); } }
    };
    auto lstore = [&](int buf) {
#pragma unroll
        for (int i = 0; i < NL; ++i) { const int c = tid + i * 512;
            if (i * 512 < NKC) { const int row = c / KC, cc = c % KC; *(LAS u32x4*)(lds + buf * STG + row * KROW + cc * 16) = stg[i]; }
            else { const int c2 = c - NKC, row = c2 / VC, cc = c2 % VC; *(LAS u32x4*)(lds + buf * STG + 64 * KROW + row * VROW + cc * 16) = stg[i]; } }
    };

    gload(0); lstore(0); __syncthreads();
    for (int kt = 0; kt < nkt; ++kt) {
        if (kt + 1 < nkt) gload(kt + 1);
        if (JOINT && kt <= myc) {
            LAS unsigned char* kb = lds + (kt & 1) * STG; LAS unsigned char* vb = kb + 64 * KROW;
            const bool far = (kt * 64 + 63 - q0w <= -91);
            f32x16 S0, S1;
#pragma unroll
            for (int i = 0; i < 16; ++i) { S0[i] = 0.f; S1[i] = 0.f; }
#pragma unroll
            for (int s = 0; s < DQK / 16; ++s) {
                const bf16x8 k0 = *(LAS const bf16x8*)(kb + koff + 32 * s), k1 = *(LAS const bf16x8*)(kb + koff + 32 * KROW + 32 * s);
                S0 = mfma32(k0, qf[s], S0); S1 = mfma32(k1, qf[s], S1);
            }
            if (BIAS && !far) {
                const int rb = kt * 64 - (q0w + l32) + 128;
#pragma unroll
                for (int i = 0; i < 16; ++i) { const int i0 = rb + crow(i, hh); S0[i] += btab[i0 < 0 ? 0 : i0]; S1[i] += btab[i0 + 32 < 0 ? 0 : i0 + 32]; }
            }
            if (mnz) {
#pragma unroll
                for (int i = 0; i < 16; ++i) { S0[i] -= m; S1[i] -= m; }
            }
            float mx = fmaxf(S0[0], S1[0]);
#pragma unroll
            for (int i = 1; i < 16; ++i) mx = fmaxf(mx, fmaxf(S0[i], S1[i]));
            mx = fmaxf(mx, __shfl_xor(mx, 32));
            if (__any(mx > 64.f || (kt == 0 && mx < -64.f))) {
                const float dm = (mx > 64.f || (kt == 0 && mx < -64.f)) ? mx : 0.f, alpha = __builtin_amdgcn_exp2f(-dm); m += dm; mnz = true;
                l *= alpha;
#pragma unroll
                for (int dt = 0; dt < DV / 32; ++dt) O[dt] *= alpha;
#pragma unroll
                for (int i = 0; i < 16; ++i) { S0[i] -= dm; S1[i] -= dm; }
            }
            float ps = 0.f;
#pragma unroll
            for (int i = 0; i < 16; ++i) { S0[i] = __builtin_amdgcn_exp2f(S0[i]); S1[i] = __builtin_amdgcn_exp2f(S1[i]); ps += S0[i] + S1[i]; }
            l += ps;
#pragma unroll
            for (int half = 0; half < 2; ++half)
#pragma unroll
                for (int s = 0; s < 2; ++s) {
                    const f32x16& S = half ? S1 : S0;
                    u32x4 pw; pw.x = pk2(S[8 * s], S[8 * s + 1]); pw.y = pk2(S[8 * s + 2], S[8 * s + 3]); pw.z = pk2(S[8 * s + 4], S[8 * s + 5]); pw.w = pk2(S[8 * s + 6], S[8 * s + 7]);
                    const bf16x8 pf = __builtin_bit_cast(bf16x8, pw);
                    LAS unsigned char* vr = vb + vtr + (32 * half + 16 * s) * VROW;
#pragma unroll
                    for (int dt = 0; dt < DV / 32; ++dt) {
                        const bf16x8 vf = cat4(trread(vr + 64 * dt), trread(vr + 8 * VROW + 64 * dt));
                        O[dt] = mfma32(vf, pf, O[dt]);
                    }
                }
        }
        if (!JOINT && kt <= myc) {
            LAS unsigned char* kb = lds + (kt & 1) * STG; LAS unsigned char* vb = kb + 64 * KROW;
            const bool far = (kt * 64 + 63 - q0w <= -91);
#pragma unroll 1
            for (int half = 0; half < 2; ++half) {
                f32x16 S;
#pragma unroll
                for (int i = 0; i < 16; ++i) S[i] = 0.f;
#pragma unroll
                for (int s = 0; s < DQK / 16; ++s) {
                    const bf16x8 kf = *(LAS const bf16x8*)(kb + koff + 32 * half * KROW + 32 * s);
                    S = mfma32(kf, qf[s], S);
                }
                if (BIAS && !far) {
                    const int rb = kt * 64 + 32 * half - (q0w + l32) + 128;
#pragma unroll
                    for (int i = 0; i < 16; ++i) { const int i0 = rb + crow(i, hh); S[i] += btab[i0 < 0 ? 0 : i0]; }
                }
                if (mnz) {
#pragma unroll
                    for (int i = 0; i < 16; ++i) S[i] -= m;
                }
                float mx = S[0];
#pragma unroll
                for (int i = 1; i < 16; ++i) mx = fmaxf(mx, S[i]);
                mx = fmaxf(mx, __shfl_xor(mx, 32));
                const bool first = (kt == 0 && half == 0);
                if (__any(mx > 64.f || (first && mx < -64.f))) {
                    const float dm = (mx > 64.f || (first && mx < -64.f)) ? mx : 0.f, alpha = __builtin_amdgcn_exp2f(-dm); m += dm; mnz = true;
                    l *= alpha;
#pragma unroll
                    for (int dt = 0; dt < DV / 32; ++dt) O[dt] *= alpha;
#pragma unroll
                    for (int i = 0; i < 16; ++i) S[i] -= dm;
                }
                float ps = 0.f;
#pragma unroll
                for (int i = 0; i < 16; ++i) { S[i] = __builtin_amdgcn_exp2f(S[i]); ps += S[i]; }
                l += ps;
#pragma unroll
                for (int s = 0; s < 2; ++s) {
                    u32x4 pw; pw.x = pk2(S[8 * s], S[8 * s + 1]); pw.y = pk2(S[8 * s + 2], S[8 * s + 3]); pw.z = pk2(S[8 * s + 4], S[8 * s + 5]); pw.w = pk2(S[8 * s + 6], S[8 * s + 7]);
                    const bf16x8 pf = __builtin_bit_cast(bf16x8, pw);
                    LAS unsigned char* vr = vb + vtr + (32 * half + 16 * s) * VROW;
#pragma unroll
                    for (int dt = 0; dt < DV / 32; ++dt) {
                        const bf16x8 vf = cat4(trread(vr + 64 * dt), trread(vr + 8 * VROW + 64 * dt));
                        O[dt] = mfma32(vf, pf, O[dt]);
                    }
                }
            }
        }
        if (kt + 1 < nkt) lstore((kt + 1) & 1);
        __syncthreads();
    }
    l += __shfl_xor(l, 32);
    const float il = 1.f / l;
#pragma unroll
    for (int dt = 0; dt < DV / 32; ++dt) O[dt] *= il;
}

DI void phase_attn_a(const Params& p, LAS unsigned char* lds) {
    const bf16_t* big = (const bf16_t*)(p.ws + ACT); bf16_t* y = (bf16_t*)(p.ws + HBUF); const float* tbg = (const float*)(p.ws + X_BIAS);
    const int tid = otid(), wid = tid >> 6, lane = tid & 63, l32 = lane & 31, hh = lane >> 5;
    constexpr int STG = 64 * (64 * 2 + 16 + 128 * 2 + 64);
    float d0 = 0.f, d1 = 0.f;
    for (int i = 0; i < 64; ++i) { d0 += p.in[5][i] * p.in[5][64 + i]; d1 += p.in[5][128 + i] * p.in[5][192 + i]; }
    const float lam_init = 0.2f, lam = __expf(d0) - __expf(d1) + lam_init;
    for (int pr = blockIdx.x; pr < 512; pr += gridDim.x) {
        const int bi = pr & 255, bh = (gridDim.x == 256) ? (bi & 7) + 8 * (bi >> 6) + 32 * (pr >> 8) : pr >> 3, j = (gridDim.x == 256) ? (bi >> 3) & 7 : pr & 7, b = bh >> 4, h = bh & 15;
        for (int half = 0; half < 2; ++half) {
            const int qb = half ? 15 - j : j;
            __syncthreads();
            if (tid < 192) ((LAS float*)(lds + 2 * STG))[tid] = tbg[h * 192 + tid];
            const size_t tok0 = (size_t)b * SEQ, tokq = tok0 + qb * 256 + wid * 32 + l32;
            f32x16 Oa[4]; LAS unsigned* Op = (LAS unsigned*)(lds + 2 * STG + 1024) + wid * 2048 + lane;
            attn_core<64, 8, 128, true, true>(lds, big + tokq * 8192 + h * 128, big + tok0 * 8192 + 2048 + h * 128, 8192, nullptr, 0, big + tok0 * 8192 + 4096 + h * 128, 8192, qb, wid, lane, nullptr, Oa);
#pragma unroll
            for (int dt = 0; dt < 4; ++dt)
#pragma unroll
                for (int i = 0; i < 8; ++i) Op[(dt * 8 + i) * 64] = pk2(Oa[dt][2 * i], Oa[dt][2 * i + 1]);
            attn_core<64, 8, 128, true, true>(lds, big + tokq * 8192 + h * 128 + 64, big + tok0 * 8192 + 2048 + h * 128 + 64, 8192, nullptr, 0, big + tok0 * 8192 + 4096 + h * 128, 8192, qb, wid, lane, nullptr, Oa);
            float ss = 0.f;
#pragma unroll
            for (int dt = 0; dt < 4; ++dt)
#pragma unroll
                for (int i = 0; i < 16; ++i) { const unsigned ow = Op[(dt * 8 + (i >> 1)) * 64]; const float o0 = (i & 1) ? __uint_as_float(ow & 0xffff0000u) : __uint_as_float(ow << 16);
                    const float o = o0 - lam * Oa[dt][i]; Oa[dt][i] = o; ss += o * o; }
            ss += __shfl_xor(ss, 32);
            const float sc = rsqrtf(ss * (1.f / 128.f) + EPS) * (1.f - lam_init);
#pragma unroll
            for (int dt = 0; dt < 4; ++dt)
#pragma unroll
                for (int g4 = 0; g4 < 4; ++g4) { const int dv = 32 * dt + 8 * g4 + 4 * hh;
                    const u32x2 gw = *(const u32x2*)(big + tokq * 8192 + 6144 + h * 128 + dv);
                    const f32x4 sg = *(const f32x4*)(p.in[6] + dv);
                    const float g0 = __uint_as_float(gw.x << 16), g1 = __uint_as_float(gw.x & 0xffff0000u), g2 = __uint_as_float(gw.y << 16), g3 = __uint_as_float(gw.y & 0xffff0000u);
                    u32x2 w; w.x = pk2(Oa[dt][4 * g4] * sc * sg[0] * silu(g0), Oa[dt][4 * g4 + 1] * sc * sg[1] * silu(g1));
                    w.y = pk2(Oa[dt][4 * g4 + 2] * sc * sg[2] * silu(g2), Oa[dt][4 * g4 + 3] * sc * sg[3] * silu(g3));
                    *(u32x2*)(y + tokq * DM + h * 128 + dv) = w; }
        }
    }
}

DI void phase_attn_d(const Params& p, LAS unsigned char* lds) {
    const bf16_t* qkv = (const bf16_t*)(p.ws + ACT); const bf16_t* lat = (const bf16_t*)(p.ws + LAT); const bf16_t* gb = (const bf16_t*)(p.ws + HBUF);
    bf16_t* y = (bf16_t*)(p.ws + HBUF);
    for (int pr = blockIdx.x; pr < 512; pr += gridDim.x) {
        const int bi = pr & 255, bh = (gridDim.x == 256) ? (bi & 7) + 8 * (bi >> 6) + 32 * (pr >> 8) : pr >> 3, j = (gridDim.x == 256) ? (bi >> 3) & 7 : pr & 7, b = bh >> 4, h = bh & 15;
        for (int half = 0; half < 2; ++half) {
            const int qb = half ? 15 - j : j;
            __syncthreads();
            const int tid = otid(), wid = tid >> 6, lane = tid & 63, l32 = lane & 31;
            const size_t tok0 = (size_t)b * SEQ, tokq = tok0 + qb * 256 + wid * 32 + l32;
            f32x16 O[4];
            attn_core<192, 16, 128, false, true>(lds, qkv + tokq * 7168 + h * 192, qkv + tok0 * 7168 + 3072 + h * 256, 7168, lat + tok0 * 1088 + 1024, 1088,
                                           qkv + tok0 * 7168 + 3072 + h * 256 + 128, 7168, qb, wid, lane, p.in[27], O);
            const int tid2 = otid(), wid2 = tid2 >> 6, lane2 = tid2 & 63;
            const size_t tokq2 = (size_t)b * SEQ + qb * 256 + wid2 * 32 + (lane2 & 31); const int hh2 = lane2 >> 5;
#pragma unroll
            for (int dt = 0; dt < 4; ++dt)
#pragma unroll
                for (int g4 = 0; g4 < 4; ++g4) { const int dv = 32 * dt + 8 * g4 + 4 * hh2;
                    const u32x2 gw = *(const u32x2*)(gb + tokq2 * DM + h * 128 + dv);
                    const float g0 = __uint_as_float(gw.x << 16), g1 = __uint_as_float(gw.x & 0xffff0000u), g2 = __uint_as_float(gw.y << 16), g3 = __uint_as_float(gw.y & 0xffff0000u);
                    u32x2 w; w.x = pk2(O[dt][4 * g4] * silu(g0), O[dt][4 * g4 + 1] * silu(g1)); w.y = pk2(O[dt][4 * g4 + 2] * silu(g2), O[dt][4 * g4 + 3] * silu(g3));
                    *(u32x2*)(y + tokq2 * DM + h * 128 + dv) = w; }
        }
    }
}

DI void phase_gla_prep(const Params& p, LAS unsigned char* lds) {
    bf16_t* big = (bf16_t*)(p.ws + ACT); float* total = (float*)(p.ws + GLA_TOT);
    LAS float* lrs = (LAS float*)lds;
    const int tid = otid(), ch0 = tid * 2;
    float wg0[16], wg1[16];
#pragma unroll
    for (int r = 0; r < 16; ++r) { wg0[r] = p.in[9][r * 1024 + ch0]; wg1[r] = p.in[9][r * 1024 + ch0 + 1]; }
    const float bs0 = p.in[10][ch0], bs1 = p.in[10][ch0 + 1];
    for (int u = blockIdx.x; u < 256; u += gridDim.x) {
        const size_t tokb = (size_t)u * 64;
        __syncthreads();
        {
            LAS bf16_t* wl = (LAS bf16_t*)(lds + 8192);
            LAS float* part = (LAS float*)(lds + 4096);
            const bf16_t* wsrc = (const bf16_t*)(p.ws + W_B_IN) + (size_t)6144 * 2048;
#pragma unroll
            for (int i = 0; i < 8; ++i) { const int c = tid + i * 512; *(LAS u32x4*)(wl + (c >> 8) * 2056 + (c & 255) * 8) = *(const u32x4*)(wsrc + (size_t)c * 8); }
            __syncthreads();
            const int w = tid >> 6, lane = tid & 63, i16 = lane & 15, quad = lane >> 4, mt = w & 3, kh = w >> 2;
            const bf16_t* xr = (const bf16_t*)(p.ws + XG) + (tokb + 16 * mt + i16) * DM + kh * 1024 + 8 * quad;
            f32x4 acc = {0.f, 0.f, 0.f, 0.f};
#pragma unroll 8
            for (int ks = 0; ks < 32; ++ks) {
                const bf16x8 a = *(const bf16x8*)(xr + 32 * ks);
                const bf16x8 bb = *(LAS const bf16x8*)(wl + i16 * 2056 + kh * 1024 + 32 * ks + 8 * quad);
                acc = __builtin_amdgcn_mfma_f32_16x16x32_bf16(a, bb, acc, 0, 0, 0);
            }
            if (kh == 1) {
#pragma unroll
                for (int j = 0; j < 4; ++j) part[(16 * mt + 4 * quad + j) * 16 + i16] = acc[j]; }
            __syncthreads();
            if (kh == 0) {
#pragma unroll
                for (int j = 0; j < 4; ++j) { const int tok = 16 * mt + 4 * quad + j;
                    const float rs = rsqrtf(((const float*)(p.ws + X_SSQ))[tokb + tok] * (1.f / DM) + EPS);
                    lrs[tok * 16 + i16] = (acc[j] + part[tok * 16 + i16]) * rs; } }
        }
        __syncthreads();
        float t0 = 0.f, t1 = 0.f;
        for (int tok = 63; tok >= 0; --tok) {
            float z0 = bs0, z1 = bs1;
#pragma unroll
            for (int r = 0; r < 16; ++r) { const float lv = lrs[tok * 16 + r]; z0 += lv * wg0[r]; z1 += lv * wg1[r]; }
            unsigned* kp = (unsigned*)(big + (tokb + tok) * 6400 + 1024 + ch0); const unsigned w = *kp;
            *kp = pk2(__uint_as_float(w << 16) * __expf(t0), __uint_as_float(w & 0xffff0000u) * __expf(t1));
            t0 += (fminf(z0, 0.f) - __logf(1.f + __expf(-fabsf(z0)))) * (1.f / 16.f); t1 += (fminf(z1, 0.f) - __logf(1.f + __expf(-fabsf(z1)))) * (1.f / 16.f);
        }
        total[(size_t)u * 1024 + ch0] = t0; total[(size_t)u * 1024 + ch0 + 1] = t1;
    }
}

DI void phase_gla_scan(const Params& p, LAS unsigned char* lds) {
    const bf16_t* big = (const bf16_t*)(p.ws + ACT); const float* total = (const float*)(p.ws + GLA_TOT); bf16_t* ob = (bf16_t*)(p.ws + HBUF);
    constexpr int KR = 576, VR = 64, SR = 528, SET = 64 * KR + 64 * VR + 1024  , ST_OFF = 2 * SET, STB = 32 * SR;
    const int tid = otid(), w = tid >> 6, lane = tid & 63, l32 = lane & 31, hh = lane >> 5, i16 = lane & 15, tq = i16 >> 2, tp = i16 & 3, blk = (lane >> 4) & 1, quad = lane >> 4;
    const int mt = w >> 1, nt = w & 1;
    for (int u = blockIdx.x; u < 256; u += gridDim.x) {
        const int ux = (gridDim.x == 256) ? ((u & 7) * 2 + (u >> 7)) * 16 + ((u >> 3) & 15) : u;
        const int b = ux >> 6, h = (ux >> 4) & 3, vs = ux & 15;
        const size_t tok0 = (size_t)b * SEQ;
        f32x16 st;
#pragma unroll
        for (int i = 0; i < 16; ++i) st[i] = 0.f;
        u32x4 rkA[4], rvA, rkB[4], rvB; float rtA = 0.f, rtB = 0.f; bf16x8 qa[8], qn[8];
        rvA = (u32x4){0u, 0u, 0u, 0u}; rvB = rvA;
        unsigned offk[4];
#pragma unroll
        for (int i = 0; i < 4; ++i) { const int idx = tid + i * 512, row = idx >> 5, cc = idx & 31; offk[i] = (unsigned)((row * 6400 + 1024 + h * 256 + cc * 8) * 2); }
        const unsigned offv = (unsigned)(((tid >> 2) * 6400 + 2048 + h * 512 + vs * 32 + (tid & 3) * 8) * 2);
        const unsigned offq = (unsigned)(((16 * mt + i16) * 6400 + h * 256 + 8 * quad) * 2);
        auto gload = [&](int c, u32x4 (&rk)[4], u32x4& rv, float& rt) {
            const char* cb = (const char*)(big + (tok0 + (size_t)c * 64) * 6400);
#pragma unroll
            for (int i = 0; i < 4; ++i) rk[i] = *(const u32x4*)(cb + offk[i]);
            if (tid < 256) { rv = *(const u32x4*)(cb + offv); rt = total[(size_t)(b * 64 + c) * 1024 + h * 256 + tid]; }
        };
        auto lstore = [&](int buf, const u32x4 (&rk)[4], const u32x4& rv, const float& rt) {
            LAS unsigned char* sb = lds + buf * SET;
#pragma unroll
            for (int i = 0; i < 4; ++i) { const int idx = tid + i * 512, row = idx >> 5, cc = idx & 31; *(LAS u32x4*)(sb + row * KR + cc * 16) = rk[i]; }
            if (tid < 256) { const int row = tid >> 2, cc = tid & 3; *(LAS u32x4*)(sb + 64 * KR + row * VR + cc * 16) = rv; ((LAS float*)(sb + 64 * KR + 64 * VR))[tid] = __expf(rt); }
        };
        auto qload = [&](int c, bf16x8 (&q)[8]) {
            const char* cb = (const char*)(big + (tok0 + (size_t)c * 64) * 6400) + offq;
#pragma unroll
            for (int ks = 0; ks < 8; ++ks) q[ks] = *(const bf16x8*)(cb + 64 * ks);
        };
        auto step = [&](int c, const bf16x8 (&qc)[8]) {
            LAS unsigned char* sb = lds + (c & 1) * SET; LAS unsigned char* stb = lds + ST_OFF + (c & 1) * STB;
#pragma unroll
            for (int g = 0; g < 4; ++g) { const f32x4 e = *(LAS const f32x4*)(sb + 64 * KR + 64 * VR + (32 * w + 8 * g + 4 * hh) * 4);
                st[4 * g] *= e[0]; st[4 * g + 1] *= e[1]; st[4 * g + 2] *= e[2]; st[4 * g + 3] *= e[3]; }
#pragma unroll
            for (int sx = 0; sx < 4; ++sx) {
                LAS unsigned char* ka = sb + (16 * sx + 8 * hh + tq) * KR + (32 * w + 16 * blk + 4 * tp) * 2;
                LAS unsigned char* va = sb + 64 * KR + (16 * sx + 8 * hh + tq) * VR + (16 * blk + 4 * tp) * 2;
                const bf16x8 af = cat4(trread(ka), trread(ka + 4 * KR)), bfv = cat4(trread(va), trread(va + 4 * VR));
                st = mfma32(af, bfv, st);
            }
#pragma unroll
            for (int g = 0; g < 4; ++g) { u32x2 wv; wv.x = pk2(st[4 * g], st[4 * g + 1]); wv.y = pk2(st[4 * g + 2], st[4 * g + 3]);
                *(LAS u32x2*)(stb + l32 * SR + (32 * w + 8 * g + 4 * hh) * 2) = wv; }
            asm volatile("s_waitcnt lgkmcnt(0)" ::: "memory");
            __builtin_amdgcn_s_barrier();
            asm volatile("" ::: "memory");
            f32x4 acc = {0.f, 0.f, 0.f, 0.f};
#pragma unroll
            for (int ks = 0; ks < 8; ++ks) {
                const bf16x8 bb = *(LAS const bf16x8*)(stb + (16 * nt + i16) * SR + (32 * ks + 8 * quad) * 2);
                acc = __builtin_amdgcn_mfma_f32_16x16x32_bf16(qc[ks], bb, acc, 0, 0, 0);
            }
#pragma unroll
            for (int jj = 0; jj < 4; ++jj) ob[(tok0 + c * 64 + 16 * mt + quad * 4 + jj) * DM + h * 512 + vs * 32 + 16 * nt + i16] = f2bf(acc[jj] * (1.f / 16.f));
        };
        __syncthreads();
        gload(0, rkA, rvA, rtA); lstore(0, rkA, rvA, rtA);
        gload(1, rkA, rvA, rtA); gload(2, rkB, rvB, rtB); qload(0, qa); qload(1, qn);
        __syncthreads();
        for (int c = 0; c < 64; c += 2) {
            lstore((c + 1) & 1, rkA, rvA, rtA);
            if (c + 3 < 64) gload(c + 3, rkA, rvA, rtA);
            step(c, qa);
            if (c + 2 < 64) qload(c + 2, qa);
            if (c + 2 < 64) lstore(c & 1, rkB, rvB, rtB);
            if (c + 4 < 64) gload(c + 4, rkB, rvB, rtB);
            step(c + 1, qn);
            if (c + 3 < 64) qload(c + 3, qn);
        }
    }
}

DI void phase_gla_post(const Params& p) {
    const bf16_t* big = (const bf16_t*)(p.ws + ACT); bf16_t* y = (bf16_t*)(p.ws + HBUF);
    const int tid = otid(), lane = tid & 63, gw = blockIdx.x * 8 + (tid >> 6), nw = gridDim.x * 8;
    float og[8];
#pragma unroll
    for (int e = 0; e < 8; ++e) og[e] = p.in[11][lane * 8 + e];
    for (int row = gw; row < MTOK; row += nw) {
#pragma unroll
        for (int hd = 0; hd < 4; ++hd) {
            bf16_t* ptr = y + (size_t)row * DM + hd * 512 + lane * 8; float f[8], g[8]; unpack8(*(const u32x4*)ptr, f);
            unpack8(*(const u32x4*)(big + (size_t)row * 6400 + 4096 + hd * 512 + lane * 8), g);
            float ss = 0.f;
#pragma unroll
            for (int e = 0; e < 8; ++e) ss += f[e] * f[e];
            ss = wsum(ss); const float sc = rsqrtf(ss * (1.f / 512.f) + EPS);
#pragma unroll
            for (int e = 0; e < 8; ++e) f[e] = f[e] * sc * og[e] * silu(g[e]);
            *(u32x4*)ptr = pack8(f);
        }
    }
}

DI void phase_conv(const Params& p) {
    const bf16_t* big = (const bf16_t*)(p.ws + ACT); bf16_t* xc = (bf16_t*)(p.ws + HBUF);
    for (size_t idx = (size_t)blockIdx.x * 512 + otid(); idx < (size_t)(MTOK / 8) * 256; idx += (size_t)gridDim.x * 512) {
        const int tok0 = (int)(idx >> 8) * 8, ch = (int)(idx & 255) * 8, t0 = tok0 & (SEQ - 1);
        float wv[4][8], bs[8];
        { const f32x4 b0 = *(const f32x4*)(p.in[15] + ch), b1 = *(const f32x4*)(p.in[15] + ch + 4);
#pragma unroll
          for (int e = 0; e < 4; ++e) { bs[e] = b0[e]; bs[4 + e] = b1[e]; } }
#pragma unroll
        for (int jx = 0; jx < 4; ++jx) { const f32x4 w0 = *(const f32x4*)(p.in[14] + jx * 2048 + ch), w1 = *(const f32x4*)(p.in[14] + jx * 2048 + ch + 4);
#pragma unroll
            for (int e = 0; e < 4; ++e) { wv[jx][e] = w0[e]; wv[jx][4 + e] = w1[e]; } }
        u32x4 raw[11];
#pragma unroll
        for (int r = 0; r < 11; ++r) raw[r] = (r >= 3 || t0 > 0) ? *(const u32x4*)(big + (size_t)(tok0 - 3 + r) * 4096 + ch) : (u32x4){0u, 0u, 0u, 0u};
#pragma unroll
        for (int o = 0; o < 8; ++o) {
            float acc[8];
#pragma unroll
            for (int e = 0; e < 8; ++e) acc[e] = bs[e];
#pragma unroll
            for (int jx = 0; jx < 4; ++jx) { float f[8]; unpack8(raw[o + jx], f);
#pragma unroll
                for (int e = 0; e < 8; ++e) acc[e] += f[e] * wv[jx][e]; }
            *(u32x4*)(xc + (size_t)(tok0 + o) * DM + ch) = pack8(acc);
        }
    }
}
DI void phase_lru_scan(const Params& p, LAS unsigned char* lds) {
    const unsigned* ax = (const unsigned*)(p.ws + ACT + 128 * MiB); const bf16_t* big = (const bf16_t*)(p.ws + ACT);
    bf16_t* y = (bf16_t*)(p.ws + HBUF);
    LAS unsigned* tile = (LAS unsigned*)lds;
    LAS float* sP = (LAS float*)(lds + 65536); LAS float* sH = sP + 512; LAS float* sC = sH + 512;
    const int tid = otid(), seg = tid >> 5, chl = tid & 31;
    for (int u = blockIdx.x; u < 256; u += gridDim.x) {
        const int b = u >> 6, ch = (u & 63) * 32 + chl;
        const size_t rowbase = (size_t)b * SEQ;
        unsigned pre[32];
#pragma unroll
        for (int i = 0; i < 32; ++i) pre[i] = ax[(rowbase + seg + 16 * i) * DM + ch];
        __syncthreads();
        if (tid < 32) sC[tid] = 0.f;
        for (int sc = 0; sc < 8; ++sc) {
#pragma unroll
            for (int i = 0; i < 32; ++i) tile[(seg + 16 * i) * 32 + chl] = pre[i];
            __syncthreads();
            if (sc + 1 < 8) {
#pragma unroll
                for (int i = 0; i < 32; ++i) pre[i] = ax[(rowbase + (sc + 1) * 512 + seg + 16 * i) * DM + ch];
            }
            float L = 0.f, H = 0.f;
#pragma unroll 8
            for (int t = 0; t < 32; ++t) { const unsigned w = tile[(seg * 32 + t) * 32 + chl]; const float la = __uint_as_float(w << 16); H = __expf(la) * H + __uint_as_float(w & 0xffff0000u); L += la; }
            sP[tid] = __expf(L); sH[tid] = H;
            __syncthreads();
            float hc = sC[chl];
            for (int sg = 0; sg < seg; ++sg) hc = sP[sg * 32 + chl] * hc + sH[sg * 32 + chl];
            const size_t r0 = rowbase + sc * 512 + seg * 32;
#pragma unroll 8
            for (int t = 0; t < 32; ++t) { const unsigned w = tile[(seg * 32 + t) * 32 + chl]; hc = __expf(__uint_as_float(w << 16)) * hc + __uint_as_float(w & 0xffff0000u);
                y[(r0 + t) * DM + ch] = f2bf(hc * silu(bf2f(big[(r0 + t) * 4096 + 2048 + ch]))); }
            __syncthreads();
            if (seg == 15) sC[chl] = hc;
        }
    }
}

DI void phase_mla_lat(const Params& p) {
    bf16_t* lat = (bf16_t*)(p.ws + LAT);
    const int tid = otid(), lane = tid & 63, gw = blockIdx.x * 8 + (tid >> 6), nw = gridDim.x * 8;
    float gq[8], gk[8];
#pragma unroll
    for (int e = 0; e < 8; ++e) { gq[e] = p.in[23][lane * 8 + e]; gk[e] = p.in[24][lane * 8 + e]; }
    const float inv = powf(10000.f, -(float)(lane & 31) * (1.f / 32.f));
    const float g1 = p.in[27][192 + 128 + (lane & 31)], g2 = p.in[27][192 + 160 + (lane & 31)];
    for (int row = gw; row < MTOK; row += nw) {
#pragma unroll
        for (int part = 0; part < 2; ++part) {
            bf16_t* ptr = lat + (size_t)row * 1088 + part * 512 + lane * 8; float f[8]; unpack8(*(const u32x4*)ptr, f);
            float ss = 0.f;
#pragma unroll
            for (int e = 0; e < 8; ++e) ss += f[e] * f[e];
            ss = wsum(ss); const float sc = rsqrtf(ss * (1.f / 512.f) + EPS);
#pragma unroll
            for (int e = 0; e < 8; ++e) f[e] = f[e] * sc * (part ? gk[e] : gq[e]);
            *(u32x4*)ptr = pack8(f);
        }
        { bf16_t* kp = lat + (size_t)row * 1088 + 1024; const int i = lane & 31;
          const float x1 = bf2f(kp[i]), x2 = bf2f(kp[i + 32]);
          float ss = (lane < 32) ? x1 * x1 + x2 * x2 : 0.f; ss = wsum(ss); const float sc = rsqrtf(ss * (1.f / 64.f) + EPS);
          const float a1 = x1 * sc * g1, a2 = x2 * sc * g2; float sn, cs; sincosf((float)(row & (SEQ - 1)) * inv, &sn, &cs);
          if (lane < 32) { kp[i] = f2bf(a1 * cs - a2 * sn); kp[i + 32] = f2bf(a2 * cs + a1 * sn); } }
    }
}
DI void phase_mla_qk(const Params& p) {
    bf16_t* qkv = (bf16_t*)(p.ws + ACT); bf16_t* lat = (bf16_t*)(p.ws + LAT); const float* qkg = p.in[27];
    const int tid = otid(), lane = tid & 63, gw = blockIdx.x * 8 + (tid >> 6), nw = gridDim.x * 8;
    const int l16 = lane & 15, l8 = lane & 7;
    float gk[8], gkr[8];
#pragma unroll
    for (int e = 0; e < 8; ++e) { gk[e] = qkg[192 + l16 * 8 + e]; gkr[e] = qkg[192 + 128 + l8 * 8 + e]; }
    float inv[8];
#pragma unroll
    for (int e = 0; e < 8; ++e) inv[e] = powf(10000.f, -(float)((l8 & 3) * 8 + e) * (1.f / 32.f));
    for (int row = gw; row < MTOK; row += nw) {
        bf16_t* qr = qkv + (size_t)row * 7168; bf16_t* kpp = lat + (size_t)row * 1088 + 1024 + l8 * 8;
        u32x4 wk[4];
#pragma unroll
        for (int i = 0; i < 4; ++i) { const int head = 4 * i + (lane >> 4); wk[i] = *(const u32x4*)(qr + 3072 + head * 256 + l16 * 8); }
        const u32x4 wp = *(const u32x4*)kpp;
        const float pos = (float)(row & (SEQ - 1));
#pragma unroll
        for (int i = 0; i < 4; ++i) {
            const int head = 4 * i + (lane >> 4);
            float f[8]; unpack8(wk[i], f); float ss = 0.f;
#pragma unroll
            for (int e = 0; e < 8; ++e) ss += f[e] * f[e];
            ss += __shfl_xor(ss, 1); ss += __shfl_xor(ss, 2); ss += __shfl_xor(ss, 4); ss += __shfl_xor(ss, 8);
            const float sc = rsqrtf(ss * (1.f / 128.f) + EPS);
#pragma unroll
            for (int e = 0; e < 8; ++e) f[e] *= sc * gk[e];
            *(u32x4*)(qr + 3072 + head * 256 + l16 * 8) = pack8(f);
        }
        { float f[8], o[8]; unpack8(wp, f); float ss = 0.f;
#pragma unroll
          for (int e = 0; e < 8; ++e) ss += f[e] * f[e];
          ss += __shfl_xor(ss, 1); ss += __shfl_xor(ss, 2); ss += __shfl_xor(ss, 4);
          const float sc = rsqrtf(ss * (1.f / 64.f) + EPS);
#pragma unroll
          for (int e = 0; e < 8; ++e) {
              const float a = f[e] * sc * gkr[e], pa = __shfl_xor(a, 4);
              float sn, cs; sincosf(pos * inv[e], &sn, &cs);
              o[e] = (l8 < 4) ? a * cs - pa * sn : a * cs + pa * sn;
          }
          if (lane < 8) *(u32x4*)kpp = pack8(o); }
    }
}

#define XB_TMO      128
#define XB_XCNT(j)  (256  + 64 * (j))
#define XB_XSUB(j)  (1280 + 64 * (j))
#define XB_XGEN(j)  (2304 + 64 * (j))
#define XB_TOP      3328
#define XB_TOPGEN   3392
#define XCD_BAR_WORDS 3456
#define XB_SPIN_CAP (1u << 22)
DI unsigned xb_ld(unsigned* p)              { return __hip_atomic_load(p, __ATOMIC_RELAXED, __HIP_MEMORY_SCOPE_AGENT); }
DI unsigned xb_add(unsigned* p, unsigned v) { return __hip_atomic_fetch_add(p, v, __ATOMIC_RELAXED, __HIP_MEMORY_SCOPE_AGENT); }
DI unsigned xb_xcc_id() { return (unsigned)__builtin_amdgcn_s_getreg((3 << 11) | 20) & 0xFu; }
#define XB_SPIN(cond, bar) do { unsigned _sp = 0; while (cond) { __builtin_amdgcn_s_sleep(1); \
    if ((++_sp & 255u) == 0u) { if (xb_ld(&(bar)[XB_TMO])) break; if (_sp > XB_SPIN_CAP) { atomicAdd(&(bar)[XB_TMO], 1u); break; } } } } while (0)
struct XcdBarrier { unsigned* bar; unsigned x; volatile LAS unsigned* st; };
DI XcdBarrier xcd_barrier_post(unsigned* bar, volatile LAS unsigned* st) {
    XcdBarrier b; b.bar = bar; b.x = xb_xcc_id(); b.st = st;
    if (threadIdx.x == 0) (void)xb_add(&bar[XB_XCNT(b.x)], 1u);
    return b;
}
DI void xcd_barrier_complete(unsigned* bar, unsigned x, unsigned& nloc, unsigned& nx) {
    const unsigned G = gridDim.x * gridDim.y * gridDim.z;
    unsigned sum, cnt, mine, sp = 0u;
    for (;;) {
        sum = 0u; cnt = 0u; mine = 0u;
#pragma unroll
        for (unsigned j = 0; j < 16; ++j) { const unsigned c = xb_ld(&bar[XB_XCNT(j)]); sum += c; cnt += (c > 0u) ? 1u : 0u; mine = (j == x) ? c : mine; }
        if (sum == G) break;
        __builtin_amdgcn_s_sleep(1);
        if ((++sp & 255u) == 0u) { if (xb_ld(&bar[XB_TMO])) break; if (sp > XB_SPIN_CAP) { atomicAdd(&bar[XB_TMO], 1u); break; } }
    }
    nloc = mine > 0u ? mine : 1u; nx = cnt > 0u ? cnt : 1u;
}
DI void xcd_barrier(const XcdBarrier& b0) {
    asm volatile("s_waitcnt vmcnt(0)" ::: "memory");
    __syncthreads();
    if (otid() == 0) {
        XcdBarrier b; b.bar = b0.bar; b.st = b0.st; b.x = xb_xcc_id();
        unsigned* bar = b.bar;
        __builtin_amdgcn_s_waitcnt(0);
        unsigned nloc = b.st[0], nx = b.st[1];
        if (nloc == 0u) { xcd_barrier_complete(bar, b.x, nloc, nx); b.st[0] = nloc; b.st[1] = nx; }
        const unsigned old = xb_add(&bar[XB_XSUB(b.x)], 1u);
        const unsigned gen = old / nloc;
        if (old + 1u == (gen + 1u) * nloc) {
            __builtin_amdgcn_fence(__ATOMIC_RELEASE, "agent");
            asm volatile("s_waitcnt vmcnt(0)" ::: "memory");
            const unsigned og = xb_add(&bar[XB_TOP], 1u);
            const unsigned tg = og / nx;
            if (og + 1u == (tg + 1u) * nx) xb_add(&bar[XB_TOPGEN], 1u);
            else XB_SPIN(xb_ld(&bar[XB_TOPGEN]) == tg, bar);
            __builtin_amdgcn_fence(__ATOMIC_ACQUIRE, "agent");
            xb_add(&bar[XB_XGEN(b.x)], 1u);
            asm volatile("s_waitcnt vmcnt(0)" ::: "memory");
        } else {
            XB_SPIN(xb_ld(&bar[XB_XGEN(b.x)]) == gen, bar);
            __builtin_amdgcn_fence(__ATOMIC_ACQUIRE, "agent");
            asm volatile("s_waitcnt vmcnt(0)" ::: "memory");
        }
    }
    __syncthreads();
}

__global__ __launch_bounds__(512, 2) void mega(const Params p) {
    extern __shared__ __attribute__((aligned(16))) unsigned char shm[];
    LAS unsigned char* lds = (LAS unsigned char*)shm;
    cg::grid_group grid = cg::this_grid();
    volatile LAS unsigned* bst = (volatile LAS unsigned*)(lds + 131072 + 1024);
    if (threadIdx.x == 0) { bst[0] = 0u; bst[1] = 0u; }
    __syncthreads();
    XcdBarrier xb = xcd_barrier_post((unsigned*)(p.ws + WS_BAR), bst); xb.x = 0;
    if constexpr ((PHMASK >> 0) & 1) { phase_convert(p, lds); }
    if constexpr ((REPMASK >> 0) & 1) { __syncthreads(); phase_convert(p, lds); }
    if constexpr ((PHMASK >> 1) & 1) { phase_bias_table(p); }
    if constexpr ((REPMASK >> 1) & 1) { __syncthreads(); phase_bias_table(p); }
    if constexpr ((PHMASK >> 2) & 1) { phase_x0(p.in[0], (bf16_t*)(uni(p.ws) + XG), (float*)(uni(p.ws) + X_SSQ) + 5 * MTOK); }
    if constexpr ((REPMASK >> 2) & 1) { __syncthreads(); phase_rmsnorm(p.in[0], p.in[1], (bf16_t*)(uni(p.ws) + HBUF)); }
    if (p.njobs < 0) grid.sync();
    xcd_barrier(xb);
    if constexpr ((PHMASK >> 3) & 1) { { pg8::EpiStoreA E{(bf16_t*)(uni(p.ws) + ACT), p.in[4], (const float*)(uni(p.ws) + X_SSQ) + 5 * MTOK}; run_gemm<0>(lds, (const bf16_t*)(uni(p.ws) + XG), (const bf16_t*)(uni(p.ws) + W_A_IN), 8192, 2048, 2048, E); } }
    if constexpr ((REPMASK >> 3) & 1) { __syncthreads(); { pg8::EpiStoreA E{(bf16_t*)(uni(p.ws) + ACT), p.in[4], (const float*)(uni(p.ws) + X_SSQ) + 5 * MTOK}; run_gemm<0>(lds, (const bf16_t*)(uni(p.ws) + XG), (const bf16_t*)(uni(p.ws) + W_A_IN), 8192, 2048, 2048, E); } }
    xcd_barrier(xb);
    if constexpr ((PHMASK >> 5) & 1) { phase_attn_a(p, lds); }
    if constexpr ((REPMASK >> 5) & 1) { __syncthreads(); phase_attn_a(p, lds); }
    xcd_barrier(xb);
    if constexpr ((PHMASK >> 6) & 1) { { pg8::EpiResid<true, false, true, true> E{nullptr, (const bf16_t*)(uni(p.ws) + XG), nullptr, (bf16_t*)(uni(p.ws) + XG), (float*)(uni(p.ws) + X_SSQ)}; run_gemm<0>(lds, (bf16_t*)(uni(p.ws) + HBUF), (const bf16_t*)(uni(p.ws) + W_A_OUT), 2048, 2048, 2048, E); } }
    if constexpr ((REPMASK >> 6) & 1) { __syncthreads(); { pg8::EpiResid<true, false, true, true> E{nullptr, (const bf16_t*)(uni(p.ws) + XG), nullptr, (bf16_t*)(uni(p.ws) + XG), (float*)(uni(p.ws) + X_SSQ)}; run_gemm<0>(lds, (bf16_t*)(uni(p.ws) + HBUF), (const bf16_t*)(uni(p.ws) + W_A_OUT), 2048, 2048, 2048, E); } }
    xcd_barrier(xb);
    if constexpr ((PHMASK >> 8) & 1) { { pg8::EpiStore E{(bf16_t*)(uni(p.ws) + ACT), 6400, (const float*)(uni(p.ws) + X_SSQ)}; run_gemm<0>(lds, (const bf16_t*)(uni(p.ws) + XG), (const bf16_t*)(uni(p.ws) + W_B_IN), 6144, 2048, 2048, E); } }
    if constexpr ((REPMASK >> 8) & 1) { __syncthreads(); { pg8::EpiStore E{(bf16_t*)(uni(p.ws) + ACT), 6400, (const float*)(uni(p.ws) + X_SSQ)}; run_gemm<0>(lds, (const bf16_t*)(uni(p.ws) + XG), (const bf16_t*)(uni(p.ws) + W_B_IN), 6144, 2048, 2048, E); } }
    xcd_barrier(xb);
    if constexpr ((PHMASK >> 9) & 1) { phase_gla_prep(p, lds); }
    if constexpr ((REPMASK >> 9) & 1) { __syncthreads(); phase_gla_prep(p, lds); }
    xcd_barrier(xb);
    if constexpr ((PHMASK >> 10) & 1) { phase_gla_scan(p, lds); }
    if constexpr ((REPMASK >> 10) & 1) { __syncthreads(); phase_gla_scan(p, lds); }
    xcd_barrier(xb);
    if constexpr ((PHMASK >> 11) & 1) { phase_gla_post(p); }
    if constexpr ((REPMASK >> 11) & 1) { __syncthreads(); phase_gla_post(p); }
    xcd_barrier(xb);
    if constexpr ((PHMASK >> 12) & 1) { { pg8::EpiResid<true, false, true, true> E{nullptr, (const bf16_t*)(uni(p.ws) + XG), nullptr, (bf16_t*)(uni(p.ws) + XG), (float*)(uni(p.ws) + X_SSQ) + MTOK}; run_gemm<0>(lds, (bf16_t*)(uni(p.ws) + HBUF), (const bf16_t*)(uni(p.ws) + W_B_OUT), 2048, 2048, 2048, E); } }
    if constexpr ((REPMASK >> 12) & 1) { __syncthreads(); { pg8::EpiResid<true, false, true, true> E{nullptr, (const bf16_t*)(uni(p.ws) + XG), nullptr, (bf16_t*)(uni(p.ws) + XG), (float*)(uni(p.ws) + X_SSQ) + MTOK}; run_gemm<0>(lds, (bf16_t*)(uni(p.ws) + HBUF), (const bf16_t*)(uni(p.ws) + W_B_OUT), 2048, 2048, 2048, E); } }
    xcd_barrier(xb);
    if constexpr ((PHMASK >> 14) & 1) { { pg8::EpiStore E{(bf16_t*)(uni(p.ws) + ACT), 4096, (const float*)(uni(p.ws) + X_SSQ) + MTOK}; run_gemm<0>(lds, (const bf16_t*)(uni(p.ws) + XG), (const bf16_t*)(uni(p.ws) + W_C_IN), 4096, 2048, 2048, E); } }
    if constexpr ((REPMASK >> 14) & 1) { __syncthreads(); { pg8::EpiStore E{(bf16_t*)(uni(p.ws) + ACT), 4096, (const float*)(uni(p.ws) + X_SSQ) + MTOK}; run_gemm<0>(lds, (const bf16_t*)(uni(p.ws) + XG), (const bf16_t*)(uni(p.ws) + W_C_IN), 4096, 2048, 2048, E); } }
    xcd_barrier(xb);
    if constexpr ((PHMASK >> 15) & 1) { phase_conv(p); }
    if constexpr ((REPMASK >> 15) & 1) { __syncthreads(); phase_conv(p); }
    xcd_barrier(xb);
    if constexpr ((PHMASK >> 16) & 1) { { pg8::EpiGates E{(bf16_t*)(uni(p.ws) + HBUF), p.in[17], p.in[19], (const float*)(uni(p.ws) + X_SP8), (unsigned*)(uni(p.ws) + ACT + 128 * MiB)}; run_gemm<2>(lds, (bf16_t*)(uni(p.ws) + HBUF), (const bf16_t*)(uni(p.ws) + W_C_GATE), 4096, 256, 2048, E); } }
    if constexpr ((REPMASK >> 16) & 1) { __syncthreads(); { pg8::EpiGates E{(bf16_t*)(uni(p.ws) + HBUF), p.in[17], p.in[19], (const float*)(uni(p.ws) + X_SP8), (unsigned*)(uni(p.ws) + ACT + 128 * MiB)}; run_gemm<2>(lds, (bf16_t*)(uni(p.ws) + HBUF), (const bf16_t*)(uni(p.ws) + W_C_GATE), 4096, 256, 2048, E); } }
    xcd_barrier(xb);
    if constexpr ((PHMASK >> 17) & 1) { phase_lru_scan(p, lds); }
    if constexpr ((REPMASK >> 17) & 1) { __syncthreads(); phase_lru_scan(p, lds); }
    xcd_barrier(xb);
    if constexpr ((PHMASK >> 18) & 1) { { pg8::EpiResid<true, false, true, true> E{nullptr, (const bf16_t*)(uni(p.ws) + XG), nullptr, (bf16_t*)(uni(p.ws) + XG), (float*)(uni(p.ws) + X_SSQ) + 2 * MTOK}; run_gemm<0>(lds, (bf16_t*)(uni(p.ws) + HBUF), (const bf16_t*)(uni(p.ws) + W_C_OUT), 2048, 2048, 2048, E); } }
    if constexpr ((REPMASK >> 18) & 1) { __syncthreads(); { pg8::EpiResid<true, false, true, true> E{nullptr, (const bf16_t*)(uni(p.ws) + XG), nullptr, (bf16_t*)(uni(p.ws) + XG), (float*)(uni(p.ws) + X_SSQ) + 2 * MTOK}; run_gemm<0>(lds, (bf16_t*)(uni(p.ws) + HBUF), (const bf16_t*)(uni(p.ws) + W_C_OUT), 2048, 2048, 2048, E); } }
    xcd_barrier(xb);
    if constexpr ((PHMASK >> 20) & 1) { { pg8::EpiStoreD E{(bf16_t*)(uni(p.ws) + LAT), (bf16_t*)(uni(p.ws) + HBUF), (const float*)(uni(p.ws) + X_SSQ) + 2 * MTOK, (float*)(uni(p.ws) + X_SSQ) + 3 * MTOK}; run_gemm<0>(lds, (const bf16_t*)(uni(p.ws) + XG), (const bf16_t*)(uni(p.ws) + W_D_IN), 3328, 2048, 2048, E); } }
    if constexpr ((REPMASK >> 20) & 1) { __syncthreads(); { pg8::EpiStoreD E{(bf16_t*)(uni(p.ws) + LAT), (bf16_t*)(uni(p.ws) + HBUF), (const float*)(uni(p.ws) + X_SSQ) + 2 * MTOK, (float*)(uni(p.ws) + X_SSQ) + 3 * MTOK}; run_gemm<0>(lds, (const bf16_t*)(uni(p.ws) + XG), (const bf16_t*)(uni(p.ws) + W_D_IN), 3328, 2048, 2048, E); } }
    xcd_barrier(xb);
    if constexpr ((PHMASK >> 22) & 1) { { pg8::EpiStoreU E{(bf16_t*)(uni(p.ws) + ACT), (const float*)(uni(p.ws) + X_SSQ) + 3 * MTOK}; run_gemm<1>(lds, (const bf16_t*)(uni(p.ws) + LAT), (const bf16_t*)(uni(p.ws) + W_D_UQKV), 7168, 512, 1088, E); } }
    if constexpr ((REPMASK >> 22) & 1) { __syncthreads(); { pg8::EpiStoreU E{(bf16_t*)(uni(p.ws) + ACT), (const float*)(uni(p.ws) + X_SSQ) + 3 * MTOK}; run_gemm<1>(lds, (const bf16_t*)(uni(p.ws) + LAT), (const bf16_t*)(uni(p.ws) + W_D_UQKV), 7168, 512, 1088, E); } }
    xcd_barrier(xb);
    if constexpr ((PHMASK >> 23) & 1) { phase_mla_qk(p); }
    if constexpr ((REPMASK >> 23) & 1) { __syncthreads(); phase_mla_qk(p); }
    xcd_barrier(xb);
    if constexpr ((PHMASK >> 24) & 1) { phase_attn_d(p, lds); }
    if constexpr ((REPMASK >> 24) & 1) { __syncthreads(); phase_attn_d(p, lds); }
    xcd_barrier(xb);
    if constexpr ((PHMASK >> 25) & 1) { { pg8::EpiResid<true, true, false, false> E{nullptr, (const bf16_t*)(uni(p.ws) + XG), uni(p.out), nullptr, nullptr}; run_gemm<0>(lds, (bf16_t*)(uni(p.ws) + HBUF), (const bf16_t*)(uni(p.ws) + W_D_OUT), 2048, 2048, 2048, E); } }
    if constexpr ((REPMASK >> 25) & 1) { __syncthreads(); { pg8::EpiResid<true, true, false, false> E{nullptr, (const bf16_t*)(uni(p.ws) + XG), uni(p.out), nullptr, nullptr}; run_gemm<0>(lds, (bf16_t*)(uni(p.ws) + HBUF), (const bf16_t*)(uni(p.ws) + W_D_OUT), 2048, 2048, 2048, E); } }
#ifdef XSYNC
    for (int i = 0; i < XSYNC; ++i) xcd_barrier(xb);
#endif
}

extern "C" void kernel_launch(void* const* d_in, const int* in_sizes, int n_in, void* d_out, int out_size, void* d_ws, size_t ws_size, hipStream_t stream) {
    static int grid_blocks = 0;
    if (!grid_blocks) {
        int dev = 0, cus = 0, per_cu = 0;
        hipGetDevice(&dev);
        hipDeviceGetAttribute(&cus, hipDeviceAttributeMultiprocessorCount, dev);
        hipFuncSetAttribute((const void*)mega, hipFuncAttributeMaxDynamicSharedMemorySize, LDS_BYTES);
        hipOccupancyMaxActiveBlocksPerMultiprocessor(&per_cu, (const void*)mega, 512, LDS_BYTES);
        if (per_cu < 1) per_cu = 1;
        grid_blocks = cus * per_cu;
        if (ws_size < EXTRA + 65536 + 6 * 65536) fprintf(stderr, "kernel_launch: workspace too small (%zu < %zu)\n", ws_size, (size_t)WS_END);
    }
    Params p; memset(&p, 0, sizeof(p));
    for (int i = 0; i < 29; ++i) p.in[i] = (const float*)d_in[i];
    p.out = (float*)d_out; p.ws = (unsigned char*)d_ws;
    unsigned char* ws = (unsigned char*)d_ws;
    int nj = 0, tiles = 0;
    auto add = [&](const float* src, size_t dst_off, int K, int N, int ldw, int npad) {
        TJob& j = p.jobs[nj++]; j.src = src; j.dst = (bf16_t*)(ws + dst_off); j.kscale = nullptr; j.K = K; j.N = N; j.ldw = ldw; j.ntn = npad / 64; j.tile0 = tiles; j.pad = 0; tiles += (npad / 64) * (K / 256);
    };
    add(p.in[3], W_A_IN, 2048, 8192, 8192, 8192); p.jobs[0].pad = 1; p.jobs[0].kscale = p.in[1];
    add(p.in[7], W_A_OUT, 2048, 2048, 2048, 2048);
    add(p.in[8], W_B_IN, 2048, 6160, 6160, 6400); p.jobs[nj - 1].kscale = p.in[1] + 2048;
    add(p.in[12], W_B_OUT, 2048, 2048, 2048, 2048);
    add(p.in[13], W_C_IN, 2048, 4096, 4096, 4096); p.jobs[nj - 1].kscale = p.in[1] + 4096;
    add(p.in[21], W_C_OUT, 2048, 2048, 2048, 2048);
    add(p.in[22], W_D_IN, 2048, 3136, 3136, 3328); p.jobs[nj - 1].kscale = p.in[1] + 6144;
    add(p.in[25], W_D_UQKV, 512, 3072, 3072, 3072); p.jobs[nj - 1].kscale = p.in[23];
    add(p.in[26], W_D_UQKV + (size_t)3072 * 512 * 2, 512, 4096, 4096, 4096); p.jobs[nj - 1].kscale = p.in[24];
    add(p.in[28], W_D_OUT, 2048, 2048, 2048, 2048);
    for (int n = 0; n < 8; ++n) for (int half = 0; half < 2; ++half) for (int bj = 0; bj < 2; ++bj)
        add(p.in[bj ? 18 : 16] + (size_t)n * 65536 + half * 128, W_C_GATE + ((size_t)((n * 2 + half) * 256 + 128 * bj)) * 256 * 2, 256, 128, 256, 128);
    p.njobs = nj; p.ntiles = tiles;
    hipMemsetAsync(ws + WS_BAR, 0, XCD_BAR_WORDS * 4, stream);
    void* args[] = {(void*)&p};
    hipError_t e = hipLaunchCooperativeKernel((const void*)mega, dim3(grid_blocks), dim3(512), args, LDS_BYTES, stream);
    if (e != hipSuccess) fprintf(stderr, "cooperative launch failed: %s (grid %d)\n", hipGetErrorString(e), grid_blocks);
}
```

```cpp
#include <hip/hip_runtime.h>
#include <hip/hip_cooperative_groups.h>
#include <cstdio>
#include <cstring>
namespace cg = cooperative_groups;

#define DI __device__ __forceinline__
#define LAS __attribute__((address_space(3)))
typedef unsigned short bf16_t;
typedef short bf16x8 __attribute__((ext_vector_type(8)));
typedef short s16x4 __attribute__((ext_vector_type(4)));
typedef float f32x2 __attribute__((ext_vector_type(2)));
typedef float f32x4 __attribute__((ext_vector_type(4)));
typedef float f32x16 __attribute__((ext_vector_type(16)));
typedef unsigned u32x2 __attribute__((ext_vector_type(2)));
typedef unsigned u32x4 __attribute__((ext_vector_type(4)));
typedef __bf16 bf16v2_t __attribute__((ext_vector_type(2)));

constexpr int MTOK = 16384, DM = 2048, SEQ = 4096;
constexpr float EPS = 1e-6f, LOG2E = 1.4426950408889634f;
constexpr size_t MiB = (size_t)1 << 20;
constexpr size_t W_A_IN = 0, W_A_OUT = 32 * MiB, W_B_IN = 40 * MiB, W_B_OUT = 65 * MiB, W_C_IN = 73 * MiB, W_C_GATE = 89 * MiB,
                 W_C_OUT = 91 * MiB, W_D_IN = 99 * MiB, W_D_UQKV = 112 * MiB, W_D_OUT = 119 * MiB, HBUF = 127 * MiB, ACT = 191 * MiB,
                 WS_END = 511 * MiB;
constexpr size_t LAT = 0;
constexpr size_t EXTRA = 511 * MiB;
constexpr size_t X_BIAS = EXTRA + 16384, X_SP8 = EXTRA + 32768, X_SSQ = EXTRA + 65536;
constexpr size_t GLA_TOT = ACT + 200 * MiB;
constexpr size_t XG = ACT + 256 * MiB;
constexpr size_t WS_BAR = EXTRA;
constexpr int LDS_BYTES = 131072 + 2048;
#ifndef PHMASK
#define PHMASK 0xffffffffull
#endif
#ifndef REPMASK
#define REPMASK 0ull
#endif

struct TJob { const float* src; bf16_t* dst; const float* kscale; int K, N, ldw, ntn, tile0, pad; };
struct Params { const float* in[29]; float* out; unsigned char* ws; int njobs, ntiles; TJob jobs[44]; };

DI int otid() { int t = threadIdx.x; asm volatile("" : "+v"(t)); return t; }
template <class T> DI T* uni(T* p) {
    const unsigned long long v = (unsigned long long)p;
    const unsigned lo = __builtin_amdgcn_readfirstlane((unsigned)v), hi = __builtin_amdgcn_readfirstlane((unsigned)(v >> 32));
    return (T*)(((unsigned long long)hi << 32) | lo);
}
DI float bf2f(bf16_t v) { return __uint_as_float((unsigned)v << 16); }
DI unsigned pk2(float a, float b) { f32x2 v = {a, b}; bf16v2_t r = __builtin_convertvector(v, bf16v2_t); return __builtin_bit_cast(unsigned, r); }
DI bf16_t f2bf(float a) { return (bf16_t)(pk2(a, 0.f) & 0xffffu); }
DI void unpack8(const u32x4 w, float (&f)[8]) {
#pragma unroll
    for (int i = 0; i < 4; ++i) { f[2 * i] = __uint_as_float(w[i] << 16); f[2 * i + 1] = __uint_as_float(w[i] & 0xffff0000u); }
}
DI u32x4 pack8(const float (&f)[8]) { u32x4 w; w.x = pk2(f[0], f[1]); w.y = pk2(f[2], f[3]); w.z = pk2(f[4], f[5]); w.w = pk2(f[6], f[7]); return w; }
DI float wsum(float v) {
#pragma unroll
    for (int m = 32; m >= 1; m >>= 1) v += __shfl_xor(v, m);
    return v;
}
DI float sigm(float x) { return 1.f / (1.f + __expf(-x)); }
DI float silu(float x) { return x / (1.f + __expf(-x)); }
DI int crow(int i, int hh) { return (i & 3) + 8 * (i >> 2) + 4 * hh; }
DI f32x16 mfma32(bf16x8 a, bf16x8 b, f32x16 c) { return __builtin_amdgcn_mfma_f32_32x32x16_bf16(a, b, c, 0, 0, 0); }
DI s16x4 trread(LAS unsigned char* p) { return __builtin_amdgcn_ds_read_tr16_b64_v4i16((LAS s16x4*)p); }
DI bf16x8 cat4(s16x4 lo, s16x4 hi) { return __builtin_shufflevector(lo, hi, 0, 1, 2, 3, 4, 5, 6, 7); }

namespace pg8 {
constexpr int BM = 256, BK = 64, HALF = 128, HTB = HALF * BK * 2, STAGE_BYTES = 8 * HTB, NXCD = 8, WGM = 8;
DI int lds_byte(int r, int c) { const int st = (r >> 4) * 2 + (c >> 5), rr = r & 15, cc = c & 31, ob = rr * 64 + cc * 2; return st * 1024 + (ob ^ (((ob >> 9) & 1) << 5)); }
DI void stage_rc(int b, int& R, int& C) { const int st = b / 1024, sb = b % 1024, swz = sb ^ (((sb >> 9) & 1) << 5); R = (st >> 1) * 16 + swz / 64; C = (st & 1) * 32 + (swz % 64) / 2; }
DI int perm32(int rho) { const int n = rho >> 4, i = rho & 15; return 8 * (i >> 2) + 4 * n + (i & 3); }
struct Unit { int pm, pn; size_t aoff, boff; };
template <int MODE> struct Sched {
    int nM, nN, nwg, G, c, lda, K;
    DI void init(int M, int N, int G_, int c_, int lda_, int K_) { nM = M / BM; nN = N / BM; nwg = nM * nN; G = G_; c = c_; lda = lda_; K = K_; }
    DI bool next(int i, Unit& u) const {
        const long L = (long)i * G + c; if (L >= nwg) return false;
        int wgid = (int)L; { const int q = nwg / NXCD, r = nwg % NXCD, xcd = wgid % NXCD, off = wgid / NXCD; wgid = (xcd < r ? xcd * (q + 1) : r * (q + 1) + (xcd - r) * q) + off; }
        const int nig = WGM * nN, gid = wgid / nig, fm = gid * WGM, gsz = (nM - fm) < WGM ? (nM - fm) : WGM;
        u.pm = fm + ((wgid % nig) % gsz); u.pn = (wgid % nig) / gsz;
        u.aoff = (size_t)u.pm * 256 * lda * 2; u.boff = (size_t)u.pn * 256 * K * 2;
        if (MODE == 1 && u.pn >= 12) u.aoff += 1024;
        if (MODE == 2) u.aoff += (size_t)(u.pn >> 1) * 512;
        return true;
    }
};

template <class Epi, class SchedT>
DI void gemm_phase(LAS unsigned char* lds, const bf16_t* Ap, const bf16_t* Btp, const int K, const int lda, const SchedT& S, const Epi& E) {
    const int tid = otid(), wid = __builtin_amdgcn_readfirstlane(tid >> 6), lane = tid & 63, wr = wid >> 2, wc = wid & 3, fr = lane & 15, fq = lane >> 4;
    const int nt = K / BK;
    unsigned voffA[2], voffB[2];
#pragma unroll
    for (int i = 0; i < 2; ++i) { int R, C; stage_rc(tid * 16 + i * 8192, R, C); const int Rb = (R & ~31) + perm32(R & 31);
        voffA[i] = (unsigned)(R * lda + C) * 2u; voffB[i] = (unsigned)(Rb * K + C) * 2u; }
    const size_t kstep = (size_t)(BK * 2);
    const size_t hstepA = (size_t)HALF * lda * 2, hstepB = (size_t)HALF * K * 2;
    const unsigned ldsw = (unsigned)wid * 1024u;
    const int aoff = lds_byte(wr * 64 + fr, fq * 8), boff = lds_byte(wc * 32 + fr, fq * 8);
#define PG8_SA(b, h) (((b) * 2 + (h)) * HTB)
#define PG8_SB(b, h) ((4 + (b) * 2 + (h)) * HTB)
#define PG8_STAGE(bufoff, gbase, voff) do { _Pragma("unroll") for (int _i = 0; _i < 2; ++_i) \
        __builtin_amdgcn_global_load_lds((const unsigned*)((const char*)(gbase) + (voff)[_i]), (LAS unsigned*)(lds + (bufoff) + ldsw + _i * 8192), 16, 0, 0); } while (0)
#define PG8_LDA(dst, b, h) do { _Pragma("unroll") for (int m = 0; m < 4; ++m) _Pragma("unroll") for (int k = 0; k < 2; ++k) dst[m][k] = *(const LAS bf16x8*)(lds + PG8_SA(b, h) + aoff + m * 2048 + k * 1024); } while (0)
#define PG8_LDB(dst, b, h) do { _Pragma("unroll") for (int n = 0; n < 2; ++n) _Pragma("unroll") for (int k = 0; k < 2; ++k) dst[n][k] = *(const LAS bf16x8*)(lds + PG8_SB(b, h) + boff + n * 2048 + k * 1024); } while (0)
#define PG8_MMA(ai, bj, At, Bt) do { __builtin_amdgcn_s_setprio(1); _Pragma("unroll") for (int m = 0; m < 4; ++m) _Pragma("unroll") for (int n = 0; n < 2; ++n) _Pragma("unroll") for (int k = 0; k < 2; ++k) \
        acc[ai][bj][m][n] = __builtin_amdgcn_mfma_f32_16x16x32_bf16(Bt[n][k], At[m][k], acc[ai][bj][m][n], 0, 0, 0); __builtin_amdgcn_s_setprio(0); } while (0)
#define PG8_WAIT_V(n) asm volatile("s_waitcnt vmcnt(" #n ")" ::: "memory")
#define PG8_WAIT_L(n) asm volatile("s_waitcnt lgkmcnt(" #n ")" ::: "memory")
#define PG8_BAR __builtin_amdgcn_s_barrier()
#define PG8_SCHED __builtin_amdgcn_sched_barrier(0)
    Unit cur, nxt; int ui = 0;
    if (!S.next(0, cur)) return;
    float pre[8]; E.prefetch(cur, wr, fr, pre);
    f32x4 acc[2][2][4][2];
#pragma unroll
    for (int a = 0; a < 2; ++a)
#pragma unroll
        for (int b = 0; b < 2; ++b)
#pragma unroll
            for (int m = 0; m < 4; ++m)
#pragma unroll
                for (int n = 0; n < 2; ++n) acc[a][b][m][n] = (f32x4){0.f, 0.f, 0.f, 0.f};
    bf16x8 At[4][2], B0[2][2], B1[2][2];
    const char* cA = (const char*)Ap + cur.aoff; const char* cB = (const char*)Btp + cur.boff;
    PG8_STAGE(PG8_SB(0, 0), cB, voffB); PG8_STAGE(PG8_SA(0, 0), cA, voffA); PG8_STAGE(PG8_SB(0, 1), cB + hstepB, voffB); PG8_STAGE(PG8_SA(0, 1), cA + hstepA, voffA);
    if (wr == 1) PG8_BAR;
    PG8_WAIT_V(4); PG8_BAR;
    PG8_STAGE(PG8_SB(1, 0), cB + kstep, voffB); PG8_STAGE(PG8_SA(1, 0), cA + kstep, voffA); PG8_STAGE(PG8_SB(1, 1), cB + hstepB + kstep, voffB);
    PG8_WAIT_V(6); PG8_BAR;
    for (;;) {
        const bool has_next = S.next(ui + 1, nxt);
        const char* nA = has_next ? (const char*)Ap + nxt.aoff : cA; const char* nB = has_next ? (const char*)Btp + nxt.boff : cB;
        for (int t = 0; t < nt; t += 2) {
            const bool last = (t == nt - 2);
            const char* a1 = cA + (size_t)(t + 1) * kstep;
            const char* a2 = last ? nA : cA + (size_t)(t + 2) * kstep; const char* b2 = last ? nB : cB + (size_t)(t + 2) * kstep;
            const char* a3 = a2 + kstep; const char* b3 = b2 + kstep;
            PG8_LDB(B0, 0, 0); PG8_SCHED; PG8_LDA(At, 0, 0); PG8_STAGE(PG8_SA(1, 1), a1 + hstepA, voffA);
            PG8_WAIT_L(8); PG8_BAR; PG8_WAIT_L(0); PG8_MMA(0, 0, At, B0); PG8_BAR; PG8_SCHED;
            PG8_LDB(B1, 0, 1); PG8_STAGE(PG8_SB(0, 0), b2, voffB);
            PG8_BAR; PG8_WAIT_L(0); PG8_MMA(0, 1, At, B1); PG8_BAR;
            PG8_LDA(At, 0, 1); PG8_STAGE(PG8_SA(0, 0), a2, voffA);
            PG8_BAR; PG8_WAIT_L(0); PG8_MMA(1, 0, At, B0); PG8_BAR; PG8_SCHED;
            PG8_STAGE(PG8_SB(0, 1), b2 + hstepB, voffB);
            PG8_WAIT_V(6); PG8_BAR; PG8_MMA(1, 1, At, B1); PG8_BAR;
            PG8_LDB(B0, 1, 0); PG8_SCHED; PG8_LDA(At, 1, 0); PG8_STAGE(PG8_SA(0, 1), a2 + hstepA, voffA);
            PG8_WAIT_L(8); PG8_BAR; PG8_WAIT_L(0); PG8_MMA(0, 0, At, B0); PG8_BAR; PG8_SCHED;
            PG8_LDB(B1, 1, 1); PG8_STAGE(PG8_SB(1, 0), b3, voffB);
            PG8_BAR; PG8_WAIT_L(0); PG8_MMA(0, 1, At, B1); PG8_BAR;
            PG8_LDA(At, 1, 1); PG8_STAGE(PG8_SA(1, 0), a3, voffA);
            PG8_BAR; PG8_WAIT_L(0); PG8_MMA(1, 0, At, B0); PG8_BAR; PG8_SCHED;
            PG8_STAGE(PG8_SB(1, 1), b3 + hstepB, voffB);
            PG8_WAIT_V(6); PG8_BAR; PG8_MMA(1, 1, At, B1); PG8_BAR;
        }
        E(acc, cur, wr, wc, fr, fq, pre);
        if (!has_next) break;
#pragma unroll
        for (int a = 0; a < 2; ++a)
#pragma unroll
            for (int b = 0; b < 2; ++b)
#pragma unroll
                for (int m = 0; m < 4; ++m)
#pragma unroll
                    for (int n = 0; n < 2; ++n) acc[a][b][m][n] = (f32x4){0.f, 0.f, 0.f, 0.f};
        cur = nxt; cA = nA; cB = nB; ++ui; E.prefetch(cur, wr, fr, pre);
    }
    PG8_WAIT_V(0);
    if (wr == 0) PG8_BAR;
    PG8_BAR;
#undef PG8_SA
#undef PG8_SB
#undef PG8_STAGE
#undef PG8_LDA
#undef PG8_LDB
#undef PG8_MMA
#undef PG8_WAIT_V
#undef PG8_WAIT_L
#undef PG8_BAR
#undef PG8_SCHED
}

typedef f32x4 Acc[2][2][4][2];
struct EpiStore {
    bf16_t* O; int ldc; const float* ssq;
    DI void prefetch(const Unit& u, int wr, int fr, float (&pre)[8]) const {
#pragma unroll
        for (int i = 0; i < 8; ++i) pre[i] = ssq ? ssq[u.pm * BM + wr * 64 + fr + (i >> 2) * HALF + (i & 3) * 16] : 0.f; }
    DI void operator()(const Acc& acc, const Unit& u, int wr, int wc, int fr, int fq, const float (&pre)[8]) const {
        const int row0 = u.pm * BM + wr * 64 + fr, col0 = u.pn * BM + wc * 32 + 8 * fq;
#pragma unroll
        for (int ai = 0; ai < 2; ++ai)
#pragma unroll
            for (int m = 0; m < 4; ++m) { bf16_t* rowp = O + (size_t)(row0 + ai * HALF + m * 16) * ldc + col0;
                const float rs = ssq ? rsqrtf(pre[ai * 4 + m] * (1.f / DM) + EPS) : 1.f;
#pragma unroll
                for (int bj = 0; bj < 2; ++bj) { const f32x4 v0 = acc[ai][bj][m][0] * rs, v1 = acc[ai][bj][m][1] * rs;
                    u32x4 w; w.x = pk2(v0[0], v0[1]); w.y = pk2(v0[2], v0[3]); w.z = pk2(v1[0], v1[1]); w.w = pk2(v1[2], v1[3]);
                    *(u32x4*)(rowp + bj * HALF) = w; } }
    }
};
struct EpiStoreA {
    bf16_t* O; const float* qkg; const float* ssq;
    DI void prefetch(const Unit& u, int wr, int fr, float (&pre)[8]) const {
#pragma unroll
        for (int i = 0; i < 8; ++i) pre[i] = ssq[u.pm * BM + wr * 64 + fr + (i >> 2) * HALF + (i & 3) * 16]; }
    DI void operator()(const Acc& acc, const Unit& u, int wr, int wc, int fr, int fq, const float (&pre)[8]) const {
        const int row0 = u.pm * BM + wr * 64 + fr, col0 = u.pn * BM + wc * 64 + 8 * fq;
        const bool nrm = u.pn < 16;
        f32x4 gn[2][2];
        if (nrm) { const float* gp = qkg + (u.pn < 8 ? 0 : 64) + 8 * fq; const float gs = u.pn < 8 ? 0.125f * LOG2E : 1.f;
#pragma unroll
            for (int bj = 0; bj < 2; ++bj) { gn[bj][0] = *(const f32x4*)(gp + 32 * bj) * gs; gn[bj][1] = *(const f32x4*)(gp + 32 * bj + 4) * gs; } }
#pragma unroll
        for (int ai = 0; ai < 2; ++ai)
#pragma unroll
            for (int m = 0; m < 4; ++m) { bf16_t* rowp = O + (size_t)(row0 + ai * HALF + m * 16) * 8192 + col0;
                f32x4 v[2][2]; const float rs = rsqrtf(pre[ai * 4 + m] * (1.f / DM) + EPS);
#pragma unroll
                for (int bj = 0; bj < 2; ++bj) { v[bj][0] = acc[ai][bj][m][0] * rs; v[bj][1] = acc[ai][bj][m][1] * rs; }
                if (nrm) { float ss = 0.f;
#pragma unroll
                    for (int bj = 0; bj < 2; ++bj)
#pragma unroll
                        for (int n = 0; n < 2; ++n) ss += v[bj][n][0] * v[bj][n][0] + v[bj][n][1] * v[bj][n][1] + v[bj][n][2] * v[bj][n][2] + v[bj][n][3] * v[bj][n][3];
                    ss += __shfl_xor(ss, 16); ss += __shfl_xor(ss, 32);
                    const float sc = rsqrtf(ss * (1.f / 64.f) + EPS);
#pragma unroll
                    for (int bj = 0; bj < 2; ++bj) { v[bj][0] = v[bj][0] * sc * gn[bj][0]; v[bj][1] = v[bj][1] * sc * gn[bj][1]; } }
#pragma unroll
                for (int bj = 0; bj < 2; ++bj) { u32x4 w; w.x = pk2(v[bj][0][0], v[bj][0][1]); w.y = pk2(v[bj][0][2], v[bj][0][3]); w.z = pk2(v[bj][1][0], v[bj][1][1]); w.w = pk2(v[bj][1][2], v[bj][1][3]);
                    *(u32x4*)(rowp + 32 * bj) = w; } }
    }
};
struct EpiStoreD {
    bf16_t* lat; bf16_t* g; const float* ssq; float* ssql;
    DI void prefetch(const Unit& u, int wr, int fr, float (&pre)[8]) const {
#pragma unroll
        for (int i = 0; i < 8; ++i) pre[i] = ssq[u.pm * BM + wr * 64 + fr + (i >> 2) * HALF + (i & 3) * 16]; }
    DI void operator()(const Acc& acc, const Unit& u, int wr, int wc, int fr, int fq, const float (&pre)[8]) const {
        const int row0 = u.pm * BM + wr * 64 + fr, col0 = u.pn * BM + wc * 32 + 8 * fq;
#pragma unroll
        for (int ai = 0; ai < 2; ++ai)
#pragma unroll
            for (int m = 0; m < 4; ++m) { const size_t row = (size_t)(row0 + ai * HALF + m * 16);
                const float rs = rsqrtf(pre[ai * 4 + m] * (1.f / DM) + EPS); float ss = 0.f;
#pragma unroll
                for (int bj = 0; bj < 2; ++bj) { const f32x4 v0 = acc[ai][bj][m][0] * rs, v1 = acc[ai][bj][m][1] * rs;
                    ss += v0[0] * v0[0] + v0[1] * v0[1] + v0[2] * v0[2] + v0[3] * v0[3] + v1[0] * v1[0] + v1[1] * v1[1] + v1[2] * v1[2] + v1[3] * v1[3];
                    u32x4 w; w.x = pk2(v0[0], v0[1]); w.y = pk2(v0[2], v0[3]); w.z = pk2(v1[0], v1[1]); w.w = pk2(v1[2], v1[3]);
                    const int col = col0 + bj * HALF;
                    if (col < 1088) *(u32x4*)(lat + row * 1088 + col) = w;
                    else if (col < 3136) *(u32x4*)(g + row * 2048 + (col - 1088)) = w; }
                if (u.pn < 4) { ss += __shfl_xor(ss, 16); ss += __shfl_xor(ss, 32); if (fq == 0) atomicAdd(ssql + (u.pn >> 1) * MTOK + row, ss); } }
    }
};
struct EpiStoreU {
    bf16_t* O; const float* ssql;
    DI void prefetch(const Unit& u, int wr, int fr, float (&pre)[8]) const {
        const float* sq = ssql + (u.pn >= 12 ? MTOK : 0);
#pragma unroll
        for (int i = 0; i < 8; ++i) pre[i] = sq[u.pm * BM + wr * 64 + fr + (i >> 2) * HALF + (i & 3) * 16]; }
    DI void operator()(const Acc& acc, const Unit& u, int wr, int wc, int fr, int fq, const float (&pre)[8]) const {
        const int row0 = u.pm * BM + wr * 64 + fr, col0 = u.pn * BM + wc * 32 + 8 * fq;
        const float* sq = ssql + (u.pn >= 12 ? MTOK : 0);
#pragma unroll
        for (int ai = 0; ai < 2; ++ai)
#pragma unroll
            for (int m = 0; m < 4; ++m) { bf16_t* rowp = O + (size_t)(row0 + ai * HALF + m * 16) * 7168 + col0;
                const float rs = rsqrtf(pre[ai * 4 + m] * (1.f / 512.f) + EPS);
#pragma unroll
                for (int bj = 0; bj < 2; ++bj) { const f32x4 v0 = acc[ai][bj][m][0] * rs, v1 = acc[ai][bj][m][1] * rs;
                    u32x4 w; w.x = pk2(v0[0], v0[1]); w.y = pk2(v0[2], v0[3]); w.z = pk2(v1[0], v1[1]); w.w = pk2(v1[2], v1[3]);
                    *(u32x4*)(rowp + bj * HALF) = w; } }
    }
};
template <bool INB, bool OUTF, bool OUTB, bool SSQ> struct EpiResid {
    const float* xf; const bf16_t* xb; float* of; bf16_t* ob; float* ssq;
    DI void prefetch(const Unit&, int, int, float (&pre)[8]) const {
#pragma unroll
        for (int i = 0; i < 8; ++i) pre[i] = 0.f; }
    DI void operator()(const Acc& acc, const Unit& u, int wr, int wc, int fr, int fq, const float (&pre)[8]) const {
        const int row0 = u.pm * BM + wr * 64 + fr, col0 = u.pn * BM + wc * 32 + 8 * fq;
#pragma unroll
        for (int ai = 0; ai < 2; ++ai)
#pragma unroll
            for (int m = 0; m < 4; ++m) { const int row = row0 + ai * HALF + m * 16; const size_t o = (size_t)row * DM + col0;
                float ss = 0.f;
#pragma unroll
                for (int bj = 0; bj < 2; ++bj) {
                    f32x4 x0, x1;
                    if (INB) { float f[8]; unpack8(*(const u32x4*)(xb + o + bj * HALF), f); x0 = (f32x4){f[0], f[1], f[2], f[3]}; x1 = (f32x4){f[4], f[5], f[6], f[7]}; }
                    else { x0 = *(const f32x4*)(xf + o + bj * HALF); x1 = *(const f32x4*)(xf + o + bj * HALF + 4); }
                    x0 += acc[ai][bj][m][0]; x1 += acc[ai][bj][m][1];
                    if (OUTF) { __builtin_nontemporal_store(x0, (f32x4*)(of + o + bj * HALF)); __builtin_nontemporal_store(x1, (f32x4*)(of + o + bj * HALF + 4)); }
                    if (SSQ) ss += x0[0] * x0[0] + x0[1] * x0[1] + x0[2] * x0[2] + x0[3] * x0[3] + x1[0] * x1[0] + x1[1] * x1[1] + x1[2] * x1[2] + x1[3] * x1[3];
                    if (OUTB) { u32x4 w; w.x = pk2(x0[0], x0[1]); w.y = pk2(x0[2], x0[3]); w.z = pk2(x1[0], x1[1]); w.w = pk2(x1[2], x1[3]);
                        *(u32x4*)(ob + o + bj * HALF) = w; } }
                if (SSQ) { ss += __shfl_xor(ss, 16); ss += __shfl_xor(ss, 32); if (fq == 0) atomicAdd(ssq + row, ss); } }
    }
};
struct EpiGates {
    const bf16_t* xc; const float* brg; const float* big; const float* sp8t; unsigned* ax;
    DI void prefetch(const Unit&, int, int, float (&pre)[8]) const {
#pragma unroll
        for (int i = 0; i < 8; ++i) pre[i] = 0.f; }
    DI void operator()(const Acc& acc, const Unit& u, int wr, int wc, int fr, int fq, const float (&pre)[8]) const {
        const int row0 = u.pm * BM + wr * 64 + fr, f0 = (u.pn >> 1) * 256 + (u.pn & 1) * 128 + wc * 32 + 8 * fq;
#pragma unroll
        for (int n = 0; n < 2; ++n) {
            const f32x4 br = *(const f32x4*)(brg + f0 + 4 * n), bi = *(const f32x4*)(big + f0 + 4 * n), sp = *(const f32x4*)(sp8t + f0 + 4 * n);
#pragma unroll
            for (int ai = 0; ai < 2; ++ai)
#pragma unroll
                for (int m = 0; m < 4; ++m) { const size_t o = (size_t)(row0 + ai * HALF + m * 16) * DM + f0 + 4 * n;
                    const u32x2 xw = *(const u32x2*)(xc + o);
                    const float xv[4] = {__uint_as_float(xw.x << 16), __uint_as_float(xw.x & 0xffff0000u), __uint_as_float(xw.y << 16), __uint_as_float(xw.y & 0xffff0000u)};
                    u32x4 w;
#pragma unroll
                    for (int e = 0; e < 4; ++e) { const float r = sigm(acc[ai][0][m][n][e] + br[e]), ig = sigm(acc[ai][1][m][n][e] + bi[e]);
                        const float la = -sp[e] * r, uu = -2.f * la;
                        const float om = uu * (1.f - uu * 0.5f * (1.f - uu * (1.f / 3.f) * (1.f - uu * 0.25f * (1.f - uu * 0.2f * (1.f - uu * (1.f / 6.f))))));
                        w[e] = pk2(la, sqrtf(fmaxf(om, 0.f)) * ig * xv[e]); }
                    *(u32x4*)(ax + o) = w; __builtin_amdgcn_sched_barrier(0); }
        }
    }
};
}

template <int MODE, class Epi>
DI void run_gemm(LAS unsigned char* lds, const bf16_t* A, const bf16_t* Bt, int N, int K, int lda, const Epi& E) {
    asm volatile("" : "+s"(K));
    pg8::Sched<MODE> S; S.init(MTOK, N, (int)gridDim.x, (int)blockIdx.x, lda, K);
    pg8::gemm_phase(lds, A, Bt, K, lda, S, E);
    __syncthreads();
}

DI void phase_convert(const Params& p, LAS unsigned char* lds) {
    LAS float* sm = (LAS float*)lds;
    const int tid = otid();
    for (int t = blockIdx.x; t < p.ntiles; t += gridDim.x) {
        int j = 0; while (j + 1 < p.njobs && p.jobs[j + 1].tile0 <= t) ++j;
        const float* src = p.jobs[j].src; bf16_t* dst = p.jobs[j].dst; const int K = p.jobs[j].K, N = p.jobs[j].N, ldw = p.jobs[j].ldw, ntn = p.jobs[j].ntn;
        const int tt = t - p.jobs[j].tile0, tn = tt % ntn, tk = tt / ntn, n0 = tn * 64, k0 = tk * 256;
        { const int n4 = (tid & 15) * 4, kr = tid >> 4; f32x4 v[8];
#pragma unroll
          for (int i = 0; i < 8; ++i) v[i] = (n0 + n4 < N) ? __builtin_nontemporal_load((const f32x4*)(src + (size_t)(k0 + kr + 32 * i) * ldw + n0 + n4)) : (f32x4){0.f, 0.f, 0.f, 0.f};
#pragma unroll
          for (int i = 0; i < 8; ++i) { LAS float* d = sm + (kr + 32 * i) * 65 + n4; d[0] = v[i][0]; d[1] = v[i][1]; d[2] = v[i][2]; d[3] = v[i][3]; } }
        __syncthreads();
        { const int nr = tid >> 3, kq = tid & 7;
#pragma unroll
          for (int jj = 0; jj < 4; ++jj) { const int kc = (kq + 8 * jj) * 8; float f[8];
#pragma unroll
              for (int e = 0; e < 8; ++e) f[e] = sm[(kc + e) * 65 + nr];
              if (p.jobs[j].kscale) { const float* ks = p.jobs[j].kscale + k0 + kc;
#pragma unroll
                  for (int e = 0; e < 8; ++e) f[e] *= ks[e]; }
              int nrow = n0 + nr; if (p.jobs[j].pad) { const int jl = nrow & 255; nrow = (nrow & ~255) + 128 * ((jl >> 5) & 1) + 32 * (jl >> 6) + (jl & 31); }
              *(u32x4*)(dst + (size_t)nrow * K + k0 + kc) = pack8(f); } }
        __syncthreads();
    }
}

DI int t5_bucket(int rel) {
    const int n = rel < 0 ? -rel : rel; int b;
    if (n < 8) b = n; else b = 8 + (n >= 12) + (n >= 16) + (n >= 23) + (n >= 32) + (n >= 46) + (n >= 64) + (n >= 91);
    return (rel > 0 ? 16 : 0) + b;
}
DI void phase_bias_table(const Params& p) {
    float* tb = (float*)(p.ws + X_BIAS);
    float* sp8 = (float*)(p.ws + X_SP8); float* ssq = (float*)(p.ws + X_SSQ);
    for (int i = blockIdx.x * 512 + otid(); i < 5 * MTOK; i += gridDim.x * 512) ssq[i] = 0.f;
    for (int i = blockIdx.x * 512 + otid(); i < 16 * 192 + 2048; i += gridDim.x * 512) {
        if (i < 16 * 192) { const int h = i / 192, idx = i % 192; tb[i] = (p.in[2][t5_bucket(idx - 128) * 16 + h] - p.in[2][15 * 16 + h]) * LOG2E; }
        else sp8[i - 16 * 192] = 8.f * log1pf(expf(-p.in[20][i - 16 * 192]));
    }
}

DI void phase_x0(const float* x, bf16_t* out, float* ssq) {
    const int tid = otid(), lane = tid & 63, gw = blockIdx.x * 8 + (tid >> 6), nw = gridDim.x * 8;
    for (int row = gw; row < MTOK; row += nw) {
        const f32x4* xr = (const f32x4*)(x + (size_t)row * DM); f32x4 v[8]; float ss = 0.f;
#pragma unroll
        for (int i = 0; i < 4; ++i) { v[2 * i] = __builtin_nontemporal_load(xr + i * 128 + lane * 2); v[2 * i + 1] = __builtin_nontemporal_load(xr + i * 128 + lane * 2 + 1); }
#pragma unroll
        for (int i = 0; i < 8; ++i) ss += v[i][0] * v[i][0] + v[i][1] * v[i][1] + v[i][2] * v[i][2] + v[i][3] * v[i][3];
        ss = wsum(ss);
        if (lane == 0) ssq[row] = ss;
#pragma unroll
        for (int i = 0; i < 4; ++i) { u32x4 w; w.x = pk2(v[2 * i][0], v[2 * i][1]); w.y = pk2(v[2 * i][2], v[2 * i][3]); w.z = pk2(v[2 * i + 1][0], v[2 * i + 1][1]); w.w = pk2(v[2 * i + 1][2], v[2 * i + 1][3]);
            *(u32x4*)(out + (size_t)row * DM + i * 512 + lane * 8) = w; }
    }
}

DI void phase_rmsnorm(const float* x, const float* g, bf16_t* out) {
    const int tid = otid(), lane = tid & 63, gw = blockIdx.x * 8 + (tid >> 6), nw = gridDim.x * 8;
    for (int row = gw; row < MTOK; row += nw) {
        const f32x4* xr = (const f32x4*)(x + (size_t)row * DM); f32x4 v[8]; float ss = 0.f;
#pragma unroll
        for (int i = 0; i < 4; ++i) { v[2 * i] = xr[i * 128 + lane * 2]; v[2 * i + 1] = xr[i * 128 + lane * 2 + 1]; }
#pragma unroll
        for (int i = 0; i < 8; ++i) ss += v[i][0] * v[i][0] + v[i][1] * v[i][1] + v[i][2] * v[i][2] + v[i][3] * v[i][3];
        ss = wsum(ss); const float sc = rsqrtf(ss * (1.f / DM) + EPS);
#pragma unroll
        for (int i = 0; i < 4; ++i) { const int c = i * 512 + lane * 8; const f32x4 g0 = *(const f32x4*)(g + c), g1 = *(const f32x4*)(g + c + 4);
            u32x4 w; w.x = pk2(v[2 * i][0] * sc * g0[0], v[2 * i][1] * sc * g0[1]); w.y = pk2(v[2 * i][2] * sc * g0[2], v[2 * i][3] * sc * g0[3]);
            w.z = pk2(v[2 * i + 1][0] * sc * g1[0], v[2 * i + 1][1] * sc * g1[1]); w.w = pk2(v[2 * i + 1][2] * sc * g1[2], v[2 * i + 1][3] * sc * g1[3]);
            *(u32x4*)(out + (size_t)row * DM + c) = w; }
    }
}

DI void phase_qknorm_a(const Params& p) {
    bf16_t* big = (bf16_t*)(p.ws + ACT); const float* qkg = p.in[4];
    const int tid = otid(), lane = tid & 63, gw = blockIdx.x * 8 + (tid >> 6), nw = gridDim.x * 8;
    float gq[8], gk[8];
#pragma unroll
    for (int e = 0; e < 8; ++e) { gq[e] = qkg[(lane & 7) * 8 + e] * (0.125f * LOG2E); gk[e] = qkg[64 + (lane & 7) * 8 + e]; }
    for (int row = gw; row < MTOK; row += nw) {
#pragma unroll
        for (int i = 0; i < 8; ++i) {
            bf16_t* ptr = big + (size_t)row * 8192 + i * 512 + lane * 8; float f[8]; unpack8(*(const u32x4*)ptr, f);
            float ss = 0.f;
#pragma unroll
            for (int e = 0; e < 8; ++e) ss += f[e] * f[e];
            ss += __shfl_xor(ss, 1); ss += __shfl_xor(ss, 2); ss += __shfl_xor(ss, 4);
            const float sc = rsqrtf(ss * (1.f / 64.f) + EPS);
#pragma unroll
            for (int e = 0; e < 8; ++e) f[e] = f[e] * sc * (i < 4 ? gq[e] : gk[e]);
            *(u32x4*)ptr = pack8(f);
        }
    }
}

template <int DQK, int KA8, int DV, bool BIAS, bool JOINT>
DI void attn_core(LAS unsigned char* lds, const bf16_t* Qrow, const bf16_t* KpA, int ldkA, const bf16_t* KpB, int ldkB, const bf16_t* Vp, int ldv,
                  int qb, int wid, int lane, const float* qng  , f32x16 (&O)[DV / 32]) {
    constexpr int KROW = DQK * 2 + 16, VROW = DV * 2 + 64  , KC = DQK / 8, VC = DV / 8, NKC = 64 * KC, NVC = 64 * VC, NL = (NKC + NVC) / 512, STG = 64 * (KROW + VROW);
    static_assert(NKC % 512 == 0 && NVC % 512 == 0, "loader split");
    const int tid = otid(), l32 = lane & 31, hh = lane >> 5, i16 = lane & 15, tq = i16 >> 2, tp = i16 & 3, blk = (lane >> 4) & 1;
    const int q0w = qb * 256 + wid * 32, nkt = 4 * qb + 4, myc = q0w >> 6;
    bf16x8 qf[DQK / 16];
#pragma unroll
    for (int s = 0; s < DQK / 16; ++s) qf[s] = *(const bf16x8*)(Qrow + 16 * s + 8 * hh);
    if constexpr (DQK == 192) {
        if (qng) {
            float ssn = 0.f, ssr = 0.f;
#pragma unroll
            for (int s = 0; s < 12; ++s) { float f[8]; unpack8(__builtin_bit_cast(u32x4, qf[s]), f); float t = 0.f;
#pragma unroll
                for (int e = 0; e < 8; ++e) t += f[e] * f[e];
                if (s < 8) ssn += t; else ssr += t; }
            ssn += __shfl_xor(ssn, 32); ssr += __shfl_xor(ssr, 32);
            const float qs = 0.07216878364870322f * LOG2E, scn = rsqrtf(ssn * (1.f / 128.f) + EPS) * qs, scr = rsqrtf(ssr * (1.f / 64.f) + EPS) * qs;
#pragma unroll
            for (int s = 0; s < 8; ++s) { float f[8]; unpack8(__builtin_bit_cast(u32x4, qf[s]), f);
                const f32x4 g0 = *(const f32x4*)(qng + 16 * s + 8 * hh), g1 = *(const f32x4*)(qng + 16 * s + 8 * hh + 4);
#pragma unroll
                for (int e = 0; e < 4; ++e) { f[e] *= scn * g0[e]; f[4 + e] *= scn * g1[e]; }
                qf[s] = __builtin_bit_cast(bf16x8, pack8(f)); }
            const float posr = (float)(qb * 256 + wid * 32 + l32) * 0.15915494309189535f;
#pragma unroll
            for (int s = 8; s < 10; ++s) { float f1[8], f2[8]; unpack8(__builtin_bit_cast(u32x4, qf[s]), f1); unpack8(__builtin_bit_cast(u32x4, qf[s + 2]), f2);
#pragma unroll
                for (int e = 0; e < 8; ++e) { const int i = 16 * (s - 8) + 8 * hh + e;
                    const float a1 = f1[e] * scr * qng[128 + i], a2 = f2[e] * scr * qng[160 + i];
                    float rev = posr * __builtin_amdgcn_exp2f(-(float)i * 0.41524101186092029f); rev -= floorf(rev);
                    const float sn = __builtin_amdgcn_sinf(rev), cs = __builtin_amdgcn_cosf(rev);
                    f1[e] = a1 * cs - a2 * sn; f2[e] = a2 * cs + a1 * sn; }
                qf[s] = __builtin_bit_cast(bf16x8, pack8(f1)); qf[s + 2] = __builtin_bit_cast(bf16x8, pack8(f2)); }
            __builtin_amdgcn_sched_barrier(0);
        }
    }
    float m = 0.f, l = 0.f; bool mnz = false;
#pragma unroll
    for (int dt = 0; dt < DV / 32; ++dt)
#pragma unroll
        for (int i = 0; i < 16; ++i) O[dt][i] = 0.f;
    u32x4 stg[NL];
    LAS const float* btab = (LAS const float*)(lds + 2 * STG);
    const unsigned koff = l32 * KROW + 16 * hh, vtr = (4 * hh + tq) * VROW + (16 * blk + 4 * tp) * 2;

    auto gload = [&](int kt) {
#pragma unroll
        for (int i = 0; i < NL; ++i) { const int c = tid + i * 512;
            if (i * 512 < NKC) { const int row = c / KC, cc = c % KC;
                const bf16_t* src = (cc < KA8) ? KpA + (size_t)(kt * 64 + row) * ldkA + cc * 8 : KpB + (size_t)(kt * 64 + row) * ldkB + (cc - KA8) * 8;
                stg[i] = *(const u32x4*)src; }
            else { const int c2 = c - NKC, row = c2 / VC, cc = c2 % VC; stg[i] = *(const u32x4*)(Vp + (size_t)(kt * 64 + row) * ldv + cc * 8); } }
    };
    auto lstore = [&](int buf) {
#pragma unroll
        for (int i = 0; i < NL; ++i) { const int c = tid + i * 512;
            if (i * 512 < NKC) { const int row = c / KC, cc = c % KC; *(LAS u32x4*)(lds + buf * STG + row * KROW + cc * 16) = stg[i]; }
            else { const int c2 = c - NKC, row = c2 / VC, cc = c2 % VC; *(LAS u32x4*)(lds + buf * STG + 64 * KROW + row * VROW + cc * 16) = stg[i]; } }
    };

    gload(0); lstore(0); __syncthreads();
    for (int kt = 0; kt < nkt; ++kt) {
        if (kt + 1 < nkt) gload(kt + 1);
        if (JOINT && kt <= myc) {
            LAS unsigned char* kb = lds + (kt & 1) * STG; LAS unsigned char* vb = kb + 64 * KROW;
            const bool far = (kt * 64 + 63 - q0w <= -91);
            f32x16 S0, S1;
#pragma unroll
            for (int i = 0; i < 16; ++i) { S0[i] = 0.f; S1[i] = 0.f; }
#pragma unroll
            for (int s = 0; s < DQK / 16; ++s) {
                const bf16x8 k0 = *(LAS const bf16x8*)(kb + koff + 32 * s), k1 = *(LAS const bf16x8*)(kb + koff + 32 * KROW + 32 * s);
                S0 = mfma32(k0, qf[s], S0); S1 = mfma32(k1, qf[s], S1);
            }
            if (BIAS && !far) {
                const int rb = kt * 64 - (q0w + l32) + 128;
#pragma unroll
                for (int i = 0; i < 16; ++i) { const int i0 = rb + crow(i, hh); S0[i] += btab[i0 < 0 ? 0 : i0]; S1[i] += btab[i0 + 32 < 0 ? 0 : i0 + 32]; }
            }
            if (mnz) {
#pragma unroll
                for (int i = 0; i < 16; ++i) { S0[i] -= m; S1[i] -= m; }
            }
            float mx = fmaxf(S0[0], S1[0]);
#pragma unroll
            for (int i = 1; i < 16; ++i) mx = fmaxf(mx, fmaxf(S0[i], S1[i]));
            mx = fmaxf(mx, __shfl_xor(mx, 32));
            if (__any(mx > 64.f || (kt == 0 && mx < -64.f))) {
                const float dm = (mx > 64.f || (kt == 0 && mx < -64.f)) ? mx : 0.f, alpha = __builtin_amdgcn_exp2f(-dm); m += dm; mnz = true;
                l *= alpha;
#pragma unroll
                for (int dt = 0; dt < DV / 32; ++dt) O[dt] *= alpha;
#pragma unroll
                for (int i = 0; i < 16; ++i) { S0[i] -= dm; S1[i] -= dm; }
            }
            float ps = 0.f;
#pragma unroll
            for (int i = 0; i < 16; ++i) { S0[i] = __builtin_amdgcn_exp2f(S0[i]); S1[i] = __builtin_amdgcn_exp2f(S1[i]); ps += S0[i] + S1[i]; }
            l += ps;
#pragma unroll
            for (int half = 0; half < 2; ++half)
#pragma unroll
                for (int s = 0; s < 2; ++s) {
                    const f32x16& S = half ? S1 : S0;
                    u32x4 pw; pw.x = pk2(S[8 * s], S[8 * s + 1]); pw.y = pk2(S[8 * s + 2], S[8 * s + 3]); pw.z = pk2(S[8 * s + 4], S[8 * s + 5]); pw.w = pk2(S[8 * s + 6], S[8 * s + 7]);
                    const bf16x8 pf = __builtin_bit_cast(bf16x8, pw);
                    LAS unsigned char* vr = vb + vtr + (32 * half + 16 * s) * VROW;
#pragma unroll
                    for (int dt = 0; dt < DV / 32; ++dt) {
                        const bf16x8 vf = cat4(trread(vr + 64 * dt), trread(vr + 8 * VROW + 64 * dt));
                        O[dt] = mfma32(vf, pf, O[dt]);
                    }
                }
        }
        if (!JOINT && kt <= myc) {
            LAS unsigned char* kb = lds + (kt & 1) * STG; LAS unsigned char* vb = kb + 64 * KROW;
            const bool far = (kt * 64 + 63 - q0w <= -91);
#pragma unroll 1
            for (int half = 0; half < 2; ++half) {
                f32x16 S;
#pragma unroll
                for (int i = 0; i < 16; ++i) S[i] = 0.f;
#pragma unroll
                for (int s = 0; s < DQK / 16; ++s) {
                    const bf16x8 kf = *(LAS const bf16x8*)(kb + koff + 32 * half * KROW + 32 * s);
                    S = mfma32(kf, qf[s], S);
                }
                if (BIAS && !far) {
                    const int rb = kt * 64 + 32 * half - (q0w + l32) + 128;
#pragma unroll
                    for (int i = 0; i < 16; ++i) { const int i0 = rb + crow(i, hh); S[i] += btab[i0 < 0 ? 0 : i0]; }
                }
                if (mnz) {
#pragma unroll
                    for (int i = 0; i < 16; ++i) S[i] -= m;
                }
                float mx = S[0];
#pragma unroll
                for (int i = 1; i < 16; ++i) mx = fmaxf(mx, S[i]);
                mx = fmaxf(mx, __shfl_xor(mx, 32));
                const bool first = (kt == 0 && half == 0);
                if (__any(mx > 64.f || (first && mx < -64.f))) {
                    const float dm = (mx > 64.f || (first && mx < -64.f)) ? mx : 0.f, alpha = __builtin_amdgcn_exp2f(-dm); m += dm; mnz = true;
                    l *= alpha;
#pragma unroll
                    for (int dt = 0; dt < DV / 32; ++dt) O[dt] *= alpha;
#pragma unroll
                    for (int i = 0; i < 16; ++i) S[i] -= dm;
                }
                float ps = 0.f;
#pragma unroll
                for (int i = 0; i < 16; ++i) { S[i] = __builtin_amdgcn_exp2f(S[i]); ps += S[i]; }
                l += ps;
#pragma unroll
                for (int s = 0; s < 2; ++s) {
                    u32x4 pw; pw.x = pk2(S[8 * s], S[8 * s + 1]); pw.y = pk2(S[8 * s + 2], S[8 * s + 3]); pw.z = pk2(S[8 * s + 4], S[8 * s + 5]); pw.w = pk2(S[8 * s + 6], S[8 * s + 7]);
                    const bf16x8 pf = __builtin_bit_cast(bf16x8, pw);
                    LAS unsigned char* vr = vb + vtr + (32 * half + 16 * s) * VROW;
#pragma unroll
                    for (int dt = 0; dt < DV / 32; ++dt) {
                        const bf16x8 vf = cat4(trread(vr + 64 * dt), trread(vr + 8 * VROW + 64 * dt));
                        O[dt] = mfma32(vf, pf, O[dt]);
                    }
                }
            }
        }
        if (kt + 1 < nkt) lstore((kt + 1) & 1);
        __syncthreads();
    }
    l += __shfl_xor(l, 32);
    const float il = 1.f / l;
#pragma unroll
    for (int dt = 0; dt < DV / 32; ++dt) O[dt] *= il;
}

DI void phase_attn_a(const Params& p, LAS unsigned char* lds) {
    const bf16_t* big = (const bf16_t*)(p.ws + ACT); bf16_t* y = (bf16_t*)(p.ws + HBUF); const float* tbg = (const float*)(p.ws + X_BIAS);
    const int tid = otid(), wid = tid >> 6, lane = tid & 63, l32 = lane & 31, hh = lane >> 5;
    constexpr int STG = 64 * (64 * 2 + 16 + 128 * 2 + 64);
    float d0 = 0.f, d1 = 0.f;
    for (int i = 0; i < 64; ++i) { d0 += p.in[5][i] * p.in[5][64 + i]; d1 += p.in[5][128 + i] * p.in[5][192 + i]; }
    const float lam_init = 0.2f, lam = __expf(d0) - __expf(d1) + lam_init;
    for (int pr = blockIdx.x; pr < 512; pr += gridDim.x) {
        const int bi = pr & 255, bh = (gridDim.x == 256) ? (bi & 7) + 8 * (bi >> 6) + 32 * (pr >> 8) : pr >> 3, j = (gridDim.x == 256) ? (bi >> 3) & 7 : pr & 7, b = bh >> 4, h = bh & 15;
        for (int half = 0; half < 2; ++half) {
            const int qb = half ? 15 - j : j;
            __syncthreads();
            if (tid < 192) ((LAS float*)(lds + 2 * STG))[tid] = tbg[h * 192 + tid];
            const size_t tok0 = (size_t)b * SEQ, tokq = tok0 + qb * 256 + wid * 32 + l32;
            f32x16 Oa[4]; LAS unsigned* Op = (LAS unsigned*)(lds + 2 * STG + 1024) + wid * 2048 + lane;
            attn_core<64, 8, 128, true, true>(lds, big + tokq * 8192 + h * 128, big + tok0 * 8192 + 2048 + h * 128, 8192, nullptr, 0, big + tok0 * 8192 + 4096 + h * 128, 8192, qb, wid, lane, nullptr, Oa);
#pragma unroll
            for (int dt = 0; dt < 4; ++dt)
#pragma unroll
                for (int i = 0; i < 8; ++i) Op[(dt * 8 + i) * 64] = pk2(Oa[dt][2 * i], Oa[dt][2 * i + 1]);
            attn_core<64, 8, 128, true, true>(lds, big + tokq * 8192 + h * 128 + 64, big + tok0 * 8192 + 2048 + h * 128 + 64, 8192, nullptr, 0, big + tok0 * 8192 + 4096 + h * 128, 8192, qb, wid, lane, nullptr, Oa);
            float ss = 0.f;
#pragma unroll
            for (int dt = 0; dt < 4; ++dt)
#pragma unroll
                for (int i = 0; i < 16; ++i) { const unsigned ow = Op[(dt * 8 + (i >> 1)) * 64]; const float o0 = (i & 1) ? __uint_as_float(ow & 0xffff0000u) : __uint_as_float(ow << 16);
                    const float o = o0 - lam * Oa[dt][i]; Oa[dt][i] = o; ss += o * o; }
            ss += __shfl_xor(ss, 32);
            const float sc = rsqrtf(ss * (1.f / 128.f) + EPS) * (1.f - lam_init);
#pragma unroll
            for (int dt = 0; dt < 4; ++dt)
#pragma unroll
                for (int g4 = 0; g4 < 4; ++g4) { const int dv = 32 * dt + 8 * g4 + 4 * hh;
                    const u32x2 gw = *(const u32x2*)(big + tokq * 8192 + 6144 + h * 128 + dv);
                    const f32x4 sg = *(const f32x4*)(p.in[6] + dv);
                    const float g0 = __uint_as_float(gw.x << 16), g1 = __uint_as_float(gw.x & 0xffff0000u), g2 = __uint_as_float(gw.y << 16), g3 = __uint_as_float(gw.y & 0xffff0000u);
                    u32x2 w; w.x = pk2(Oa[dt][4 * g4] * sc * sg[0] * silu(g0), Oa[dt][4 * g4 + 1] * sc * sg[1] * silu(g1));
                    w.y = pk2(Oa[dt][4 * g4 + 2] * sc * sg[2] * silu(g2), Oa[dt][4 * g4 + 3] * sc * sg[3] * silu(g3));
                    *(u32x2*)(y + tokq * DM + h * 128 + dv) = w; }
        }
    }
}

DI void phase_attn_d(const Params& p, LAS unsigned char* lds) {
    const bf16_t* qkv = (const bf16_t*)(p.ws + ACT); const bf16_t* lat = (const bf16_t*)(p.ws + LAT); const bf16_t* gb = (const bf16_t*)(p.ws + HBUF);
    bf16_t* y = (bf16_t*)(p.ws + HBUF);
    for (int pr = blockIdx.x; pr < 512; pr += gridDim.x) {
        const int bi = pr & 255, bh = (gridDim.x == 256) ? (bi & 7) + 8 * (bi >> 6) + 32 * (pr >> 8) : pr >> 3, j = (gridDim.x == 256) ? (bi >> 3) & 7 : pr & 7, b = bh >> 4, h = bh & 15;
        for (int half = 0; half < 2; ++half) {
            const int qb = half ? 15 - j : j;
            __syncthreads();
            const int tid = otid(), wid = tid >> 6, lane = tid & 63, l32 = lane & 31;
            const size_t tok0 = (size_t)b * SEQ, tokq = tok0 + qb * 256 + wid * 32 + l32;
            f32x16 O[4];
            attn_core<192, 16, 128, false, true>(lds, qkv + tokq * 7168 + h * 192, qkv + tok0 * 7168 + 3072 + h * 256, 7168, lat + tok0 * 1088 + 1024, 1088,
                                           qkv + tok0 * 7168 + 3072 + h * 256 + 128, 7168, qb, wid, lane, p.in[27], O);
            const int tid2 = otid(), wid2 = tid2 >> 6, lane2 = tid2 & 63;
            const size_t tokq2 = (size_t)b * SEQ + qb * 256 + wid2 * 32 + (lane2 & 31); const int hh2 = lane2 >> 5;
#pragma unroll
            for (int dt = 0; dt < 4; ++dt)
#pragma unroll
                for (int g4 = 0; g4 < 4; ++g4) { const int dv = 32 * dt + 8 * g4 + 4 * hh2;
                    const u32x2 gw = *(const u32x2*)(gb + tokq2 * DM + h * 128 + dv);
                    const float g0 = __uint_as_float(gw.x << 16), g1 = __uint_as_float(gw.x & 0xffff0000u), g2 = __uint_as_float(gw.y << 16), g3 = __uint_as_float(gw.y & 0xffff0000u);
                    u32x2 w; w.x = pk2(O[dt][4 * g4] * silu(g0), O[dt][4 * g4 + 1] * silu(g1)); w.y = pk2(O[dt][4 * g4 + 2] * silu(g2), O[dt][4 * g4 + 3] * silu(g3));
                    *(u32x2*)(y + tokq2 * DM + h * 128 + dv) = w; }
        }
    }
}

DI void phase_gla_prep(const Params& p, LAS unsigned char* lds) {
    bf16_t* big = (bf16_t*)(p.ws + ACT); float* total = (float*)(p.ws + GLA_TOT);
    LAS float* lrs = (LAS float*)lds;
    const int tid = otid(), ch0 = tid * 2;
    float wg0[16], wg1[16];
#pragma unroll
    for (int r = 0; r < 16; ++r) { wg0[r] = p.in[9][r * 1024 + ch0]; wg1[r] = p.in[9][r * 1024 + ch0 + 1]; }
    const float bs0 = p.in[10][ch0], bs1 = p.in[10][ch0 + 1];
    for (int u = blockIdx.x; u < 256; u += gridDim.x) {
        const size_t tokb = (size_t)u * 64;
        __syncthreads();
        {
            LAS bf16_t* wl = (LAS bf16_t*)(lds + 8192);
            LAS float* part = (LAS float*)(lds + 4096);
            const bf16_t* wsrc = (const bf16_t*)(p.ws + W_B_IN) + (size_t)6144 * 2048;
#pragma unroll
            for (int i = 0; i < 8; ++i) { const int c = tid + i * 512; *(LAS u32x4*)(wl + (c >> 8) * 2056 + (c & 255) * 8) = *(const u32x4*)(wsrc + (size_t)c * 8); }
            __syncthreads();
            const int w = tid >> 6, lane = tid & 63, i16 = lane & 15, quad = lane >> 4, mt = w & 3, kh = w >> 2;
            const bf16_t* xr = (const bf16_t*)(p.ws + XG) + (tokb + 16 * mt + i16) * DM + kh * 1024 + 8 * quad;
            f32x4 acc = {0.f, 0.f, 0.f, 0.f};
#pragma unroll 8
            for (int ks = 0; ks < 32; ++ks) {
                const bf16x8 a = *(const bf16x8*)(xr + 32 * ks);
                const bf16x8 bb = *(LAS const bf16x8*)(wl + i16 * 2056 + kh * 1024 + 32 * ks + 8 * quad);
                acc = __builtin_amdgcn_mfma_f32_16x16x32_bf16(a, bb, acc, 0, 0, 0);
            }
            if (kh == 1) {
#pragma unroll
                for (int j = 0; j < 4; ++j) part[(16 * mt + 4 * quad + j) * 16 + i16] = acc[j]; }
            __syncthreads();
            if (kh == 0) {
#pragma unroll
                for (int j = 0; j < 4; ++j) { const int tok = 16 * mt + 4 * quad + j;
                    const float rs = rsqrtf(((const float*)(p.ws + X_SSQ))[tokb + tok] * (1.f / DM) + EPS);
                    lrs[tok * 16 + i16] = (acc[j] + part[tok * 16 + i16]) * rs; } }
        }
        __syncthreads();
        float t0 = 0.f, t1 = 0.f;
        for (int tok = 63; tok >= 0; --tok) {
            float z0 = bs0, z1 = bs1;
#pragma unroll
            for (int r = 0; r < 16; ++r) { const float lv = lrs[tok * 16 + r]; z0 += lv * wg0[r]; z1 += lv * wg1[r]; }
            unsigned* kp = (unsigned*)(big + (tokb + tok) * 6400 + 1024 + ch0); const unsigned w = *kp;
            *kp = pk2(__uint_as_float(w << 16) * __expf(t0), __uint_as_float(w & 0xffff0000u) * __expf(t1));
            t0 += (fminf(z0, 0.f) - __logf(1.f + __expf(-fabsf(z0)))) * (1.f / 16.f); t1 += (fminf(z1, 0.f) - __logf(1.f + __expf(-fabsf(z1)))) * (1.f / 16.f);
        }
        total[(size_t)u * 1024 + ch0] = t0; total[(size_t)u * 1024 + ch0 + 1] = t1;
    }
}

DI void phase_gla_scan(const Params& p, LAS unsigned char* lds) {
    const bf16_t* big = (const bf16_t*)(p.ws + ACT); const float* total = (const float*)(p.ws + GLA_TOT); bf16_t* ob = (bf16_t*)(p.ws + HBUF);
    constexpr int KR = 576, VR = 64, SR = 528, SET = 64 * KR + 64 * VR + 1024  , ST_OFF = 2 * SET, STB = 32 * SR;
    const int tid = otid(), w = tid >> 6, lane = tid & 63, l32 = lane & 31, hh = lane >> 5, i16 = lane & 15, tq = i16 >> 2, tp = i16 & 3, blk = (lane >> 4) & 1, quad = lane >> 4;
    const int mt = w >> 1, nt = w & 1;
    for (int u = blockIdx.x; u < 256; u += gridDim.x) {
        const int ux = (gridDim.x == 256) ? ((u & 7) * 2 + (u >> 7)) * 16 + ((u >> 3) & 15) : u;
        const int b = ux >> 6, h = (ux >> 4) & 3, vs = ux & 15;
        const size_t tok0 = (size_t)b * SEQ;
        f32x16 st;
#pragma unroll
        for (int i = 0; i < 16; ++i) st[i] = 0.f;
        u32x4 rkA[4], rvA, rkB[4], rvB; float rtA = 0.f, rtB = 0.f; bf16x8 qa[8], qn[8];
        rvA = (u32x4){0u, 0u, 0u, 0u}; rvB = rvA;
        unsigned offk[4];
#pragma unroll
        for (int i = 0; i < 4; ++i) { const int idx = tid + i * 512, row = idx >> 5, cc = idx & 31; offk[i] = (unsigned)((row * 6400 + 1024 + h * 256 + cc * 8) * 2); }
        const unsigned offv = (unsigned)(((tid >> 2) * 6400 + 2048 + h * 512 + vs * 32 + (tid & 3) * 8) * 2);
        const unsigned offq = (unsigned)(((16 * mt + i16) * 6400 + h * 256 + 8 * quad) * 2);
        auto gload = [&](int c, u32x4 (&rk)[4], u32x4& rv, float& rt) {
            const char* cb = (const char*)(big + (tok0 + (size_t)c * 64) * 6400);
#pragma unroll
            for (int i = 0; i < 4; ++i) rk[i] = *(const u32x4*)(cb + offk[i]);
            if (tid < 256) { rv = *(const u32x4*)(cb + offv); rt = total[(size_t)(b * 64 + c) * 1024 + h * 256 + tid]; }
        };
        auto lstore = [&](int buf, const u32x4 (&rk)[4], const u32x4& rv, const float& rt) {
            LAS unsigned char* sb = lds + buf * SET;
#pragma unroll
            for (int i = 0; i < 4; ++i) { const int idx = tid + i * 512, row = idx >> 5, cc = idx & 31; *(LAS u32x4*)(sb + row * KR + cc * 16) = rk[i]; }
            if (tid < 256) { const int row = tid >> 2, cc = tid & 3; *(LAS u32x4*)(sb + 64 * KR + row * VR + cc * 16) = rv; ((LAS float*)(sb + 64 * KR + 64 * VR))[tid] = __expf(rt); }
        };
        auto qload = [&](int c, bf16x8 (&q)[8]) {
            const char* cb = (const char*)(big + (tok0 + (size_t)c * 64) * 6400) + offq;
#pragma unroll
            for (int ks = 0; ks < 8; ++ks) q[ks] = *(const bf16x8*)(cb + 64 * ks);
        };
        auto step = [&](int c, const bf16x8 (&qc)[8]) {
            LAS unsigned char* sb = lds + (c & 1) * SET; LAS unsigned char* stb = lds + ST_OFF + (c & 1) * STB;
#pragma unroll
            for (int g = 0; g < 4; ++g) { const f32x4 e = *(LAS const f32x4*)(sb + 64 * KR + 64 * VR + (32 * w + 8 * g + 4 * hh) * 4);
                st[4 * g] *= e[0]; st[4 * g + 1] *= e[1]; st[4 * g + 2] *= e[2]; st[4 * g + 3] *= e[3]; }
#pragma unroll
            for (int sx = 0; sx < 4; ++sx) {
                LAS unsigned char* ka = sb + (16 * sx + 8 * hh + tq) * KR + (32 * w + 16 * blk + 4 * tp) * 2;
                LAS unsigned char* va = sb + 64 * KR + (16 * sx + 8 * hh + tq) * VR + (16 * blk + 4 * tp) * 2;
                const bf16x8 af = cat4(trread(ka), trread(ka + 4 * KR)), bfv = cat4(trread(va), trread(va + 4 * VR));
                st = mfma32(af, bfv, st);
            }
#pragma unroll
            for (int g = 0; g < 4; ++g) { u32x2 wv; wv.x = pk2(st[4 * g], st[4 * g + 1]); wv.y = pk2(st[4 * g + 2], st[4 * g + 3]);
                *(LAS u32x2*)(stb + l32 * SR + (32 * w + 8 * g + 4 * hh) * 2) = wv; }
            asm volatile("s_waitcnt lgkmcnt(0)" ::: "memory");
            __builtin_amdgcn_s_barrier();
            asm volatile("" ::: "memory");
            f32x4 acc = {0.f, 0.f, 0.f, 0.f};
#pragma unroll
            for (int ks = 0; ks < 8; ++ks) {
                const bf16x8 bb = *(LAS const bf16x8*)(stb + (16 * nt + i16) * SR + (32 * ks + 8 * quad) * 2);
                acc = __builtin_amdgcn_mfma_f32_16x16x32_bf16(qc[ks], bb, acc, 0, 0, 0);
            }
#pragma unroll
            for (int jj = 0; jj < 4; ++jj) ob[(tok0 + c * 64 + 16 * mt + quad * 4 + jj) * DM + h * 512 + vs * 32 + 16 * nt + i16] = f2bf(acc[jj] * (1.f / 16.f));
        };
        __syncthreads();
        gload(0, rkA, rvA, rtA); lstore(0, rkA, rvA, rtA);
        gload(1, rkA, rvA, rtA); gload(2, rkB, rvB, rtB); qload(0, qa); qload(1, qn);
        __syncthreads();
        for (int c = 0; c < 64; c += 2) {
            lstore((c + 1) & 1, rkA, rvA, rtA);
            if (c + 3 < 64) gload(c + 3, rkA, rvA, rtA);
            step(c, qa);
            if (c + 2 < 64) qload(c + 2, qa);
            if (c + 2 < 64) lstore(c & 1, rkB, rvB, rtB);
            if (c + 4 < 64) gload(c + 4, rkB, rvB, rtB);
            step(c + 1, qn);
            if (c + 3 < 64) qload(c + 3, qn);
        }
    }
}

DI void phase_gla_post(const Params& p) {
    const bf16_t* big = (const bf16_t*)(p.ws + ACT); bf16_t* y = (bf16_t*)(p.ws + HBUF);
    const int tid = otid(), lane = tid & 63, gw = blockIdx.x * 8 + (tid >> 6), nw = gridDim.x * 8;
    float og[8];
#pragma unroll
    for (int e = 0; e < 8; ++e) og[e] = p.in[11][lane * 8 + e];
    for (int row = gw; row < MTOK; row += 2 * nw) {
        u32x4 wo[2][4], wg[2][4]; bool ok[2]; size_t rr[2];
#pragma unroll
        for (int r = 0; r < 2; ++r) { ok[r] = row + r * nw < MTOK; rr[r] = ok[r] ? (size_t)(row + r * nw) : (size_t)row;
#pragma unroll
            for (int hd = 0; hd < 4; ++hd) { wo[r][hd] = *(const u32x4*)(y + rr[r] * DM + hd * 512 + lane * 8); wg[r][hd] = *(const u32x4*)(big + rr[r] * 6400 + 4096 + hd * 512 + lane * 8); } }
#pragma unroll
        for (int r = 0; r < 2; ++r)
#pragma unroll
            for (int hd = 0; hd < 4; ++hd) {
                float f[8], g[8]; unpack8(wo[r][hd], f); unpack8(wg[r][hd], g);
                float ss = 0.f;
#pragma unroll
                for (int e = 0; e < 8; ++e) ss += f[e] * f[e];
                ss = wsum(ss); const float sc = rsqrtf(ss * (1.f / 512.f) + EPS);
#pragma unroll
                for (int e = 0; e < 8; ++e) f[e] = f[e] * sc * og[e] * silu(g[e]);
                if (ok[r]) *(u32x4*)(y + rr[r] * DM + hd * 512 + lane * 8) = pack8(f);
            }
    }
}

DI void phase_conv(const Params& p) {
    const bf16_t* big = (const bf16_t*)(p.ws + ACT); bf16_t* xc = (bf16_t*)(p.ws + HBUF);
    for (size_t idx = (size_t)blockIdx.x * 512 + otid(); idx < (size_t)(MTOK / 8) * 256; idx += (size_t)gridDim.x * 512) {
        const int tok0 = (int)(idx >> 8) * 8, ch = (int)(idx & 255) * 8, t0 = tok0 & (SEQ - 1);
        float wv[4][8], bs[8];
        { const f32x4 b0 = *(const f32x4*)(p.in[15] + ch), b1 = *(const f32x4*)(p.in[15] + ch + 4);
#pragma unroll
          for (int e = 0; e < 4; ++e) { bs[e] = b0[e]; bs[4 + e] = b1[e]; } }
#pragma unroll
        for (int jx = 0; jx < 4; ++jx) { const f32x4 w0 = *(const f32x4*)(p.in[14] + jx * 2048 + ch), w1 = *(const f32x4*)(p.in[14] + jx * 2048 + ch + 4);
#pragma unroll
            for (int e = 0; e < 4; ++e) { wv[jx][e] = w0[e]; wv[jx][4 + e] = w1[e]; } }
        u32x4 raw[11];
#pragma unroll
        for (int r = 0; r < 11; ++r) raw[r] = (r >= 3 || t0 > 0) ? *(const u32x4*)(big + (size_t)(tok0 - 3 + r) * 4096 + ch) : (u32x4){0u, 0u, 0u, 0u};
#pragma unroll
        for (int o = 0; o < 8; ++o) {
            float acc[8];
#pragma unroll
            for (int e = 0; e < 8; ++e) acc[e] = bs[e];
#pragma unroll
            for (int jx = 0; jx < 4; ++jx) { float f[8]; unpack8(raw[o + jx], f);
#pragma unroll
                for (int e = 0; e < 8; ++e) acc[e] += f[e] * wv[jx][e]; }
            *(u32x4*)(xc + (size_t)(tok0 + o) * DM + ch) = pack8(acc);
        }
    }
}
DI void phase_lru_scan(const Params& p, LAS unsigned char* lds) {
    const unsigned* ax = (const unsigned*)(p.ws + ACT + 128 * MiB); const bf16_t* big = (const bf16_t*)(p.ws + ACT);
    bf16_t* y = (bf16_t*)(p.ws + HBUF);
    LAS unsigned* tile = (LAS unsigned*)lds;
    LAS float* sP = (LAS float*)(lds + 65536); LAS float* sH = sP + 512; LAS float* sC = sH + 512;
    const int tid = otid(), seg = tid >> 5, chl = tid & 31;
    for (int u = blockIdx.x; u < 256; u += gridDim.x) {
        const int b = u >> 6, ch = (u & 63) * 32 + chl;
        const size_t rowbase = (size_t)b * SEQ;
        unsigned pre[32];
#pragma unroll
        for (int i = 0; i < 32; ++i) pre[i] = ax[(rowbase + seg + 16 * i) * DM + ch];
        __syncthreads();
        if (tid < 32) sC[tid] = 0.f;
        for (int sc = 0; sc < 8; ++sc) {
#pragma unroll
            for (int i = 0; i < 32; ++i) tile[(seg + 16 * i) * 32 + chl] = pre[i];
            __syncthreads();
            if (sc + 1 < 8) {
#pragma unroll
                for (int i = 0; i < 32; ++i) pre[i] = ax[(rowbase + (sc + 1) * 512 + seg + 16 * i) * DM + ch];
            }
            float L = 0.f, H = 0.f;
#pragma unroll 8
            for (int t = 0; t < 32; ++t) { const unsigned w = tile[(seg * 32 + t) * 32 + chl]; const float la = __uint_as_float(w << 16); H = __expf(la) * H + __uint_as_float(w & 0xffff0000u); L += la; }
            sP[tid] = __expf(L); sH[tid] = H;
            __syncthreads();
            float hc = sC[chl];
            for (int sg = 0; sg < seg; ++sg) hc = sP[sg * 32 + chl] * hc + sH[sg * 32 + chl];
            const size_t r0 = rowbase + sc * 512 + seg * 32;
#pragma unroll 8
            for (int t = 0; t < 32; ++t) { const unsigned w = tile[(seg * 32 + t) * 32 + chl]; hc = __expf(__uint_as_float(w << 16)) * hc + __uint_as_float(w & 0xffff0000u);
                y[(r0 + t) * DM + ch] = f2bf(hc * silu(bf2f(big[(r0 + t) * 4096 + 2048 + ch]))); }
            __syncthreads();
            if (seg == 15) sC[chl] = hc;
        }
    }
}

DI void phase_mla_lat(const Params& p) {
    bf16_t* lat = (bf16_t*)(p.ws + LAT);
    const int tid = otid(), lane = tid & 63, gw = blockIdx.x * 8 + (tid >> 6), nw = gridDim.x * 8;
    float gq[8], gk[8];
#pragma unroll
    for (int e = 0; e < 8; ++e) { gq[e] = p.in[23][lane * 8 + e]; gk[e] = p.in[24][lane * 8 + e]; }
    const float inv = powf(10000.f, -(float)(lane & 31) * (1.f / 32.f));
    const float g1 = p.in[27][192 + 128 + (lane & 31)], g2 = p.in[27][192 + 160 + (lane & 31)];
    for (int row = gw; row < MTOK; row += nw) {
#pragma unroll
        for (int part = 0; part < 2; ++part) {
            bf16_t* ptr = lat + (size_t)row * 1088 + part * 512 + lane * 8; float f[8]; unpack8(*(const u32x4*)ptr, f);
            float ss = 0.f;
#pragma unroll
            for (int e = 0; e < 8; ++e) ss += f[e] * f[e];
            ss = wsum(ss); const float sc = rsqrtf(ss * (1.f / 512.f) + EPS);
#pragma unroll
            for (int e = 0; e < 8; ++e) f[e] = f[e] * sc * (part ? gk[e] : gq[e]);
            *(u32x4*)ptr = pack8(f);
        }
        { bf16_t* kp = lat + (size_t)row * 1088 + 1024; const int i = lane & 31;
          const float x1 = bf2f(kp[i]), x2 = bf2f(kp[i + 32]);
          float ss = (lane < 32) ? x1 * x1 + x2 * x2 : 0.f; ss = wsum(ss); const float sc = rsqrtf(ss * (1.f / 64.f) + EPS);
          const float a1 = x1 * sc * g1, a2 = x2 * sc * g2; float sn, cs; sincosf((float)(row & (SEQ - 1)) * inv, &sn, &cs);
          if (lane < 32) { kp[i] = f2bf(a1 * cs - a2 * sn); kp[i + 32] = f2bf(a2 * cs + a1 * sn); } }
    }
}
DI void phase_mla_qk(const Params& p) {
    bf16_t* qkv = (bf16_t*)(p.ws + ACT); bf16_t* lat = (bf16_t*)(p.ws + LAT); const float* qkg = p.in[27];
    const int tid = otid(), lane = tid & 63, gw = blockIdx.x * 8 + (tid >> 6), nw = gridDim.x * 8;
    const int l16 = lane & 15, l8 = lane & 7;
    float gk[8], gkr[8];
#pragma unroll
    for (int e = 0; e < 8; ++e) { gk[e] = qkg[192 + l16 * 8 + e]; gkr[e] = qkg[192 + 128 + l8 * 8 + e]; }
    float inv[8];
#pragma unroll
    for (int e = 0; e < 8; ++e) inv[e] = powf(10000.f, -(float)((l8 & 3) * 8 + e) * (1.f / 32.f));
    for (int row0 = gw; row0 < MTOK; row0 += 2 * nw) {
        u32x4 wk[2][4], wp[2]; bool ok[2]; int rw[2];
#pragma unroll
        for (int r = 0; r < 2; ++r) { ok[r] = row0 + r * nw < MTOK; rw[r] = ok[r] ? row0 + r * nw : row0;
            const bf16_t* qr = qkv + (size_t)rw[r] * 7168;
#pragma unroll
            for (int i = 0; i < 4; ++i) { const int head = 4 * i + (lane >> 4); wk[r][i] = *(const u32x4*)(qr + 3072 + head * 256 + l16 * 8); }
            wp[r] = *(const u32x4*)(lat + (size_t)rw[r] * 1088 + 1024 + l8 * 8); }
#pragma unroll
        for (int r = 0; r < 2; ++r) {
            bf16_t* qr = qkv + (size_t)rw[r] * 7168; bf16_t* kpp = lat + (size_t)rw[r] * 1088 + 1024 + l8 * 8;
            const float pos = (float)(rw[r] & (SEQ - 1));
#pragma unroll
            for (int i = 0; i < 4; ++i) {
                const int head = 4 * i + (lane >> 4);
                float f[8]; unpack8(wk[r][i], f); float ss = 0.f;
#pragma unroll
                for (int e = 0; e < 8; ++e) ss += f[e] * f[e];
                ss += __shfl_xor(ss, 1); ss += __shfl_xor(ss, 2); ss += __shfl_xor(ss, 4); ss += __shfl_xor(ss, 8);
                const float sc = rsqrtf(ss * (1.f / 128.f) + EPS);
#pragma unroll
                for (int e = 0; e < 8; ++e) f[e] *= sc * gk[e];
                if (ok[r]) *(u32x4*)(qr + 3072 + head * 256 + l16 * 8) = pack8(f);
            }
            { float f[8], o[8]; unpack8(wp[r], f); float ss = 0.f;
#pragma unroll
              for (int e = 0; e < 8; ++e) ss += f[e] * f[e];
              ss += __shfl_xor(ss, 1); ss += __shfl_xor(ss, 2); ss += __shfl_xor(ss, 4);
              const float sc = rsqrtf(ss * (1.f / 64.f) + EPS);
#pragma unroll
              for (int e = 0; e < 8; ++e) {
                  const float a = f[e] * sc * gkr[e], pa = __shfl_xor(a, 4);
                  float sn, cs; sincosf(pos * inv[e], &sn, &cs);
                  o[e] = (l8 < 4) ? a * cs - pa * sn : a * cs + pa * sn;
              }
              if (ok[r] && lane < 8) *(u32x4*)kpp = pack8(o); }
        }
    }
}

#define XB_TMO      128
#define XB_XCNT(j)  (256  + 64 * (j))
#define XB_XSUB(j)  (1280 + 64 * (j))
#define XB_XGEN(j)  (2304 + 64 * (j))
#define XB_TOP      3328
#define XB_TOPGEN   3392
#define XCD_BAR_WORDS 3456
#define XB_SPIN_CAP (1u << 22)
DI unsigned xb_ld(unsigned* p)              { return __hip_atomic_load(p, __ATOMIC_RELAXED, __HIP_MEMORY_SCOPE_AGENT); }
DI unsigned xb_add(unsigned* p, unsigned v) { return __hip_atomic_fetch_add(p, v, __ATOMIC_RELAXED, __HIP_MEMORY_SCOPE_AGENT); }
DI unsigned xb_xcc_id() { return (unsigned)__builtin_amdgcn_s_getreg((3 << 11) | 20) & 0xFu; }
#define XB_SPIN(cond, bar) do { unsigned _sp = 0; while (cond) { __builtin_amdgcn_s_sleep(1); \
    if ((++_sp & 255u) == 0u) { if (xb_ld(&(bar)[XB_TMO])) break; if (_sp > XB_SPIN_CAP) { atomicAdd(&(bar)[XB_TMO], 1u); break; } } } } while (0)
struct XcdBarrier { unsigned* bar; unsigned x; volatile LAS unsigned* st; };
DI XcdBarrier xcd_barrier_post(unsigned* bar, volatile LAS unsigned* st) {
    XcdBarrier b; b.bar = bar; b.x = xb_xcc_id(); b.st = st;
    if (threadIdx.x == 0) (void)xb_add(&bar[XB_XCNT(b.x)], 1u);
    return b;
}
DI void xcd_barrier_complete(unsigned* bar, unsigned x, unsigned& nloc, unsigned& nx) {
    const unsigned G = gridDim.x * gridDim.y * gridDim.z;
    unsigned sum, cnt, mine, sp = 0u;
    for (;;) {
        sum = 0u; cnt = 0u; mine = 0u;
#pragma unroll
        for (unsigned j = 0; j < 16; ++j) { const unsigned c = xb_ld(&bar[XB_XCNT(j)]); sum += c; cnt += (c > 0u) ? 1u : 0u; mine = (j == x) ? c : mine; }
        if (sum == G) break;
        __builtin_amdgcn_s_sleep(1);
        if ((++sp & 255u) == 0u) { if (xb_ld(&bar[XB_TMO])) break; if (sp > XB_SPIN_CAP) { atomicAdd(&bar[XB_TMO], 1u); break; } }
    }
    nloc = mine > 0u ? mine : 1u; nx = cnt > 0u ? cnt : 1u;
}
DI void xcd_barrier(const XcdBarrier& b0) {
    asm volatile("s_waitcnt vmcnt(0)" ::: "memory");
    __syncthreads();
    if (otid() == 0) {
        XcdBarrier b; b.bar = b0.bar; b.st = b0.st; b.x = xb_xcc_id();
        unsigned* bar = b.bar;
        __builtin_amdgcn_s_waitcnt(0);
        unsigned nloc = b.st[0], nx = b.st[1];
        if (nloc == 0u) { xcd_barrier_complete(bar, b.x, nloc, nx); b.st[0] = nloc; b.st[1] = nx; }
        const unsigned old = xb_add(&bar[XB_XSUB(b.x)], 1u);
        const unsigned gen = old / nloc;
        if (old + 1u == (gen + 1u) * nloc) {
            __builtin_amdgcn_fence(__ATOMIC_RELEASE, "agent");
            asm volatile("s_waitcnt vmcnt(0)" ::: "memory");
            const unsigned og = xb_add(&bar[XB_TOP], 1u);
            const unsigned tg = og / nx;
            if (og + 1u == (tg + 1u) * nx) xb_add(&bar[XB_TOPGEN], 1u);
            else XB_SPIN(xb_ld(&bar[XB_TOPGEN]) == tg, bar);
            __builtin_amdgcn_fence(__ATOMIC_ACQUIRE, "agent");
            xb_add(&bar[XB_XGEN(b.x)], 1u);
            asm volatile("s_waitcnt vmcnt(0)" ::: "memory");
        } else {
            XB_SPIN(xb_ld(&bar[XB_XGEN(b.x)]) == gen, bar);
            __builtin_amdgcn_fence(__ATOMIC_ACQUIRE, "agent");
            asm volatile("s_waitcnt vmcnt(0)" ::: "memory");
        }
    }
    __syncthreads();
}

__global__ __launch_bounds__(512, 2) void mega(const Params p) {
    extern __shared__ __attribute__((aligned(16))) unsigned char shm[];
    LAS unsigned char* lds = (LAS unsigned char*)shm;
    cg::grid_group grid = cg::this_grid();
    volatile LAS unsigned* bst = (volatile LAS unsigned*)(lds + 131072 + 1024);
    if (threadIdx.x == 0) { bst[0] = 0u; bst[1] = 0u; }
    __syncthreads();
    XcdBarrier xb = xcd_barrier_post((unsigned*)(p.ws + WS_BAR), bst); xb.x = 0;
    if constexpr ((PHMASK >> 0) & 1) { phase_convert(p, lds); }
    if constexpr ((REPMASK >> 0) & 1) { __syncthreads(); phase_convert(p, lds); }
    if constexpr ((PHMASK >> 1) & 1) { phase_bias_table(p); }
    if constexpr ((REPMASK >> 1) & 1) { __syncthreads(); phase_bias_table(p); }
    if constexpr ((PHMASK >> 2) & 1) { phase_x0(p.in[0], (bf16_t*)(uni(p.ws) + XG), (float*)(uni(p.ws) + X_SSQ) + 5 * MTOK); }
    if constexpr ((REPMASK >> 2) & 1) { __syncthreads(); phase_rmsnorm(p.in[0], p.in[1], (bf16_t*)(uni(p.ws) + HBUF)); }
    if (p.njobs < 0) grid.sync();
    xcd_barrier(xb);
    if constexpr ((PHMASK >> 3) & 1) { { pg8::EpiStoreA E{(bf16_t*)(uni(p.ws) + ACT), p.in[4], (const float*)(uni(p.ws) + X_SSQ) + 5 * MTOK}; run_gemm<0>(lds, (const bf16_t*)(uni(p.ws) + XG), (const bf16_t*)(uni(p.ws) + W_A_IN), 8192, 2048, 2048, E); } }
    if constexpr ((REPMASK >> 3) & 1) { __syncthreads(); { pg8::EpiStoreA E{(bf16_t*)(uni(p.ws) + ACT), p.in[4], (const float*)(uni(p.ws) + X_SSQ) + 5 * MTOK}; run_gemm<0>(lds, (const bf16_t*)(uni(p.ws) + XG), (const bf16_t*)(uni(p.ws) + W_A_IN), 8192, 2048, 2048, E); } }
    xcd_barrier(xb);
    if constexpr ((PHMASK >> 5) & 1) { phase_attn_a(p, lds); }
    if constexpr ((REPMASK >> 5) & 1) { __syncthreads(); phase_attn_a(p, lds); }
    xcd_barrier(xb);
    if constexpr ((PHMASK >> 6) & 1) { { pg8::EpiResid<true, false, true, true> E{nullptr, (const bf16_t*)(uni(p.ws) + XG), nullptr, (bf16_t*)(uni(p.ws) + XG), (float*)(uni(p.ws) + X_SSQ)}; run_gemm<0>(lds, (bf16_t*)(uni(p.ws) + HBUF), (const bf16_t*)(uni(p.ws) + W_A_OUT), 2048, 2048, 2048, E); } }
    if constexpr ((REPMASK >> 6) & 1) { __syncthreads(); { pg8::EpiResid<true, false, true, true> E{nullptr, (const bf16_t*)(uni(p.ws) + XG), nullptr, (bf16_t*)(uni(p.ws) + XG), (float*)(uni(p.ws) + X_SSQ)}; run_gemm<0>(lds, (bf16_t*)(uni(p.ws) + HBUF), (const bf16_t*)(uni(p.ws) + W_A_OUT), 2048, 2048, 2048, E); } }
    xcd_barrier(xb);
    if constexpr ((PHMASK >> 8) & 1) { { pg8::EpiStore E{(bf16_t*)(uni(p.ws) + ACT), 6400, (const float*)(uni(p.ws) + X_SSQ)}; run_gemm<0>(lds, (const bf16_t*)(uni(p.ws) + XG), (const bf16_t*)(uni(p.ws) + W_B_IN), 6144, 2048, 2048, E); } }
    if constexpr ((REPMASK >> 8) & 1) { __syncthreads(); { pg8::EpiStore E{(bf16_t*)(uni(p.ws) + ACT), 6400, (const float*)(uni(p.ws) + X_SSQ)}; run_gemm<0>(lds, (const bf16_t*)(uni(p.ws) + XG), (const bf16_t*)(uni(p.ws) + W_B_IN), 6144, 2048, 2048, E); } }
    xcd_barrier(xb);
    if constexpr ((PHMASK >> 9) & 1) { phase_gla_prep(p, lds); }
    if constexpr ((REPMASK >> 9) & 1) { __syncthreads(); phase_gla_prep(p, lds); }
    xcd_barrier(xb);
    if constexpr ((PHMASK >> 10) & 1) { phase_gla_scan(p, lds); }
    if constexpr ((REPMASK >> 10) & 1) { __syncthreads(); phase_gla_scan(p, lds); }
    xcd_barrier(xb);
    if constexpr ((PHMASK >> 11) & 1) { phase_gla_post(p); }
    if constexpr ((REPMASK >> 11) & 1) { __syncthreads(); phase_gla_post(p); }
    xcd_barrier(xb);
    if constexpr ((PHMASK >> 12) & 1) { { pg8::EpiResid<true, false, true, true> E{nullptr, (const bf16_t*)(uni(p.ws) + XG), nullptr, (bf16_t*)(uni(p.ws) + XG), (float*)(uni(p.ws) + X_SSQ) + MTOK}; run_gemm<0>(lds, (bf16_t*)(uni(p.ws) + HBUF), (const bf16_t*)(uni(p.ws) + W_B_OUT), 2048, 2048, 2048, E); } }
    if constexpr ((REPMASK >> 12) & 1) { __syncthreads(); { pg8::EpiResid<true, false, true, true> E{nullptr, (const bf16_t*)(uni(p.ws) + XG), nullptr, (bf16_t*)(uni(p.ws) + XG), (float*)(uni(p.ws) + X_SSQ) + MTOK}; run_gemm<0>(lds, (bf16_t*)(uni(p.ws) + HBUF), (const bf16_t*)(uni(p.ws) + W_B_OUT), 2048, 2048, 2048, E); } }
    xcd_barrier(xb);
    if constexpr ((PHMASK >> 14) & 1) { { pg8::EpiStore E{(bf16_t*)(uni(p.ws) + ACT), 4096, (const float*)(uni(p.ws) + X_SSQ) + MTOK}; run_gemm<0>(lds, (const bf16_t*)(uni(p.ws) + XG), (const bf16_t*)(uni(p.ws) + W_C_IN), 4096, 2048, 2048, E); } }
    if constexpr ((REPMASK >> 14) & 1) { __syncthreads(); { pg8::EpiStore E{(bf16_t*)(uni(p.ws) + ACT), 4096, (const float*)(uni(p.ws) + X_SSQ) + MTOK}; run_gemm<0>(lds, (const bf16_t*)(uni(p.ws) + XG), (const bf16_t*)(uni(p.ws) + W_C_IN), 4096, 2048, 2048, E); } }
    xcd_barrier(xb);
    if constexpr ((PHMASK >> 15) & 1) { phase_conv(p); }
    if constexpr ((REPMASK >> 15) & 1) { __syncthreads(); phase_conv(p); }
    xcd_barrier(xb);
    if constexpr ((PHMASK >> 16) & 1) { { pg8::EpiGates E{(bf16_t*)(uni(p.ws) + HBUF), p.in[17], p.in[19], (const float*)(uni(p.ws) + X_SP8), (unsigned*)(uni(p.ws) + ACT + 128 * MiB)}; run_gemm<2>(lds, (bf16_t*)(uni(p.ws) + HBUF), (const bf16_t*)(uni(p.ws) + W_C_GATE), 4096, 256, 2048, E); } }
    if constexpr ((REPMASK >> 16) & 1) { __syncthreads(); { pg8::EpiGates E{(bf16_t*)(uni(p.ws) + HBUF), p.in[17], p.in[19], (const float*)(uni(p.ws) + X_SP8), (unsigned*)(uni(p.ws) + ACT + 128 * MiB)}; run_gemm<2>(lds, (bf16_t*)(uni(p.ws) + HBUF), (const bf16_t*)(uni(p.ws) + W_C_GATE), 4096, 256, 2048, E); } }
    xcd_barrier(xb);
    if constexpr ((PHMASK >> 17) & 1) { phase_lru_scan(p, lds); }
    if constexpr ((REPMASK >> 17) & 1) { __syncthreads(); phase_lru_scan(p, lds); }
    xcd_barrier(xb);
    if constexpr ((PHMASK >> 18) & 1) { { pg8::EpiResid<true, false, true, true> E{nullptr, (const bf16_t*)(uni(p.ws) + XG), nullptr, (bf16_t*)(uni(p.ws) + XG), (float*)(uni(p.ws) + X_SSQ) + 2 * MTOK}; run_gemm<0>(lds, (bf16_t*)(uni(p.ws) + HBUF), (const bf16_t*)(uni(p.ws) + W_C_OUT), 2048, 2048, 2048, E); } }
    if constexpr ((REPMASK >> 18) & 1) { __syncthreads(); { pg8::EpiResid<true, false, true, true> E{nullptr, (const bf16_t*)(uni(p.ws) + XG), nullptr, (bf16_t*)(uni(p.ws) + XG), (float*)(uni(p.ws) + X_SSQ) + 2 * MTOK}; run_gemm<0>(lds, (bf16_t*)(uni(p.ws) + HBUF), (const bf16_t*)(uni(p.ws) + W_C_OUT), 2048, 2048, 2048, E); } }
    xcd_barrier(xb);
    if constexpr ((PHMASK >> 20) & 1) { { pg8::EpiStoreD E{(bf16_t*)(uni(p.ws) + LAT), (bf16_t*)(uni(p.ws) + HBUF), (const float*)(uni(p.ws) + X_SSQ) + 2 * MTOK, (float*)(uni(p.ws) + X_SSQ) + 3 * MTOK}; run_gemm<0>(lds, (const bf16_t*)(uni(p.ws) + XG), (const bf16_t*)(uni(p.ws) + W_D_IN), 3328, 2048, 2048, E); } }
    if constexpr ((REPMASK >> 20) & 1) { __syncthreads(); { pg8::EpiStoreD E{(bf16_t*)(uni(p.ws) + LAT), (bf16_t*)(uni(p.ws) + HBUF), (const float*)(uni(p.ws) + X_SSQ) + 2 * MTOK, (float*)(uni(p.ws) + X_SSQ) + 3 * MTOK}; run_gemm<0>(lds, (const bf16_t*)(uni(p.ws) + XG), (const bf16_t*)(uni(p.ws) + W_D_IN), 3328, 2048, 2048, E); } }
    xcd_barrier(xb);
    if constexpr ((PHMASK >> 22) & 1) { { pg8::EpiStoreU E{(bf16_t*)(uni(p.ws) + ACT), (const float*)(uni(p.ws) + X_SSQ) + 3 * MTOK}; run_gemm<1>(lds, (const bf16_t*)(uni(p.ws) + LAT), (const bf16_t*)(uni(p.ws) + W_D_UQKV), 7168, 512, 1088, E); } }
    if constexpr ((REPMASK >> 22) & 1) { __syncthreads(); { pg8::EpiStoreU E{(bf16_t*)(uni(p.ws) + ACT), (const float*)(uni(p.ws) + X_SSQ) + 3 * MTOK}; run_gemm<1>(lds, (const bf16_t*)(uni(p.ws) + LAT), (const bf16_t*)(uni(p.ws) + W_D_UQKV), 7168, 512, 1088, E); } }
    xcd_barrier(xb);
    if constexpr ((PHMASK >> 23) & 1) { phase_mla_qk(p); }
    if constexpr ((REPMASK >> 23) & 1) { __syncthreads(); phase_mla_qk(p); }
    xcd_barrier(xb);
    if constexpr ((PHMASK >> 24) & 1) { phase_attn_d(p, lds); }
    if constexpr ((REPMASK >> 24) & 1) { __syncthreads(); phase_attn_d(p, lds); }
    xcd_barrier(xb);
    if constexpr ((PHMASK >> 25) & 1) { { pg8::EpiResid<true, true, false, false> E{nullptr, (const bf16_t*)(uni(p.ws) + XG), uni(p.out), nullptr, nullptr}; run_gemm<0>(lds, (bf16_t*)(uni(p.ws) + HBUF), (const bf16_t*)(uni(p.ws) + W_D_OUT), 2048, 2048, 2048, E); } }
    if constexpr ((REPMASK >> 25) & 1) { __syncthreads(); { pg8::EpiResid<true, true, false, false> E{nullptr, (const bf16_t*)(uni(p.ws) + XG), uni(p.out), nullptr, nullptr}; run_gemm<0>(lds, (bf16_t*)(uni(p.ws) + HBUF), (const bf16_t*)(uni(p.ws) + W_D_OUT), 2048, 2048, 2048, E); } }
#ifdef XSYNC
    for (int i = 0; i < XSYNC; ++i) xcd_barrier(xb);
#endif
}

extern "C" void kernel_launch(void* const* d_in, const int* in_sizes, int n_in, void* d_out, int out_size, void* d_ws, size_t ws_size, hipStream_t stream) {
    static int grid_blocks = 0;
    if (!grid_blocks) {
        int dev = 0, cus = 0, per_cu = 0;
        hipGetDevice(&dev);
        hipDeviceGetAttribute(&cus, hipDeviceAttributeMultiprocessorCount, dev);
        hipFuncSetAttribute((const void*)mega, hipFuncAttributeMaxDynamicSharedMemorySize, LDS_BYTES);
        hipOccupancyMaxActiveBlocksPerMultiprocessor(&per_cu, (const void*)mega, 512, LDS_BYTES);
        if (per_cu < 1) per_cu = 1;
        grid_blocks = cus * per_cu;
        if (ws_size < EXTRA + 65536 + 6 * 65536) fprintf(stderr, "kernel_launch: workspace too small (%zu < %zu)\n", ws_size, (size_t)WS_END);
    }
    Params p; memset(&p, 0, sizeof(p));
    for (int i = 0; i < 29; ++i) p.in[i] = (const float*)d_in[i];
    p.out = (float*)d_out; p.ws = (unsigned char*)d_ws;
    unsigned char* ws = (unsigned char*)d_ws;
    int nj = 0, tiles = 0;
    auto add = [&](const float* src, size_t dst_off, int K, int N, int ldw, int npad) {
        TJob& j = p.jobs[nj++]; j.src = src; j.dst = (bf16_t*)(ws + dst_off); j.kscale = nullptr; j.K = K; j.N = N; j.ldw = ldw; j.ntn = npad / 64; j.tile0 = tiles; j.pad = 0; tiles += (npad / 64) * (K / 256);
    };
    add(p.in[3], W_A_IN, 2048, 8192, 8192, 8192); p.jobs[0].pad = 1; p.jobs[0].kscale = p.in[1];
    add(p.in[7], W_A_OUT, 2048, 2048, 2048, 2048);
    add(p.in[8], W_B_IN, 2048, 6160, 6160, 6400); p.jobs[nj - 1].kscale = p.in[1] + 2048;
    add(p.in[12], W_B_OUT, 2048, 2048, 2048, 2048);
    add(p.in[13], W_C_IN, 2048, 4096, 4096, 4096); p.jobs[nj - 1].kscale = p.in[1] + 4096;
    add(p.in[21], W_C_OUT, 2048, 2048, 2048, 2048);
    add(p.in[22], W_D_IN, 2048, 3136, 3136, 3328); p.jobs[nj - 1].kscale = p.in[1] + 6144;
    add(p.in[25], W_D_UQKV, 512, 3072, 3072, 3072); p.jobs[nj - 1].kscale = p.in[23];
    add(p.in[26], W_D_UQKV + (size_t)3072 * 512 * 2, 512, 4096, 4096, 4096); p.jobs[nj - 1].kscale = p.in[24];
    add(p.in[28], W_D_OUT, 2048, 2048, 2048, 2048);
    for (int n = 0; n < 8; ++n) for (int half = 0; half < 2; ++half) for (int bj = 0; bj < 2; ++bj)
        add(p.in[bj ? 18 : 16] + (size_t)n * 65536 + half * 128, W_C_GATE + ((size_t)((n * 2 + half) * 256 + 128 * bj)) * 256 * 2, 256, 128, 256, 128);
    p.njobs = nj; p.ntiles = tiles;
    hipMemsetAsync(ws + WS_BAR, 0, XCD_BAR_WORDS * 4, stream);
    void* args[] = {(void*)&p};
    hipError_t e = hipLaunchCooperativeKernel((const void*)mega, dim3(grid_blocks), dim3(512), args, LDS_BYTES, stream);
    if (e != hipSuccess) fprintf(stderr, "cooperative launch failed: %s (grid %d)\n", hipGetErrorString(e), grid_blocks);
}
```

```cpp
#include <hip/hip_runtime.h>
#include <hip/hip_cooperative_groups.h>
#include <cstdio>
#include <cstring>
namespace cg = cooperative_groups;

#define DI __device__ __forceinline__
#define LAS __attribute__((address_space(3)))
typedef unsigned short bf16_t;
typedef short bf16x8 __attribute__((ext_vector_type(8)));
typedef short s16x4 __attribute__((ext_vector_type(4)));
typedef float f32x2 __attribute__((ext_vector_type(2)));
typedef float f32x4 __attribute__((ext_vector_type(4)));
typedef float f32x16 __attribute__((ext_vector_type(16)));
typedef unsigned u32x2 __attribute__((ext_vector_type(2)));
typedef unsigned u32x4 __attribute__((ext_vector_type(4)));
typedef __bf16 bf16v2_t __attribute__((ext_vector_type(2)));

constexpr int MTOK = 16384, DM = 2048, SEQ = 4096;
constexpr float EPS = 1e-6f, LOG2E = 1.4426950408889634f;
constexpr size_t MiB = (size_t)1 << 20;
constexpr size_t W_A_IN = 0, W_A_OUT = 32 * MiB, W_B_IN = 40 * MiB, W_B_OUT = 65 * MiB, W_C_IN = 73 * MiB, W_C_GATE = 89 * MiB,
                 W_C_OUT = 91 * MiB, W_D_IN = 99 * MiB, W_D_UQKV = 112 * MiB, W_D_OUT = 119 * MiB, HBUF = 127 * MiB, ACT = 191 * MiB,
                 WS_END = 511 * MiB;
constexpr size_t LAT = 0;
constexpr size_t EXTRA = 511 * MiB;
constexpr size_t X_BIAS = EXTRA + 16384, X_SP8 = EXTRA + 32768, X_SSQ = EXTRA + 65536;
constexpr size_t GLA_TOT = ACT + 200 * MiB;
constexpr size_t XG = ACT + 256 * MiB;
constexpr size_t WS_BAR = EXTRA;
constexpr int LDS_BYTES = 131072 + 2048;
#ifndef PHMASK
#define PHMASK 0xffffffffull
#endif
#ifndef REPMASK
#define REPMASK 0ull
#endif

struct TJob { const float* src; bf16_t* dst; const float* kscale; int K, N, ldw, ntn, tile0, pad; };
struct Params { const float* in[29]; float* out; unsigned char* ws; int njobs, ntiles; TJob jobs[44]; };

DI int otid() { int t = threadIdx.x; asm volatile("" : "+v"(t)); return t; }
template <class T> DI T* uni(T* p) {
    const unsigned long long v = (unsigned long long)p;
    const unsigned lo = __builtin_amdgcn_readfirstlane((unsigned)v), hi = __builtin_amdgcn_readfirstlane((unsigned)(v >> 32));
    return (T*)(((unsigned long long)hi << 32) | lo);
}
DI float bf2f(bf16_t v) { return __uint_as_float((unsigned)v << 16); }
DI unsigned pk2(float a, float b) { f32x2 v = {a, b}; bf16v2_t r = __builtin_convertvector(v, bf16v2_t); return __builtin_bit_cast(unsigned, r); }
DI bf16_t f2bf(float a) { return (bf16_t)(pk2(a, 0.f) & 0xffffu); }
DI void unpack8(const u32x4 w, float (&f)[8]) {
#pragma unroll
    for (int i = 0; i < 4; ++i) { f[2 * i] = __uint_as_float(w[i] << 16); f[2 * i + 1] = __uint_as_float(w[i] & 0xffff0000u); }
}
DI u32x4 pack8(const float (&f)[8]) { u32x4 w; w.x = pk2(f[0], f[1]); w.y = pk2(f[2], f[3]); w.z = pk2(f[4], f[5]); w.w = pk2(f[6], f[7]); return w; }
DI float wsum(float v) {
#pragma unroll
    for (int m = 32; m >= 1; m >>= 1) v += __shfl_xor(v, m);
    return v;
}
DI float sigm(float x) { return 1.f / (1.f + __expf(-x)); }
DI float silu(float x) { return x / (1.f + __expf(-x)); }
DI int crow(int i, int hh) { return (i & 3) + 8 * (i >> 2) + 4 * hh; }
DI f32x16 mfma32(bf16x8 a, bf16x8 b, f32x16 c) { return __builtin_amdgcn_mfma_f32_32x32x16_bf16(a, b, c, 0, 0, 0); }
DI s16x4 trread(LAS unsigned char* p) { return __builtin_amdgcn_ds_read_tr16_b64_v4i16((LAS s16x4*)p); }
DI bf16x8 cat4(s16x4 lo, s16x4 hi) { return __builtin_shufflevector(lo, hi, 0, 1, 2, 3, 4, 5, 6, 7); }

namespace pg8 {
constexpr int BM = 256, BK = 64, HALF = 128, HTB = HALF * BK * 2, STAGE_BYTES = 8 * HTB, NXCD = 8, WGM = 8;
DI int lds_byte(int r, int c) { const int st = (r >> 4) * 2 + (c >> 5), rr = r & 15, cc = c & 31, ob = rr * 64 + cc * 2; return st * 1024 + (ob ^ (((ob >> 9) & 1) << 5)); }
DI void stage_rc(int b, int& R, int& C) { const int st = b / 1024, sb = b % 1024, swz = sb ^ (((sb >> 9) & 1) << 5); R = (st >> 1) * 16 + swz / 64; C = (st & 1) * 32 + (swz % 64) / 2; }
DI int perm32(int rho) { const int n = rho >> 4, i = rho & 15; return 8 * (i >> 2) + 4 * n + (i & 3); }
struct Unit { int pm, pn; size_t aoff, boff; };
template <int MODE> struct Sched {
    int nM, nN, nwg, G, c, lda, K;
    DI void init(int M, int N, int G_, int c_, int lda_, int K_) { nM = M / BM; nN = N / BM; nwg = nM * nN; G = G_; c = c_; lda = lda_; K = K_; }
    DI bool next(int i, Unit& u) const {
        const long L = (long)i * G + c; if (L >= nwg) return false;
        int wgid = (int)L; { const int q = nwg / NXCD, r = nwg % NXCD, xcd = wgid % NXCD, off = wgid / NXCD; wgid = (xcd < r ? xcd * (q + 1) : r * (q + 1) + (xcd - r) * q) + off; }
        const int nig = WGM * nN, gid = wgid / nig, fm = gid * WGM, gsz = (nM - fm) < WGM ? (nM - fm) : WGM;
        u.pm = fm + ((wgid % nig) % gsz); u.pn = (wgid % nig) / gsz;
        u.aoff = (size_t)u.pm * 256 * lda * 2; u.boff = (size_t)u.pn * 256 * K * 2;
        if (MODE == 1 && u.pn >= 12) u.aoff += 1024;
        if (MODE == 2) u.aoff += (size_t)(u.pn >> 1) * 512;
        return true;
    }
};

template <class Epi, class SchedT>
DI void gemm_phase(LAS unsigned char* lds, const bf16_t* Ap, const bf16_t* Btp, const int K, const int lda, const SchedT& S, const Epi& E) {
    const int tid = otid(), wid = __builtin_amdgcn_readfirstlane(tid >> 6), lane = tid & 63, wr = wid >> 2, wc = wid & 3, fr = lane & 15, fq = lane >> 4;
    const int nt = K / BK;
    unsigned voffA[2], voffB[2];
#pragma unroll
    for (int i = 0; i < 2; ++i) { int R, C; stage_rc(tid * 16 + i * 8192, R, C); const int Rb = (R & ~31) + perm32(R & 31);
        voffA[i] = (unsigned)(R * lda + C) * 2u; voffB[i] = (unsigned)(Rb * K + C) * 2u; }
    const size_t kstep = (size_t)(BK * 2);
    const size_t hstepA = (size_t)HALF * lda * 2, hstepB = (size_t)HALF * K * 2;
    const unsigned ldsw = (unsigned)wid * 1024u;
    const int aoff = lds_byte(wr * 64 + fr, fq * 8), boff = lds_byte(wc * 32 + fr, fq * 8);
#define PG8_SA(b, h) (((b) * 2 + (h)) * HTB)
#define PG8_SB(b, h) ((4 + (b) * 2 + (h)) * HTB)
#define PG8_STAGE(bufoff, gbase, voff) do { _Pragma("unroll") for (int _i = 0; _i < 2; ++_i) \
        __builtin_amdgcn_global_load_lds((const unsigned*)((const char*)(gbase) + (voff)[_i]), (LAS unsigned*)(lds + (bufoff) + ldsw + _i * 8192), 16, 0, 0); } while (0)
#define PG8_LDA(dst, b, h) do { _Pragma("unroll") for (int m = 0; m < 4; ++m) _Pragma("unroll") for (int k = 0; k < 2; ++k) dst[m][k] = *(const LAS bf16x8*)(lds + PG8_SA(b, h) + aoff + m * 2048 + k * 1024); } while (0)
#define PG8_LDB(dst, b, h) do { _Pragma("unroll") for (int n = 0; n < 2; ++n) _Pragma("unroll") for (int k = 0; k < 2; ++k) dst[n][k] = *(const LAS bf16x8*)(lds + PG8_SB(b, h) + boff + n * 2048 + k * 1024); } while (0)
#define PG8_MMA(ai, bj, At, Bt) do { __builtin_amdgcn_s_setprio(1); _Pragma("unroll") for (int m = 0; m < 4; ++m) _Pragma("unroll") for (int n = 0; n < 2; ++n) _Pragma("unroll") for (int k = 0; k < 2; ++k) \
        acc[ai][bj][m][n] = __builtin_amdgcn_mfma_f32_16x16x32_bf16(Bt[n][k], At[m][k], acc[ai][bj][m][n], 0, 0, 0); __builtin_amdgcn_s_setprio(0); } while (0)
#define PG8_WAIT_V(n) asm volatile("s_waitcnt vmcnt(" #n ")" ::: "memory")
#define PG8_WAIT_L(n) asm volatile("s_waitcnt lgkmcnt(" #n ")" ::: "memory")
#define PG8_BAR __builtin_amdgcn_s_barrier()
#define PG8_SCHED __builtin_amdgcn_sched_barrier(0)
    Unit cur, nxt; int ui = 0;
    if (!S.next(0, cur)) return;
    float pre[8]; E.prefetch(cur, wr, fr, pre);
    f32x4 acc[2][2][4][2];
#pragma unroll
    for (int a = 0; a < 2; ++a)
#pragma unroll
        for (int b = 0; b < 2; ++b)
#pragma unroll
            for (int m = 0; m < 4; ++m)
#pragma unroll
                for (int n = 0; n < 2; ++n) acc[a][b][m][n] = (f32x4){0.f, 0.f, 0.f, 0.f};
    bf16x8 At[4][2], B0[2][2], B1[2][2];
    const char* cA = (const char*)Ap + cur.aoff; const char* cB = (const char*)Btp + cur.boff;
    PG8_STAGE(PG8_SB(0, 0), cB, voffB); PG8_STAGE(PG8_SA(0, 0), cA, voffA); PG8_STAGE(PG8_SB(0, 1), cB + hstepB, voffB); PG8_STAGE(PG8_SA(0, 1), cA + hstepA, voffA);
    if (wr == 1) PG8_BAR;
    PG8_WAIT_V(4); PG8_BAR;
    PG8_STAGE(PG8_SB(1, 0), cB + kstep, voffB); PG8_STAGE(PG8_SA(1, 0), cA + kstep, voffA); PG8_STAGE(PG8_SB(1, 1), cB + hstepB + kstep, voffB);
    PG8_WAIT_V(6); PG8_BAR;
    for (;;) {
        const bool has_next = S.next(ui + 1, nxt);
        const char* nA = has_next ? (const char*)Ap + nxt.aoff : cA; const char* nB = has_next ? (const char*)Btp + nxt.boff : cB;
        for (int t = 0; t < nt; t += 2) {
            const bool last = (t == nt - 2);
            const char* a1 = cA + (size_t)(t + 1) * kstep;
            const char* a2 = last ? nA : cA + (size_t)(t + 2) * kstep; const char* b2 = last ? nB : cB + (size_t)(t + 2) * kstep;
            const char* a3 = a2 + kstep; const char* b3 = b2 + kstep;
            PG8_LDB(B0, 0, 0); PG8_SCHED; PG8_LDA(At, 0, 0); PG8_STAGE(PG8_SA(1, 1), a1 + hstepA, voffA);
            PG8_WAIT_L(8); PG8_BAR; PG8_WAIT_L(0); PG8_MMA(0, 0, At, B0); PG8_BAR; PG8_SCHED;
            PG8_LDB(B1, 0, 1); PG8_STAGE(PG8_SB(0, 0), b2, voffB);
            PG8_BAR; PG8_WAIT_L(0); PG8_MMA(0, 1, At, B1); PG8_BAR;
            PG8_LDA(At, 0, 1); PG8_STAGE(PG8_SA(0, 0), a2, voffA);
            PG8_BAR; PG8_WAIT_L(0); PG8_MMA(1, 0, At, B0); PG8_BAR; PG8_SCHED;
            PG8_STAGE(PG8_SB(0, 1), b2 + hstepB, voffB);
            PG8_WAIT_V(6); PG8_BAR; PG8_MMA(1, 1, At, B1); PG8_BAR;
            PG8_LDB(B0, 1, 0); PG8_SCHED; PG8_LDA(At, 1, 0); PG8_STAGE(PG8_SA(0, 1), a2 + hstepA, voffA);
            PG8_WAIT_L(8); PG8_BAR; PG8_WAIT_L(0); PG8_MMA(0, 0, At, B0); PG8_BAR; PG8_SCHED;
            PG8_LDB(B1, 1, 1); PG8_STAGE(PG8_SB(1, 0), b3, voffB);
            PG8_BAR; PG8_WAIT_L(0); PG8_MMA(0, 1, At, B1); PG8_BAR;
            PG8_LDA(At, 1, 1); PG8_STAGE(PG8_SA(1, 0), a3, voffA);
            PG8_BAR; PG8_WAIT_L(0); PG8_MMA(1, 0, At, B0); PG8_BAR; PG8_SCHED;
            PG8_STAGE(PG8_SB(1, 1), b3 + hstepB, voffB);
            PG8_WAIT_V(6); PG8_BAR; PG8_MMA(1, 1, At, B1); PG8_BAR;
        }
        E(acc, cur, wr, wc, fr, fq, pre);
        if (!has_next) break;
#pragma unroll
        for (int a = 0; a < 2; ++a)
#pragma unroll
            for (int b = 0; b < 2; ++b)
#pragma unroll
                for (int m = 0; m < 4; ++m)
#pragma unroll
                    for (int n = 0; n < 2; ++n) acc[a][b][m][n] = (f32x4){0.f, 0.f, 0.f, 0.f};
        cur = nxt; cA = nA; cB = nB; ++ui; E.prefetch(cur, wr, fr, pre);
    }
    PG8_WAIT_V(0);
    if (wr == 0) PG8_BAR;
    PG8_BAR;
#undef PG8_SA
#undef PG8_SB
#undef PG8_STAGE
#undef PG8_LDA
#undef PG8_LDB
#undef PG8_MMA
#undef PG8_WAIT_V
#undef PG8_WAIT_L
#undef PG8_BAR
#undef PG8_SCHED
}

typedef f32x4 Acc[2][2][4][2];
struct EpiStore {
    bf16_t* O; int ldc; const float* ssq;
    DI void prefetch(const Unit& u, int wr, int fr, float (&pre)[8]) const {
#pragma unroll
        for (int i = 0; i < 8; ++i) pre[i] = ssq ? ssq[u.pm * BM + wr * 64 + fr + (i >> 2) * HALF + (i & 3) * 16] : 0.f; }
    DI void operator()(const Acc& acc, const Unit& u, int wr, int wc, int fr, int fq, const float (&pre)[8]) const {
        const int row0 = u.pm * BM + wr * 64 + fr, col0 = u.pn * BM + wc * 32 + 8 * fq;
#pragma unroll
        for (int ai = 0; ai < 2; ++ai)
#pragma unroll
            for (int m = 0; m < 4; ++m) { bf16_t* rowp = O + (size_t)(row0 + ai * HALF + m * 16) * ldc + col0;
                const float rs = ssq ? rsqrtf(pre[ai * 4 + m] * (1.f / DM) + EPS) : 1.f;
#pragma unroll
                for (int bj = 0; bj < 2; ++bj) { const f32x4 v0 = acc[ai][bj][m][0] * rs, v1 = acc[ai][bj][m][1] * rs;
                    u32x4 w; w.x = pk2(v0[0], v0[1]); w.y = pk2(v0[2], v0[3]); w.z = pk2(v1[0], v1[1]); w.w = pk2(v1[2], v1[3]);
                    *(u32x4*)(rowp + bj * HALF) = w; } }
    }
};
struct EpiStoreA {
    bf16_t* O; const float* qkg; const float* ssq;
    DI void prefetch(const Unit& u, int wr, int fr, float (&pre)[8]) const {
#pragma unroll
        for (int i = 0; i < 8; ++i) pre[i] = ssq[u.pm * BM + wr * 64 + fr + (i >> 2) * HALF + (i & 3) * 16]; }
    DI void operator()(const Acc& acc, const Unit& u, int wr, int wc, int fr, int fq, const float (&pre)[8]) const {
        const int row0 = u.pm * BM + wr * 64 + fr, col0 = u.pn * BM + wc * 64 + 8 * fq;
        const bool nrm = u.pn < 16;
        f32x4 gn[2][2];
        if (nrm) { const float* gp = qkg + (u.pn < 8 ? 0 : 64) + 8 * fq; const float gs = u.pn < 8 ? 0.125f * LOG2E : 1.f;
#pragma unroll
            for (int bj = 0; bj < 2; ++bj) { gn[bj][0] = *(const f32x4*)(gp + 32 * bj) * gs; gn[bj][1] = *(const f32x4*)(gp + 32 * bj + 4) * gs; } }
#pragma unroll
        for (int ai = 0; ai < 2; ++ai)
#pragma unroll
            for (int m = 0; m < 4; ++m) { bf16_t* rowp = O + (size_t)(row0 + ai * HALF + m * 16) * 8192 + col0;
                f32x4 v[2][2]; const float rs = rsqrtf(pre[ai * 4 + m] * (1.f / DM) + EPS);
#pragma unroll
                for (int bj = 0; bj < 2; ++bj) { v[bj][0] = acc[ai][bj][m][0] * rs; v[bj][1] = acc[ai][bj][m][1] * rs; }
                if (nrm) { float ss = 0.f;
#pragma unroll
                    for (int bj = 0; bj < 2; ++bj)
#pragma unroll
                        for (int n = 0; n < 2; ++n) ss += v[bj][n][0] * v[bj][n][0] + v[bj][n][1] * v[bj][n][1] + v[bj][n][2] * v[bj][n][2] + v[bj][n][3] * v[bj][n][3];
                    ss += __shfl_xor(ss, 16); ss += __shfl_xor(ss, 32);
                    const float sc = rsqrtf(ss * (1.f / 64.f) + EPS);
#pragma unroll
                    for (int bj = 0; bj < 2; ++bj) { v[bj][0] = v[bj][0] * sc * gn[bj][0]; v[bj][1] = v[bj][1] * sc * gn[bj][1]; } }
#pragma unroll
                for (int bj = 0; bj < 2; ++bj) { u32x4 w; w.x = pk2(v[bj][0][0], v[bj][0][1]); w.y = pk2(v[bj][0][2], v[bj][0][3]); w.z = pk2(v[bj][1][0], v[bj][1][1]); w.w = pk2(v[bj][1][2], v[bj][1][3]);
                    *(u32x4*)(rowp + 32 * bj) = w; } }
    }
};
struct EpiStoreD {
    bf16_t* lat; bf16_t* g; const float* ssq; float* ssql;
    DI void prefetch(const Unit& u, int wr, int fr, float (&pre)[8]) const {
#pragma unroll
        for (int i = 0; i < 8; ++i) pre[i] = ssq[u.pm * BM + wr * 64 + fr + (i >> 2) * HALF + (i & 3) * 16]; }
    DI void operator()(const Acc& acc, const Unit& u, int wr, int wc, int fr, int fq, const float (&pre)[8]) const {
        const int row0 = u.pm * BM + wr * 64 + fr, col0 = u.pn * BM + wc * 32 + 8 * fq;
#pragma unroll
        for (int ai = 0; ai < 2; ++ai)
#pragma unroll
            for (int m = 0; m < 4; ++m) { const size_t row = (size_t)(row0 + ai * HALF + m * 16);
                const float rs = rsqrtf(pre[ai * 4 + m] * (1.f / DM) + EPS); float ss = 0.f;
#pragma unroll
                for (int bj = 0; bj < 2; ++bj) { const f32x4 v0 = acc[ai][bj][m][0] * rs, v1 = acc[ai][bj][m][1] * rs;
                    ss += v0[0] * v0[0] + v0[1] * v0[1] + v0[2] * v0[2] + v0[3] * v0[3] + v1[0] * v1[0] + v1[1] * v1[1] + v1[2] * v1[2] + v1[3] * v1[3];
                    u32x4 w; w.x = pk2(v0[0], v0[1]); w.y = pk2(v0[2], v0[3]); w.z = pk2(v1[0], v1[1]); w.w = pk2(v1[2], v1[3]);
                    const int col = col0 + bj * HALF;
                    if (col < 1088) *(u32x4*)(lat + row * 1088 + col) = w;
                    else if (col < 3136) *(u32x4*)(g + row * 2048 + (col - 1088)) = w; }
                if (u.pn < 4) { ss += __shfl_xor(ss, 16); ss += __shfl_xor(ss, 32); if (fq == 0) atomicAdd(ssql + (u.pn >> 1) * MTOK + row, ss); } }
    }
};
struct EpiStoreU {
    bf16_t* O; const float* ssql;
    DI void prefetch(const Unit& u, int wr, int fr, float (&pre)[8]) const {
        const float* sq = ssql + (u.pn >= 12 ? MTOK : 0);
#pragma unroll
        for (int i = 0; i < 8; ++i) pre[i] = sq[u.pm * BM + wr * 64 + fr + (i >> 2) * HALF + (i & 3) * 16]; }
    DI void operator()(const Acc& acc, const Unit& u, int wr, int wc, int fr, int fq, const float (&pre)[8]) const {
        const int row0 = u.pm * BM + wr * 64 + fr, col0 = u.pn * BM + wc * 32 + 8 * fq;
        const float* sq = ssql + (u.pn >= 12 ? MTOK : 0);
#pragma unroll
        for (int ai = 0; ai < 2; ++ai)
#pragma unroll
            for (int m = 0; m < 4; ++m) { bf16_t* rowp = O + (size_t)(row0 + ai * HALF + m * 16) * 7168 + col0;
                const float rs = rsqrtf(pre[ai * 4 + m] * (1.f / 512.f) + EPS);
#pragma unroll
                for (int bj = 0; bj < 2; ++bj) { const f32x4 v0 = acc[ai][bj][m][0] * rs, v1 = acc[ai][bj][m][1] * rs;
                    u32x4 w; w.x = pk2(v0[0], v0[1]); w.y = pk2(v0[2], v0[3]); w.z = pk2(v1[0], v1[1]); w.w = pk2(v1[2], v1[3]);
                    *(u32x4*)(rowp + bj * HALF) = w; } }
    }
};
template <bool INB, bool OUTF, bool OUTB, bool SSQ> struct EpiResid {
    const float* xf; const bf16_t* xb; float* of; bf16_t* ob; float* ssq;
    DI void prefetch(const Unit&, int, int, float (&pre)[8]) const {
#pragma unroll
        for (int i = 0; i < 8; ++i) pre[i] = 0.f; }
    DI void operator()(const Acc& acc, const Unit& u, int wr, int wc, int fr, int fq, const float (&pre)[8]) const {
        const int row0 = u.pm * BM + wr * 64 + fr, col0 = u.pn * BM + wc * 32 + 8 * fq;
#pragma unroll
        for (int ai = 0; ai < 2; ++ai)
#pragma unroll
            for (int m = 0; m < 4; ++m) { const int row = row0 + ai * HALF + m * 16; const size_t o = (size_t)row * DM + col0;
                float ss = 0.f;
#pragma unroll
                for (int bj = 0; bj < 2; ++bj) {
                    f32x4 x0, x1;
                    if (INB) { float f[8]; unpack8(*(const u32x4*)(xb + o + bj * HALF), f); x0 = (f32x4){f[0], f[1], f[2], f[3]}; x1 = (f32x4){f[4], f[5], f[6], f[7]}; }
                    else { x0 = *(const f32x4*)(xf + o + bj * HALF); x1 = *(const f32x4*)(xf + o + bj * HALF + 4); }
                    x0 += acc[ai][bj][m][0]; x1 += acc[ai][bj][m][1];
                    if (OUTF) { __builtin_nontemporal_store(x0, (f32x4*)(of + o + bj * HALF)); __builtin_nontemporal_store(x1, (f32x4*)(of + o + bj * HALF + 4)); }
                    if (SSQ) ss += x0[0] * x0[0] + x0[1] * x0[1] + x0[2] * x0[2] + x0[3] * x0[3] + x1[0] * x1[0] + x1[1] * x1[1] + x1[2] * x1[2] + x1[3] * x1[3];
                    if (OUTB) { u32x4 w; w.x = pk2(x0[0], x0[1]); w.y = pk2(x0[2], x0[3]); w.z = pk2(x1[0], x1[1]); w.w = pk2(x1[2], x1[3]);
                        *(u32x4*)(ob + o + bj * HALF) = w; } }
                if (SSQ) { ss += __shfl_xor(ss, 16); ss += __shfl_xor(ss, 32); if (fq == 0) atomicAdd(ssq + row, ss); } }
    }
};
struct EpiGates {
    const bf16_t* xc; const float* brg; const float* big; const float* sp8t; unsigned* ax;
    DI void prefetch(const Unit&, int, int, float (&pre)[8]) const {
#pragma unroll
        for (int i = 0; i < 8; ++i) pre[i] = 0.f; }
    DI void operator()(const Acc& acc, const Unit& u, int wr, int wc, int fr, int fq, const float (&pre)[8]) const {
        const int row0 = u.pm * BM + wr * 64 + fr, f0 = (u.pn >> 1) * 256 + (u.pn & 1) * 128 + wc * 32 + 8 * fq;
#pragma unroll
        for (int n = 0; n < 2; ++n) {
            const f32x4 br = *(const f32x4*)(brg + f0 + 4 * n), bi = *(const f32x4*)(big + f0 + 4 * n), sp = *(const f32x4*)(sp8t + f0 + 4 * n);
#pragma unroll
            for (int ai = 0; ai < 2; ++ai)
#pragma unroll
                for (int m = 0; m < 4; ++m) { const size_t o = (size_t)(row0 + ai * HALF + m * 16) * DM + f0 + 4 * n;
                    const u32x2 xw = *(const u32x2*)(xc + o);
                    const float xv[4] = {__uint_as_float(xw.x << 16), __uint_as_float(xw.x & 0xffff0000u), __uint_as_float(xw.y << 16), __uint_as_float(xw.y & 0xffff0000u)};
                    u32x4 w;
#pragma unroll
                    for (int e = 0; e < 4; ++e) { const float r = sigm(acc[ai][0][m][n][e] + br[e]), ig = sigm(acc[ai][1][m][n][e] + bi[e]);
                        const float la = -sp[e] * r, uu = -2.f * la;
                        const float om = uu * (1.f - uu * 0.5f * (1.f - uu * (1.f / 3.f) * (1.f - uu * 0.25f * (1.f - uu * 0.2f * (1.f - uu * (1.f / 6.f))))));
                        w[e] = pk2(la, sqrtf(fmaxf(om, 0.f)) * ig * xv[e]); }
                    *(u32x4*)(ax + o) = w; __builtin_amdgcn_sched_barrier(0); }
        }
    }
};
}

template <int MODE, class Epi>
DI void run_gemm(LAS unsigned char* lds, const bf16_t* A, const bf16_t* Bt, int N, int K, int lda, const Epi& E) {
    asm volatile("" : "+s"(K));
    pg8::Sched<MODE> S; S.init(MTOK, N, (int)gridDim.x, (int)blockIdx.x, lda, K);
    pg8::gemm_phase(lds, A, Bt, K, lda, S, E);
    __syncthreads();
}

DI void phase_convert(const Params& p, LAS unsigned char* lds) {
    LAS float* sm = (LAS float*)lds;
    const int tid = otid();
    for (int t = blockIdx.x; t < p.ntiles; t += gridDim.x) {
        int j = 0; while (j + 1 < p.njobs && p.jobs[j + 1].tile0 <= t) ++j;
        const float* src = p.jobs[j].src; bf16_t* dst = p.jobs[j].dst; const int K = p.jobs[j].K, N = p.jobs[j].N, ldw = p.jobs[j].ldw, ntn = p.jobs[j].ntn;
        const int tt = t - p.jobs[j].tile0, tn = tt % ntn, tk = tt / ntn, n0 = tn * 64, k0 = tk * 256;
        { const int n4 = (tid & 15) * 4, kr = tid >> 4; f32x4 v[8];
#pragma unroll
          for (int i = 0; i < 8; ++i) v[i] = (n0 + n4 < N) ? __builtin_nontemporal_load((const f32x4*)(src + (size_t)(k0 + kr + 32 * i) * ldw + n0 + n4)) : (f32x4){0.f, 0.f, 0.f, 0.f};
#pragma unroll
          for (int i = 0; i < 8; ++i) { LAS float* d = sm + (kr + 32 * i) * 65 + n4; d[0] = v[i][0]; d[1] = v[i][1]; d[2] = v[i][2]; d[3] = v[i][3]; } }
        __syncthreads();
        { const int nr = tid >> 3, kq = tid & 7;
#pragma unroll
          for (int jj = 0; jj < 4; ++jj) { const int kc = (kq + 8 * jj) * 8; float f[8];
#pragma unroll
              for (int e = 0; e < 8; ++e) f[e] = sm[(kc + e) * 65 + nr];
              if (p.jobs[j].kscale) { const float* ks = p.jobs[j].kscale + k0 + kc;
#pragma unroll
                  for (int e = 0; e < 8; ++e) f[e] *= ks[e]; }
              int nrow = n0 + nr; if (p.jobs[j].pad) { const int jl = nrow & 255; nrow = (nrow & ~255) + 128 * ((jl >> 5) & 1) + 32 * (jl >> 6) + (jl & 31); }
              *(u32x4*)(dst + (size_t)nrow * K + k0 + kc) = pack8(f); } }
        __syncthreads();
    }
}

DI int t5_bucket(int rel) {
    const int n = rel < 0 ? -rel : rel; int b;
    if (n < 8) b = n; else b = 8 + (n >= 12) + (n >= 16) + (n >= 23) + (n >= 32) + (n >= 46) + (n >= 64) + (n >= 91);
    return (rel > 0 ? 16 : 0) + b;
}
DI void phase_bias_table(const Params& p) {
    float* tb = (float*)(p.ws + X_BIAS);
    float* sp8 = (float*)(p.ws + X_SP8); float* ssq = (float*)(p.ws + X_SSQ);
    for (int i = blockIdx.x * 512 + otid(); i < 5 * MTOK; i += gridDim.x * 512) ssq[i] = 0.f;
    for (int i = blockIdx.x * 512 + otid(); i < 16 * 192 + 2048; i += gridDim.x * 512) {
        if (i < 16 * 192) { const int h = i / 192, idx = i % 192; tb[i] = (p.in[2][t5_bucket(idx - 128) * 16 + h] - p.in[2][15 * 16 + h]) * LOG2E; }
        else sp8[i - 16 * 192] = 8.f * log1pf(expf(-p.in[20][i - 16 * 192]));
    }
}

DI void phase_x0(const float* x, bf16_t* out, float* ssq) {
    const int tid = otid(), lane = tid & 63, gw = blockIdx.x * 8 + (tid >> 6), nw = gridDim.x * 8;
    for (int row0 = gw; row0 < MTOK; row0 += 2 * nw) {
        f32x4 v[2][8]; bool ok[2]; int rw[2];
#pragma unroll
        for (int r = 0; r < 2; ++r) { ok[r] = row0 + r * nw < MTOK; rw[r] = ok[r] ? row0 + r * nw : row0;
            const f32x4* xr = (const f32x4*)(x + (size_t)rw[r] * DM);
#pragma unroll
            for (int i = 0; i < 4; ++i) { v[r][2 * i] = __builtin_nontemporal_load(xr + i * 128 + lane * 2); v[r][2 * i + 1] = __builtin_nontemporal_load(xr + i * 128 + lane * 2 + 1); } }
#pragma unroll
        for (int r = 0; r < 2; ++r) {
            float ss = 0.f;
#pragma unroll
            for (int i = 0; i < 8; ++i) ss += v[r][i][0] * v[r][i][0] + v[r][i][1] * v[r][i][1] + v[r][i][2] * v[r][i][2] + v[r][i][3] * v[r][i][3];
            ss = wsum(ss);
            if (ok[r]) {
                if (lane == 0) ssq[rw[r]] = ss;
#pragma unroll
                for (int i = 0; i < 4; ++i) { u32x4 w; w.x = pk2(v[r][2 * i][0], v[r][2 * i][1]); w.y = pk2(v[r][2 * i][2], v[r][2 * i][3]); w.z = pk2(v[r][2 * i + 1][0], v[r][2 * i + 1][1]); w.w = pk2(v[r][2 * i + 1][2], v[r][2 * i + 1][3]);
                    *(u32x4*)(out + (size_t)rw[r] * DM + i * 512 + lane * 8) = w; }
            }
        }
    }
}

DI void phase_rmsnorm(const float* x, const float* g, bf16_t* out) {
    const int tid = otid(), lane = tid & 63, gw = blockIdx.x * 8 + (tid >> 6), nw = gridDim.x * 8;
    for (int row = gw; row < MTOK; row += nw) {
        const f32x4* xr = (const f32x4*)(x + (size_t)row * DM); f32x4 v[8]; float ss = 0.f;
#pragma unroll
        for (int i = 0; i < 4; ++i) { v[2 * i] = xr[i * 128 + lane * 2]; v[2 * i + 1] = xr[i * 128 + lane * 2 + 1]; }
#pragma unroll
        for (int i = 0; i < 8; ++i) ss += v[i][0] * v[i][0] + v[i][1] * v[i][1] + v[i][2] * v[i][2] + v[i][3] * v[i][3];
        ss = wsum(ss); const float sc = rsqrtf(ss * (1.f / DM) + EPS);
#pragma unroll
        for (int i = 0; i < 4; ++i) { const int c = i * 512 + lane * 8; const f32x4 g0 = *(const f32x4*)(g + c), g1 = *(const f32x4*)(g + c + 4);
            u32x4 w; w.x = pk2(v[2 * i][0] * sc * g0[0], v[2 * i][1] * sc * g0[1]); w.y = pk2(v[2 * i][2] * sc * g0[2], v[2 * i][3] * sc * g0[3]);
            w.z = pk2(v[2 * i + 1][0] * sc * g1[0], v[2 * i + 1][1] * sc * g1[1]); w.w = pk2(v[2 * i + 1][2] * sc * g1[2], v[2 * i + 1][3] * sc * g1[3]);
            *(u32x4*)(out + (size_t)row * DM + c) = w; }
    }
}

DI void phase_qknorm_a(const Params& p) {
    bf16_t* big = (bf16_t*)(p.ws + ACT); const float* qkg = p.in[4];
    const int tid = otid(), lane = tid & 63, gw = blockIdx.x * 8 + (tid >> 6), nw = gridDim.x * 8;
    float gq[8], gk[8];
#pragma unroll
    for (int e = 0; e < 8; ++e) { gq[e] = qkg[(lane & 7) * 8 + e] * (0.125f * LOG2E); gk[e] = qkg[64 + (lane & 7) * 8 + e]; }
    for (int row = gw; row < MTOK; row += nw) {
#pragma unroll
        for (int i = 0; i < 8; ++i) {
            bf16_t* ptr = big + (size_t)row * 8192 + i * 512 + lane * 8; float f[8]; unpack8(*(const u32x4*)ptr, f);
            float ss = 0.f;
#pragma unroll
            for (int e = 0; e < 8; ++e) ss += f[e] * f[e];
            ss += __shfl_xor(ss, 1); ss += __shfl_xor(ss, 2); ss += __shfl_xor(ss, 4);
            const float sc = rsqrtf(ss * (1.f / 64.f) + EPS);
#pragma unroll
            for (int e = 0; e < 8; ++e) f[e] = f[e] * sc * (i < 4 ? gq[e] : gk[e]);
            *(u32x4*)ptr = pack8(f);
        }
    }
}

template <int DQK, int KA8, int DV, bool BIAS, bool JOINT>
DI void attn_core(LAS unsigned char* lds, const bf16_t* Qrow, const bf16_t* KpA, int ldkA, const bf16_t* KpB, int ldkB, const bf16_t* Vp, int ldv,
                  int qb, int wid, int lane, const float* qng  , f32x16 (&O)[DV / 32]) {
    constexpr int KROW = DQK * 2 + 16, VROW = DV * 2 + 64  , KC = DQK / 8, VC = DV / 8, NKC = 64 * KC, NVC = 64 * VC, NL = (NKC + NVC) / 512, STG = 64 * (KROW + VROW);
    static_assert(NKC % 512 == 0 && NVC % 512 == 0, "loader split");
    const int tid = otid(), l32 = lane & 31, hh = lane >> 5, i16 = lane & 15, tq = i16 >> 2, tp = i16 & 3, blk = (lane >> 4) & 1;
    const int q0w = qb * 256 + wid * 32, nkt = 4 * qb + 4, myc = q0w >> 6;
    bf16x8 qf[DQK / 16];
#pragma unroll
    for (int s = 0; s < DQK / 16; ++s) qf[s] = *(const bf16x8*)(Qrow + 16 * s + 8 * hh);
    if constexpr (DQK == 192) {
        if (qng) {
            float ssn = 0.f, ssr = 0.f;
#pragma unroll
            for (int s = 0; s < 12; ++s) { float f[8]; unpack8(__builtin_bit_cast(u32x4, qf[s]), f); float t = 0.f;
#pragma unroll
                for (int e = 0; e < 8; ++e) t += f[e] * f[e];
                if (s < 8) ssn += t; else ssr += t; }
            ssn += __shfl_xor(ssn, 32); ssr += __shfl_xor(ssr, 32);
            const float qs = 0.07216878364870322f * LOG2E, scn = rsqrtf(ssn * (1.f / 128.f) + EPS) * qs, scr = rsqrtf(ssr * (1.f / 64.f) + EPS) * qs;
#pragma unroll
            for (int s = 0; s < 8; ++s) { float f[8]; unpack8(__builtin_bit_cast(u32x4, qf[s]), f);
                const f32x4 g0 = *(const f32x4*)(qng + 16 * s + 8 * hh), g1 = *(const f32x4*)(qng + 16 * s + 8 * hh + 4);
#pragma unroll
                for (int e = 0; e < 4; ++e) { f[e] *= scn * g0[e]; f[4 + e] *= scn * g1[e]; }
                qf[s] = __builtin_bit_cast(bf16x8, pack8(f)); }
            const float posr = (float)(qb * 256 + wid * 32 + l32) * 0.15915494309189535f;
#pragma unroll
            for (int s = 8; s < 10; ++s) { float f1[8], f2[8]; unpack8(__builtin_bit_cast(u32x4, qf[s]), f1); unpack8(__builtin_bit_cast(u32x4, qf[s + 2]), f2);
#pragma unroll
                for (int e = 0; e < 8; ++e) { const int i = 16 * (s - 8) + 8 * hh + e;
                    const float a1 = f1[e] * scr * qng[128 + i], a2 = f2[e] * scr * qng[160 + i];
                    float rev = posr * __builtin_amdgcn_exp2f(-(float)i * 0.41524101186092029f); rev -= floorf(rev);
                    const float sn = __builtin_amdgcn_sinf(rev), cs = __builtin_amdgcn_cosf(rev);
                    f1[e] = a1 * cs - a2 * sn; f2[e] = a2 * cs + a1 * sn; }
                qf[s] = __builtin_bit_cast(bf16x8, pack8(f1)); qf[s + 2] = __builtin_bit_cast(bf16x8, pack8(f2)); }
            __builtin_amdgcn_sched_barrier(0);
        }
    }
    float m = 0.f, l = 0.f; bool mnz = false;
#pragma unroll
    for (int dt = 0; dt < DV / 32; ++dt)
#pragma unroll
        for (int i = 0; i < 16; ++i) O[dt][i] = 0.f;
    u32x4 stg[NL];
    LAS const float* btab = (LAS const float*)(lds + 2 * STG);
    const unsigned koff = l32 * KROW + 16 * hh, vtr = (4 * hh + tq) * VROW + (16 * blk + 4 * tp) * 2;

    auto gload = [&](int kt) {
#pragma unroll
        for (int i = 0; i < NL; ++i) { const int c = tid + i * 512;
            if (i * 512 < NKC) { const int row = c / KC, cc = c % KC;
                const bf16_t* src = (cc < KA8) ? KpA + (size_t)(kt * 64 + row) * ldkA + cc * 8 : KpB + (size_t)(kt * 64 + row) * ldkB + (cc - KA8) * 8;
                stg[i] = *(const u32x4*)src; }
            else { const int c2 = c - NKC, row = c2 / VC, cc = c2 % VC; stg[i] = *(const u32x4*)(Vp + (size_t)(kt * 64 + row) * ldv + cc * 8); } }
    };
    auto lstore = [&](int buf) {
#pragma unroll
        for (int i = 0; i < NL; ++i) { const int c = tid + i * 512;
            if (i * 512 < NKC) { const int row = c / KC, cc = c % KC; *(LAS u32x4*)(lds + buf * STG + row * KROW + cc * 16) = stg[i]; }
            else { const int c2 = c - NKC, row = c2 / VC, cc = c2 % VC; *(LAS u32x4*)(lds + buf * STG + 64 * KROW + row * VROW + cc * 16) = stg[i]; } }
    };

    gload(0); lstore(0); __syncthreads();
    for (int kt = 0; kt < nkt; ++kt) {
        if (kt + 1 < nkt) gload(kt + 1);
        if (JOINT && kt <= myc) {
            LAS unsigned char* kb = lds + (kt & 1) * STG; LAS unsigned char* vb = kb + 64 * KROW;
            const bool far = (kt * 64 + 63 - q0w <= -91);
            f32x16 S0, S1;
#pragma unroll
            for (int i = 0; i < 16; ++i) { S0[i] = 0.f; S1[i] = 0.f; }
#pragma unroll
            for (int s = 0; s < DQK / 16; ++s) {
                const bf16x8 k0 = *(LAS const bf16x8*)(kb + koff + 32 * s), k1 = *(LAS const bf16x8*)(kb + koff + 32 * KROW + 32 * s);
                S0 = mfma32(k0, qf[s], S0); S1 = mfma32(k1, qf[s], S1);
            }
            if (BIAS && !far) {
                const int rb = kt * 64 - (q0w + l32) + 128;
#pragma unroll
                for (int i = 0; i < 16; ++i) { const int i0 = rb + crow(i, hh); S0[i] += btab[i0 < 0 ? 0 : i0]; S1[i] += btab[i0 + 32 < 0 ? 0 : i0 + 32]; }
            }
            if (mnz) {
#pragma unroll
                for (int i = 0; i < 16; ++i) { S0[i] -= m; S1[i] -= m; }
            }
            float mx = fmaxf(S0[0], S1[0]);
#pragma unroll
            for (int i = 1; i < 16; ++i) mx = fmaxf(mx, fmaxf(S0[i], S1[i]));
            mx = fmaxf(mx, __shfl_xor(mx, 32));
            if (__any(mx > 64.f || (kt == 0 && mx < -64.f))) {
                const float dm = (mx > 64.f || (kt == 0 && mx < -64.f)) ? mx : 0.f, alpha = __builtin_amdgcn_exp2f(-dm); m += dm; mnz = true;
                l *= alpha;
#pragma unroll
                for (int dt = 0; dt < DV / 32; ++dt) O[dt] *= alpha;
#pragma unroll
                for (int i = 0; i < 16; ++i) { S0[i] -= dm; S1[i] -= dm; }
            }
            float ps = 0.f;
#pragma unroll
            for (int i = 0; i < 16; ++i) { S0[i] = __builtin_amdgcn_exp2f(S0[i]); S1[i] = __builtin_amdgcn_exp2f(S1[i]); ps += S0[i] + S1[i]; }
            l += ps;
#pragma unroll
            for (int half = 0; half < 2; ++half)
#pragma unroll
                for (int s = 0; s < 2; ++s) {
                    const f32x16& S = half ? S1 : S0;
                    u32x4 pw; pw.x = pk2(S[8 * s], S[8 * s + 1]); pw.y = pk2(S[8 * s + 2], S[8 * s + 3]); pw.z = pk2(S[8 * s + 4], S[8 * s + 5]); pw.w = pk2(S[8 * s + 6], S[8 * s + 7]);
                    const bf16x8 pf = __builtin_bit_cast(bf16x8, pw);
                    LAS unsigned char* vr = vb + vtr + (32 * half + 16 * s) * VROW;
#pragma unroll
                    for (int dt = 0; dt < DV / 32; ++dt) {
                        const bf16x8 vf = cat4(trread(vr + 64 * dt), trread(vr + 8 * VROW + 64 * dt));
                        O[dt] = mfma32(vf, pf, O[dt]);
                    }
                }
        }
        if (!JOINT && kt <= myc) {
            LAS unsigned char* kb = lds + (kt & 1) * STG; LAS unsigned char* vb = kb + 64 * KROW;
            const bool far = (kt * 64 + 63 - q0w <= -91);
#pragma unroll 1
            for (int half = 0; half < 2; ++half) {
                f32x16 S;
#pragma unroll
                for (int i = 0; i < 16; ++i) S[i] = 0.f;
#pragma unroll
                for (int s = 0; s < DQK / 16; ++s) {
                    const bf16x8 kf = *(LAS const bf16x8*)(kb + koff + 32 * half * KROW + 32 * s);
                    S = mfma32(kf, qf[s], S);
                }
                if (BIAS && !far) {
                    const int rb = kt * 64 + 32 * half - (q0w + l32) + 128;
#pragma unroll
                    for (int i = 0; i < 16; ++i) { const int i0 = rb + crow(i, hh); S[i] += btab[i0 < 0 ? 0 : i0]; }
                }
                if (mnz) {
#pragma unroll
                    for (int i = 0; i < 16; ++i) S[i] -= m;
                }
                float mx = S[0];
#pragma unroll
                for (int i = 1; i < 16; ++i) mx = fmaxf(mx, S[i]);
                mx = fmaxf(mx, __shfl_xor(mx, 32));
                const bool first = (kt == 0 && half == 0);
                if (__any(mx > 64.f || (first && mx < -64.f))) {
                    const float dm = (mx > 64.f || (first && mx < -64.f)) ? mx : 0.f, alpha = __builtin_amdgcn_exp2f(-dm); m += dm; mnz = true;
                    l *= alpha;
#pragma unroll
                    for (int dt = 0; dt < DV / 32; ++dt) O[dt] *= alpha;
#pragma unroll
                    for (int i = 0; i < 16; ++i) S[i] -= dm;
                }
                float ps = 0.f;
#pragma unroll
                for (int i = 0; i < 16; ++i) { S[i] = __builtin_amdgcn_exp2f(S[i]); ps += S[i]; }
                l += ps;
#pragma unroll
                for (int s = 0; s < 2; ++s) {
                    u32x4 pw; pw.x = pk2(S[8 * s], S[8 * s + 1]); pw.y = pk2(S[8 * s + 2], S[8 * s + 3]); pw.z = pk2(S[8 * s + 4], S[8 * s + 5]); pw.w = pk2(S[8 * s + 6], S[8 * s + 7]);
                    const bf16x8 pf = __builtin_bit_cast(bf16x8, pw);
                    LAS unsigned char* vr = vb + vtr + (32 * half + 16 * s) * VROW;
#pragma unroll
                    for (int dt = 0; dt < DV / 32; ++dt) {
                        const bf16x8 vf = cat4(trread(vr + 64 * dt), trread(vr + 8 * VROW + 64 * dt));
                        O[dt] = mfma32(vf, pf, O[dt]);
                    }
                }
            }
        }
        if (kt + 1 < nkt) lstore((kt + 1) & 1);
        __syncthreads();
    }
    l += __shfl_xor(l, 32);
    const float il = 1.f / l;
#pragma unroll
    for (int dt = 0; dt < DV / 32; ++dt) O[dt] *= il;
}

DI void phase_attn_a(const Params& p, LAS unsigned char* lds) {
    const bf16_t* big = (const bf16_t*)(p.ws + ACT); bf16_t* y = (bf16_t*)(p.ws + HBUF); const float* tbg = (const float*)(p.ws + X_BIAS);
    const int tid = otid(), wid = tid >> 6, lane = tid & 63, l32 = lane & 31, hh = lane >> 5;
    constexpr int STG = 64 * (64 * 2 + 16 + 128 * 2 + 64);
    float d0 = 0.f, d1 = 0.f;
    for (int i = 0; i < 64; ++i) { d0 += p.in[5][i] * p.in[5][64 + i]; d1 += p.in[5][128 + i] * p.in[5][192 + i]; }
    const float lam_init = 0.2f, lam = __expf(d0) - __expf(d1) + lam_init;
    for (int pr = blockIdx.x; pr < 512; pr += gridDim.x) {
        const int bi = pr & 255, bh = (gridDim.x == 256) ? (bi & 7) + 8 * (bi >> 6) + 32 * (pr >> 8) : pr >> 3, j = (gridDim.x == 256) ? (bi >> 3) & 7 : pr & 7, b = bh >> 4, h = bh & 15;
        for (int half = 0; half < 2; ++half) {
            const int qb = half ? 15 - j : j;
            __syncthreads();
            if (tid < 192) ((LAS float*)(lds + 2 * STG))[tid] = tbg[h * 192 + tid];
            const size_t tok0 = (size_t)b * SEQ, tokq = tok0 + qb * 256 + wid * 32 + l32;
            f32x16 Oa[4]; LAS unsigned* Op = (LAS unsigned*)(lds + 2 * STG + 1024) + wid * 2048 + lane;
            attn_core<64, 8, 128, true, true>(lds, big + tokq * 8192 + h * 128, big + tok0 * 8192 + 2048 + h * 128, 8192, nullptr, 0, big + tok0 * 8192 + 4096 + h * 128, 8192, qb, wid, lane, nullptr, Oa);
#pragma unroll
            for (int dt = 0; dt < 4; ++dt)
#pragma unroll
                for (int i = 0; i < 8; ++i) Op[(dt * 8 + i) * 64] = pk2(Oa[dt][2 * i], Oa[dt][2 * i + 1]);
            attn_core<64, 8, 128, true, true>(lds, big + tokq * 8192 + h * 128 + 64, big + tok0 * 8192 + 2048 + h * 128 + 64, 8192, nullptr, 0, big + tok0 * 8192 + 4096 + h * 128, 8192, qb, wid, lane, nullptr, Oa);
            float ss = 0.f;
#pragma unroll
            for (int dt = 0; dt < 4; ++dt)
#pragma unroll
                for (int i = 0; i < 16; ++i) { const unsigned ow = Op[(dt * 8 + (i >> 1)) * 64]; const float o0 = (i & 1) ? __uint_as_float(ow & 0xffff0000u) : __uint_as_float(ow << 16);
                    const float o = o0 - lam * Oa[dt][i]; Oa[dt][i] = o; ss += o * o; }
            ss += __shfl_xor(ss, 32);
            const float sc = rsqrtf(ss * (1.f / 128.f) + EPS) * (1.f - lam_init);
#pragma unroll
            for (int dt = 0; dt < 4; ++dt)
#pragma unroll
                for (int g4 = 0; g4 < 4; ++g4) { const int dv = 32 * dt + 8 * g4 + 4 * hh;
                    const u32x2 gw = *(const u32x2*)(big + tokq * 8192 + 6144 + h * 128 + dv);
                    const f32x4 sg = *(const f32x4*)(p.in[6] + dv);
                    const float g0 = __uint_as_float(gw.x << 16), g1 = __uint_as_float(gw.x & 0xffff0000u), g2 = __uint_as_float(gw.y << 16), g3 = __uint_as_float(gw.y & 0xffff0000u);
                    u32x2 w; w.x = pk2(Oa[dt][4 * g4] * sc * sg[0] * silu(g0), Oa[dt][4 * g4 + 1] * sc * sg[1] * silu(g1));
                    w.y = pk2(Oa[dt][4 * g4 + 2] * sc * sg[2] * silu(g2), Oa[dt][4 * g4 + 3] * sc * sg[3] * silu(g3));
                    *(u32x2*)(y + tokq * DM + h * 128 + dv) = w; }
        }
    }
}

DI void phase_attn_d(const Params& p, LAS unsigned char* lds) {
    const bf16_t* qkv = (const bf16_t*)(p.ws + ACT); const bf16_t* lat = (const bf16_t*)(p.ws + LAT); const bf16_t* gb = (const bf16_t*)(p.ws + HBUF);
    bf16_t* y = (bf16_t*)(p.ws + HBUF);
    for (int pr = blockIdx.x; pr < 512; pr += gridDim.x) {
        const int bi = pr & 255, bh = (gridDim.x == 256) ? (bi & 7) + 8 * (bi >> 6) + 32 * (pr >> 8) : pr >> 3, j = (gridDim.x == 256) ? (bi >> 3) & 7 : pr & 7, b = bh >> 4, h = bh & 15;
        for (int half = 0; half < 2; ++half) {
            const int qb = half ? 15 - j : j;
            __syncthreads();
            const int tid = otid(), wid = tid >> 6, lane = tid & 63, l32 = lane & 31;
            const size_t tok0 = (size_t)b * SEQ, tokq = tok0 + qb * 256 + wid * 32 + l32;
            f32x16 O[4];
            attn_core<192, 16, 128, false, true>(lds, qkv + tokq * 7168 + h * 192, qkv + tok0 * 7168 + 3072 + h * 256, 7168, lat + tok0 * 1088 + 1024, 1088,
                                           qkv + tok0 * 7168 + 3072 + h * 256 + 128, 7168, qb, wid, lane, p.in[27], O);
            const int tid2 = otid(), wid2 = tid2 >> 6, lane2 = tid2 & 63;
            const size_t tokq2 = (size_t)b * SEQ + qb * 256 + wid2 * 32 + (lane2 & 31); const int hh2 = lane2 >> 5;
#pragma unroll
            for (int dt = 0; dt < 4; ++dt)
#pragma unroll
                for (int g4 = 0; g4 < 4; ++g4) { const int dv = 32 * dt + 8 * g4 + 4 * hh2;
                    const u32x2 gw = *(const u32x2*)(gb + tokq2 * DM + h * 128 + dv);
                    const float g0 = __uint_as_float(gw.x << 16), g1 = __uint_as_float(gw.x & 0xffff0000u), g2 = __uint_as_float(gw.y << 16), g3 = __uint_as_float(gw.y & 0xffff0000u);
                    u32x2 w; w.x = pk2(O[dt][4 * g4] * silu(g0), O[dt][4 * g4 + 1] * silu(g1)); w.y = pk2(O[dt][4 * g4 + 2] * silu(g2), O[dt][4 * g4 + 3] * silu(g3));
                    *(u32x2*)(y + tokq2 * DM + h * 128 + dv) = w; }
        }
    }
}

DI void phase_gla_prep(const Params& p, LAS unsigned char* lds) {
    bf16_t* big = (bf16_t*)(p.ws + ACT); float* total = (float*)(p.ws + GLA_TOT);
    LAS float* lrs = (LAS float*)lds;
    const int tid = otid(), ch0 = tid * 2;
    float wg0[16], wg1[16];
#pragma unroll
    for (int r = 0; r < 16; ++r) { wg0[r] = p.in[9][r * 1024 + ch0]; wg1[r] = p.in[9][r * 1024 + ch0 + 1]; }
    const float bs0 = p.in[10][ch0], bs1 = p.in[10][ch0 + 1];
    for (int u = blockIdx.x; u < 256; u += gridDim.x) {
        const size_t tokb = (size_t)u * 64;
        __syncthreads();
        {
            LAS bf16_t* wl = (LAS bf16_t*)(lds + 8192);
            LAS float* part = (LAS float*)(lds + 4096);
            const bf16_t* wsrc = (const bf16_t*)(p.ws + W_B_IN) + (size_t)6144 * 2048;
#pragma unroll
            for (int i = 0; i < 8; ++i) { const int c = tid + i * 512; *(LAS u32x4*)(wl + (c >> 8) * 2056 + (c & 255) * 8) = *(const u32x4*)(wsrc + (size_t)c * 8); }
            __syncthreads();
            const int w = tid >> 6, lane = tid & 63, i16 = lane & 15, quad = lane >> 4, mt = w & 3, kh = w >> 2;
            const bf16_t* xr = (const bf16_t*)(p.ws + XG) + (tokb + 16 * mt + i16) * DM + kh * 1024 + 8 * quad;
            f32x4 acc = {0.f, 0.f, 0.f, 0.f};
#pragma unroll 8
            for (int ks = 0; ks < 32; ++ks) {
                const bf16x8 a = *(const bf16x8*)(xr + 32 * ks);
                const bf16x8 bb = *(LAS const bf16x8*)(wl + i16 * 2056 + kh * 1024 + 32 * ks + 8 * quad);
                acc = __builtin_amdgcn_mfma_f32_16x16x32_bf16(a, bb, acc, 0, 0, 0);
            }
            if (kh == 1) {
#pragma unroll
                for (int j = 0; j < 4; ++j) part[(16 * mt + 4 * quad + j) * 16 + i16] = acc[j]; }
            __syncthreads();
            if (kh == 0) {
#pragma unroll
                for (int j = 0; j < 4; ++j) { const int tok = 16 * mt + 4 * quad + j;
                    const float rs = rsqrtf(((const float*)(p.ws + X_SSQ))[tokb + tok] * (1.f / DM) + EPS);
                    lrs[tok * 16 + i16] = (acc[j] + part[tok * 16 + i16]) * rs; } }
        }
        __syncthreads();
        float t0 = 0.f, t1 = 0.f;
        for (int tok = 63; tok >= 0; --tok) {
            float z0 = bs0, z1 = bs1;
#pragma unroll
            for (int r = 0; r < 16; ++r) { const float lv = lrs[tok * 16 + r]; z0 += lv * wg0[r]; z1 += lv * wg1[r]; }
            unsigned* kp = (unsigned*)(big + (tokb + tok) * 6400 + 1024 + ch0); const unsigned w = *kp;
            *kp = pk2(__uint_as_float(w << 16) * __expf(t0), __uint_as_float(w & 0xffff0000u) * __expf(t1));
            t0 += (fminf(z0, 0.f) - __logf(1.f + __expf(-fabsf(z0)))) * (1.f / 16.f); t1 += (fminf(z1, 0.f) - __logf(1.f + __expf(-fabsf(z1)))) * (1.f / 16.f);
        }
        total[(size_t)u * 1024 + ch0] = t0; total[(size_t)u * 1024 + ch0 + 1] = t1;
    }
}

DI void phase_gla_scan(const Params& p, LAS unsigned char* lds) {
    const bf16_t* big = (const bf16_t*)(p.ws + ACT); const float* total = (const float*)(p.ws + GLA_TOT); bf16_t* ob = (bf16_t*)(p.ws + HBUF);
    constexpr int KR = 576, VR = 64, SR = 528, SET = 64 * KR + 64 * VR + 1024  , ST_OFF = 2 * SET, STB = 32 * SR;
    const int tid = otid(), w = tid >> 6, lane = tid & 63, l32 = lane & 31, hh = lane >> 5, i16 = lane & 15, tq = i16 >> 2, tp = i16 & 3, blk = (lane >> 4) & 1, quad = lane >> 4;
    const int mt = w >> 1, nt = w & 1;
    for (int u = blockIdx.x; u < 256; u += gridDim.x) {
        const int ux = (gridDim.x == 256) ? ((u & 7) * 2 + (u >> 7)) * 16 + ((u >> 3) & 15) : u;
        const int b = ux >> 6, h = (ux >> 4) & 3, vs = ux & 15;
        const size_t tok0 = (size_t)b * SEQ;
        f32x16 st;
#pragma unroll
        for (int i = 0; i < 16; ++i) st[i] = 0.f;
        u32x4 rkA[4], rvA, rkB[4], rvB; float rtA = 0.f, rtB = 0.f; bf16x8 qa[8], qn[8];
        rvA = (u32x4){0u, 0u, 0u, 0u}; rvB = rvA;
        unsigned offk[4];
#pragma unroll
        for (int i = 0; i < 4; ++i) { const int idx = tid + i * 512, row = idx >> 5, cc = idx & 31; offk[i] = (unsigned)((row * 6400 + 1024 + h * 256 + cc * 8) * 2); }
        const unsigned offv = (unsigned)(((tid >> 2) * 6400 + 2048 + h * 512 + vs * 32 + (tid & 3) * 8) * 2);
        const unsigned offq = (unsigned)(((16 * mt + i16) * 6400 + h * 256 + 8 * quad) * 2);
        auto gload = [&](int c, u32x4 (&rk)[4], u32x4& rv, float& rt) {
            const char* cb = (const char*)(big + (tok0 + (size_t)c * 64) * 6400);
#pragma unroll
            for (int i = 0; i < 4; ++i) rk[i] = *(const u32x4*)(cb + offk[i]);
            if (tid < 256) { rv = *(const u32x4*)(cb + offv); rt = total[(size_t)(b * 64 + c) * 1024 + h * 256 + tid]; }
        };
        auto lstore = [&](int buf, const u32x4 (&rk)[4], const u32x4& rv, const float& rt) {
            LAS unsigned char* sb = lds + buf * SET;
#pragma unroll
            for (int i = 0; i < 4; ++i) { const int idx = tid + i * 512, row = idx >> 5, cc = idx & 31; *(LAS u32x4*)(sb + row * KR + cc * 16) = rk[i]; }
            if (tid < 256) { const int row = tid >> 2, cc = tid & 3; *(LAS u32x4*)(sb + 64 * KR + row * VR + cc * 16) = rv; ((LAS float*)(sb + 64 * KR + 64 * VR))[tid] = __expf(rt); }
        };
        auto qload = [&](int c, bf16x8 (&q)[8]) {
            const char* cb = (const char*)(big + (tok0 + (size_t)c * 64) * 6400) + offq;
#pragma unroll
            for (int ks = 0; ks < 8; ++ks) q[ks] = *(const bf16x8*)(cb + 64 * ks);
        };
        auto step = [&](int c, const bf16x8 (&qc)[8]) {
            LAS unsigned char* sb = lds + (c & 1) * SET; LAS unsigned char* stb = lds + ST_OFF + (c & 1) * STB;
#pragma unroll
            for (int g = 0; g < 4; ++g) { const f32x4 e = *(LAS const f32x4*)(sb + 64 * KR + 64 * VR + (32 * w + 8 * g + 4 * hh) * 4);
                st[4 * g] *= e[0]; st[4 * g + 1] *= e[1]; st[4 * g + 2] *= e[2]; st[4 * g + 3] *= e[3]; }
#pragma unroll
            for (int sx = 0; sx < 4; ++sx) {
                LAS unsigned char* ka = sb + (16 * sx + 8 * hh + tq) * KR + (32 * w + 16 * blk + 4 * tp) * 2;
                LAS unsigned char* va = sb + 64 * KR + (16 * sx + 8 * hh + tq) * VR + (16 * blk + 4 * tp) * 2;
                const bf16x8 af = cat4(trread(ka), trread(ka + 4 * KR)), bfv = cat4(trread(va), trread(va + 4 * VR));
                st = mfma32(af, bfv, st);
            }
#pragma unroll
            for (int g = 0; g < 4; ++g) { u32x2 wv; wv.x = pk2(st[4 * g], st[4 * g + 1]); wv.y = pk2(st[4 * g + 2], st[4 * g + 3]);
                *(LAS u32x2*)(stb + l32 * SR + (32 * w + 8 * g + 4 * hh) * 2) = wv; }
            asm volatile("s_waitcnt lgkmcnt(0)" ::: "memory");
            __builtin_amdgcn_s_barrier();
            asm volatile("" ::: "memory");
            f32x4 acc = {0.f, 0.f, 0.f, 0.f};
#pragma unroll
            for (int ks = 0; ks < 8; ++ks) {
                const bf16x8 bb = *(LAS const bf16x8*)(stb + (16 * nt + i16) * SR + (32 * ks + 8 * quad) * 2);
                acc = __builtin_amdgcn_mfma_f32_16x16x32_bf16(qc[ks], bb, acc, 0, 0, 0);
            }
#pragma unroll
            for (int jj = 0; jj < 4; ++jj) ob[(tok0 + c * 64 + 16 * mt + quad * 4 + jj) * DM + h * 512 + vs * 32 + 16 * nt + i16] = f2bf(acc[jj] * (1.f / 16.f));
        };
        __syncthreads();
        gload(0, rkA, rvA, rtA); lstore(0, rkA, rvA, rtA);
        gload(1, rkA, rvA, rtA); gload(2, rkB, rvB, rtB); qload(0, qa); qload(1, qn);
        __syncthreads();
        for (int c = 0; c < 64; c += 2) {
            lstore((c + 1) & 1, rkA, rvA, rtA);
            if (c + 3 < 64) gload(c + 3, rkA, rvA, rtA);
            step(c, qa);
            if (c + 2 < 64) qload(c + 2, qa);
            if (c + 2 < 64) lstore(c & 1, rkB, rvB, rtB);
            if (c + 4 < 64) gload(c + 4, rkB, rvB, rtB);
            step(c + 1, qn);
            if (c + 3 < 64) qload(c + 3, qn);
        }
    }
}

DI void phase_gla_post(const Params& p) {
    const bf16_t* big = (const bf16_t*)(p.ws + ACT); bf16_t* y = (bf16_t*)(p.ws + HBUF);
    const int tid = otid(), lane = tid & 63, gw = blockIdx.x * 8 + (tid >> 6), nw = gridDim.x * 8;
    float og[8];
#pragma unroll
    for (int e = 0; e < 8; ++e) og[e] = p.in[11][lane * 8 + e];
    for (int row = gw; row < MTOK; row += 2 * nw) {
        u32x4 wo[2][4], wg[2][4]; bool ok[2]; size_t rr[2];
#pragma unroll
        for (int r = 0; r < 2; ++r) { ok[r] = row + r * nw < MTOK; rr[r] = ok[r] ? (size_t)(row + r * nw) : (size_t)row;
#pragma unroll
            for (int hd = 0; hd < 4; ++hd) { wo[r][hd] = *(const u32x4*)(y + rr[r] * DM + hd * 512 + lane * 8); wg[r][hd] = *(const u32x4*)(big + rr[r] * 6400 + 4096 + hd * 512 + lane * 8); } }
#pragma unroll
        for (int r = 0; r < 2; ++r)
#pragma unroll
            for (int hd = 0; hd < 4; ++hd) {
                float f[8], g[8]; unpack8(wo[r][hd], f); unpack8(wg[r][hd], g);
                float ss = 0.f;
#pragma unroll
                for (int e = 0; e < 8; ++e) ss += f[e] * f[e];
                ss = wsum(ss); const float sc = rsqrtf(ss * (1.f / 512.f) + EPS);
#pragma unroll
                for (int e = 0; e < 8; ++e) f[e] = f[e] * sc * og[e] * silu(g[e]);
                if (ok[r]) *(u32x4*)(y + rr[r] * DM + hd * 512 + lane * 8) = pack8(f);
            }
    }
}

DI void phase_conv(const Params& p) {
    const bf16_t* big = (const bf16_t*)(p.ws + ACT); bf16_t* xc = (bf16_t*)(p.ws + HBUF);
    for (size_t idx = (size_t)blockIdx.x * 512 + otid(); idx < (size_t)(MTOK / 8) * 256; idx += (size_t)gridDim.x * 512) {
        const int tok0 = (int)(idx >> 8) * 8, ch = (int)(idx & 255) * 8, t0 = tok0 & (SEQ - 1);
        float wv[4][8], bs[8];
        { const f32x4 b0 = *(const f32x4*)(p.in[15] + ch), b1 = *(const f32x4*)(p.in[15] + ch + 4);
#pragma unroll
          for (int e = 0; e < 4; ++e) { bs[e] = b0[e]; bs[4 + e] = b1[e]; } }
#pragma unroll
        for (int jx = 0; jx < 4; ++jx) { const f32x4 w0 = *(const f32x4*)(p.in[14] + jx * 2048 + ch), w1 = *(const f32x4*)(p.in[14] + jx * 2048 + ch + 4);
#pragma unroll
            for (int e = 0; e < 4; ++e) { wv[jx][e] = w0[e]; wv[jx][4 + e] = w1[e]; } }
        u32x4 raw[11];
#pragma unroll
        for (int r = 0; r < 11; ++r) raw[r] = (r >= 3 || t0 > 0) ? *(const u32x4*)(big + (size_t)(tok0 - 3 + r) * 4096 + ch) : (u32x4){0u, 0u, 0u, 0u};
#pragma unroll
        for (int o = 0; o < 8; ++o) {
            float acc[8];
#pragma unroll
            for (int e = 0; e < 8; ++e) acc[e] = bs[e];
#pragma unroll
            for (int jx = 0; jx < 4; ++jx) { float f[8]; unpack8(raw[o + jx], f);
#pragma unroll
                for (int e = 0; e < 8; ++e) acc[e] += f[e] * wv[jx][e]; }
            *(u32x4*)(xc + (size_t)(tok0 + o) * DM + ch) = pack8(acc);
        }
    }
}
DI void phase_lru_scan(const Params& p, LAS unsigned char* lds) {
    const unsigned* ax = (const unsigned*)(p.ws + ACT + 128 * MiB); const bf16_t* big = (const bf16_t*)(p.ws + ACT);
    bf16_t* y = (bf16_t*)(p.ws + HBUF);
    LAS unsigned* tile = (LAS unsigned*)lds;
    LAS float* sP = (LAS float*)(lds + 65536); LAS float* sH = sP + 512; LAS float* sC = sH + 512;
    const int tid = otid(), seg = tid >> 5, chl = tid & 31;
    for (int u = blockIdx.x; u < 256; u += gridDim.x) {
        const int b = u >> 6, ch = (u & 63) * 32 + chl;
        const size_t rowbase = (size_t)b * SEQ;
        unsigned pre[32];
#pragma unroll
        for (int i = 0; i < 32; ++i) pre[i] = ax[(rowbase + seg + 16 * i) * DM + ch];
        __syncthreads();
        if (tid < 32) sC[tid] = 0.f;
        for (int sc = 0; sc < 8; ++sc) {
#pragma unroll
            for (int i = 0; i < 32; ++i) tile[(seg + 16 * i) * 32 + chl] = pre[i];
            __syncthreads();
            if (sc + 1 < 8) {
#pragma unroll
                for (int i = 0; i < 32; ++i) pre[i] = ax[(rowbase + (sc + 1) * 512 + seg + 16 * i) * DM + ch];
            }
            float L = 0.f, H = 0.f;
#pragma unroll 8
            for (int t = 0; t < 32; ++t) { const unsigned w = tile[(seg * 32 + t) * 32 + chl]; const float la = __uint_as_float(w << 16); H = __expf(la) * H + __uint_as_float(w & 0xffff0000u); L += la; }
            sP[tid] = __expf(L); sH[tid] = H;
            __syncthreads();
            float hc = sC[chl];
            for (int sg = 0; sg < seg; ++sg) hc = sP[sg * 32 + chl] * hc + sH[sg * 32 + chl];
            const size_t r0 = rowbase + sc * 512 + seg * 32;
#pragma unroll 8
            for (int t = 0; t < 32; ++t) { const unsigned w = tile[(seg * 32 + t) * 32 + chl]; hc = __expf(__uint_as_float(w << 16)) * hc + __uint_as_float(w & 0xffff0000u);
                y[(r0 + t) * DM + ch] = f2bf(hc * silu(bf2f(big[(r0 + t) * 4096 + 2048 + ch]))); }
            __syncthreads();
            if (seg == 15) sC[chl] = hc;
        }
    }
}

DI void phase_mla_lat(const Params& p) {
    bf16_t* lat = (bf16_t*)(p.ws + LAT);
    const int tid = otid(), lane = tid & 63, gw = blockIdx.x * 8 + (tid >> 6), nw = gridDim.x * 8;
    float gq[8], gk[8];
#pragma unroll
    for (int e = 0; e < 8; ++e) { gq[e] = p.in[23][lane * 8 + e]; gk[e] = p.in[24][lane * 8 + e]; }
    const float inv = powf(10000.f, -(float)(lane & 31) * (1.f / 32.f));
    const float g1 = p.in[27][192 + 128 + (lane & 31)], g2 = p.in[27][192 + 160 + (lane & 31)];
    for (int row = gw; row < MTOK; row += nw) {
#pragma unroll
        for (int part = 0; part < 2; ++part) {
            bf16_t* ptr = lat + (size_t)row * 1088 + part * 512 + lane * 8; float f[8]; unpack8(*(const u32x4*)ptr, f);
            float ss = 0.f;
#pragma unroll
            for (int e = 0; e < 8; ++e) ss += f[e] * f[e];
            ss = wsum(ss); const float sc = rsqrtf(ss * (1.f / 512.f) + EPS);
#pragma unroll
            for (int e = 0; e < 8; ++e) f[e] = f[e] * sc * (part ? gk[e] : gq[e]);
            *(u32x4*)ptr = pack8(f);
        }
        { bf16_t* kp = lat + (size_t)row * 1088 + 1024; const int i = lane & 31;
          const float x1 = bf2f(kp[i]), x2 = bf2f(kp[i + 32]);
          float ss = (lane < 32) ? x1 * x1 + x2 * x2 : 0.f; ss = wsum(ss); const float sc = rsqrtf(ss * (1.f / 64.f) + EPS);
          const float a1 = x1 * sc * g1, a2 = x2 * sc * g2; float sn, cs; sincosf((float)(row & (SEQ - 1)) * inv, &sn, &cs);
          if (lane < 32) { kp[i] = f2bf(a1 * cs - a2 * sn); kp[i + 32] = f2bf(a2 * cs + a1 * sn); } }
    }
}
DI void phase_mla_qk(const Params& p) {
    bf16_t* qkv = (bf16_t*)(p.ws + ACT); bf16_t* lat = (bf16_t*)(p.ws + LAT); const float* qkg = p.in[27];
    const int tid = otid(), lane = tid & 63, gw = blockIdx.x * 8 + (tid >> 6), nw = gridDim.x * 8;
    const int l16 = lane & 15, l8 = lane & 7;
    float gk[8], gkr[8];
#pragma unroll
    for (int e = 0; e < 8; ++e) { gk[e] = qkg[192 + l16 * 8 + e]; gkr[e] = qkg[192 + 128 + l8 * 8 + e]; }
    float inv[8];
#pragma unroll
    for (int e = 0; e < 8; ++e) inv[e] = powf(10000.f, -(float)((l8 & 3) * 8 + e) * (1.f / 32.f));
    for (int row0 = gw; row0 < MTOK; row0 += 2 * nw) {
        u32x4 wk[2][4], wp[2]; bool ok[2]; int rw[2];
#pragma unroll
        for (int r = 0; r < 2; ++r) { ok[r] = row0 + r * nw < MTOK; rw[r] = ok[r] ? row0 + r * nw : row0;
            const bf16_t* qr = qkv + (size_t)rw[r] * 7168;
#pragma unroll
            for (int i = 0; i < 4; ++i) { const int head = 4 * i + (lane >> 4); wk[r][i] = *(const u32x4*)(qr + 3072 + head * 256 + l16 * 8); }
            wp[r] = *(const u32x4*)(lat + (size_t)rw[r] * 1088 + 1024 + l8 * 8); }
#pragma unroll
        for (int r = 0; r < 2; ++r) {
            bf16_t* qr = qkv + (size_t)rw[r] * 7168; bf16_t* kpp = lat + (size_t)rw[r] * 1088 + 1024 + l8 * 8;
            const float pos = (float)(rw[r] & (SEQ - 1));
#pragma unroll
            for (int i = 0; i < 4; ++i) {
                const int head = 4 * i + (lane >> 4);
                float f[8]; unpack8(wk[r][i], f); float ss = 0.f;
#pragma unroll
                for (int e = 0; e < 8; ++e) ss += f[e] * f[e];
                ss += __shfl_xor(ss, 1); ss += __shfl_xor(ss, 2); ss += __shfl_xor(ss, 4); ss += __shfl_xor(ss, 8);
                const float sc = rsqrtf(ss * (1.f / 128.f) + EPS);
#pragma unroll
                for (int e = 0; e < 8; ++e) f[e] *= sc * gk[e];
                if (ok[r]) *(u32x4*)(qr + 3072 + head * 256 + l16 * 8) = pack8(f);
            }
            { float f[8], o[8]; unpack8(wp[r], f); float ss = 0.f;
#pragma unroll
              for (int e = 0; e < 8; ++e) ss += f[e] * f[e];
              ss += __shfl_xor(ss, 1); ss += __shfl_xor(ss, 2); ss += __shfl_xor(ss, 4);
              const float sc = rsqrtf(ss * (1.f / 64.f) + EPS);
#pragma unroll
              for (int e = 0; e < 8; ++e) {
                  const float a = f[e] * sc * gkr[e], pa = __shfl_xor(a, 4);
                  float sn, cs; sincosf(pos * inv[e], &sn, &cs);
                  o[e] = (l8 < 4) ? a * cs - pa * sn : a * cs + pa * sn;
              }
              if (ok[r] && lane < 8) *(u32x4*)kpp = pack8(o); }
        }
    }
}

#define XB_TMO      128
#define XB_XCNT(j)  (256  + 64 * (j))
#define XB_XSUB(j)  (1280 + 64 * (j))
#define XB_XGEN(j)  (2304 + 64 * (j))
#define XB_TOP      3328
#define XB_TOPGEN   3392
#define XCD_BAR_WORDS 3456
#define XB_SPIN_CAP (1u << 22)
DI unsigned xb_ld(unsigned* p)              { return __hip_atomic_load(p, __ATOMIC_RELAXED, __HIP_MEMORY_SCOPE_AGENT); }
DI unsigned xb_add(unsigned* p, unsigned v) { return __hip_atomic_fetch_add(p, v, __ATOMIC_RELAXED, __HIP_MEMORY_SCOPE_AGENT); }
DI unsigned xb_xcc_id() { return (unsigned)__builtin_amdgcn_s_getreg((3 << 11) | 20) & 0xFu; }
#define XB_SPIN(cond, bar) do { unsigned _sp = 0; while (cond) { __builtin_amdgcn_s_sleep(1); \
    if ((++_sp & 255u) == 0u) { if (xb_ld(&(bar)[XB_TMO])) break; if (_sp > XB_SPIN_CAP) { atomicAdd(&(bar)[XB_TMO], 1u); break; } } } } while (0)
struct XcdBarrier { unsigned* bar; unsigned x; volatile LAS unsigned* st; };
DI XcdBarrier xcd_barrier_post(unsigned* bar, volatile LAS unsigned* st) {
    XcdBarrier b; b.bar = bar; b.x = xb_xcc_id(); b.st = st;
    if (threadIdx.x == 0) (void)xb_add(&bar[XB_XCNT(b.x)], 1u);
    return b;
}
DI void xcd_barrier_complete(unsigned* bar, unsigned x, unsigned& nloc, unsigned& nx) {
    const unsigned G = gridDim.x * gridDim.y * gridDim.z;
    unsigned sum, cnt, mine, sp = 0u;
    for (;;) {
        sum = 0u; cnt = 0u; mine = 0u;
#pragma unroll
        for (unsigned j = 0; j < 16; ++j) { const unsigned c = xb_ld(&bar[XB_XCNT(j)]); sum += c; cnt += (c > 0u) ? 1u : 0u; mine = (j == x) ? c : mine; }
        if (sum == G) break;
        __builtin_amdgcn_s_sleep(1);
        if ((++sp & 255u) == 0u) { if (xb_ld(&bar[XB_TMO])) break; if (sp > XB_SPIN_CAP) { atomicAdd(&bar[XB_TMO], 1u); break; } }
    }
    nloc = mine > 0u ? mine : 1u; nx = cnt > 0u ? cnt : 1u;
}
DI void xcd_barrier(const XcdBarrier& b0) {
    asm volatile("s_waitcnt vmcnt(0)" ::: "memory");
    __syncthreads();
    if (otid() == 0) {
        XcdBarrier b; b.bar = b0.bar; b.st = b0.st; b.x = xb_xcc_id();
        unsigned* bar = b.bar;
        __builtin_amdgcn_s_waitcnt(0);
        unsigned nloc = b.st[0], nx = b.st[1];
        if (nloc == 0u) { xcd_barrier_complete(bar, b.x, nloc, nx); b.st[0] = nloc; b.st[1] = nx; }
        const unsigned old = xb_add(&bar[XB_XSUB(b.x)], 1u);
        const unsigned gen = old / nloc;
        if (old + 1u == (gen + 1u) * nloc) {
            __builtin_amdgcn_fence(__ATOMIC_RELEASE, "agent");
            asm volatile("s_waitcnt vmcnt(0)" ::: "memory");
            const unsigned og = xb_add(&bar[XB_TOP], 1u);
            const unsigned tg = og / nx;
            if (og + 1u == (tg + 1u) * nx) xb_add(&bar[XB_TOPGEN], 1u);
            else XB_SPIN(xb_ld(&bar[XB_TOPGEN]) == tg, bar);
            __builtin_amdgcn_fence(__ATOMIC_ACQUIRE, "agent");
            xb_add(&bar[XB_XGEN(b.x)], 1u);
            asm volatile("s_waitcnt vmcnt(0)" ::: "memory");
        } else {
            XB_SPIN(xb_ld(&bar[XB_XGEN(b.x)]) == gen, bar);
            __builtin_amdgcn_fence(__ATOMIC_ACQUIRE, "agent");
            asm volatile("s_waitcnt vmcnt(0)" ::: "memory");
        }
    }
    __syncthreads();
}

__global__ __launch_bounds__(512, 2) void mega(const Params p) {
    extern __shared__ __attribute__((aligned(16))) unsigned char shm[];
    LAS unsigned char* lds = (LAS unsigned char*)shm;
    cg::grid_group grid = cg::this_grid();
    volatile LAS unsigned* bst = (volatile LAS unsigned*)(lds + 131072 + 1024);
    if (threadIdx.x == 0) { bst[0] = 0u; bst[1] = 0u; }
    __syncthreads();
    XcdBarrier xb = xcd_barrier_post((unsigned*)(p.ws + WS_BAR), bst); xb.x = 0;
    if constexpr ((PHMASK >> 0) & 1) { phase_convert(p, lds); }
    if constexpr ((REPMASK >> 0) & 1) { __syncthreads(); phase_convert(p, lds); }
    if constexpr ((PHMASK >> 1) & 1) { phase_bias_table(p); }
    if constexpr ((REPMASK >> 1) & 1) { __syncthreads(); phase_bias_table(p); }
    if constexpr ((PHMASK >> 2) & 1) { phase_x0(p.in[0], (bf16_t*)(uni(p.ws) + XG), (float*)(uni(p.ws) + X_SSQ) + 5 * MTOK); }
    if constexpr ((REPMASK >> 2) & 1) { __syncthreads(); phase_rmsnorm(p.in[0], p.in[1], (bf16_t*)(uni(p.ws) + HBUF)); }
    if (p.njobs < 0) grid.sync();
    xcd_barrier(xb);
    if constexpr ((PHMASK >> 3) & 1) { { pg8::EpiStoreA E{(bf16_t*)(uni(p.ws) + ACT), p.in[4], (const float*)(uni(p.ws) + X_SSQ) + 5 * MTOK}; run_gemm<0>(lds, (const bf16_t*)(uni(p.ws) + XG), (const bf16_t*)(uni(p.ws) + W_A_IN), 8192, 2048, 2048, E); } }
    if constexpr ((REPMASK >> 3) & 1) { __syncthreads(); { pg8::EpiStoreA E{(bf16_t*)(uni(p.ws) + ACT), p.in[4], (const float*)(uni(p.ws) + X_SSQ) + 5 * MTOK}; run_gemm<0>(lds, (const bf16_t*)(uni(p.ws) + XG), (const bf16_t*)(uni(p.ws) + W_A_IN), 8192, 2048, 2048, E); } }
    xcd_barrier(xb);
    if constexpr ((PHMASK >> 5) & 1) { phase_attn_a(p, lds); }
    if constexpr ((REPMASK >> 5) & 1) { __syncthreads(); phase_attn_a(p, lds); }
    xcd_barrier(xb);
    if constexpr ((PHMASK >> 6) & 1) { { pg8::EpiResid<true, false, true, true> E{nullptr, (const bf16_t*)(uni(p.ws) + XG), nullptr, (bf16_t*)(uni(p.ws) + XG), (float*)(uni(p.ws) + X_SSQ)}; run_gemm<0>(lds, (bf16_t*)(uni(p.ws) + HBUF), (const bf16_t*)(uni(p.ws) + W_A_OUT), 2048, 2048, 2048, E); } }
    if constexpr ((REPMASK >> 6) & 1) { __syncthreads(); { pg8::EpiResid<true, false, true, true> E{nullptr, (const bf16_t*)(uni(p.ws) + XG), nullptr, (bf16_t*)(uni(p.ws) + XG), (float*)(uni(p.ws) + X_SSQ)}; run_gemm<0>(lds, (bf16_t*)(uni(p.ws) + HBUF), (const bf16_t*)(uni(p.ws) + W_A_OUT), 2048, 2048, 2048, E); } }
    xcd_barrier(xb);
    if constexpr ((PHMASK >> 8) & 1) { { pg8::EpiStore E{(bf16_t*)(uni(p.ws) + ACT), 6400, (const float*)(uni(p.ws) + X_SSQ)}; run_gemm<0>(lds, (const bf16_t*)(uni(p.ws) + XG), (const bf16_t*)(uni(p.ws) + W_B_IN), 6144, 2048, 2048, E); } }
    if constexpr ((REPMASK >> 8) & 1) { __syncthreads(); { pg8::EpiStore E{(bf16_t*)(uni(p.ws) + ACT), 6400, (const float*)(uni(p.ws) + X_SSQ)}; run_gemm<0>(lds, (const bf16_t*)(uni(p.ws) + XG), (const bf16_t*)(uni(p.ws) + W_B_IN), 6144, 2048, 2048, E); } }
    xcd_barrier(xb);
    if constexpr ((PHMASK >> 9) & 1) { phase_gla_prep(p, lds); }
    if constexpr ((REPMASK >> 9) & 1) { __syncthreads(); phase_gla_prep(p, lds); }
    xcd_barrier(xb);
    if constexpr ((PHMASK >> 10) & 1) { phase_gla_scan(p, lds); }
    if constexpr ((REPMASK >> 10) & 1) { __syncthreads(); phase_gla_scan(p, lds); }
    xcd_barrier(xb);
    if constexpr ((PHMASK >> 11) & 1) { phase_gla_post(p); }
    if constexpr ((REPMASK >> 11) & 1) { __syncthreads(); phase_gla_post(p); }
    xcd_barrier(xb);
    if constexpr ((PHMASK >> 12) & 1) { { pg8::EpiResid<true, false, true, true> E{nullptr, (const bf16_t*)(uni(p.ws) + XG), nullptr, (bf16_t*)(uni(p.ws) + XG), (float*)(uni(p.ws) + X_SSQ) + MTOK}; run_gemm<0>(lds, (bf16_t*)(uni(p.ws) + HBUF), (const bf16_t*)(uni(p.ws) + W_B_OUT), 2048, 2048, 2048, E); } }
    if constexpr ((REPMASK >> 12) & 1) { __syncthreads(); { pg8::EpiResid<true, false, true, true> E{nullptr, (const bf16_t*)(uni(p.ws) + XG), nullptr, (bf16_t*)(uni(p.ws) + XG), (float*)(uni(p.ws) + X_SSQ) + MTOK}; run_gemm<0>(lds, (bf16_t*)(uni(p.ws) + HBUF), (const bf16_t*)(uni(p.ws) + W_B_OUT), 2048, 2048, 2048, E); } }
    xcd_barrier(xb);
    if constexpr ((PHMASK >> 14) & 1) { { pg8::EpiStore E{(bf16_t*)(uni(p.ws) + ACT), 4096, (const float*)(uni(p.ws) + X_SSQ) + MTOK}; run_gemm<0>(lds, (const bf16_t*)(uni(p.ws) + XG), (const bf16_t*)(uni(p.ws) + W_C_IN), 4096, 2048, 2048, E); } }
    if constexpr ((REPMASK >> 14) & 1) { __syncthreads(); { pg8::EpiStore E{(bf16_t*)(uni(p.ws) + ACT), 4096, (const float*)(uni(p.ws) + X_SSQ) + MTOK}; run_gemm<0>(lds, (const bf16_t*)(uni(p.ws) + XG), (const bf16_t*)(uni(p.ws) + W_C_IN), 4096, 2048, 2048, E); } }
    xcd_barrier(xb);
    if constexpr ((PHMASK >> 15) & 1) { phase_conv(p); }
    if constexpr ((REPMASK >> 15) & 1) { __syncthreads(); phase_conv(p); }
    xcd_barrier(xb);
    if constexpr ((PHMASK >> 16) & 1) { { pg8::EpiGates E{(bf16_t*)(uni(p.ws) + HBUF), p.in[17], p.in[19], (const float*)(uni(p.ws) + X_SP8), (unsigned*)(uni(p.ws) + ACT + 128 * MiB)}; run_gemm<2>(lds, (bf16_t*)(uni(p.ws) + HBUF), (const bf16_t*)(uni(p.ws) + W_C_GATE), 4096, 256, 2048, E); } }
    if constexpr ((REPMASK >> 16) & 1) { __syncthreads(); { pg8::EpiGates E{(bf16_t*)(uni(p.ws) + HBUF), p.in[17], p.in[19], (const float*)(uni(p.ws) + X_SP8), (unsigned*)(uni(p.ws) + ACT + 128 * MiB)}; run_gemm<2>(lds, (bf16_t*)(uni(p.ws) + HBUF), (const bf16_t*)(uni(p.ws) + W_C_GATE), 4096, 256, 2048, E); } }
    xcd_barrier(xb);
    if constexpr ((PHMASK >> 17) & 1) { phase_lru_scan(p, lds); }
    if constexpr ((REPMASK >> 17) & 1) { __syncthreads(); phase_lru_scan(p, lds); }
    xcd_barrier(xb);
    if constexpr ((PHMASK >> 18) & 1) { { pg8::EpiResid<true, false, true, true> E{nullptr, (const bf16_t*)(uni(p.ws) + XG), nullptr, (bf16_t*)(uni(p.ws) + XG), (float*)(uni(p.ws) + X_SSQ) + 2 * MTOK}; run_gemm<0>(lds, (bf16_t*)(uni(p.ws) + HBUF), (const bf16_t*)(uni(p.ws) + W_C_OUT), 2048, 2048, 2048, E); } }
    if constexpr ((REPMASK >> 18) & 1) { __syncthreads(); { pg8::EpiResid<true, false, true, true> E{nullptr, (const bf16_t*)(uni(p.ws) + XG), nullptr, (bf16_t*)(uni(p.ws) + XG), (float*)(uni(p.ws) + X_SSQ) + 2 * MTOK}; run_gemm<0>(lds, (bf16_t*)(uni(p.ws) + HBUF), (const bf16_t*)(uni(p.ws) + W_C_OUT), 2048, 2048, 2048, E); } }
    xcd_barrier(xb);
    if constexpr ((PHMASK >> 20) & 1) { { pg8::EpiStoreD E{(bf16_t*)(uni(p.ws) + LAT), (bf16_t*)(uni(p.ws) + HBUF), (const float*)(uni(p.ws) + X_SSQ) + 2 * MTOK, (float*)(uni(p.ws) + X_SSQ) + 3 * MTOK}; run_gemm<0>(lds, (const bf16_t*)(uni(p.ws) + XG), (const bf16_t*)(uni(p.ws) + W_D_IN), 3328, 2048, 2048, E); } }
    if constexpr ((REPMASK >> 20) & 1) { __syncthreads(); { pg8::EpiStoreD E{(bf16_t*)(uni(p.ws) + LAT), (bf16_t*)(uni(p.ws) + HBUF), (const float*)(uni(p.ws) + X_SSQ) + 2 * MTOK, (float*)(uni(p.ws) + X_SSQ) + 3 * MTOK}; run_gemm<0>(lds, (const bf16_t*)(uni(p.ws) + XG), (const bf16_t*)(uni(p.ws) + W_D_IN), 3328, 2048, 2048, E); } }
    xcd_barrier(xb);
    if constexpr ((PHMASK >> 22) & 1) { { pg8::EpiStoreU E{(bf16_t*)(uni(p.ws) + ACT), (const float*)(uni(p.ws) + X_SSQ) + 3 * MTOK}; run_gemm<1>(lds, (const bf16_t*)(uni(p.ws) + LAT), (const bf16_t*)(uni(p.ws) + W_D_UQKV), 7168, 512, 1088, E); } }
    if constexpr ((REPMASK >> 22) & 1) { __syncthreads(); { pg8::EpiStoreU E{(bf16_t*)(uni(p.ws) + ACT), (const float*)(uni(p.ws) + X_SSQ) + 3 * MTOK}; run_gemm<1>(lds, (const bf16_t*)(uni(p.ws) + LAT), (const bf16_t*)(uni(p.ws) + W_D_UQKV), 7168, 512, 1088, E); } }
    xcd_barrier(xb);
    if constexpr ((PHMASK >> 23) & 1) { phase_mla_qk(p); }
    if constexpr ((REPMASK >> 23) & 1) { __syncthreads(); phase_mla_qk(p); }
    xcd_barrier(xb);
    if constexpr ((PHMASK >> 24) & 1) { phase_attn_d(p, lds); }
    if constexpr ((REPMASK >> 24) & 1) { __syncthreads(); phase_attn_d(p, lds); }
    xcd_barrier(xb);
    if constexpr ((PHMASK >> 25) & 1) { { pg8::EpiResid<true, true, false, false> E{nullptr, (const bf16_t*)(uni(p.ws) + XG), uni(p.out), nullptr, nullptr}; run_gemm<0>(lds, (bf16_t*)(uni(p.ws) + HBUF), (const bf16_t*)(uni(p.ws) + W_D_OUT), 2048, 2048, 2048, E); } }
    if constexpr ((REPMASK >> 25) & 1) { __syncthreads(); { pg8::EpiResid<true, true, false, false> E{nullptr, (const bf16_t*)(uni(p.ws) + XG), uni(p.out), nullptr, nullptr}; run_gemm<0>(lds, (bf16_t*)(uni(p.ws) + HBUF), (const bf16_t*)(uni(p.ws) + W_D_OUT), 2048, 2048, 2048, E); } }
#ifdef XSYNC
    for (int i = 0; i < XSYNC; ++i) xcd_barrier(xb);
#endif
}

extern "C" void kernel_launch(void* const* d_in, const int* in_sizes, int n_in, void* d_out, int out_size, void* d_ws, size_t ws_size, hipStream_t stream) {
    static int grid_blocks = 0;
    if (!grid_blocks) {
        int dev = 0, cus = 0, per_cu = 0;
        hipGetDevice(&dev);
        hipDeviceGetAttribute(&cus, hipDeviceAttributeMultiprocessorCount, dev);
        hipFuncSetAttribute((const void*)mega, hipFuncAttributeMaxDynamicSharedMemorySize, LDS_BYTES);
        hipOccupancyMaxActiveBlocksPerMultiprocessor(&per_cu, (const void*)mega, 512, LDS_BYTES);
        if (per_cu < 1) per_cu = 1;
        grid_blocks = cus * per_cu;
        if (ws_size < EXTRA + 65536 + 6 * 65536) fprintf(stderr, "kernel_launch: workspace too small (%zu < %zu)\n", ws_size, (size_t)WS_END);
    }
    Params p; memset(&p, 0, sizeof(p));
    for (int i = 0; i < 29; ++i) p.in[i] = (const float*)d_in[i];
    p.out = (float*)d_out; p.ws = (unsigned char*)d_ws;
    unsigned char* ws = (unsigned char*)d_ws;
    int nj = 0, tiles = 0;
    auto add = [&](const float* src, size_t dst_off, int K, int N, int ldw, int npad) {
        TJob& j = p.jobs[nj++]; j.src = src; j.dst = (bf16_t*)(ws + dst_off); j.kscale = nullptr; j.K = K; j.N = N; j.ldw = ldw; j.ntn = npad / 64; j.tile0 = tiles; j.pad = 0; tiles += (npad / 64) * (K / 256);
    };
    add(p.in[3], W_A_IN, 2048, 8192, 8192, 8192); p.jobs[0].pad = 1; p.jobs[0].kscale = p.in[1];
    add(p.in[7], W_A_OUT, 2048, 2048, 2048, 2048);
    add(p.in[8], W_B_IN, 2048, 6160, 6160, 6400); p.jobs[nj - 1].kscale = p.in[1] + 2048;
    add(p.in[12], W_B_OUT, 2048, 2048, 2048, 2048);
    add(p.in[13], W_C_IN, 2048, 4096, 4096, 4096); p.jobs[nj - 1].kscale = p.in[1] + 4096;
    add(p.in[21], W_C_OUT, 2048, 2048, 2048, 2048);
    add(p.in[22], W_D_IN, 2048, 3136, 3136, 3328); p.jobs[nj - 1].kscale = p.in[1] + 6144;
    add(p.in[25], W_D_UQKV, 512, 3072, 3072, 3072); p.jobs[nj - 1].kscale = p.in[23];
    add(p.in[26], W_D_UQKV + (size_t)3072 * 512 * 2, 512, 4096, 4096, 4096); p.jobs[nj - 1].kscale = p.in[24];
    add(p.in[28], W_D_OUT, 2048, 2048, 2048, 2048);
    for (int n = 0; n < 8; ++n) for (int half = 0; half < 2; ++half) for (int bj = 0; bj < 2; ++bj)
        add(p.in[bj ? 18 : 16] + (size_t)n * 65536 + half * 128, W_C_GATE + ((size_t)((n * 2 + half) * 256 + 128 * bj)) * 256 * 2, 256, 128, 256, 128);
    p.njobs = nj; p.ntiles = tiles;
    hipMemsetAsync(ws + WS_BAR, 0, XCD_BAR_WORDS * 4, stream);
    void* args[] = {(void*)&p};
    hipError_t e = hipLaunchCooperativeKernel((const void*)mega, dim3(grid_blocks), dim3(512), args, LDS_BYTES, stream);
    if (e != hipSuccess) fprintf(stderr, "cooperative launch failed: %s (grid %d)\n", hipGetErrorString(e), grid_blocks);
}
```

```cpp
#include <hip/hip_runtime.h>
#include <hip/hip_cooperative_groups.h>
#include <cstdio>
#include <cstring>
namespace cg = cooperative_groups;

#define DI __device__ __forceinline__
#define LAS __attribute__((address_space(3)))
typedef unsigned short bf16_t;
typedef short bf16x8 __attribute__((ext_vector_type(8)));
typedef short s16x4 __attribute__((ext_vector_type(4)));
typedef float f32x2 __attribute__((ext_vector_type(2)));
typedef float f32x4 __attribute__((ext_vector_type(4)));
typedef float f32x16 __attribute__((ext_vector_type(16)));
typedef unsigned u32x2 __attribute__((ext_vector_type(2)));
typedef unsigned u32x4 __attribute__((ext_vector_type(4)));
typedef __bf16 bf16v2_t __attribute__((ext_vector_type(2)));

constexpr int MTOK = 16384, DM = 2048, SEQ = 4096;
constexpr float EPS = 1e-6f, LOG2E = 1.4426950408889634f;
constexpr size_t MiB = (size_t)1 << 20;
constexpr size_t W_A_IN = 0, W_A_OUT = 32 * MiB, W_B_IN = 40 * MiB, W_B_OUT = 65 * MiB, W_C_IN = 73 * MiB, W_C_GATE = 89 * MiB,
                 W_C_OUT = 91 * MiB, W_D_IN = 99 * MiB, W_D_UQKV = 112 * MiB, W_D_OUT = 119 * MiB, HBUF = 127 * MiB, ACT = 191 * MiB,
                 WS_END = 511 * MiB;
constexpr size_t LAT = 0;
constexpr size_t EXTRA = 511 * MiB;
constexpr size_t X_BIAS = EXTRA + 16384, X_SP8 = EXTRA + 32768, X_SSQ = EXTRA + 65536;
constexpr size_t GLA_TOT = ACT + 200 * MiB;
constexpr size_t XG = ACT + 256 * MiB;
constexpr size_t WS_BAR = EXTRA;
constexpr int LDS_BYTES = 131072 + 2048;
#ifndef PHMASK
#define PHMASK 0xffffffffull
#endif
#ifndef REPMASK
#define REPMASK 0ull
#endif

struct TJob { const float* src; bf16_t* dst; const float* kscale; int K, N, ldw, ntn, tile0, pad; };
struct Params { const float* in[29]; float* out; unsigned char* ws; int njobs, ntiles; TJob jobs[44]; };

DI int otid() { int t = threadIdx.x; asm volatile("" : "+v"(t)); return t; }
template <class T> DI T* uni(T* p) {
    const unsigned long long v = (unsigned long long)p;
    const unsigned lo = __builtin_amdgcn_readfirstlane((unsigned)v), hi = __builtin_amdgcn_readfirstlane((unsigned)(v >> 32));
    return (T*)(((unsigned long long)hi << 32) | lo);
}
DI float bf2f(bf16_t v) { return __uint_as_float((unsigned)v << 16); }
DI unsigned pk2(float a, float b) { f32x2 v = {a, b}; bf16v2_t r = __builtin_convertvector(v, bf16v2_t); return __builtin_bit_cast(unsigned, r); }
DI bf16_t f2bf(float a) { return (bf16_t)(pk2(a, 0.f) & 0xffffu); }
DI void unpack8(const u32x4 w, float (&f)[8]) {
#pragma unroll
    for (int i = 0; i < 4; ++i) { f[2 * i] = __uint_as_float(w[i] << 16); f[2 * i + 1] = __uint_as_float(w[i] & 0xffff0000u); }
}
DI u32x4 pack8(const float (&f)[8]) { u32x4 w; w.x = pk2(f[0], f[1]); w.y = pk2(f[2], f[3]); w.z = pk2(f[4], f[5]); w.w = pk2(f[6], f[7]); return w; }
DI float wsum(float v) {
#pragma unroll
    for (int m = 32; m >= 1; m >>= 1) v += __shfl_xor(v, m);
    return v;
}
DI float sigm(float x) { return 1.f / (1.f + __expf(-x)); }
DI float silu(float x) { return x / (1.f + __expf(-x)); }
DI int crow(int i, int hh) { return (i & 3) + 8 * (i >> 2) + 4 * hh; }
DI f32x16 mfma32(bf16x8 a, bf16x8 b, f32x16 c) { return __builtin_amdgcn_mfma_f32_32x32x16_bf16(a, b, c, 0, 0, 0); }
DI s16x4 trread(LAS unsigned char* p) { return __builtin_amdgcn_ds_read_tr16_b64_v4i16((LAS s16x4*)p); }
DI bf16x8 cat4(s16x4 lo, s16x4 hi) { return __builtin_shufflevector(lo, hi, 0, 1, 2, 3, 4, 5, 6, 7); }

namespace pg8 {
constexpr int BM = 256, BK = 64, HALF = 128, HTB = HALF * BK * 2, STAGE_BYTES = 8 * HTB, NXCD = 8, WGM = 8;
DI int lds_byte(int r, int c) { const int st = (r >> 4) * 2 + (c >> 5), rr = r & 15, cc = c & 31, ob = rr * 64 + cc * 2; return st * 1024 + (ob ^ (((ob >> 9) & 1) << 5)); }
DI void stage_rc(int b, int& R, int& C) { const int st = b / 1024, sb = b % 1024, swz = sb ^ (((sb >> 9) & 1) << 5); R = (st >> 1) * 16 + swz / 64; C = (st & 1) * 32 + (swz % 64) / 2; }
DI int perm32(int rho) { const int n = rho >> 4, i = rho & 15; return 8 * (i >> 2) + 4 * n + (i & 3); }
struct Unit { int pm, pn; size_t aoff, boff; };
template <int MODE> struct Sched {
    int nM, nN, nwg, G, c, lda, K;
    DI void init(int M, int N, int G_, int c_, int lda_, int K_) { nM = M / BM; nN = N / BM; nwg = nM * nN; G = G_; c = c_; lda = lda_; K = K_; }
    DI bool next(int i, Unit& u) const {
        const long L = (long)i * G + c; if (L >= nwg) return false;
        int wgid = (int)L; { const int q = nwg / NXCD, r = nwg % NXCD, xcd = wgid % NXCD, off = wgid / NXCD; wgid = (xcd < r ? xcd * (q + 1) : r * (q + 1) + (xcd - r) * q) + off; }
        const int nig = WGM * nN, gid = wgid / nig, fm = gid * WGM, gsz = (nM - fm) < WGM ? (nM - fm) : WGM;
        u.pm = fm + ((wgid % nig) % gsz); u.pn = (wgid % nig) / gsz;
        u.aoff = (size_t)u.pm * 256 * lda * 2; u.boff = (size_t)u.pn * 256 * K * 2;
        if (MODE == 1 && u.pn >= 12) u.aoff += 1024;
        if (MODE == 2) u.aoff += (size_t)(u.pn >> 1) * 512;
        return true;
    }
};

template <class Epi, class SchedT>
DI void gemm_phase(LAS unsigned char* lds, const bf16_t* Ap, const bf16_t* Btp, const int K, const int lda, const SchedT& S, const Epi& E) {
    const int tid = otid(), wid = __builtin_amdgcn_readfirstlane(tid >> 6), lane = tid & 63, wr = wid >> 2, wc = wid & 3, fr = lane & 15, fq = lane >> 4;
    const int nt = K / BK;
    unsigned voffA[2], voffB[2];
#pragma unroll
    for (int i = 0; i < 2; ++i) { int R, C; stage_rc(tid * 16 + i * 8192, R, C); const int Rb = (R & ~31) + perm32(R & 31);
        voffA[i] = (unsigned)(R * lda + C) * 2u; voffB[i] = (unsigned)(Rb * K + C) * 2u; }
    const size_t kstep = (size_t)(BK * 2);
    const size_t hstepA = (size_t)HALF * lda * 2, hstepB = (size_t)HALF * K * 2;
    const unsigned ldsw = (unsigned)wid * 1024u;
    const int aoff = lds_byte(wr * 64 + fr, fq * 8), boff = lds_byte(wc * 32 + fr, fq * 8);
#define PG8_SA(b, h) (((b) * 2 + (h)) * HTB)
#define PG8_SB(b, h) ((4 + (b) * 2 + (h)) * HTB)
#define PG8_STAGE(bufoff, gbase, voff) do { _Pragma("unroll") for (int _i = 0; _i < 2; ++_i) \
        __builtin_amdgcn_global_load_lds((const unsigned*)((const char*)(gbase) + (voff)[_i]), (LAS unsigned*)(lds + (bufoff) + ldsw + _i * 8192), 16, 0, 0); } while (0)
#define PG8_LDA(dst, b, h) do { _Pragma("unroll") for (int m = 0; m < 4; ++m) _Pragma("unroll") for (int k = 0; k < 2; ++k) dst[m][k] = *(const LAS bf16x8*)(lds + PG8_SA(b, h) + aoff + m * 2048 + k * 1024); } while (0)
#define PG8_LDB(dst, b, h) do { _Pragma("unroll") for (int n = 0; n < 2; ++n) _Pragma("unroll") for (int k = 0; k < 2; ++k) dst[n][k] = *(const LAS bf16x8*)(lds + PG8_SB(b, h) + boff + n * 2048 + k * 1024); } while (0)
#define PG8_MMA(ai, bj, At, Bt) do { __builtin_amdgcn_s_setprio(1); _Pragma("unroll") for (int m = 0; m < 4; ++m) _Pragma("unroll") for (int n = 0; n < 2; ++n) _Pragma("unroll") for (int k = 0; k < 2; ++k) \
        acc[ai][bj][m][n] = __builtin_amdgcn_mfma_f32_16x16x32_bf16(Bt[n][k], At[m][k], acc[ai][bj][m][n], 0, 0, 0); __builtin_amdgcn_s_setprio(0); } while (0)
#define PG8_WAIT_V(n) asm volatile("s_waitcnt vmcnt(" #n ")" ::: "memory")
#define PG8_WAIT_L(n) asm volatile("s_waitcnt lgkmcnt(" #n ")" ::: "memory")
#define PG8_BAR __builtin_amdgcn_s_barrier()
#define PG8_SCHED __builtin_amdgcn_sched_barrier(0)
    Unit cur, nxt; int ui = 0;
    if (!S.next(0, cur)) return;
    float pre[8]; E.prefetch(cur, wr, fr, pre);
    f32x4 acc[2][2][4][2];
#pragma unroll
    for (int a = 0; a < 2; ++a)
#pragma unroll
        for (int b = 0; b < 2; ++b)
#pragma unroll
            for (int m = 0; m < 4; ++m)
#pragma unroll
                for (int n = 0; n < 2; ++n) acc[a][b][m][n] = (f32x4){0.f, 0.f, 0.f, 0.f};
    bf16x8 At[4][2], B0[2][2], B1[2][2];
    const char* cA = (const char*)Ap + cur.aoff; const char* cB = (const char*)Btp + cur.boff;
    PG8_STAGE(PG8_SB(0, 0), cB, voffB); PG8_STAGE(PG8_SA(0, 0), cA, voffA); PG8_STAGE(PG8_SB(0, 1), cB + hstepB, voffB); PG8_STAGE(PG8_SA(0, 1), cA + hstepA, voffA);
    if (wr == 1) PG8_BAR;
    PG8_WAIT_V(4); PG8_BAR;
    PG8_STAGE(PG8_SB(1, 0), cB + kstep, voffB); PG8_STAGE(PG8_SA(1, 0), cA + kstep, voffA); PG8_STAGE(PG8_SB(1, 1), cB + hstepB + kstep, voffB);
    PG8_WAIT_V(6); PG8_BAR;
    for (;;) {
        const bool has_next = S.next(ui + 1, nxt);
        const char* nA = has_next ? (const char*)Ap + nxt.aoff : cA; const char* nB = has_next ? (const char*)Btp + nxt.boff : cB;
        for (int t = 0; t < nt; t += 2) {
            const bool last = (t == nt - 2);
            const char* a1 = cA + (size_t)(t + 1) * kstep;
            const char* a2 = last ? nA : cA + (size_t)(t + 2) * kstep; const char* b2 = last ? nB : cB + (size_t)(t + 2) * kstep;
            const char* a3 = a2 + kstep; const char* b3 = b2 + kstep;
            PG8_LDB(B0, 0, 0); PG8_SCHED; PG8_LDA(At, 0, 0); PG8_STAGE(PG8_SA(1, 1), a1 + hstepA, voffA);
            PG8_WAIT_L(8); PG8_BAR; PG8_WAIT_L(0); PG8_MMA(0, 0, At, B0); PG8_BAR; PG8_SCHED;
            PG8_LDB(B1, 0, 1); PG8_STAGE(PG8_SB(0, 0), b2, voffB);
            PG8_BAR; PG8_WAIT_L(0); PG8_MMA(0, 1, At, B1); PG8_BAR;
            PG8_LDA(At, 0, 1); PG8_STAGE(PG8_SA(0, 0), a2, voffA);
            PG8_BAR; PG8_WAIT_L(0); PG8_MMA(1, 0, At, B0); PG8_BAR; PG8_SCHED;
            PG8_STAGE(PG8_SB(0, 1), b2 + hstepB, voffB);
            PG8_WAIT_V(6); PG8_BAR; PG8_MMA(1, 1, At, B1); PG8_BAR;
            PG8_LDB(B0, 1, 0); PG8_SCHED; PG8_LDA(At, 1, 0); PG8_STAGE(PG8_SA(0, 1), a2 + hstepA, voffA);
            PG8_WAIT_L(8); PG8_BAR; PG8_WAIT_L(0); PG8_MMA(0, 0, At, B0); PG8_BAR; PG8_SCHED;
            PG8_LDB(B1, 1, 1); PG8_STAGE(PG8_SB(1, 0), b3, voffB);
            PG8_BAR; PG8_WAIT_L(0); PG8_MMA(0, 1, At, B1); PG8_BAR;
            PG8_LDA(At, 1, 1); PG8_STAGE(PG8_SA(1, 0), a3, voffA);
            PG8_BAR; PG8_WAIT_L(0); PG8_MMA(1, 0, At, B0); PG8_BAR; PG8_SCHED;
            PG8_STAGE(PG8_SB(1, 1), b3 + hstepB, voffB);
            PG8_WAIT_V(6); PG8_BAR; PG8_MMA(1, 1, At, B1); PG8_BAR;
        }
        E(acc, cur, wr, wc, fr, fq, pre);
        if (!has_next) break;
#pragma unroll
        for (int a = 0; a < 2; ++a)
#pragma unroll
            for (int b = 0; b < 2; ++b)
#pragma unroll
                for (int m = 0; m < 4; ++m)
#pragma unroll
                    for (int n = 0; n < 2; ++n) acc[a][b][m][n] = (f32x4){0.f, 0.f, 0.f, 0.f};
        cur = nxt; cA = nA; cB = nB; ++ui; E.prefetch(cur, wr, fr, pre);
    }
    PG8_WAIT_V(0);
    if (wr == 0) PG8_BAR;
    PG8_BAR;
#undef PG8_SA
#undef PG8_SB
#undef PG8_STAGE
#undef PG8_LDA
#undef PG8_LDB
#undef PG8_MMA
#undef PG8_WAIT_V
#undef PG8_WAIT_L
#undef PG8_BAR
#undef PG8_SCHED
}

typedef f32x4 Acc[2][2][4][2];
struct EpiStore {
    bf16_t* O; int ldc; const float* ssq;
    DI void prefetch(const Unit& u, int wr, int fr, float (&pre)[8]) const {
#pragma unroll
        for (int i = 0; i < 8; ++i) pre[i] = ssq ? ssq[u.pm * BM + wr * 64 + fr + (i >> 2) * HALF + (i & 3) * 16] : 0.f; }
    DI void operator()(const Acc& acc, const Unit& u, int wr, int wc, int fr, int fq, const float (&pre)[8]) const {
        const int row0 = u.pm * BM + wr * 64 + fr, col0 = u.pn * BM + wc * 32 + 8 * fq;
#pragma unroll
        for (int ai = 0; ai < 2; ++ai)
#pragma unroll
            for (int m = 0; m < 4; ++m) { bf16_t* rowp = O + (size_t)(row0 + ai * HALF + m * 16) * ldc + col0;
                const float rs = ssq ? rsqrtf(pre[ai * 4 + m] * (1.f / DM) + EPS) : 1.f;
#pragma unroll
                for (int bj = 0; bj < 2; ++bj) { const f32x4 v0 = acc[ai][bj][m][0] * rs, v1 = acc[ai][bj][m][1] * rs;
                    u32x4 w; w.x = pk2(v0[0], v0[1]); w.y = pk2(v0[2], v0[3]); w.z = pk2(v1[0], v1[1]); w.w = pk2(v1[2], v1[3]);
                    *(u32x4*)(rowp + bj * HALF) = w; } }
    }
};
struct EpiStoreA {
    bf16_t* O; const float* qkg; const float* ssq;
    DI void prefetch(const Unit& u, int wr, int fr, float (&pre)[8]) const {
#pragma unroll
        for (int i = 0; i < 8; ++i) pre[i] = ssq[u.pm * BM + wr * 64 + fr + (i >> 2) * HALF + (i & 3) * 16]; }
    DI void operator()(const Acc& acc, const Unit& u, int wr, int wc, int fr, int fq, const float (&pre)[8]) const {
        const int row0 = u.pm * BM + wr * 64 + fr, col0 = u.pn * BM + wc * 64 + 8 * fq;
        const bool nrm = u.pn < 16;
        f32x4 gn[2][2];
        if (nrm) { const float* gp = qkg + (u.pn < 8 ? 0 : 64) + 8 * fq; const float gs = u.pn < 8 ? 0.125f * LOG2E : 1.f;
#pragma unroll
            for (int bj = 0; bj < 2; ++bj) { gn[bj][0] = *(const f32x4*)(gp + 32 * bj) * gs; gn[bj][1] = *(const f32x4*)(gp + 32 * bj + 4) * gs; } }
#pragma unroll
        for (int ai = 0; ai < 2; ++ai)
#pragma unroll
            for (int m = 0; m < 4; ++m) { bf16_t* rowp = O + (size_t)(row0 + ai * HALF + m * 16) * 8192 + col0;
                f32x4 v[2][2]; const float rs = rsqrtf(pre[ai * 4 + m] * (1.f / DM) + EPS);
#pragma unroll
                for (int bj = 0; bj < 2; ++bj) { v[bj][0] = acc[ai][bj][m][0] * rs; v[bj][1] = acc[ai][bj][m][1] * rs; }
                if (nrm) { float ss = 0.f;
#pragma unroll
                    for (int bj = 0; bj < 2; ++bj)
#pragma unroll
                        for (int n = 0; n < 2; ++n) ss += v[bj][n][0] * v[bj][n][0] + v[bj][n][1] * v[bj][n][1] + v[bj][n][2] * v[bj][n][2] + v[bj][n][3] * v[bj][n][3];
                    ss += __shfl_xor(ss, 16); ss += __shfl_xor(ss, 32);
                    const float sc = rsqrtf(ss * (1.f / 64.f) + EPS);
#pragma unroll
                    for (int bj = 0; bj < 2; ++bj) { v[bj][0] = v[bj][0] * sc * gn[bj][0]; v[bj][1] = v[bj][1] * sc * gn[bj][1]; } }
#pragma unroll
                for (int bj = 0; bj < 2; ++bj) { u32x4 w; w.x = pk2(v[bj][0][0], v[bj][0][1]); w.y = pk2(v[bj][0][2], v[bj][0][3]); w.z = pk2(v[bj][1][0], v[bj][1][1]); w.w = pk2(v[bj][1][2], v[bj][1][3]);
                    *(u32x4*)(rowp + 32 * bj) = w; } }
    }
};
struct EpiStoreD {
    bf16_t* lat; bf16_t* g; const float* ssq; float* ssql;
    DI void prefetch(const Unit& u, int wr, int fr, float (&pre)[8]) const {
#pragma unroll
        for (int i = 0; i < 8; ++i) pre[i] = ssq[u.pm * BM + wr * 64 + fr + (i >> 2) * HALF + (i & 3) * 16]; }
    DI void operator()(const Acc& acc, const Unit& u, int wr, int wc, int fr, int fq, const float (&pre)[8]) const {
        const int row0 = u.pm * BM + wr * 64 + fr, col0 = u.pn * BM + wc * 32 + 8 * fq;
#pragma unroll
        for (int ai = 0; ai < 2; ++ai)
#pragma unroll
            for (int m = 0; m < 4; ++m) { const size_t row = (size_t)(row0 + ai * HALF + m * 16);
                const float rs = rsqrtf(pre[ai * 4 + m] * (1.f / DM) + EPS); float ss = 0.f;
#pragma unroll
                for (int bj = 0; bj < 2; ++bj) { const f32x4 v0 = acc[ai][bj][m][0] * rs, v1 = acc[ai][bj][m][1] * rs;
                    ss += v0[0] * v0[0] + v0[1] * v0[1] + v0[2] * v0[2] + v0[3] * v0[3] + v1[0] * v1[0] + v1[1] * v1[1] + v1[2] * v1[2] + v1[3] * v1[3];
                    u32x4 w; w.x = pk2(v0[0], v0[1]); w.y = pk2(v0[2], v0[3]); w.z = pk2(v1[0], v1[1]); w.w = pk2(v1[2], v1[3]);
                    const int col = col0 + bj * HALF;
                    if (col < 1088) *(u32x4*)(lat + row * 1088 + col) = w;
                    else if (col < 3136) *(u32x4*)(g + row * 2048 + (col - 1088)) = w; }
                if (u.pn < 4) { ss += __shfl_xor(ss, 16); ss += __shfl_xor(ss, 32); if (fq == 0) atomicAdd(ssql + (u.pn >> 1) * MTOK + row, ss); } }
    }
};
struct EpiStoreU {
    bf16_t* O; const float* ssql;
    DI void prefetch(const Unit& u, int wr, int fr, float (&pre)[8]) const {
        const float* sq = ssql + (u.pn >= 12 ? MTOK : 0);
#pragma unroll
        for (int i = 0; i < 8; ++i) pre[i] = sq[u.pm * BM + wr * 64 + fr + (i >> 2) * HALF + (i & 3) * 16]; }
    DI void operator()(const Acc& acc, const Unit& u, int wr, int wc, int fr, int fq, const float (&pre)[8]) const {
        const int row0 = u.pm * BM + wr * 64 + fr, col0 = u.pn * BM + wc * 32 + 8 * fq;
        const float* sq = ssql + (u.pn >= 12 ? MTOK : 0);
#pragma unroll
        for (int ai = 0; ai < 2; ++ai)
#pragma unroll
            for (int m = 0; m < 4; ++m) { bf16_t* rowp = O + (size_t)(row0 + ai * HALF + m * 16) * 7168 + col0;
                const float rs = rsqrtf(pre[ai * 4 + m] * (1.f / 512.f) + EPS);
#pragma unroll
                for (int bj = 0; bj < 2; ++bj) { const f32x4 v0 = acc[ai][bj][m][0] * rs, v1 = acc[ai][bj][m][1] * rs;
                    u32x4 w; w.x = pk2(v0[0], v0[1]); w.y = pk2(v0[2], v0[3]); w.z = pk2(v1[0], v1[1]); w.w = pk2(v1[2], v1[3]);
                    *(u32x4*)(rowp + bj * HALF) = w; } }
    }
};
template <bool INB, bool OUTF, bool OUTB, bool SSQ> struct EpiResid {
    const float* xf; const bf16_t* xb; float* of; bf16_t* ob; float* ssq;
    DI void prefetch(const Unit&, int, int, float (&pre)[8]) const {
#pragma unroll
        for (int i = 0; i < 8; ++i) pre[i] = 0.f; }
    DI void operator()(const Acc& acc, const Unit& u, int wr, int wc, int fr, int fq, const float (&pre)[8]) const {
        const int row0 = u.pm * BM + wr * 64 + fr, col0 = u.pn * BM + wc * 32 + 8 * fq;
#pragma unroll
        for (int ai = 0; ai < 2; ++ai)
#pragma unroll
            for (int m = 0; m < 4; ++m) { const int row = row0 + ai * HALF + m * 16; const size_t o = (size_t)row * DM + col0;
                float ss = 0.f;
#pragma unroll
                for (int bj = 0; bj < 2; ++bj) {
                    f32x4 x0, x1;
                    if (INB) { float f[8]; unpack8(*(const u32x4*)(xb + o + bj * HALF), f); x0 = (f32x4){f[0], f[1], f[2], f[3]}; x1 = (f32x4){f[4], f[5], f[6], f[7]}; }
                    else { x0 = *(const f32x4*)(xf + o + bj * HALF); x1 = *(const f32x4*)(xf + o + bj * HALF + 4); }
                    x0 += acc[ai][bj][m][0]; x1 += acc[ai][bj][m][1];
                    if (OUTF) { __builtin_nontemporal_store(x0, (f32x4*)(of + o + bj * HALF)); __builtin_nontemporal_store(x1, (f32x4*)(of + o + bj * HALF + 4)); }
                    if (SSQ) ss += x0[0] * x0[0] + x0[1] * x0[1] + x0[2] * x0[2] + x0[3] * x0[3] + x1[0] * x1[0] + x1[1] * x1[1] + x1[2] * x1[2] + x1[3] * x1[3];
                    if (OUTB) { u32x4 w; w.x = pk2(x0[0], x0[1]); w.y = pk2(x0[2], x0[3]); w.z = pk2(x1[0], x1[1]); w.w = pk2(x1[2], x1[3]);
                        *(u32x4*)(ob + o + bj * HALF) = w; } }
                if (SSQ) { ss += __shfl_xor(ss, 16); ss += __shfl_xor(ss, 32); if (fq == 0) atomicAdd(ssq + row, ss); } }
    }
};
struct EpiGates {
    const bf16_t* xc; const float* brg; const float* big; const float* sp8t; unsigned* ax;
    DI void prefetch(const Unit&, int, int, float (&pre)[8]) const {
#pragma unroll
        for (int i = 0; i < 8; ++i) pre[i] = 0.f; }
    DI void operator()(const Acc& acc, const Unit& u, int wr, int wc, int fr, int fq, const float (&pre)[8]) const {
        const int row0 = u.pm * BM + wr * 64 + fr, f0 = (u.pn >> 1) * 256 + (u.pn & 1) * 128 + wc * 32 + 8 * fq;
#pragma unroll
        for (int n = 0; n < 2; ++n) {
            const f32x4 br = *(const f32x4*)(brg + f0 + 4 * n), bi = *(const f32x4*)(big + f0 + 4 * n), sp = *(const f32x4*)(sp8t + f0 + 4 * n);
#pragma unroll
            for (int ai = 0; ai < 2; ++ai)
#pragma unroll
                for (int m = 0; m < 4; ++m) { const size_t o = (size_t)(row0 + ai * HALF + m * 16) * DM + f0 + 4 * n;
                    const u32x2 xw = *(const u32x2*)(xc + o);
                    const float xv[4] = {__uint_as_float(xw.x << 16), __uint_as_float(xw.x & 0xffff0000u), __uint_as_float(xw.y << 16), __uint_as_float(xw.y & 0xffff0000u)};
                    u32x4 w;
#pragma unroll
                    for (int e = 0; e < 4; ++e) { const float r = sigm(acc[ai][0][m][n][e] + br[e]), ig = sigm(acc[ai][1][m][n][e] + bi[e]);
                        const float la = -sp[e] * r, uu = -2.f * la;
                        const float om = uu * (1.f - uu * 0.5f * (1.f - uu * (1.f / 3.f) * (1.f - uu * 0.25f * (1.f - uu * 0.2f * (1.f - uu * (1.f / 6.f))))));
                        w[e] = pk2(la, sqrtf(fmaxf(om, 0.f)) * ig * xv[e]); }
                    *(u32x4*)(ax + o) = w; __builtin_amdgcn_sched_barrier(0); }
        }
    }
};
}

template <int MODE, class Epi>
DI void run_gemm(LAS unsigned char* lds, const bf16_t* A, const bf16_t* Bt, int N, int K, int lda, const Epi& E) {
    asm volatile("" : "+s"(K));
    pg8::Sched<MODE> S; S.init(MTOK, N, (int)gridDim.x, (int)blockIdx.x, lda, K);
    pg8::gemm_phase(lds, A, Bt, K, lda, S, E);
    __syncthreads();
}

DI void phase_convert(const Params& p, LAS unsigned char* lds) {
    LAS float* sm = (LAS float*)lds;
    const int tid = otid();
    for (int t = blockIdx.x; t < p.ntiles; t += gridDim.x) {
        int j = 0; while (j + 1 < p.njobs && p.jobs[j + 1].tile0 <= t) ++j;
        const float* src = p.jobs[j].src; bf16_t* dst = p.jobs[j].dst; const int K = p.jobs[j].K, N = p.jobs[j].N, ldw = p.jobs[j].ldw, ntn = p.jobs[j].ntn;
        const int tt = t - p.jobs[j].tile0, tn = tt % ntn, tk = tt / ntn, n0 = tn * 64, k0 = tk * 256;
        { const int n4 = (tid & 15) * 4, kr = tid >> 4; f32x4 v[8];
#pragma unroll
          for (int i = 0; i < 8; ++i) v[i] = (n0 + n4 < N) ? __builtin_nontemporal_load((const f32x4*)(src + (size_t)(k0 + kr + 32 * i) * ldw + n0 + n4)) : (f32x4){0.f, 0.f, 0.f, 0.f};
#pragma unroll
          for (int i = 0; i < 8; ++i) { LAS float* d = sm + (kr + 32 * i) * 65 + n4; d[0] = v[i][0]; d[1] = v[i][1]; d[2] = v[i][2]; d[3] = v[i][3]; } }
        __syncthreads();
        { const int nr = tid >> 3, kq = tid & 7;
#pragma unroll
          for (int jj = 0; jj < 4; ++jj) { const int kc = (kq + 8 * jj) * 8; float f[8];
#pragma unroll
              for (int e = 0; e < 8; ++e) f[e] = sm[(kc + e) * 65 + nr];
              if (p.jobs[j].kscale) { const float* ks = p.jobs[j].kscale + k0 + kc;
#pragma unroll
                  for (int e = 0; e < 8; ++e) f[e] *= ks[e]; }
              int nrow = n0 + nr; if (p.jobs[j].pad) { const int jl = nrow & 255; nrow = (nrow & ~255) + 128 * ((jl >> 5) & 1) + 32 * (jl >> 6) + (jl & 31); }
              *(u32x4*)(dst + (size_t)nrow * K + k0 + kc) = pack8(f); } }
        __syncthreads();
    }
}

DI int t5_bucket(int rel) {
    const int n = rel < 0 ? -rel : rel; int b;
    if (n < 8) b = n; else b = 8 + (n >= 12) + (n >= 16) + (n >= 23) + (n >= 32) + (n >= 46) + (n >= 64) + (n >= 91);
    return (rel > 0 ? 16 : 0) + b;
}
DI void phase_bias_table(const Params& p) {
    float* tb = (float*)(p.ws + X_BIAS);
    float* sp8 = (float*)(p.ws + X_SP8); float* ssq = (float*)(p.ws + X_SSQ);
    for (int i = blockIdx.x * 512 + otid(); i < 5 * MTOK; i += gridDim.x * 512) ssq[i] = 0.f;
    for (int i = blockIdx.x * 512 + otid(); i < 16 * 192 + 2048; i += gridDim.x * 512) {
        if (i < 16 * 192) { const int h = i / 192, idx = i % 192; tb[i] = (p.in[2][t5_bucket(idx - 128) * 16 + h] - p.in[2][15 * 16 + h]) * LOG2E; }
        else sp8[i - 16 * 192] = 8.f * log1pf(expf(-p.in[20][i - 16 * 192]));
    }
}

DI void phase_x0(const float* x, bf16_t* out, float* ssq) {
    const int tid = otid(), lane = tid & 63, gw = blockIdx.x * 8 + (tid >> 6), nw = gridDim.x * 8;
    for (int row0 = gw; row0 < MTOK; row0 += 2 * nw) {
        f32x4 v[2][8]; bool ok[2]; int rw[2];
#pragma unroll
        for (int r = 0; r < 2; ++r) { ok[r] = row0 + r * nw < MTOK; rw[r] = ok[r] ? row0 + r * nw : row0;
            const f32x4* xr = (const f32x4*)(x + (size_t)rw[r] * DM);
#pragma unroll
            for (int i = 0; i < 4; ++i) { v[r][2 * i] = __builtin_nontemporal_load(xr + i * 128 + lane * 2); v[r][2 * i + 1] = __builtin_nontemporal_load(xr + i * 128 + lane * 2 + 1); } }
#pragma unroll
        for (int r = 0; r < 2; ++r) {
            float ss = 0.f;
#pragma unroll
            for (int i = 0; i < 8; ++i) ss += v[r][i][0] * v[r][i][0] + v[r][i][1] * v[r][i][1] + v[r][i][2] * v[r][i][2] + v[r][i][3] * v[r][i][3];
            ss = wsum(ss);
            if (ok[r]) {
                if (lane == 0) ssq[rw[r]] = ss;
#pragma unroll
                for (int i = 0; i < 4; ++i) { u32x4 w; w.x = pk2(v[r][2 * i][0], v[r][2 * i][1]); w.y = pk2(v[r][2 * i][2], v[r][2 * i][3]); w.z = pk2(v[r][2 * i + 1][0], v[r][2 * i + 1][1]); w.w = pk2(v[r][2 * i + 1][2], v[r][2 * i + 1][3]);
                    *(u32x4*)(out + (size_t)rw[r] * DM + i * 512 + lane * 8) = w; }
            }
        }
    }
}

DI void phase_rmsnorm(const float* x, const float* g, bf16_t* out) {
    const int tid = otid(), lane = tid & 63, gw = blockIdx.x * 8 + (tid >> 6), nw = gridDim.x * 8;
    for (int row = gw; row < MTOK; row += nw) {
        const f32x4* xr = (const f32x4*)(x + (size_t)row * DM); f32x4 v[8]; float ss = 0.f;
#pragma unroll
        for (int i = 0; i < 4; ++i) { v[2 * i] = xr[i * 128 + lane * 2]; v[2 * i + 1] = xr[i * 128 + lane * 2 + 1]; }
#pragma unroll
        for (int i = 0; i < 8; ++i) ss += v[i][0] * v[i][0] + v[i][1] * v[i][1] + v[i][2] * v[i][2] + v[i][3] * v[i][3];
        ss = wsum(ss); const float sc = rsqrtf(ss * (1.f / DM) + EPS);
#pragma unroll
        for (int i = 0; i < 4; ++i) { const int c = i * 512 + lane * 8; const f32x4 g0 = *(const f32x4*)(g + c), g1 = *(const f32x4*)(g + c + 4);
            u32x4 w; w.x = pk2(v[2 * i][0] * sc * g0[0], v[2 * i][1] * sc * g0[1]); w.y = pk2(v[2 * i][2] * sc * g0[2], v[2 * i][3] * sc * g0[3]);
            w.z = pk2(v[2 * i + 1][0] * sc * g1[0], v[2 * i + 1][1] * sc * g1[1]); w.w = pk2(v[2 * i + 1][2] * sc * g1[2], v[2 * i + 1][3] * sc * g1[3]);
            *(u32x4*)(out + (size_t)row * DM + c) = w; }
    }
}

DI void phase_qknorm_a(const Params& p) {
    bf16_t* big = (bf16_t*)(p.ws + ACT); const float* qkg = p.in[4];
    const int tid = otid(), lane = tid & 63, gw = blockIdx.x * 8 + (tid >> 6), nw = gridDim.x * 8;
    float gq[8], gk[8];
#pragma unroll
    for (int e = 0; e < 8; ++e) { gq[e] = qkg[(lane & 7) * 8 + e] * (0.125f * LOG2E); gk[e] = qkg[64 + (lane & 7) * 8 + e]; }
    for (int row = gw; row < MTOK; row += nw) {
#pragma unroll
        for (int i = 0; i < 8; ++i) {
            bf16_t* ptr = big + (size_t)row * 8192 + i * 512 + lane * 8; float f[8]; unpack8(*(const u32x4*)ptr, f);
            float ss = 0.f;
#pragma unroll
            for (int e = 0; e < 8; ++e) ss += f[e] * f[e];
            ss += __shfl_xor(ss, 1); ss += __shfl_xor(ss, 2); ss += __shfl_xor(ss, 4);
            const float sc = rsqrtf(ss * (1.f / 64.f) + EPS);
#pragma unroll
            for (int e = 0; e < 8; ++e) f[e] = f[e] * sc * (i < 4 ? gq[e] : gk[e]);
            *(u32x4*)ptr = pack8(f);
        }
    }
}

template <int DQK, int KA8, int DV, bool BIAS, bool JOINT>
DI void attn_core(LAS unsigned char* lds, const bf16_t* Qrow, const bf16_t* KpA, int ldkA, const bf16_t* KpB, int ldkB, const bf16_t* Vp, int ldv,
                  int qb, int wid, int lane, const float* qng  , f32x16 (&O)[DV / 32]) {
    constexpr int KROW = DQK * 2 + 16, VROW = DV * 2 + 64  , KC = DQK / 8, VC = DV / 8, NKC = 64 * KC, NVC = 64 * VC, NL = (NKC + NVC) / 512, STG = 64 * (KROW + VROW);
    static_assert(NKC % 512 == 0 && NVC % 512 == 0, "loader split");
    const int tid = otid(), l32 = lane & 31, hh = lane >> 5, i16 = lane & 15, tq = i16 >> 2, tp = i16 & 3, blk = (lane >> 4) & 1;
    const int q0w = qb * 256 + wid * 32, nkt = 4 * qb + 4, myc = q0w >> 6;
    bf16x8 qf[DQK / 16];
#pragma unroll
    for (int s = 0; s < DQK / 16; ++s) qf[s] = *(const bf16x8*)(Qrow + 16 * s + 8 * hh);
    if constexpr (DQK == 192) {
        if (qng) {
            float ssn = 0.f, ssr = 0.f;
#pragma unroll
            for (int s = 0; s < 12; ++s) { float f[8]; unpack8(__builtin_bit_cast(u32x4, qf[s]), f); float t = 0.f;
#pragma unroll
                for (int e = 0; e < 8; ++e) t += f[e] * f[e];
                if (s < 8) ssn += t; else ssr += t; }
            ssn += __shfl_xor(ssn, 32); ssr += __shfl_xor(ssr, 32);
            const float qs = 0.07216878364870322f * LOG2E, scn = rsqrtf(ssn * (1.f / 128.f) + EPS) * qs, scr = rsqrtf(ssr * (1.f / 64.f) + EPS) * qs;
#pragma unroll
            for (int s = 0; s < 8; ++s) { float f[8]; unpack8(__builtin_bit_cast(u32x4, qf[s]), f);
                const f32x4 g0 = *(const f32x4*)(qng + 16 * s + 8 * hh), g1 = *(const f32x4*)(qng + 16 * s + 8 * hh + 4);
#pragma unroll
                for (int e = 0; e < 4; ++e) { f[e] *= scn * g0[e]; f[4 + e] *= scn * g1[e]; }
                qf[s] = __builtin_bit_cast(bf16x8, pack8(f)); }
            const float posr = (float)(qb * 256 + wid * 32 + l32) * 0.15915494309189535f;
#pragma unroll
            for (int s = 8; s < 10; ++s) { float f1[8], f2[8]; unpack8(__builtin_bit_cast(u32x4, qf[s]), f1); unpack8(__builtin_bit_cast(u32x4, qf[s + 2]), f2);
#pragma unroll
                for (int e = 0; e < 8; ++e) { const int i = 16 * (s - 8) + 8 * hh + e;
                    const float a1 = f1[e] * scr * qng[128 + i], a2 = f2[e] * scr * qng[160 + i];
                    float rev = posr * __builtin_amdgcn_exp2f(-(float)i * 0.41524101186092029f); rev -= floorf(rev);
                    const float sn = __builtin_amdgcn_sinf(rev), cs = __builtin_amdgcn_cosf(rev);
                    f1[e] = a1 * cs - a2 * sn; f2[e] = a2 * cs + a1 * sn; }
                qf[s] = __builtin_bit_cast(bf16x8, pack8(f1)); qf[s + 2] = __builtin_bit_cast(bf16x8, pack8(f2)); }
            __builtin_amdgcn_sched_barrier(0);
        }
    }
    float m = 0.f, l = 0.f; bool mnz = false;
#pragma unroll
    for (int dt = 0; dt < DV / 32; ++dt)
#pragma unroll
        for (int i = 0; i < 16; ++i) O[dt][i] = 0.f;
    u32x4 stg[NL];
    LAS const float* btab = (LAS const float*)(lds + 2 * STG);
    const unsigned koff = l32 * KROW + 16 * hh, vtr = (4 * hh + tq) * VROW + (16 * blk + 4 * tp) * 2;

    auto gload = [&](int kt) {
#pragma unroll
        for (int i = 0; i < NL; ++i) { const int c = tid + i * 512;
            if (i * 512 < NKC) { const int row = c / KC, cc = c % KC;
                const bf16_t* src = (cc < KA8) ? KpA + (size_t)(kt * 64 + row) * ldkA + cc * 8 : KpB + (size_t)(kt * 64 + row) * ldkB + (cc - KA8) * 8;
                stg[i] = *(const u32x4*)src; }
            else { const int c2 = c - NKC, row = c2 / VC, cc = c2 % VC; stg[i] = *(const u32x4*)(Vp + (size_t)(kt * 64 + row) * ldv + cc * 8); } }
    };
    auto lstore = [&](int buf) {
#pragma unroll
        for (int i = 0; i < NL; ++i) { const int c = tid + i * 512;
            if (i * 512 < NKC) { const int row = c / KC, cc = c % KC; *(LAS u32x4*)(lds + buf * STG + row * KROW + cc * 16) = stg[i]; }
            else { const int c2 = c - NKC, row = c2 / VC, cc = c2 % VC; *(LAS u32x4*)(lds + buf * STG + 64 * KROW + row * VROW + cc * 16) = stg[i]; } }
    };

    gload(0); lstore(0); __syncthreads();
    for (int kt = 0; kt < nkt; ++kt) {
        if (kt + 1 < nkt) gload(kt + 1);
        if (JOINT && kt <= myc) {
            LAS unsigned char* kb = lds + (kt & 1) * STG; LAS unsigned char* vb = kb + 64 * KROW;
            const bool far = (kt * 64 + 63 - q0w <= -91);
            f32x16 S0, S1;
#pragma unroll
            for (int i = 0; i < 16; ++i) { S0[i] = 0.f; S1[i] = 0.f; }
#pragma unroll
            for (int s = 0; s < DQK / 16; ++s) {
                const bf16x8 k0 = *(LAS const bf16x8*)(kb + koff + 32 * s), k1 = *(LAS const bf16x8*)(kb + koff + 32 * KROW + 32 * s);
                S0 = mfma32(k0, qf[s], S0); S1 = mfma32(k1, qf[s], S1);
            }
            if (BIAS && !far) {
                const int rb = kt * 64 - (q0w + l32) + 128;
#pragma unroll
                for (int i = 0; i < 16; ++i) { const int i0 = rb + crow(i, hh); S0[i] += btab[i0 < 0 ? 0 : i0]; S1[i] += btab[i0 + 32 < 0 ? 0 : i0 + 32]; }
            }
            if (mnz) {
#pragma unroll
                for (int i = 0; i < 16; ++i) { S0[i] -= m; S1[i] -= m; }
            }
            float mx = fmaxf(S0[0], S1[0]);
#pragma unroll
            for (int i = 1; i < 16; ++i) mx = fmaxf(mx, fmaxf(S0[i], S1[i]));
            mx = fmaxf(mx, __shfl_xor(mx, 32));
            if (__any(mx > 64.f || (kt == 0 && mx < -64.f))) {
                const float dm = (mx > 64.f || (kt == 0 && mx < -64.f)) ? mx : 0.f, alpha = __builtin_amdgcn_exp2f(-dm); m += dm; mnz = true;
                l *= alpha;
#pragma unroll
                for (int dt = 0; dt < DV / 32; ++dt) O[dt] *= alpha;
#pragma unroll
                for (int i = 0; i < 16; ++i) { S0[i] -= dm; S1[i] -= dm; }
            }
            float ps = 0.f;
#pragma unroll
            for (int i = 0; i < 16; ++i) { S0[i] = __builtin_amdgcn_exp2f(S0[i]); S1[i] = __builtin_amdgcn_exp2f(S1[i]); ps += S0[i] + S1[i]; }
            l += ps;
#pragma unroll
            for (int half = 0; half < 2; ++half)
#pragma unroll
                for (int s = 0; s < 2; ++s) {
                    const f32x16& S = half ? S1 : S0;
                    u32x4 pw; pw.x = pk2(S[8 * s], S[8 * s + 1]); pw.y = pk2(S[8 * s + 2], S[8 * s + 3]); pw.z = pk2(S[8 * s + 4], S[8 * s + 5]); pw.w = pk2(S[8 * s + 6], S[8 * s + 7]);
                    const bf16x8 pf = __builtin_bit_cast(bf16x8, pw);
                    LAS unsigned char* vr = vb + vtr + (32 * half + 16 * s) * VROW;
#pragma unroll
                    for (int dt = 0; dt < DV / 32; ++dt) {
                        const bf16x8 vf = cat4(trread(vr + 64 * dt), trread(vr + 8 * VROW + 64 * dt));
                        O[dt] = mfma32(vf, pf, O[dt]);
                    }
                }
        }
        if (!JOINT && kt <= myc) {
            LAS unsigned char* kb = lds + (kt & 1) * STG; LAS unsigned char* vb = kb + 64 * KROW;
            const bool far = (kt * 64 + 63 - q0w <= -91);
#pragma unroll 1
            for (int half = 0; half < 2; ++half) {
                f32x16 S;
#pragma unroll
                for (int i = 0; i < 16; ++i) S[i] = 0.f;
#pragma unroll
                for (int s = 0; s < DQK / 16; ++s) {
                    const bf16x8 kf = *(LAS const bf16x8*)(kb + koff + 32 * half * KROW + 32 * s);
                    S = mfma32(kf, qf[s], S);
                }
                if (BIAS && !far) {
                    const int rb = kt * 64 + 32 * half - (q0w + l32) + 128;
#pragma unroll
                    for (int i = 0; i < 16; ++i) { const int i0 = rb + crow(i, hh); S[i] += btab[i0 < 0 ? 0 : i0]; }
                }
                if (mnz) {
#pragma unroll
                    for (int i = 0; i < 16; ++i) S[i] -= m;
                }
                float mx = S[0];
#pragma unroll
                for (int i = 1; i < 16; ++i) mx = fmaxf(mx, S[i]);
                mx = fmaxf(mx, __shfl_xor(mx, 32));
                const bool first = (kt == 0 && half == 0);
                if (__any(mx > 64.f || (first && mx < -64.f))) {
                    const float dm = (mx > 64.f || (first && mx < -64.f)) ? mx : 0.f, alpha = __builtin_amdgcn_exp2f(-dm); m += dm; mnz = true;
                    l *= alpha;
#pragma unroll
                    for (int dt = 0; dt < DV / 32; ++dt) O[dt] *= alpha;
#pragma unroll
                    for (int i = 0; i < 16; ++i) S[i] -= dm;
                }
                float ps = 0.f;
#pragma unroll
                for (int i = 0; i < 16; ++i) { S[i] = __builtin_amdgcn_exp2f(S[i]); ps += S[i]; }
                l += ps;
#pragma unroll
                for (int s = 0; s < 2; ++s) {
                    u32x4 pw; pw.x = pk2(S[8 * s], S[8 * s + 1]); pw.y = pk2(S[8 * s + 2], S[8 * s + 3]); pw.z = pk2(S[8 * s + 4], S[8 * s + 5]); pw.w = pk2(S[8 * s + 6], S[8 * s + 7]);
                    const bf16x8 pf = __builtin_bit_cast(bf16x8, pw);
                    LAS unsigned char* vr = vb + vtr + (32 * half + 16 * s) * VROW;
#pragma unroll
                    for (int dt = 0; dt < DV / 32; ++dt) {
                        const bf16x8 vf = cat4(trread(vr + 64 * dt), trread(vr + 8 * VROW + 64 * dt));
                        O[dt] = mfma32(vf, pf, O[dt]);
                    }
                }
            }
        }
        if (kt + 1 < nkt) lstore((kt + 1) & 1);
        __syncthreads();
    }
    l += __shfl_xor(l, 32);
    const float il = 1.f / l;
#pragma unroll
    for (int dt = 0; dt < DV / 32; ++dt) O[dt] *= il;
}

DI void phase_attn_a(const Params& p, LAS unsigned char* lds) {
    const bf16_t* big = (const bf16_t*)(p.ws + ACT); bf16_t* y = (bf16_t*)(p.ws + HBUF); const float* tbg = (const float*)(p.ws + X_BIAS);
    const int tid = otid(), wid = tid >> 6, lane = tid & 63, l32 = lane & 31, hh = lane >> 5;
    constexpr int STG = 64 * (64 * 2 + 16 + 128 * 2 + 64);
    float d0 = 0.f, d1 = 0.f;
    for (int i = 0; i < 64; ++i) { d0 += p.in[5][i] * p.in[5][64 + i]; d1 += p.in[5][128 + i] * p.in[5][192 + i]; }
    const float lam_init = 0.2f, lam = __expf(d0) - __expf(d1) + lam_init;
    for (int pr = blockIdx.x; pr < 512; pr += gridDim.x) {
        const int bi = pr & 255, bh = (gridDim.x == 256) ? (bi & 7) + 8 * (bi >> 6) + 32 * (pr >> 8) : pr >> 3, j = (gridDim.x == 256) ? (bi >> 3) & 7 : pr & 7, b = bh >> 4, h = bh & 15;
        for (int half = 0; half < 2; ++half) {
            const int qb = half ? 15 - j : j;
            __syncthreads();
            if (tid < 192) ((LAS float*)(lds + 2 * STG))[tid] = tbg[h * 192 + tid];
            const size_t tok0 = (size_t)b * SEQ, tokq = tok0 + qb * 256 + wid * 32 + l32;
            f32x16 Oa[4]; LAS unsigned* Op = (LAS unsigned*)(lds + 2 * STG + 1024) + wid * 2048 + lane;
            attn_core<64, 8, 128, true, true>(lds, big + tokq * 8192 + h * 128, big + tok0 * 8192 + 2048 + h * 128, 8192, nullptr, 0, big + tok0 * 8192 + 4096 + h * 128, 8192, qb, wid, lane, nullptr, Oa);
#pragma unroll
            for (int dt = 0; dt < 4; ++dt)
#pragma unroll
                for (int i = 0; i < 8; ++i) Op[(dt * 8 + i) * 64] = pk2(Oa[dt][2 * i], Oa[dt][2 * i + 1]);
            attn_core<64, 8, 128, true, true>(lds, big + tokq * 8192 + h * 128 + 64, big + tok0 * 8192 + 2048 + h * 128 + 64, 8192, nullptr, 0, big + tok0 * 8192 + 4096 + h * 128, 8192, qb, wid, lane, nullptr, Oa);
            float ss = 0.f;
#pragma unroll
            for (int dt = 0; dt < 4; ++dt)
#pragma unroll
                for (int i = 0; i < 16; ++i) { const unsigned ow = Op[(dt * 8 + (i >> 1)) * 64]; const float o0 = (i & 1) ? __uint_as_float(ow & 0xffff0000u) : __uint_as_float(ow << 16);
                    const float o = o0 - lam * Oa[dt][i]; Oa[dt][i] = o; ss += o * o; }
            ss += __shfl_xor(ss, 32);
            const float sc = rsqrtf(ss * (1.f / 128.f) + EPS) * (1.f - lam_init);
#pragma unroll
            for (int dt = 0; dt < 4; ++dt)
#pragma unroll
                for (int g4 = 0; g4 < 4; ++g4) { const int dv = 32 * dt + 8 * g4 + 4 * hh;
                    const u32x2 gw = *(const u32x2*)(big + tokq * 8192 + 6144 + h * 128 + dv);
                    const f32x4 sg = *(const f32x4*)(p.in[6] + dv);
                    const float g0 = __uint_as_float(gw.x << 16), g1 = __uint_as_float(gw.x & 0xffff0000u), g2 = __uint_as_float(gw.y << 16), g3 = __uint_as_float(gw.y & 0xffff0000u);
                    u32x2 w; w.x = pk2(Oa[dt][4 * g4] * sc * sg[0] * silu(g0), Oa[dt][4 * g4 + 1] * sc * sg[1] * silu(g1));
                    w.y = pk2(Oa[dt][4 * g4 + 2] * sc * sg[2] * silu(g2), Oa[dt][4 * g4 + 3] * sc * sg[3] * silu(g3));
                    *(u32x2*)(y + tokq * DM + h * 128 + dv) = w; }
        }
    }
}

DI void phase_attn_d(const Params& p, LAS unsigned char* lds) {
    const bf16_t* qkv = (const bf16_t*)(p.ws + ACT); const bf16_t* lat = (const bf16_t*)(p.ws + LAT); const bf16_t* gb = (const bf16_t*)(p.ws + HBUF);
    bf16_t* y = (bf16_t*)(p.ws + HBUF);
    for (int pr = blockIdx.x; pr < 512; pr += gridDim.x) {
        const int bi = pr & 255, bh = (gridDim.x == 256) ? (bi & 7) + 8 * (bi >> 6) + 32 * (pr >> 8) : pr >> 3, j = (gridDim.x == 256) ? (bi >> 3) & 7 : pr & 7, b = bh >> 4, h = bh & 15;
        for (int half = 0; half < 2; ++half) {
            const int qb = half ? 15 - j : j;
            __syncthreads();
            const int tid = otid(), wid = tid >> 6, lane = tid & 63, l32 = lane & 31;
            const size_t tok0 = (size_t)b * SEQ, tokq = tok0 + qb * 256 + wid * 32 + l32;
            f32x16 O[4];
            attn_core<192, 16, 128, false, true>(lds, qkv + tokq * 7168 + h * 192, qkv + tok0 * 7168 + 3072 + h * 256, 7168, lat + tok0 * 1088 + 1024, 1088,
                                           qkv + tok0 * 7168 + 3072 + h * 256 + 128, 7168, qb, wid, lane, p.in[27], O);
            const int tid2 = otid(), wid2 = tid2 >> 6, lane2 = tid2 & 63;
            const size_t tokq2 = (size_t)b * SEQ + qb * 256 + wid2 * 32 + (lane2 & 31); const int hh2 = lane2 >> 5;
#pragma unroll
            for (int dt = 0; dt < 4; ++dt)
#pragma unroll
                for (int g4 = 0; g4 < 4; ++g4) { const int dv = 32 * dt + 8 * g4 + 4 * hh2;
                    const u32x2 gw = *(const u32x2*)(gb + tokq2 * DM + h * 128 + dv);
                    const float g0 = __uint_as_float(gw.x << 16), g1 = __uint_as_float(gw.x & 0xffff0000u), g2 = __uint_as_float(gw.y << 16), g3 = __uint_as_float(gw.y & 0xffff0000u);
                    u32x2 w; w.x = pk2(O[dt][4 * g4] * silu(g0), O[dt][4 * g4 + 1] * silu(g1)); w.y = pk2(O[dt][4 * g4 + 2] * silu(g2), O[dt][4 * g4 + 3] * silu(g3));
                    *(u32x2*)(y + tokq2 * DM + h * 128 + dv) = w; }
        }
    }
}

DI void phase_gla_prep(const Params& p, LAS unsigned char* lds) {
    bf16_t* big = (bf16_t*)(p.ws + ACT); float* total = (float*)(p.ws + GLA_TOT);
    LAS float* lrs = (LAS float*)lds;
    const int tid = otid(), ch0 = tid * 2;
    float wg0[16], wg1[16];
#pragma unroll
    for (int r = 0; r < 16; ++r) { wg0[r] = p.in[9][r * 1024 + ch0]; wg1[r] = p.in[9][r * 1024 + ch0 + 1]; }
    const float bs0 = p.in[10][ch0], bs1 = p.in[10][ch0 + 1];
    for (int u = blockIdx.x; u < 256; u += gridDim.x) {
        const size_t tokb = (size_t)u * 64;
        __syncthreads();
        {
            LAS bf16_t* wl = (LAS bf16_t*)(lds + 8192);
            LAS float* part = (LAS float*)(lds + 4096);
            const bf16_t* wsrc = (const bf16_t*)(p.ws + W_B_IN) + (size_t)6144 * 2048;
#pragma unroll
            for (int i = 0; i < 8; ++i) { const int c = tid + i * 512; *(LAS u32x4*)(wl + (c >> 8) * 2056 + (c & 255) * 8) = *(const u32x4*)(wsrc + (size_t)c * 8); }
            __syncthreads();
            const int w = tid >> 6, lane = tid & 63, i16 = lane & 15, quad = lane >> 4, mt = w & 3, kh = w >> 2;
            const bf16_t* xr = (const bf16_t*)(p.ws + XG) + (tokb + 16 * mt + i16) * DM + kh * 1024 + 8 * quad;
            f32x4 acc = {0.f, 0.f, 0.f, 0.f};
#pragma unroll 8
            for (int ks = 0; ks < 32; ++ks) {
                const bf16x8 a = *(const bf16x8*)(xr + 32 * ks);
                const bf16x8 bb = *(LAS const bf16x8*)(wl + i16 * 2056 + kh * 1024 + 32 * ks + 8 * quad);
                acc = __builtin_amdgcn_mfma_f32_16x16x32_bf16(a, bb, acc, 0, 0, 0);
            }
            if (kh == 1) {
#pragma unroll
                for (int j = 0; j < 4; ++j) part[(16 * mt + 4 * quad + j) * 16 + i16] = acc[j]; }
            __syncthreads();
            if (kh == 0) {
#pragma unroll
                for (int j = 0; j < 4; ++j) { const int tok = 16 * mt + 4 * quad + j;
                    const float rs = rsqrtf(((const float*)(p.ws + X_SSQ))[tokb + tok] * (1.f / DM) + EPS);
                    lrs[tok * 16 + i16] = (acc[j] + part[tok * 16 + i16]) * rs; } }
        }
        __syncthreads();
        float t0 = 0.f, t1 = 0.f;
        for (int tg = 3; tg >= 0; --tg) {
            unsigned kw[16];
#pragma unroll
            for (int i = 0; i < 16; ++i) kw[i] = *(const unsigned*)(big + (tokb + tg * 16 + i) * 6400 + 1024 + ch0);
#pragma unroll
            for (int i = 15; i >= 0; --i) { const int tok = tg * 16 + i;
                float z0 = bs0, z1 = bs1;
#pragma unroll
                for (int r = 0; r < 16; ++r) { const float lv = lrs[tok * 16 + r]; z0 += lv * wg0[r]; z1 += lv * wg1[r]; }
                *(unsigned*)(big + (tokb + tok) * 6400 + 1024 + ch0) = pk2(__uint_as_float(kw[i] << 16) * __expf(t0), __uint_as_float(kw[i] & 0xffff0000u) * __expf(t1));
                t0 += (fminf(z0, 0.f) - __logf(1.f + __expf(-fabsf(z0)))) * (1.f / 16.f); t1 += (fminf(z1, 0.f) - __logf(1.f + __expf(-fabsf(z1)))) * (1.f / 16.f);
            }
        }
        total[(size_t)u * 1024 + ch0] = t0; total[(size_t)u * 1024 + ch0 + 1] = t1;
    }
}

DI void phase_gla_scan(const Params& p, LAS unsigned char* lds) {
    const bf16_t* big = (const bf16_t*)(p.ws + ACT); const float* total = (const float*)(p.ws + GLA_TOT); bf16_t* ob = (bf16_t*)(p.ws + HBUF);
    constexpr int KR = 576, VR = 64, SR = 528, SET = 64 * KR + 64 * VR + 1024  , ST_OFF = 2 * SET, STB = 32 * SR;
    const int tid = otid(), w = tid >> 6, lane = tid & 63, l32 = lane & 31, hh = lane >> 5, i16 = lane & 15, tq = i16 >> 2, tp = i16 & 3, blk = (lane >> 4) & 1, quad = lane >> 4;
    const int mt = w >> 1, nt = w & 1;
    for (int u = blockIdx.x; u < 256; u += gridDim.x) {
        const int ux = (gridDim.x == 256) ? ((u & 7) * 2 + (u >> 7)) * 16 + ((u >> 3) & 15) : u;
        const int b = ux >> 6, h = (ux >> 4) & 3, vs = ux & 15;
        const size_t tok0 = (size_t)b * SEQ;
        f32x16 st;
#pragma unroll
        for (int i = 0; i < 16; ++i) st[i] = 0.f;
        u32x4 rkA[4], rvA, rkB[4], rvB; float rtA = 0.f, rtB = 0.f; bf16x8 qa[8], qn[8];
        rvA = (u32x4){0u, 0u, 0u, 0u}; rvB = rvA;
        unsigned offk[4];
#pragma unroll
        for (int i = 0; i < 4; ++i) { const int idx = tid + i * 512, row = idx >> 5, cc = idx & 31; offk[i] = (unsigned)((row * 6400 + 1024 + h * 256 + cc * 8) * 2); }
        const unsigned offv = (unsigned)(((tid >> 2) * 6400 + 2048 + h * 512 + vs * 32 + (tid & 3) * 8) * 2);
        const unsigned offq = (unsigned)(((16 * mt + i16) * 6400 + h * 256 + 8 * quad) * 2);
        auto gload = [&](int c, u32x4 (&rk)[4], u32x4& rv, float& rt) {
            const char* cb = (const char*)(big + (tok0 + (size_t)c * 64) * 6400);
#pragma unroll
            for (int i = 0; i < 4; ++i) rk[i] = *(const u32x4*)(cb + offk[i]);
            if (tid < 256) { rv = *(const u32x4*)(cb + offv); rt = total[(size_t)(b * 64 + c) * 1024 + h * 256 + tid]; }
        };
        auto lstore = [&](int buf, const u32x4 (&rk)[4], const u32x4& rv, const float& rt) {
            LAS unsigned char* sb = lds + buf * SET;
#pragma unroll
            for (int i = 0; i < 4; ++i) { const int idx = tid + i * 512, row = idx >> 5, cc = idx & 31; *(LAS u32x4*)(sb + row * KR + cc * 16) = rk[i]; }
            if (tid < 256) { const int row = tid >> 2, cc = tid & 3; *(LAS u32x4*)(sb + 64 * KR + row * VR + cc * 16) = rv; ((LAS float*)(sb + 64 * KR + 64 * VR))[tid] = __expf(rt); }
        };
        auto qload = [&](int c, bf16x8 (&q)[8]) {
            const char* cb = (const char*)(big + (tok0 + (size_t)c * 64) * 6400) + offq;
#pragma unroll
            for (int ks = 0; ks < 8; ++ks) q[ks] = *(const bf16x8*)(cb + 64 * ks);
        };
        auto step = [&](int c, const bf16x8 (&qc)[8]) {
            LAS unsigned char* sb = lds + (c & 1) * SET; LAS unsigned char* stb = lds + ST_OFF + (c & 1) * STB;
#pragma unroll
            for (int g = 0; g < 4; ++g) { const f32x4 e = *(LAS const f32x4*)(sb + 64 * KR + 64 * VR + (32 * w + 8 * g + 4 * hh) * 4);
                st[4 * g] *= e[0]; st[4 * g + 1] *= e[1]; st[4 * g + 2] *= e[2]; st[4 * g + 3] *= e[3]; }
#pragma unroll
            for (int sx = 0; sx < 4; ++sx) {
                LAS unsigned char* ka = sb + (16 * sx + 8 * hh + tq) * KR + (32 * w + 16 * blk + 4 * tp) * 2;
                LAS unsigned char* va = sb + 64 * KR + (16 * sx + 8 * hh + tq) * VR + (16 * blk + 4 * tp) * 2;
                const bf16x8 af = cat4(trread(ka), trread(ka + 4 * KR)), bfv = cat4(trread(va), trread(va + 4 * VR));
                st = mfma32(af, bfv, st);
            }
#pragma unroll
            for (int g = 0; g < 4; ++g) { u32x2 wv; wv.x = pk2(st[4 * g], st[4 * g + 1]); wv.y = pk2(st[4 * g + 2], st[4 * g + 3]);
                *(LAS u32x2*)(stb + l32 * SR + (32 * w + 8 * g + 4 * hh) * 2) = wv; }
            asm volatile("s_waitcnt lgkmcnt(0)" ::: "memory");
            __builtin_amdgcn_s_barrier();
            asm volatile("" ::: "memory");
            f32x4 acc = {0.f, 0.f, 0.f, 0.f};
#pragma unroll
            for (int ks = 0; ks < 8; ++ks) {
                const bf16x8 bb = *(LAS const bf16x8*)(stb + (16 * nt + i16) * SR + (32 * ks + 8 * quad) * 2);
                acc = __builtin_amdgcn_mfma_f32_16x16x32_bf16(qc[ks], bb, acc, 0, 0, 0);
            }
#pragma unroll
            for (int jj = 0; jj < 4; ++jj) ob[(tok0 + c * 64 + 16 * mt + quad * 4 + jj) * DM + h * 512 + vs * 32 + 16 * nt + i16] = f2bf(acc[jj] * (1.f / 16.f));
        };
        __syncthreads();
        gload(0, rkA, rvA, rtA); lstore(0, rkA, rvA, rtA);
        gload(1, rkA, rvA, rtA); gload(2, rkB, rvB, rtB); qload(0, qa); qload(1, qn);
        __syncthreads();
        for (int c = 0; c < 64; c += 2) {
            lstore((c + 1) & 1, rkA, rvA, rtA);
            if (c + 3 < 64) gload(c + 3, rkA, rvA, rtA);
            step(c, qa);
            if (c + 2 < 64) qload(c + 2, qa);
            if (c + 2 < 64) lstore(c & 1, rkB, rvB, rtB);
            if (c + 4 < 64) gload(c + 4, rkB, rvB, rtB);
            step(c + 1, qn);
            if (c + 3 < 64) qload(c + 3, qn);
        }
    }
}

DI void phase_gla_post(const Params& p) {
    const bf16_t* big = (const bf16_t*)(p.ws + ACT); bf16_t* y = (bf16_t*)(p.ws + HBUF);
    const int tid = otid(), lane = tid & 63, gw = blockIdx.x * 8 + (tid >> 6), nw = gridDim.x * 8;
    float og[8];
#pragma unroll
    for (int e = 0; e < 8; ++e) og[e] = p.in[11][lane * 8 + e];
    for (int row = gw; row < MTOK; row += 2 * nw) {
        u32x4 wo[2][4], wg[2][4]; bool ok[2]; size_t rr[2];
#pragma unroll
        for (int r = 0; r < 2; ++r) { ok[r] = row + r * nw < MTOK; rr[r] = ok[r] ? (size_t)(row + r * nw) : (size_t)row;
#pragma unroll
            for (int hd = 0; hd < 4; ++hd) { wo[r][hd] = *(const u32x4*)(y + rr[r] * DM + hd * 512 + lane * 8); wg[r][hd] = *(const u32x4*)(big + rr[r] * 6400 + 4096 + hd * 512 + lane * 8); } }
#pragma unroll
        for (int r = 0; r < 2; ++r)
#pragma unroll
            for (int hd = 0; hd < 4; ++hd) {
                float f[8], g[8]; unpack8(wo[r][hd], f); unpack8(wg[r][hd], g);
                float ss = 0.f;
#pragma unroll
                for (int e = 0; e < 8; ++e) ss += f[e] * f[e];
                ss = wsum(ss); const float sc = rsqrtf(ss * (1.f / 512.f) + EPS);
#pragma unroll
                for (int e = 0; e < 8; ++e) f[e] = f[e] * sc * og[e] * silu(g[e]);
                if (ok[r]) *(u32x4*)(y + rr[r] * DM + hd * 512 + lane * 8) = pack8(f);
            }
    }
}

DI void phase_conv(const Params& p) {
    const bf16_t* big = (const bf16_t*)(p.ws + ACT); bf16_t* xc = (bf16_t*)(p.ws + HBUF);
    for (size_t idx = (size_t)blockIdx.x * 512 + otid(); idx < (size_t)(MTOK / 8) * 256; idx += (size_t)gridDim.x * 512) {
        const int tok0 = (int)(idx >> 8) * 8, ch = (int)(idx & 255) * 8, t0 = tok0 & (SEQ - 1);
        float wv[4][8], bs[8];
        { const f32x4 b0 = *(const f32x4*)(p.in[15] + ch), b1 = *(const f32x4*)(p.in[15] + ch + 4);
#pragma unroll
          for (int e = 0; e < 4; ++e) { bs[e] = b0[e]; bs[4 + e] = b1[e]; } }
#pragma unroll
        for (int jx = 0; jx < 4; ++jx) { const f32x4 w0 = *(const f32x4*)(p.in[14] + jx * 2048 + ch), w1 = *(const f32x4*)(p.in[14] + jx * 2048 + ch + 4);
#pragma unroll
            for (int e = 0; e < 4; ++e) { wv[jx][e] = w0[e]; wv[jx][4 + e] = w1[e]; } }
        u32x4 raw[11];
#pragma unroll
        for (int r = 0; r < 11; ++r) raw[r] = (r >= 3 || t0 > 0) ? *(const u32x4*)(big + (size_t)(tok0 - 3 + r) * 4096 + ch) : (u32x4){0u, 0u, 0u, 0u};
#pragma unroll
        for (int o = 0; o < 8; ++o) {
            float acc[8];
#pragma unroll
            for (int e = 0; e < 8; ++e) acc[e] = bs[e];
#pragma unroll
            for (int jx = 0; jx < 4; ++jx) { float f[8]; unpack8(raw[o + jx], f);
#pragma unroll
                for (int e = 0; e < 8; ++e) acc[e] += f[e] * wv[jx][e]; }
            *(u32x4*)(xc + (size_t)(tok0 + o) * DM + ch) = pack8(acc);
        }
    }
}
DI void phase_lru_scan(const Params& p, LAS unsigned char* lds) {
    const unsigned* ax = (const unsigned*)(p.ws + ACT + 128 * MiB); const bf16_t* big = (const bf16_t*)(p.ws + ACT);
    bf16_t* y = (bf16_t*)(p.ws + HBUF);
    LAS unsigned* tile = (LAS unsigned*)lds;
    LAS float* sP = (LAS float*)(lds + 65536); LAS float* sH = sP + 512; LAS float* sC = sH + 512;
    const int tid = otid(), seg = tid >> 5, chl = tid & 31;
    for (int u = blockIdx.x; u < 256; u += gridDim.x) {
        const int b = u >> 6, ch = (u & 63) * 32 + chl;
        const size_t rowbase = (size_t)b * SEQ;
        unsigned pre[32];
#pragma unroll
        for (int i = 0; i < 32; ++i) pre[i] = ax[(rowbase + seg + 16 * i) * DM + ch];
        __syncthreads();
        if (tid < 32) sC[tid] = 0.f;
        for (int sc = 0; sc < 8; ++sc) {
#pragma unroll
            for (int i = 0; i < 32; ++i) tile[(seg + 16 * i) * 32 + chl] = pre[i];
            __syncthreads();
            if (sc + 1 < 8) {
#pragma unroll
                for (int i = 0; i < 32; ++i) pre[i] = ax[(rowbase + (sc + 1) * 512 + seg + 16 * i) * DM + ch];
            }
            float L = 0.f, H = 0.f;
#pragma unroll 8
            for (int t = 0; t < 32; ++t) { const unsigned w = tile[(seg * 32 + t) * 32 + chl]; const float la = __uint_as_float(w << 16); H = __expf(la) * H + __uint_as_float(w & 0xffff0000u); L += la; }
            sP[tid] = __expf(L); sH[tid] = H;
            __syncthreads();
            float hc = sC[chl];
            for (int sg = 0; sg < seg; ++sg) hc = sP[sg * 32 + chl] * hc + sH[sg * 32 + chl];
            const size_t r0 = rowbase + sc * 512 + seg * 32;
#pragma unroll 8
            for (int t = 0; t < 32; ++t) { const unsigned w = tile[(seg * 32 + t) * 32 + chl]; hc = __expf(__uint_as_float(w << 16)) * hc + __uint_as_float(w & 0xffff0000u);
                y[(r0 + t) * DM + ch] = f2bf(hc * silu(bf2f(big[(r0 + t) * 4096 + 2048 + ch]))); }
            __syncthreads();
            if (seg == 15) sC[chl] = hc;
        }
    }
}

DI void phase_mla_lat(const Params& p) {
    bf16_t* lat = (bf16_t*)(p.ws + LAT);
    const int tid = otid(), lane = tid & 63, gw = blockIdx.x * 8 + (tid >> 6), nw = gridDim.x * 8;
    float gq[8], gk[8];
#pragma unroll
    for (int e = 0; e < 8; ++e) { gq[e] = p.in[23][lane * 8 + e]; gk[e] = p.in[24][lane * 8 + e]; }
    const float inv = powf(10000.f, -(float)(lane & 31) * (1.f / 32.f));
    const float g1 = p.in[27][192 + 128 + (lane & 31)], g2 = p.in[27][192 + 160 + (lane & 31)];
    for (int row = gw; row < MTOK; row += nw) {
#pragma unroll
        for (int part = 0; part < 2; ++part) {
            bf16_t* ptr = lat + (size_t)row * 1088 + part * 512 + lane * 8; float f[8]; unpack8(*(const u32x4*)ptr, f);
            float ss = 0.f;
#pragma unroll
            for (int e = 0; e < 8; ++e) ss += f[e] * f[e];
            ss = wsum(ss); const float sc = rsqrtf(ss * (1.f / 512.f) + EPS);
#pragma unroll
            for (int e = 0; e < 8; ++e) f[e] = f[e] * sc * (part ? gk[e] : gq[e]);
            *(u32x4*)ptr = pack8(f);
        }
        { bf16_t* kp = lat + (size_t)row * 1088 + 1024; const int i = lane & 31;
          const float x1 = bf2f(kp[i]), x2 = bf2f(kp[i + 32]);
          float ss = (lane < 32) ? x1 * x1 + x2 * x2 : 0.f; ss = wsum(ss); const float sc = rsqrtf(ss * (1.f / 64.f) + EPS);
          const float a1 = x1 * sc * g1, a2 = x2 * sc * g2; float sn, cs; sincosf((float)(row & (SEQ - 1)) * inv, &sn, &cs);
          if (lane < 32) { kp[i] = f2bf(a1 * cs - a2 * sn); kp[i + 32] = f2bf(a2 * cs + a1 * sn); } }
    }
}
DI void phase_mla_qk(const Params& p) {
    bf16_t* qkv = (bf16_t*)(p.ws + ACT); bf16_t* lat = (bf16_t*)(p.ws + LAT); const float* qkg = p.in[27];
    const int tid = otid(), lane = tid & 63, gw = blockIdx.x * 8 + (tid >> 6), nw = gridDim.x * 8;
    const int l16 = lane & 15, l8 = lane & 7;
    float gk[8], gkr[8];
#pragma unroll
    for (int e = 0; e < 8; ++e) { gk[e] = qkg[192 + l16 * 8 + e]; gkr[e] = qkg[192 + 128 + l8 * 8 + e]; }
    float inv[8];
#pragma unroll
    for (int e = 0; e < 8; ++e) inv[e] = powf(10000.f, -(float)((l8 & 3) * 8 + e) * (1.f / 32.f));
    for (int row0 = gw; row0 < MTOK; row0 += 2 * nw) {
        u32x4 wk[2][4], wp[2]; bool ok[2]; int rw[2];
#pragma unroll
        for (int r = 0; r < 2; ++r) { ok[r] = row0 + r * nw < MTOK; rw[r] = ok[r] ? row0 + r * nw : row0;
            const bf16_t* qr = qkv + (size_t)rw[r] * 7168;
#pragma unroll
            for (int i = 0; i < 4; ++i) { const int head = 4 * i + (lane >> 4); wk[r][i] = *(const u32x4*)(qr + 3072 + head * 256 + l16 * 8); }
            wp[r] = *(const u32x4*)(lat + (size_t)rw[r] * 1088 + 1024 + l8 * 8); }
#pragma unroll
        for (int r = 0; r < 2; ++r) {
            bf16_t* qr = qkv + (size_t)rw[r] * 7168; bf16_t* kpp = lat + (size_t)rw[r] * 1088 + 1024 + l8 * 8;
            const float pos = (float)(rw[r] & (SEQ - 1));
#pragma unroll
            for (int i = 0; i < 4; ++i) {
                const int head = 4 * i + (lane >> 4);
                float f[8]; unpack8(wk[r][i], f); float ss = 0.f;
#pragma unroll
                for (int e = 0; e < 8; ++e) ss += f[e] * f[e];
                ss += __shfl_xor(ss, 1); ss += __shfl_xor(ss, 2); ss += __shfl_xor(ss, 4); ss += __shfl_xor(ss, 8);
                const float sc = rsqrtf(ss * (1.f / 128.f) + EPS);
#pragma unroll
                for (int e = 0; e < 8; ++e) f[e] *= sc * gk[e];
                if (ok[r]) *(u32x4*)(qr + 3072 + head * 256 + l16 * 8) = pack8(f);
            }
            { float f[8], o[8]; unpack8(wp[r], f); float ss = 0.f;
#pragma unroll
              for (int e = 0; e < 8; ++e) ss += f[e] * f[e];
              ss += __shfl_xor(ss, 1); ss += __shfl_xor(ss, 2); ss += __shfl_xor(ss, 4);
              const float sc = rsqrtf(ss * (1.f / 64.f) + EPS);
#pragma unroll
              for (int e = 0; e < 8; ++e) {
                  const float a = f[e] * sc * gkr[e], pa = __shfl_xor(a, 4);
                  float sn, cs; sincosf(pos * inv[e], &sn, &cs);
                  o[e] = (l8 < 4) ? a * cs - pa * sn : a * cs + pa * sn;
              }
              if (ok[r] && lane < 8) *(u32x4*)kpp = pack8(o); }
        }
    }
}

#define XB_TMO      128
#define XB_XCNT(j)  (256  + 64 * (j))
#define XB_XSUB(j)  (1280 + 64 * (j))
#define XB_XGEN(j)  (2304 + 64 * (j))
#define XB_TOP      3328
#define XB_TOPGEN   3392
#define XCD_BAR_WORDS 3456
#define XB_SPIN_CAP (1u << 22)
DI unsigned xb_ld(unsigned* p)              { return __hip_atomic_load(p, __ATOMIC_RELAXED, __HIP_MEMORY_SCOPE_AGENT); }
DI unsigned xb_add(unsigned* p, unsigned v) { return __hip_atomic_fetch_add(p, v, __ATOMIC_RELAXED, __HIP_MEMORY_SCOPE_AGENT); }
DI unsigned xb_xcc_id() { return (unsigned)__builtin_amdgcn_s_getreg((3 << 11) | 20) & 0xFu; }
#define XB_SPIN(cond, bar) do { unsigned _sp = 0; while (cond) { __builtin_amdgcn_s_sleep(1); \
    if ((++_sp & 255u) == 0u) { if (xb_ld(&(bar)[XB_TMO])) break; if (_sp > XB_SPIN_CAP) { atomicAdd(&(bar)[XB_TMO], 1u); break; } } } } while (0)
struct XcdBarrier { unsigned* bar; unsigned x; volatile LAS unsigned* st; };
DI XcdBarrier xcd_barrier_post(unsigned* bar, volatile LAS unsigned* st) {
    XcdBarrier b; b.bar = bar; b.x = xb_xcc_id(); b.st = st;
    if (threadIdx.x == 0) (void)xb_add(&bar[XB_XCNT(b.x)], 1u);
    return b;
}
DI void xcd_barrier_complete(unsigned* bar, unsigned x, unsigned& nloc, unsigned& nx) {
    const unsigned G = gridDim.x * gridDim.y * gridDim.z;
    unsigned sum, cnt, mine, sp = 0u;
    for (;;) {
        sum = 0u; cnt = 0u; mine = 0u;
#pragma unroll
        for (unsigned j = 0; j < 16; ++j) { const unsigned c = xb_ld(&bar[XB_XCNT(j)]); sum += c; cnt += (c > 0u) ? 1u : 0u; mine = (j == x) ? c : mine; }
        if (sum == G) break;
        __builtin_amdgcn_s_sleep(1);
        if ((++sp & 255u) == 0u) { if (xb_ld(&bar[XB_TMO])) break; if (sp > XB_SPIN_CAP) { atomicAdd(&bar[XB_TMO], 1u); break; } }
    }
    nloc = mine > 0u ? mine : 1u; nx = cnt > 0u ? cnt : 1u;
}
DI void xcd_barrier(const XcdBarrier& b0) {
    asm volatile("s_waitcnt vmcnt(0)" ::: "memory");
    __syncthreads();
    if (otid() == 0) {
        XcdBarrier b; b.bar = b0.bar; b.st = b0.st; b.x = xb_xcc_id();
        unsigned* bar = b.bar;
        __builtin_amdgcn_s_waitcnt(0);
        unsigned nloc = b.st[0], nx = b.st[1];
        if (nloc == 0u) { xcd_barrier_complete(bar, b.x, nloc, nx); b.st[0] = nloc; b.st[1] = nx; }
        const unsigned old = xb_add(&bar[XB_XSUB(b.x)], 1u);
        const unsigned gen = old / nloc;
        if (old + 1u == (gen + 1u) * nloc) {
            __builtin_amdgcn_fence(__ATOMIC_RELEASE, "agent");
            asm volatile("s_waitcnt vmcnt(0)" ::: "memory");
            const unsigned og = xb_add(&bar[XB_TOP], 1u);
            const unsigned tg = og / nx;
            if (og + 1u == (tg + 1u) * nx) xb_add(&bar[XB_TOPGEN], 1u);
            else XB_SPIN(xb_ld(&bar[XB_TOPGEN]) == tg, bar);
            __builtin_amdgcn_fence(__ATOMIC_ACQUIRE, "agent");
            xb_add(&bar[XB_XGEN(b.x)], 1u);
            asm volatile("s_waitcnt vmcnt(0)" ::: "memory");
        } else {
            XB_SPIN(xb_ld(&bar[XB_XGEN(b.x)]) == gen, bar);
            __builtin_amdgcn_fence(__ATOMIC_ACQUIRE, "agent");
            asm volatile("s_waitcnt vmcnt(0)" ::: "memory");
        }
    }
    __syncthreads();
}

__global__ __launch_bounds__(512, 2) void mega(const Params p) {
    extern __shared__ __attribute__((aligned(16))) unsigned char shm[];
    LAS unsigned char* lds = (LAS unsigned char*)shm;
    cg::grid_group grid = cg::this_grid();
    volatile LAS unsigned* bst = (volatile LAS unsigned*)(lds + 131072 + 1024);
    if (threadIdx.x == 0) { bst[0] = 0u; bst[1] = 0u; }
    __syncthreads();
    XcdBarrier xb = xcd_barrier_post((unsigned*)(p.ws + WS_BAR), bst); xb.x = 0;
    if constexpr ((PHMASK >> 0) & 1) { phase_convert(p, lds); }
    if constexpr ((REPMASK >> 0) & 1) { __syncthreads(); phase_convert(p, lds); }
    if constexpr ((PHMASK >> 1) & 1) { phase_bias_table(p); }
    if constexpr ((REPMASK >> 1) & 1) { __syncthreads(); phase_bias_table(p); }
    if constexpr ((PHMASK >> 2) & 1) { phase_x0(p.in[0], (bf16_t*)(uni(p.ws) + XG), (float*)(uni(p.ws) + X_SSQ) + 5 * MTOK); }
    if constexpr ((REPMASK >> 2) & 1) { __syncthreads(); phase_rmsnorm(p.in[0], p.in[1], (bf16_t*)(uni(p.ws) + HBUF)); }
    if (p.njobs < 0) grid.sync();
    xcd_barrier(xb);
    if constexpr ((PHMASK >> 3) & 1) { { pg8::EpiStoreA E{(bf16_t*)(uni(p.ws) + ACT), p.in[4], (const float*)(uni(p.ws) + X_SSQ) + 5 * MTOK}; run_gemm<0>(lds, (const bf16_t*)(uni(p.ws) + XG), (const bf16_t*)(uni(p.ws) + W_A_IN), 8192, 2048, 2048, E); } }
    if constexpr ((REPMASK >> 3) & 1) { __syncthreads(); { pg8::EpiStoreA E{(bf16_t*)(uni(p.ws) + ACT), p.in[4], (const float*)(uni(p.ws) + X_SSQ) + 5 * MTOK}; run_gemm<0>(lds, (const bf16_t*)(uni(p.ws) + XG), (const bf16_t*)(uni(p.ws) + W_A_IN), 8192, 2048, 2048, E); } }
    xcd_barrier(xb);
    if constexpr ((PHMASK >> 5) & 1) { phase_attn_a(p, lds); }
    if constexpr ((REPMASK >> 5) & 1) { __syncthreads(); phase_attn_a(p, lds); }
    xcd_barrier(xb);
    if constexpr ((PHMASK >> 6) & 1) { { pg8::EpiResid<true, false, true, true> E{nullptr, (const bf16_t*)(uni(p.ws) + XG), nullptr, (bf16_t*)(uni(p.ws) + XG), (float*)(uni(p.ws) + X_SSQ)}; run_gemm<0>(lds, (bf16_t*)(uni(p.ws) + HBUF), (const bf16_t*)(uni(p.ws) + W_A_OUT), 2048, 2048, 2048, E); } }
    if constexpr ((REPMASK >> 6) & 1) { __syncthreads(); { pg8::EpiResid<true, false, true, true> E{nullptr, (const bf16_t*)(uni(p.ws) + XG), nullptr, (bf16_t*)(uni(p.ws) + XG), (float*)(uni(p.ws) + X_SSQ)}; run_gemm<0>(lds, (bf16_t*)(uni(p.ws) + HBUF), (const bf16_t*)(uni(p.ws) + W_A_OUT), 2048, 2048, 2048, E); } }
    xcd_barrier(xb);
    if constexpr ((PHMASK >> 8) & 1) { { pg8::EpiStore E{(bf16_t*)(uni(p.ws) + ACT), 6400, (const float*)(uni(p.ws) + X_SSQ)}; run_gemm<0>(lds, (const bf16_t*)(uni(p.ws) + XG), (const bf16_t*)(uni(p.ws) + W_B_IN), 6144, 2048, 2048, E); } }
    if constexpr ((REPMASK >> 8) & 1) { __syncthreads(); { pg8::EpiStore E{(bf16_t*)(uni(p.ws) + ACT), 6400, (const float*)(uni(p.ws) + X_SSQ)}; run_gemm<0>(lds, (const bf16_t*)(uni(p.ws) + XG), (const bf16_t*)(uni(p.ws) + W_B_IN), 6144, 2048, 2048, E); } }
    xcd_barrier(xb);
    if constexpr ((PHMASK >> 9) & 1) { phase_gla_prep(p, lds); }
    if constexpr ((REPMASK >> 9) & 1) { __syncthreads(); phase_gla_prep(p, lds); }
    xcd_barrier(xb);
    if constexpr ((PHMASK >> 10) & 1) { phase_gla_scan(p, lds); }
    if constexpr ((REPMASK >> 10) & 1) { __syncthreads(); phase_gla_scan(p, lds); }
    xcd_barrier(xb);
    if constexpr ((PHMASK >> 11) & 1) { phase_gla_post(p); }
    if constexpr ((REPMASK >> 11) & 1) { __syncthreads(); phase_gla_post(p); }
    xcd_barrier(xb);
    if constexpr ((PHMASK >> 12) & 1) { { pg8::EpiResid<true, false, true, true> E{nullptr, (const bf16_t*)(uni(p.ws) + XG), nullptr, (bf16_t*)(uni(p.ws) + XG), (float*)(uni(p.ws) + X_SSQ) + MTOK}; run_gemm<0>(lds, (bf16_t*)(uni(p.ws) + HBUF), (const bf16_t*)(uni(p.ws) + W_B_OUT), 2048, 2048, 2048, E); } }
    if constexpr ((REPMASK >> 12) & 1) { __syncthreads(); { pg8::EpiResid<true, false, true, true> E{nullptr, (const bf16_t*)(uni(p.ws) + XG), nullptr, (bf16_t*)(uni(p.ws) + XG), (float*)(uni(p.ws) + X_SSQ) + MTOK}; run_gemm<0>(lds, (bf16_t*)(uni(p.ws) + HBUF), (const bf16_t*)(uni(p.ws) + W_B_OUT), 2048, 2048, 2048, E); } }
    xcd_barrier(xb);
    if constexpr ((PHMASK >> 14) & 1) { { pg8::EpiStore E{(bf16_t*)(uni(p.ws) + ACT), 4096, (const float*)(uni(p.ws) + X_SSQ) + MTOK}; run_gemm<0>(lds, (const bf16_t*)(uni(p.ws) + XG), (const bf16_t*)(uni(p.ws) + W_C_IN), 4096, 2048, 2048, E); } }
    if constexpr ((REPMASK >> 14) & 1) { __syncthreads(); { pg8::EpiStore E{(bf16_t*)(uni(p.ws) + ACT), 4096, (const float*)(uni(p.ws) + X_SSQ) + MTOK}; run_gemm<0>(lds, (const bf16_t*)(uni(p.ws) + XG), (const bf16_t*)(uni(p.ws) + W_C_IN), 4096, 2048, 2048, E); } }
    xcd_barrier(xb);
    if constexpr ((PHMASK >> 15) & 1) { phase_conv(p); }
    if constexpr ((REPMASK >> 15) & 1) { __syncthreads(); phase_conv(p); }
    xcd_barrier(xb);
    if constexpr ((PHMASK >> 16) & 1) { { pg8::EpiGates E{(bf16_t*)(uni(p.ws) + HBUF), p.in[17], p.in[19], (const float*)(uni(p.ws) + X_SP8), (unsigned*)(uni(p.ws) + ACT + 128 * MiB)}; run_gemm<2>(lds, (bf16_t*)(uni(p.ws) + HBUF), (const bf16_t*)(uni(p.ws) + W_C_GATE), 4096, 256, 2048, E); } }
    if constexpr ((REPMASK >> 16) & 1) { __syncthreads(); { pg8::EpiGates E{(bf16_t*)(uni(p.ws) + HBUF), p.in[17], p.in[19], (const float*)(uni(p.ws) + X_SP8), (unsigned*)(uni(p.ws) + ACT + 128 * MiB)}; run_gemm<2>(lds, (bf16_t*)(uni(p.ws) + HBUF), (const bf16_t*)(uni(p.ws) + W_C_GATE), 4096, 256, 2048, E); } }
    xcd_barrier(xb);
    if constexpr ((PHMASK >> 17) & 1) { phase_lru_scan(p, lds); }
    if constexpr ((REPMASK >> 17) & 1) { __syncthreads(); phase_lru_scan(p, lds); }
    xcd_barrier(xb);
    if constexpr ((PHMASK >> 18) & 1) { { pg8::EpiResid<true, false, true, true> E{nullptr, (const bf16_t*)(uni(p.ws) + XG), nullptr, (bf16_t*)(uni(p.ws) + XG), (float*)(uni(p.ws) + X_SSQ) + 2 * MTOK}; run_gemm<0>(lds, (bf16_t*)(uni(p.ws) + HBUF), (const bf16_t*)(uni(p.ws) + W_C_OUT), 2048, 2048, 2048, E); } }
    if constexpr ((REPMASK >> 18) & 1) { __syncthreads(); { pg8::EpiResid<true, false, true, true> E{nullptr, (const bf16_t*)(uni(p.ws) + XG), nullptr, (bf16_t*)(uni(p.ws) + XG), (float*)(uni(p.ws) + X_SSQ) + 2 * MTOK}; run_gemm<0>(lds, (bf16_t*)(uni(p.ws) + HBUF), (const bf16_t*)(uni(p.ws) + W_C_OUT), 2048, 2048, 2048, E); } }
    xcd_barrier(xb);
    if constexpr ((PHMASK >> 20) & 1) { { pg8::EpiStoreD E{(bf16_t*)(uni(p.ws) + LAT), (bf16_t*)(uni(p.ws) + HBUF), (const float*)(uni(p.ws) + X_SSQ) + 2 * MTOK, (float*)(uni(p.ws) + X_SSQ) + 3 * MTOK}; run_gemm<0>(lds, (const bf16_t*)(uni(p.ws) + XG), (const bf16_t*)(uni(p.ws) + W_D_IN), 3328, 2048, 2048, E); } }
    if constexpr ((REPMASK >> 20) & 1) { __syncthreads(); { pg8::EpiStoreD E{(bf16_t*)(uni(p.ws) + LAT), (bf16_t*)(uni(p.ws) + HBUF), (const float*)(uni(p.ws) + X_SSQ) + 2 * MTOK, (float*)(uni(p.ws) + X_SSQ) + 3 * MTOK}; run_gemm<0>(lds, (const bf16_t*)(uni(p.ws) + XG), (const bf16_t*)(uni(p.ws) + W_D_IN), 3328, 2048, 2048, E); } }
    xcd_barrier(xb);
    if constexpr ((PHMASK >> 22) & 1) { { pg8::EpiStoreU E{(bf16_t*)(uni(p.ws) + ACT), (const float*)(uni(p.ws) + X_SSQ) + 3 * MTOK}; run_gemm<1>(lds, (const bf16_t*)(uni(p.ws) + LAT), (const bf16_t*)(uni(p.ws) + W_D_UQKV), 7168, 512, 1088, E); } }
    if constexpr ((REPMASK >> 22) & 1) { __syncthreads(); { pg8::EpiStoreU E{(bf16_t*)(uni(p.ws) + ACT), (const float*)(uni(p.ws) + X_SSQ) + 3 * MTOK}; run_gemm<1>(lds, (const bf16_t*)(uni(p.ws) + LAT), (const bf16_t*)(uni(p.ws) + W_D_UQKV), 7168, 512, 1088, E); } }
    xcd_barrier(xb);
    if constexpr ((PHMASK >> 23) & 1) { phase_mla_qk(p); }
    if constexpr ((REPMASK >> 23) & 1) { __syncthreads(); phase_mla_qk(p); }
    xcd_barrier(xb);
    if constexpr ((PHMASK >> 24) & 1) { phase_attn_d(p, lds); }
    if constexpr ((REPMASK >> 24) & 1) { __syncthreads(); phase_attn_d(p, lds); }
    xcd_barrier(xb);
    if constexpr ((PHMASK >> 25) & 1) { { pg8::EpiResid<true, true, false, false> E{nullptr, (const bf16_t*)(uni(p.ws) + XG), uni(p.out), nullptr, nullptr}; run_gemm<0>(lds, (bf16_t*)(uni(p.ws) + HBUF), (const bf16_t*)(uni(p.ws) + W_D_OUT), 2048, 2048, 2048, E); } }
    if constexpr ((REPMASK >> 25) & 1) { __syncthreads(); { pg8::EpiResid<true, true, false, false> E{nullptr, (const bf16_t*)(uni(p.ws) + XG), uni(p.out), nullptr, nullptr}; run_gemm<0>(lds, (bf16_t*)(uni(p.ws) + HBUF), (const bf16_t*)(uni(p.ws) + W_D_OUT), 2048, 2048, 2048, E); } }
#ifdef XSYNC
    for (int i = 0; i < XSYNC; ++i) xcd_barrier(xb);
#endif
}

extern "C" void kernel_launch(void* const* d_in, const int* in_sizes, int n_in, void* d_out, int out_size, void* d_ws, size_t ws_size, hipStream_t stream) {
    static int grid_blocks = 0;
    if (!grid_blocks) {
        int dev = 0, cus = 0, per_cu = 0;
        hipGetDevice(&dev);
        hipDeviceGetAttribute(&cus, hipDeviceAttributeMultiprocessorCount, dev);
        hipFuncSetAttribute((const void*)mega, hipFuncAttributeMaxDynamicSharedMemorySize, LDS_BYTES);
        hipOccupancyMaxActiveBlocksPerMultiprocessor(&per_cu, (const void*)mega, 512, LDS_BYTES);
        if (per_cu < 1) per_cu = 1;
        grid_blocks = cus * per_cu;
        if (ws_size < EXTRA + 65536 + 6 * 65536) fprintf(stderr, "kernel_launch: workspace too small (%zu < %zu)\n", ws_size, (size_t)WS_END);
    }
    Params p; memset(&p, 0, sizeof(p));
    for (int i = 0; i < 29; ++i) p.in[i] = (const float*)d_in[i];
    p.out = (float*)d_out; p.ws = (unsigned char*)d_ws;
    unsigned char* ws = (unsigned char*)d_ws;
    int nj = 0, tiles = 0;
    auto add = [&](const float* src, size_t dst_off, int K, int N, int ldw, int npad) {
        TJob& j = p.jobs[nj++]; j.src = src; j.dst = (bf16_t*)(ws + dst_off); j.kscale = nullptr; j.K = K; j.N = N; j.ldw = ldw; j.ntn = npad / 64; j.tile0 = tiles; j.pad = 0; tiles += (npad / 64) * (K / 256);
    };
    add(p.in[3], W_A_IN, 2048, 8192, 8192, 8192); p.jobs[0].pad = 1; p.jobs[0].kscale = p.in[1];
    add(p.in[7], W_A_OUT, 2048, 2048, 2048, 2048);
    add(p.in[8], W_B_IN, 2048, 6160, 6160, 6400); p.jobs[nj - 1].kscale = p.in[1] + 2048;
    add(p.in[12], W_B_OUT, 2048, 2048, 2048, 2048);
    add(p.in[13], W_C_IN, 2048, 4096, 4096, 4096); p.jobs[nj - 1].kscale = p.in[1] + 4096;
    add(p.in[21], W_C_OUT, 2048, 2048, 2048, 2048);
    add(p.in[22], W_D_IN, 2048, 3136, 3136, 3328); p.jobs[nj - 1].kscale = p.in[1] + 6144;
    add(p.in[25], W_D_UQKV, 512, 3072, 3072, 3072); p.jobs[nj - 1].kscale = p.in[23];
    add(p.in[26], W_D_UQKV + (size_t)3072 * 512 * 2, 512, 4096, 4096, 4096); p.jobs[nj - 1].kscale = p.in[24];
    add(p.in[28], W_D_OUT, 2048, 2048, 2048, 2048);
    for (int n = 0; n < 8; ++n) for (int half = 0; half < 2; ++half) for (int bj = 0; bj < 2; ++bj)
        add(p.in[bj ? 18 : 16] + (size_t)n * 65536 + half * 128, W_C_GATE + ((size_t)((n * 2 + half) * 256 + 128 * bj)) * 256 * 2, 256, 128, 256, 128);
    p.njobs = nj; p.ntiles = tiles;
    hipMemsetAsync(ws + WS_BAR, 0, XCD_BAR_WORDS * 4, stream);
    void* args[] = {(void*)&p};
    hipError_t e = hipLaunchCooperativeKernel((const void*)mega, dim3(grid_blocks), dim3(512), args, LDS_BYTES, stream);
    if (e != hipSuccess) fprintf(stderr, "cooperative launch failed: %s (grid %d)\n", hipGetErrorString(e), grid_blocks);
}
```

```cpp
#include <hip/hip_runtime.h>
#include <hip/hip_cooperative_groups.h>
#include <cstdio>
#include <cstring>
namespace cg = cooperative_groups;

#define DI __device__ __forceinline__
#define LAS __attribute__((address_space(3)))
typedef unsigned short bf16_t;
typedef short bf16x8 __attribute__((ext_vector_type(8)));
typedef short s16x4 __attribute__((ext_vector_type(4)));
typedef float f32x2 __attribute__((ext_vector_type(2)));
typedef float f32x4 __attribute__((ext_vector_type(4)));
typedef float f32x16 __attribute__((ext_vector_type(16)));
typedef unsigned u32x2 __attribute__((ext_vector_type(2)));
typedef unsigned u32x4 __attribute__((ext_vector_type(4)));
typedef __bf16 bf16v2_t __attribute__((ext_vector_type(2)));

constexpr int MTOK = 16384, DM = 2048, SEQ = 4096;
constexpr float EPS = 1e-6f, LOG2E = 1.4426950408889634f;
constexpr size_t MiB = (size_t)1 << 20;
constexpr size_t W_A_IN = 0, W_A_OUT = 32 * MiB, W_B_IN = 40 * MiB, W_B_OUT = 65 * MiB, W_C_IN = 73 * MiB, W_C_GATE = 89 * MiB,
                 W_C_OUT = 91 * MiB, W_D_IN = 99 * MiB, W_D_UQKV = 112 * MiB, W_D_OUT = 119 * MiB, HBUF = 127 * MiB, ACT = 191 * MiB,
                 WS_END = 511 * MiB;
constexpr size_t LAT = 0;
constexpr size_t EXTRA = 511 * MiB;
constexpr size_t X_BIAS = EXTRA + 16384, X_SP8 = EXTRA + 32768, X_SSQ = EXTRA + 65536;
constexpr size_t GLA_TOT = ACT + 200 * MiB;
constexpr size_t XG = ACT + 256 * MiB;
constexpr size_t WS_BAR = EXTRA;
constexpr int LDS_BYTES = 131072 + 2048;
#ifndef PHMASK
#define PHMASK 0xffffffffull
#endif
#ifndef REPMASK
#define REPMASK 0ull
#endif

struct TJob { const float* src; bf16_t* dst; const float* kscale; int K, N, ldw, ntn, tile0, pad; };
struct Params { const float* in[29]; float* out; unsigned char* ws; int njobs, ntiles; TJob jobs[44]; };

DI int otid() { int t = threadIdx.x; asm volatile("" : "+v"(t)); return t; }
template <class T> DI T* uni(T* p) {
    const unsigned long long v = (unsigned long long)p;
    const unsigned lo = __builtin_amdgcn_readfirstlane((unsigned)v), hi = __builtin_amdgcn_readfirstlane((unsigned)(v >> 32));
    return (T*)(((unsigned long long)hi << 32) | lo);
}
DI float bf2f(bf16_t v) { return __uint_as_float((unsigned)v << 16); }
DI unsigned pk2(float a, float b) { f32x2 v = {a, b}; bf16v2_t r = __builtin_convertvector(v, bf16v2_t); return __builtin_bit_cast(unsigned, r); }
DI bf16_t f2bf(float a) { return (bf16_t)(pk2(a, 0.f) & 0xffffu); }
DI void unpack8(const u32x4 w, float (&f)[8]) {
#pragma unroll
    for (int i = 0; i < 4; ++i) { f[2 * i] = __uint_as_float(w[i] << 16); f[2 * i + 1] = __uint_as_float(w[i] & 0xffff0000u); }
}
DI u32x4 pack8(const float (&f)[8]) { u32x4 w; w.x = pk2(f[0], f[1]); w.y = pk2(f[2], f[3]); w.z = pk2(f[4], f[5]); w.w = pk2(f[6], f[7]); return w; }
DI float wsum(float v) {
#pragma unroll
    for (int m = 32; m >= 1; m >>= 1) v += __shfl_xor(v, m);
    return v;
}
DI float sigm(float x) { return 1.f / (1.f + __expf(-x)); }
DI float silu(float x) { return x / (1.f + __expf(-x)); }
DI int crow(int i, int hh) { return (i & 3) + 8 * (i >> 2) + 4 * hh; }
DI f32x16 mfma32(bf16x8 a, bf16x8 b, f32x16 c) { return __builtin_amdgcn_mfma_f32_32x32x16_bf16(a, b, c, 0, 0, 0); }
DI s16x4 trread(LAS unsigned char* p) { return __builtin_amdgcn_ds_read_tr16_b64_v4i16((LAS s16x4*)p); }
DI bf16x8 cat4(s16x4 lo, s16x4 hi) { return __builtin_shufflevector(lo, hi, 0, 1, 2, 3, 4, 5, 6, 7); }

namespace pg8 {
constexpr int BM = 256, BK = 64, HALF = 128, HTB = HALF * BK * 2, STAGE_BYTES = 8 * HTB, NXCD = 8, WGM = 8;
DI int lds_byte(int r, int c) { const int st = (r >> 4) * 2 + (c >> 5), rr = r & 15, cc = c & 31, ob = rr * 64 + cc * 2; return st * 1024 + (ob ^ (((ob >> 9) & 1) << 5)); }
DI void stage_rc(int b, int& R, int& C) { const int st = b / 1024, sb = b % 1024, swz = sb ^ (((sb >> 9) & 1) << 5); R = (st >> 1) * 16 + swz / 64; C = (st & 1) * 32 + (swz % 64) / 2; }
DI int perm32(int rho) { const int n = rho >> 4, i = rho & 15; return 8 * (i >> 2) + 4 * n + (i & 3); }
struct Unit { int pm, pn; size_t aoff, boff; };
template <int MODE> struct Sched {
    int nM, nN, nwg, G, c, lda, K;
    DI void init(int M, int N, int G_, int c_, int lda_, int K_) { nM = M / BM; nN = N / BM; nwg = nM * nN; G = G_; c = c_; lda = lda_; K = K_; }
    DI bool next(int i, Unit& u) const {
        const long L = (long)i * G + c; if (L >= nwg) return false;
        int wgid = (int)L; { const int q = nwg / NXCD, r = nwg % NXCD, xcd = wgid % NXCD, off = wgid / NXCD; wgid = (xcd < r ? xcd * (q + 1) : r * (q + 1) + (xcd - r) * q) + off; }
        const int nig = WGM * nN, gid = wgid / nig, fm = gid * WGM, gsz = (nM - fm) < WGM ? (nM - fm) : WGM;
        u.pm = fm + ((wgid % nig) % gsz); u.pn = (wgid % nig) / gsz;
        u.aoff = (size_t)u.pm * 256 * lda * 2; u.boff = (size_t)u.pn * 256 * K * 2;
        if (MODE == 1 && u.pn >= 12) u.aoff += 1024;
        if (MODE == 2) u.aoff += (size_t)(u.pn >> 1) * 512;
        return true;
    }
};

template <class Epi, class SchedT>
DI void gemm_phase(LAS unsigned char* lds, const bf16_t* Ap, const bf16_t* Btp, const int K, const int lda, const SchedT& S, const Epi& E) {
    const int tid = otid(), wid = __builtin_amdgcn_readfirstlane(tid >> 6), lane = tid & 63, wr = wid >> 2, wc = wid & 3, fr = lane & 15, fq = lane >> 4;
    const int nt = K / BK;
    unsigned voffA[2], voffB[2];
#pragma unroll
    for (int i = 0; i < 2; ++i) { int R, C; stage_rc(tid * 16 + i * 8192, R, C); const int Rb = (R & ~31) + perm32(R & 31);
        voffA[i] = (unsigned)(R * lda + C) * 2u; voffB[i] = (unsigned)(Rb * K + C) * 2u; }
    const size_t kstep = (size_t)(BK * 2);
    const size_t hstepA = (size_t)HALF * lda * 2, hstepB = (size_t)HALF * K * 2;
    const unsigned ldsw = (unsigned)wid * 1024u;
    const int aoff = lds_byte(wr * 64 + fr, fq * 8), boff = lds_byte(wc * 32 + fr, fq * 8);
#define PG8_SA(b, h) (((b) * 2 + (h)) * HTB)
#define PG8_SB(b, h) ((4 + (b) * 2 + (h)) * HTB)
#define PG8_STAGE(bufoff, gbase, voff) do { _Pragma("unroll") for (int _i = 0; _i < 2; ++_i) \
        __builtin_amdgcn_global_load_lds((const unsigned*)((const char*)(gbase) + (voff)[_i]), (LAS unsigned*)(lds + (bufoff) + ldsw + _i * 8192), 16, 0, 0); } while (0)
#define PG8_LDA(dst, b, h) do { _Pragma("unroll") for (int m = 0; m < 4; ++m) _Pragma("unroll") for (int k = 0; k < 2; ++k) dst[m][k] = *(const LAS bf16x8*)(lds + PG8_SA(b, h) + aoff + m * 2048 + k * 1024); } while (0)
#define PG8_LDB(dst, b, h) do { _Pragma("unroll") for (int n = 0; n < 2; ++n) _Pragma("unroll") for (int k = 0; k < 2; ++k) dst[n][k] = *(const LAS bf16x8*)(lds + PG8_SB(b, h) + boff + n * 2048 + k * 1024); } while (0)
#define PG8_MMA(ai, bj, At, Bt) do { __builtin_amdgcn_s_setprio(1); _Pragma("unroll") for (int m = 0; m < 4; ++m) _Pragma("unroll") for (int n = 0; n < 2; ++n) _Pragma("unroll") for (int k = 0; k < 2; ++k) \
        acc[ai][bj][m][n] = __builtin_amdgcn_mfma_f32_16x16x32_bf16(Bt[n][k], At[m][k], acc[ai][bj][m][n], 0, 0, 0); __builtin_amdgcn_s_setprio(0); } while (0)
#define PG8_WAIT_V(n) asm volatile("s_waitcnt vmcnt(" #n ")" ::: "memory")
#define PG8_WAIT_L(n) asm volatile("s_waitcnt lgkmcnt(" #n ")" ::: "memory")
#define PG8_BAR __builtin_amdgcn_s_barrier()
#define PG8_SCHED __builtin_amdgcn_sched_barrier(0)
    Unit cur, nxt; int ui = 0;
    if (!S.next(0, cur)) return;
    float pre[8]; E.prefetch(cur, wr, fr, pre);
    f32x4 acc[2][2][4][2];
#pragma unroll
    for (int a = 0; a < 2; ++a)
#pragma unroll
        for (int b = 0; b < 2; ++b)
#pragma unroll
            for (int m = 0; m < 4; ++m)
#pragma unroll
                for (int n = 0; n < 2; ++n) acc[a][b][m][n] = (f32x4){0.f, 0.f, 0.f, 0.f};
    bf16x8 At[4][2], B0[2][2], B1[2][2];
    const char* cA = (const char*)Ap + cur.aoff; const char* cB = (const char*)Btp + cur.boff;
    PG8_STAGE(PG8_SB(0, 0), cB, voffB); PG8_STAGE(PG8_SA(0, 0), cA, voffA); PG8_STAGE(PG8_SB(0, 1), cB + hstepB, voffB); PG8_STAGE(PG8_SA(0, 1), cA + hstepA, voffA);
    if (wr == 1) PG8_BAR;
    PG8_WAIT_V(4); PG8_BAR;
    PG8_STAGE(PG8_SB(1, 0), cB + kstep, voffB); PG8_STAGE(PG8_SA(1, 0), cA + kstep, voffA); PG8_STAGE(PG8_SB(1, 1), cB + hstepB + kstep, voffB);
    PG8_WAIT_V(6); PG8_BAR;
    for (;;) {
        const bool has_next = S.next(ui + 1, nxt);
        const char* nA = has_next ? (const char*)Ap + nxt.aoff : cA; const char* nB = has_next ? (const char*)Btp + nxt.boff : cB;
        for (int t = 0; t < nt; t += 2) {
            const bool last = (t == nt - 2);
            const char* a1 = cA + (size_t)(t + 1) * kstep;
            const char* a2 = last ? nA : cA + (size_t)(t + 2) * kstep; const char* b2 = last ? nB : cB + (size_t)(t + 2) * kstep;
            const char* a3 = a2 + kstep; const char* b3 = b2 + kstep;
            PG8_LDB(B0, 0, 0); PG8_SCHED; PG8_LDA(At, 0, 0); PG8_STAGE(PG8_SA(1, 1), a1 + hstepA, voffA);
            PG8_WAIT_L(8); PG8_BAR; PG8_WAIT_L(0); PG8_MMA(0, 0, At, B0); PG8_BAR; PG8_SCHED;
            PG8_LDB(B1, 0, 1); PG8_STAGE(PG8_SB(0, 0), b2, voffB);
            PG8_BAR; PG8_WAIT_L(0); PG8_MMA(0, 1, At, B1); PG8_BAR;
            PG8_LDA(At, 0, 1); PG8_STAGE(PG8_SA(0, 0), a2, voffA);
            PG8_BAR; PG8_WAIT_L(0); PG8_MMA(1, 0, At, B0); PG8_BAR; PG8_SCHED;
            PG8_STAGE(PG8_SB(0, 1), b2 + hstepB, voffB);
            PG8_WAIT_V(6); PG8_BAR; PG8_MMA(1, 1, At, B1); PG8_BAR;
            PG8_LDB(B0, 1, 0); PG8_SCHED; PG8_LDA(At, 1, 0); PG8_STAGE(PG8_SA(0, 1), a2 + hstepA, voffA);
            PG8_WAIT_L(8); PG8_BAR; PG8_WAIT_L(0); PG8_MMA(0, 0, At, B0); PG8_BAR; PG8_SCHED;
            PG8_LDB(B1, 1, 1); PG8_STAGE(PG8_SB(1, 0), b3, voffB);
            PG8_BAR; PG8_WAIT_L(0); PG8_MMA(0, 1, At, B1); PG8_BAR;
            PG8_LDA(At, 1, 1); PG8_STAGE(PG8_SA(1, 0), a3, voffA);
            PG8_BAR; PG8_WAIT_L(0); PG8_MMA(1, 0, At, B0); PG8_BAR; PG8_SCHED;
            PG8_STAGE(PG8_SB(1, 1), b3 + hstepB, voffB);
            PG8_WAIT_V(6); PG8_BAR; PG8_MMA(1, 1, At, B1); PG8_BAR;
        }
        E(acc, cur, wr, wc, fr, fq, pre);
        if (!has_next) break;
#pragma unroll
        for (int a = 0; a < 2; ++a)
#pragma unroll
            for (int b = 0; b < 2; ++b)
#pragma unroll
                for (int m = 0; m < 4; ++m)
#pragma unroll
                    for (int n = 0; n < 2; ++n) acc[a][b][m][n] = (f32x4){0.f, 0.f, 0.f, 0.f};
        cur = nxt; cA = nA; cB = nB; ++ui; E.prefetch(cur, wr, fr, pre);
    }
    PG8_WAIT_V(0);
    if (wr == 0) PG8_BAR;
    PG8_BAR;
#undef PG8_SA
#undef PG8_SB
#undef PG8_STAGE
#undef PG8_LDA
#undef PG8_LDB
#undef PG8_MMA
#undef PG8_WAIT_V
#undef PG8_WAIT_L
#undef PG8_BAR
#undef PG8_SCHED
}

typedef f32x4 Acc[2][2][4][2];
struct EpiStore {
    bf16_t* O; int ldc; const float* ssq;
    DI void prefetch(const Unit& u, int wr, int fr, float (&pre)[8]) const {
#pragma unroll
        for (int i = 0; i < 8; ++i) pre[i] = ssq ? ssq[u.pm * BM + wr * 64 + fr + (i >> 2) * HALF + (i & 3) * 16] : 0.f; }
    DI void operator()(const Acc& acc, const Unit& u, int wr, int wc, int fr, int fq, const float (&pre)[8]) const {
        const int row0 = u.pm * BM + wr * 64 + fr, col0 = u.pn * BM + wc * 32 + 8 * fq;
#pragma unroll
        for (int ai = 0; ai < 2; ++ai)
#pragma unroll
            for (int m = 0; m < 4; ++m) { bf16_t* rowp = O + (size_t)(row0 + ai * HALF + m * 16) * ldc + col0;
                const float rs = ssq ? rsqrtf(pre[ai * 4 + m] * (1.f / DM) + EPS) : 1.f;
#pragma unroll
                for (int bj = 0; bj < 2; ++bj) { const f32x4 v0 = acc[ai][bj][m][0] * rs, v1 = acc[ai][bj][m][1] * rs;
                    u32x4 w; w.x = pk2(v0[0], v0[1]); w.y = pk2(v0[2], v0[3]); w.z = pk2(v1[0], v1[1]); w.w = pk2(v1[2], v1[3]);
                    *(u32x4*)(rowp + bj * HALF) = w; } }
    }
};
struct EpiStoreA {
    bf16_t* O; const float* qkg; const float* ssq;
    DI void prefetch(const Unit& u, int wr, int fr, float (&pre)[8]) const {
#pragma unroll
        for (int i = 0; i < 8; ++i) pre[i] = ssq[u.pm * BM + wr * 64 + fr + (i >> 2) * HALF + (i & 3) * 16]; }
    DI void operator()(const Acc& acc, const Unit& u, int wr, int wc, int fr, int fq, const float (&pre)[8]) const {
        const int row0 = u.pm * BM + wr * 64 + fr, col0 = u.pn * BM + wc * 64 + 8 * fq;
        const bool nrm = u.pn < 16;
        f32x4 gn[2][2];
        if (nrm) { const float* gp = qkg + (u.pn < 8 ? 0 : 64) + 8 * fq; const float gs = u.pn < 8 ? 0.125f * LOG2E : 1.f;
#pragma unroll
            for (int bj = 0; bj < 2; ++bj) { gn[bj][0] = *(const f32x4*)(gp + 32 * bj) * gs; gn[bj][1] = *(const f32x4*)(gp + 32 * bj + 4) * gs; } }
#pragma unroll
        for (int ai = 0; ai < 2; ++ai)
#pragma unroll
            for (int m = 0; m < 4; ++m) { bf16_t* rowp = O + (size_t)(row0 + ai * HALF + m * 16) * 8192 + col0;
                f32x4 v[2][2]; const float rs = rsqrtf(pre[ai * 4 + m] * (1.f / DM) + EPS);
#pragma unroll
                for (int bj = 0; bj < 2; ++bj) { v[bj][0] = acc[ai][bj][m][0] * rs; v[bj][1] = acc[ai][bj][m][1] * rs; }
                if (nrm) { float ss = 0.f;
#pragma unroll
                    for (int bj = 0; bj < 2; ++bj)
#pragma unroll
                        for (int n = 0; n < 2; ++n) ss += v[bj][n][0] * v[bj][n][0] + v[bj][n][1] * v[bj][n][1] + v[bj][n][2] * v[bj][n][2] + v[bj][n][3] * v[bj][n][3];
                    ss += __shfl_xor(ss, 16); ss += __shfl_xor(ss, 32);
                    const float sc = rsqrtf(ss * (1.f / 64.f) + EPS);
#pragma unroll
                    for (int bj = 0; bj < 2; ++bj) { v[bj][0] = v[bj][0] * sc * gn[bj][0]; v[bj][1] = v[bj][1] * sc * gn[bj][1]; } }
#pragma unroll
                for (int bj = 0; bj < 2; ++bj) { u32x4 w; w.x = pk2(v[bj][0][0], v[bj][0][1]); w.y = pk2(v[bj][0][2], v[bj][0][3]); w.z = pk2(v[bj][1][0], v[bj][1][1]); w.w = pk2(v[bj][1][2], v[bj][1][3]);
                    *(u32x4*)(rowp + 32 * bj) = w; } }
    }
};
struct EpiStoreD {
    bf16_t* lat; bf16_t* g; const float* ssq; float* ssql;
    DI void prefetch(const Unit& u, int wr, int fr, float (&pre)[8]) const {
#pragma unroll
        for (int i = 0; i < 8; ++i) pre[i] = ssq[u.pm * BM + wr * 64 + fr + (i >> 2) * HALF + (i & 3) * 16]; }
    DI void operator()(const Acc& acc, const Unit& u, int wr, int wc, int fr, int fq, const float (&pre)[8]) const {
        const int row0 = u.pm * BM + wr * 64 + fr, col0 = u.pn * BM + wc * 32 + 8 * fq;
#pragma unroll
        for (int ai = 0; ai < 2; ++ai)
#pragma unroll
            for (int m = 0; m < 4; ++m) { const size_t row = (size_t)(row0 + ai * HALF + m * 16);
                const float rs = rsqrtf(pre[ai * 4 + m] * (1.f / DM) + EPS); float ss = 0.f;
#pragma unroll
                for (int bj = 0; bj < 2; ++bj) { const f32x4 v0 = acc[ai][bj][m][0] * rs, v1 = acc[ai][bj][m][1] * rs;
                    ss += v0[0] * v0[0] + v0[1] * v0[1] + v0[2] * v0[2] + v0[3] * v0[3] + v1[0] * v1[0] + v1[1] * v1[1] + v1[2] * v1[2] + v1[3] * v1[3];
                    u32x4 w; w.x = pk2(v0[0], v0[1]); w.y = pk2(v0[2], v0[3]); w.z = pk2(v1[0], v1[1]); w.w = pk2(v1[2], v1[3]);
                    const int col = col0 + bj * HALF;
                    if (col < 1088) *(u32x4*)(lat + row * 1088 + col) = w;
                    else if (col < 3136) *(u32x4*)(g + row * 2048 + (col - 1088)) = w; }
                if (u.pn < 4) { ss += __shfl_xor(ss, 16); ss += __shfl_xor(ss, 32); if (fq == 0) atomicAdd(ssql + (u.pn >> 1) * MTOK + row, ss); } }
    }
};
struct EpiStoreU {
    bf16_t* O; const float* ssql;
    DI void prefetch(const Unit& u, int wr, int fr, float (&pre)[8]) const {
        const float* sq = ssql + (u.pn >= 12 ? MTOK : 0);
#pragma unroll
        for (int i = 0; i < 8; ++i) pre[i] = sq[u.pm * BM + wr * 64 + fr + (i >> 2) * HALF + (i & 3) * 16]; }
    DI void operator()(const Acc& acc, const Unit& u, int wr, int wc, int fr, int fq, const float (&pre)[8]) const {
        const int row0 = u.pm * BM + wr * 64 + fr, col0 = u.pn * BM + wc * 32 + 8 * fq;
        const float* sq = ssql + (u.pn >= 12 ? MTOK : 0);
#pragma unroll
        for (int ai = 0; ai < 2; ++ai)
#pragma unroll
            for (int m = 0; m < 4; ++m) { bf16_t* rowp = O + (size_t)(row0 + ai * HALF + m * 16) * 7168 + col0;
                const float rs = rsqrtf(pre[ai * 4 + m] * (1.f / 512.f) + EPS);
#pragma unroll
                for (int bj = 0; bj < 2; ++bj) { const f32x4 v0 = acc[ai][bj][m][0] * rs, v1 = acc[ai][bj][m][1] * rs;
                    u32x4 w; w.x = pk2(v0[0], v0[1]); w.y = pk2(v0[2], v0[3]); w.z = pk2(v1[0], v1[1]); w.w = pk2(v1[2], v1[3]);
                    *(u32x4*)(rowp + bj * HALF) = w; } }
    }
};
template <bool INB, bool OUTF, bool OUTB, bool SSQ> struct EpiResid {
    const float* xf; const bf16_t* xb; float* of; bf16_t* ob; float* ssq;
    DI void prefetch(const Unit&, int, int, float (&pre)[8]) const {
#pragma unroll
        for (int i = 0; i < 8; ++i) pre[i] = 0.f; }
    DI void operator()(const Acc& acc, const Unit& u, int wr, int wc, int fr, int fq, const float (&pre)[8]) const {
        const int row0 = u.pm * BM + wr * 64 + fr, col0 = u.pn * BM + wc * 32 + 8 * fq;
#pragma unroll
        for (int ai = 0; ai < 2; ++ai)
#pragma unroll
            for (int m = 0; m < 4; ++m) { const int row = row0 + ai * HALF + m * 16; const size_t o = (size_t)row * DM + col0;
                float ss = 0.f;
#pragma unroll
                for (int bj = 0; bj < 2; ++bj) {
                    f32x4 x0, x1;
                    if (INB) { float f[8]; unpack8(*(const u32x4*)(xb + o + bj * HALF), f); x0 = (f32x4){f[0], f[1], f[2], f[3]}; x1 = (f32x4){f[4], f[5], f[6], f[7]}; }
                    else { x0 = *(const f32x4*)(xf + o + bj * HALF); x1 = *(const f32x4*)(xf + o + bj * HALF + 4); }
                    x0 += acc[ai][bj][m][0]; x1 += acc[ai][bj][m][1];
                    if (OUTF) { __builtin_nontemporal_store(x0, (f32x4*)(of + o + bj * HALF)); __builtin_nontemporal_store(x1, (f32x4*)(of + o + bj * HALF + 4)); }
                    if (SSQ) ss += x0[0] * x0[0] + x0[1] * x0[1] + x0[2] * x0[2] + x0[3] * x0[3] + x1[0] * x1[0] + x1[1] * x1[1] + x1[2] * x1[2] + x1[3] * x1[3];
                    if (OUTB) { u32x4 w; w.x = pk2(x0[0], x0[1]); w.y = pk2(x0[2], x0[3]); w.z = pk2(x1[0], x1[1]); w.w = pk2(x1[2], x1[3]);
                        *(u32x4*)(ob + o + bj * HALF) = w; } }
                if (SSQ) { ss += __shfl_xor(ss, 16); ss += __shfl_xor(ss, 32); if (fq == 0) atomicAdd(ssq + row, ss); } }
    }
};
struct EpiGates {
    const bf16_t* xc; const float* brg; const float* big; const float* sp8t; unsigned* ax;
    DI void prefetch(const Unit&, int, int, float (&pre)[8]) const {
#pragma unroll
        for (int i = 0; i < 8; ++i) pre[i] = 0.f; }
    DI void operator()(const Acc& acc, const Unit& u, int wr, int wc, int fr, int fq, const float (&pre)[8]) const {
        const int row0 = u.pm * BM + wr * 64 + fr, f0 = (u.pn >> 1) * 256 + (u.pn & 1) * 128 + wc * 32 + 8 * fq;
#pragma unroll
        for (int n = 0; n < 2; ++n) {
            const f32x4 br = *(const f32x4*)(brg + f0 + 4 * n), bi = *(const f32x4*)(big + f0 + 4 * n), sp = *(const f32x4*)(sp8t + f0 + 4 * n);
#pragma unroll
            for (int ai = 0; ai < 2; ++ai)
#pragma unroll
                for (int m = 0; m < 4; ++m) { const size_t o = (size_t)(row0 + ai * HALF + m * 16) * DM + f0 + 4 * n;
                    const u32x2 xw = *(const u32x2*)(xc + o);
                    const float xv[4] = {__uint_as_float(xw.x << 16), __uint_as_float(xw.x & 0xffff0000u), __uint_as_float(xw.y << 16), __uint_as_float(xw.y & 0xffff0000u)};
                    u32x4 w;
#pragma unroll
                    for (int e = 0; e < 4; ++e) { const float r = sigm(acc[ai][0][m][n][e] + br[e]), ig = sigm(acc[ai][1][m][n][e] + bi[e]);
                        const float la = -sp[e] * r, uu = -2.f * la;
                        const float om = uu * (1.f - uu * 0.5f * (1.f - uu * (1.f / 3.f) * (1.f - uu * 0.25f * (1.f - uu * 0.2f * (1.f - uu * (1.f / 6.f))))));
                        w[e] = pk2(la, sqrtf(fmaxf(om, 0.f)) * ig * xv[e]); }
                    *(u32x4*)(ax + o) = w; __builtin_amdgcn_sched_barrier(0); }
        }
    }
};
}

template <int MODE, class Epi>
DI void run_gemm(LAS unsigned char* lds, const bf16_t* A, const bf16_t* Bt, int N, int K, int lda, const Epi& E) {
    asm volatile("" : "+s"(K));
    pg8::Sched<MODE> S; S.init(MTOK, N, (int)gridDim.x, (int)blockIdx.x, lda, K);
    pg8::gemm_phase(lds, A, Bt, K, lda, S, E);
    __syncthreads();
}

DI void phase_convert(const Params& p, LAS unsigned char* lds) {
    LAS float* sm = (LAS float*)lds;
    const int tid = otid();
    for (int t = blockIdx.x; t < p.ntiles; t += gridDim.x) {
        int j = 0; while (j + 1 < p.njobs && p.jobs[j + 1].tile0 <= t) ++j;
        const float* src = p.jobs[j].src; bf16_t* dst = p.jobs[j].dst; const int K = p.jobs[j].K, N = p.jobs[j].N, ldw = p.jobs[j].ldw, ntn = p.jobs[j].ntn;
        const int tt = t - p.jobs[j].tile0, tn = tt % ntn, tk = tt / ntn, n0 = tn * 64, k0 = tk * 256;
        { const int n4 = (tid & 15) * 4, kr = tid >> 4; f32x4 v[8];
#pragma unroll
          for (int i = 0; i < 8; ++i) v[i] = (n0 + n4 < N) ? __builtin_nontemporal_load((const f32x4*)(src + (size_t)(k0 + kr + 32 * i) * ldw + n0 + n4)) : (f32x4){0.f, 0.f, 0.f, 0.f};
#pragma unroll
          for (int i = 0; i < 8; ++i) { LAS float* d = sm + (kr + 32 * i) * 65 + n4; d[0] = v[i][0]; d[1] = v[i][1]; d[2] = v[i][2]; d[3] = v[i][3]; } }
        __syncthreads();
        { const int nr = tid >> 3, kq = tid & 7;
#pragma unroll
          for (int jj = 0; jj < 4; ++jj) { const int kc = (kq + 8 * jj) * 8; float f[8];
#pragma unroll
              for (int e = 0; e < 8; ++e) f[e] = sm[(kc + e) * 65 + nr];
              if (p.jobs[j].kscale) { const float* ks = p.jobs[j].kscale + k0 + kc;
#pragma unroll
                  for (int e = 0; e < 8; ++e) f[e] *= ks[e]; }
              int nrow = n0 + nr; if (p.jobs[j].pad) { const int jl = nrow & 255; nrow = (nrow & ~255) + 128 * ((jl >> 5) & 1) + 32 * (jl >> 6) + (jl & 31); }
              *(u32x4*)(dst + (size_t)nrow * K + k0 + kc) = pack8(f); } }
        __syncthreads();
    }
}

DI int t5_bucket(int rel) {
    const int n = rel < 0 ? -rel : rel; int b;
    if (n < 8) b = n; else b = 8 + (n >= 12) + (n >= 16) + (n >= 23) + (n >= 32) + (n >= 46) + (n >= 64) + (n >= 91);
    return (rel > 0 ? 16 : 0) + b;
}
DI void phase_bias_table(const Params& p) {
    float* tb = (float*)(p.ws + X_BIAS);
    float* sp8 = (float*)(p.ws + X_SP8); float* ssq = (float*)(p.ws + X_SSQ);
    for (int i = blockIdx.x * 512 + otid(); i < 5 * MTOK; i += gridDim.x * 512) ssq[i] = 0.f;
    for (int i = blockIdx.x * 512 + otid(); i < 16 * 192 + 2048; i += gridDim.x * 512) {
        if (i < 16 * 192) { const int h = i / 192, idx = i % 192; tb[i] = (p.in[2][t5_bucket(idx - 128) * 16 + h] - p.in[2][15 * 16 + h]) * LOG2E; }
        else sp8[i - 16 * 192] = 8.f * log1pf(expf(-p.in[20][i - 16 * 192]));
    }
}

DI void phase_x0(const float* x, bf16_t* out, float* ssq) {
    const int tid = otid(), lane = tid & 63, gw = blockIdx.x * 8 + (tid >> 6), nw = gridDim.x * 8;
    for (int row0 = gw; row0 < MTOK; row0 += 2 * nw) {
        f32x4 v[2][8]; bool ok[2]; int rw[2];
#pragma unroll
        for (int r = 0; r < 2; ++r) { ok[r] = row0 + r * nw < MTOK; rw[r] = ok[r] ? row0 + r * nw : row0;
            const f32x4* xr = (const f32x4*)(x + (size_t)rw[r] * DM);
#pragma unroll
            for (int i = 0; i < 4; ++i) { v[r][2 * i] = __builtin_nontemporal_load(xr + i * 128 + lane * 2); v[r][2 * i + 1] = __builtin_nontemporal_load(xr + i * 128 + lane * 2 + 1); } }
#pragma unroll
        for (int r = 0; r < 2; ++r) {
            float ss = 0.f;
#pragma unroll
            for (int i = 0; i < 8; ++i) ss += v[r][i][0] * v[r][i][0] + v[r][i][1] * v[r][i][1] + v[r][i][2] * v[r][i][2] + v[r][i][3] * v[r][i][3];
            ss = wsum(ss);
            if (ok[r]) {
                if (lane == 0) ssq[rw[r]] = ss;
#pragma unroll
                for (int i = 0; i < 4; ++i) { u32x4 w; w.x = pk2(v[r][2 * i][0], v[r][2 * i][1]); w.y = pk2(v[r][2 * i][2], v[r][2 * i][3]); w.z = pk2(v[r][2 * i + 1][0], v[r][2 * i + 1][1]); w.w = pk2(v[r][2 * i + 1][2], v[r][2 * i + 1][3]);
                    *(u32x4*)(out + (size_t)rw[r] * DM + i * 512 + lane * 8) = w; }
            }
        }
    }
}

DI void phase_rmsnorm(const float* x, const float* g, bf16_t* out) {
    const int tid = otid(), lane = tid & 63, gw = blockIdx.x * 8 + (tid >> 6), nw = gridDim.x * 8;
    for (int row = gw; row < MTOK; row += nw) {
        const f32x4* xr = (const f32x4*)(x + (size_t)row * DM); f32x4 v[8]; float ss = 0.f;
#pragma unroll
        for (int i = 0; i < 4; ++i) { v[2 * i] = xr[i * 128 + lane * 2]; v[2 * i + 1] = xr[i * 128 + lane * 2 + 1]; }
#pragma unroll
        for (int i = 0; i < 8; ++i) ss += v[i][0] * v[i][0] + v[i][1] * v[i][1] + v[i][2] * v[i][2] + v[i][3] * v[i][3];
        ss = wsum(ss); const float sc = rsqrtf(ss * (1.f / DM) + EPS);
#pragma unroll
        for (int i = 0; i < 4; ++i) { const int c = i * 512 + lane * 8; const f32x4 g0 = *(const f32x4*)(g + c), g1 = *(const f32x4*)(g + c + 4);
            u32x4 w; w.x = pk2(v[2 * i][0] * sc * g0[0], v[2 * i][1] * sc * g0[1]); w.y = pk2(v[2 * i][2] * sc * g0[2], v[2 * i][3] * sc * g0[3]);
            w.z = pk2(v[2 * i + 1][0] * sc * g1[0], v[2 * i + 1][1] * sc * g1[1]); w.w = pk2(v[2 * i + 1][2] * sc * g1[2], v[2 * i + 1][3] * sc * g1[3]);
            *(u32x4*)(out + (size_t)row * DM + c) = w; }
    }
}

DI void phase_qknorm_a(const Params& p) {
    bf16_t* big = (bf16_t*)(p.ws + ACT); const float* qkg = p.in[4];
    const int tid = otid(), lane = tid & 63, gw = blockIdx.x * 8 + (tid >> 6), nw = gridDim.x * 8;
    float gq[8], gk[8];
#pragma unroll
    for (int e = 0; e < 8; ++e) { gq[e] = qkg[(lane & 7) * 8 + e] * (0.125f * LOG2E); gk[e] = qkg[64 + (lane & 7) * 8 + e]; }
    for (int row = gw; row < MTOK; row += nw) {
#pragma unroll
        for (int i = 0; i < 8; ++i) {
            bf16_t* ptr = big + (size_t)row * 8192 + i * 512 + lane * 8; float f[8]; unpack8(*(const u32x4*)ptr, f);
            float ss = 0.f;
#pragma unroll
            for (int e = 0; e < 8; ++e) ss += f[e] * f[e];
            ss += __shfl_xor(ss, 1); ss += __shfl_xor(ss, 2); ss += __shfl_xor(ss, 4);
            const float sc = rsqrtf(ss * (1.f / 64.f) + EPS);
#pragma unroll
            for (int e = 0; e < 8; ++e) f[e] = f[e] * sc * (i < 4 ? gq[e] : gk[e]);
            *(u32x4*)ptr = pack8(f);
        }
    }
}

template <int DQK, int KA8, int DV, bool BIAS, bool JOINT>
DI void attn_core(LAS unsigned char* lds, const bf16_t* Qrow, const bf16_t* KpA, int ldkA, const bf16_t* KpB, int ldkB, const bf16_t* Vp, int ldv,
                  int qb, int wid, int lane, const float* qng  , f32x16 (&O)[DV / 32]) {
    constexpr int KROW = DQK * 2 + 16, VROW = DV * 2 + 64  , KC = DQK / 8, VC = DV / 8, NKC = 64 * KC, NVC = 64 * VC, NL = (NKC + NVC) / 512, STG = 64 * (KROW + VROW);
    static_assert(NKC % 512 == 0 && NVC % 512 == 0, "loader split");
    const int tid = otid(), l32 = lane & 31, hh = lane >> 5, i16 = lane & 15, tq = i16 >> 2, tp = i16 & 3, blk = (lane >> 4) & 1;
    const int q0w = qb * 256 + wid * 32, nkt = 4 * qb + 4, myc = q0w >> 6;
    bf16x8 qf[DQK / 16];
#pragma unroll
    for (int s = 0; s < DQK / 16; ++s) qf[s] = *(const bf16x8*)(Qrow + 16 * s + 8 * hh);
    if constexpr (DQK == 192) {
        if (qng) {
            float ssn = 0.f, ssr = 0.f;
#pragma unroll
            for (int s = 0; s < 12; ++s) { float f[8]; unpack8(__builtin_bit_cast(u32x4, qf[s]), f); float t = 0.f;
#pragma unroll
                for (int e = 0; e < 8; ++e) t += f[e] * f[e];
                if (s < 8) ssn += t; else ssr += t; }
            ssn += __shfl_xor(ssn, 32); ssr += __shfl_xor(ssr, 32);
            const float qs = 0.07216878364870322f * LOG2E, scn = rsqrtf(ssn * (1.f / 128.f) + EPS) * qs, scr = rsqrtf(ssr * (1.f / 64.f) + EPS) * qs;
#pragma unroll
            for (int s = 0; s < 8; ++s) { float f[8]; unpack8(__builtin_bit_cast(u32x4, qf[s]), f);
                const f32x4 g0 = *(const f32x4*)(qng + 16 * s + 8 * hh), g1 = *(const f32x4*)(qng + 16 * s + 8 * hh + 4);
#pragma unroll
                for (int e = 0; e < 4; ++e) { f[e] *= scn * g0[e]; f[4 + e] *= scn * g1[e]; }
                qf[s] = __builtin_bit_cast(bf16x8, pack8(f)); }
            const float posr = (float)(qb * 256 + wid * 32 + l32) * 0.15915494309189535f;
#pragma unroll
            for (int s = 8; s < 10; ++s) { float f1[8], f2[8]; unpack8(__builtin_bit_cast(u32x4, qf[s]), f1); unpack8(__builtin_bit_cast(u32x4, qf[s + 2]), f2);
#pragma unroll
                for (int e = 0; e < 8; ++e) { const int i = 16 * (s - 8) + 8 * hh + e;
                    const float a1 = f1[e] * scr * qng[128 + i], a2 = f2[e] * scr * qng[160 + i];
                    float rev = posr * __builtin_amdgcn_exp2f(-(float)i * 0.41524101186092029f); rev -= floorf(rev);
                    const float sn = __builtin_amdgcn_sinf(rev), cs = __builtin_amdgcn_cosf(rev);
                    f1[e] = a1 * cs - a2 * sn; f2[e] = a2 * cs + a1 * sn; }
                qf[s] = __builtin_bit_cast(bf16x8, pack8(f1)); qf[s + 2] = __builtin_bit_cast(bf16x8, pack8(f2)); }
            __builtin_amdgcn_sched_barrier(0);
        }
    }
    float m = 0.f, l = 0.f; bool mnz = false;
#pragma unroll
    for (int dt = 0; dt < DV / 32; ++dt)
#pragma unroll
        for (int i = 0; i < 16; ++i) O[dt][i] = 0.f;
    u32x4 stg[NL];
    LAS const float* btab = (LAS const float*)(lds + 2 * STG);
    const unsigned koff = l32 * KROW + 16 * hh, vtr = (4 * hh + tq) * VROW + (16 * blk + 4 * tp) * 2;

    auto gload = [&](int kt) {
#pragma unroll
        for (int i = 0; i < NL; ++i) { const int c = tid + i * 512;
            if (i * 512 < NKC) { const int row = c / KC, cc = c % KC;
                const bf16_t* src = (cc < KA8) ? KpA + (size_t)(kt * 64 + row) * ldkA + cc * 8 : KpB + (size_t)(kt * 64 + row) * ldkB + (cc - KA8) * 8;
                stg[i] = *(const u32x4*)src; }
            else { const int c2 = c - NKC, row = c2 / VC, cc = c2 % VC; stg[i] = *(const u32x4*)(Vp + (size_t)(kt * 64 + row) * ldv + cc * 8); } }
    };
    auto lstore = [&](int buf) {
#pragma unroll
        for (int i = 0; i < NL; ++i) { const int c = tid + i * 512;
            if (i * 512 < NKC) { const int row = c / KC, cc = c % KC; *(LAS u32x4*)(lds + buf * STG + row * KROW + cc * 16) = stg[i]; }
            else { const int c2 = c - NKC, row = c2 / VC, cc = c2 % VC; *(LAS u32x4*)(lds + buf * STG + 64 * KROW + row * VROW + cc * 16) = stg[i]; } }
    };

    gload(0); lstore(0); __syncthreads();
    for (int kt = 0; kt < nkt; ++kt) {
        if (kt + 1 < nkt) gload(kt + 1);
        if (JOINT && kt <= myc) {
            LAS unsigned char* kb = lds + (kt & 1) * STG; LAS unsigned char* vb = kb + 64 * KROW;
            const bool far = (kt * 64 + 63 - q0w <= -91);
            f32x16 S0, S1;
#pragma unroll
            for (int i = 0; i < 16; ++i) { S0[i] = 0.f; S1[i] = 0.f; }
#pragma unroll
            for (int s = 0; s < DQK / 16; ++s) {
                const bf16x8 k0 = *(LAS const bf16x8*)(kb + koff + 32 * s), k1 = *(LAS const bf16x8*)(kb + koff + 32 * KROW + 32 * s);
                S0 = mfma32(k0, qf[s], S0); S1 = mfma32(k1, qf[s], S1);
            }
            if (BIAS && !far) {
                const int rb = kt * 64 - (q0w + l32) + 128;
#pragma unroll
                for (int i = 0; i < 16; ++i) { const int i0 = rb + crow(i, hh); S0[i] += btab[i0 < 0 ? 0 : i0]; S1[i] += btab[i0 + 32 < 0 ? 0 : i0 + 32]; }
            }
            if (mnz) {
#pragma unroll
                for (int i = 0; i < 16; ++i) { S0[i] -= m; S1[i] -= m; }
            }
            float mx = fmaxf(S0[0], S1[0]);
#pragma unroll
            for (int i = 1; i < 16; ++i) mx = fmaxf(mx, fmaxf(S0[i], S1[i]));
            mx = fmaxf(mx, __shfl_xor(mx, 32));
            if (__any(mx > 64.f || (kt == 0 && mx < -64.f))) {
                const float dm = (mx > 64.f || (kt == 0 && mx < -64.f)) ? mx : 0.f, alpha = __builtin_amdgcn_exp2f(-dm); m += dm; mnz = true;
                l *= alpha;
#pragma unroll
                for (int dt = 0; dt < DV / 32; ++dt) O[dt] *= alpha;
#pragma unroll
                for (int i = 0; i < 16; ++i) { S0[i] -= dm; S1[i] -= dm; }
            }
            float ps = 0.f;
#pragma unroll
            for (int i = 0; i < 16; ++i) { S0[i] = __builtin_amdgcn_exp2f(S0[i]); S1[i] = __builtin_amdgcn_exp2f(S1[i]); ps += S0[i] + S1[i]; }
            l += ps;
#pragma unroll
            for (int half = 0; half < 2; ++half)
#pragma unroll
                for (int s = 0; s < 2; ++s) {
                    const f32x16& S = half ? S1 : S0;
                    u32x4 pw; pw.x = pk2(S[8 * s], S[8 * s + 1]); pw.y = pk2(S[8 * s + 2], S[8 * s + 3]); pw.z = pk2(S[8 * s + 4], S[8 * s + 5]); pw.w = pk2(S[8 * s + 6], S[8 * s + 7]);
                    const bf16x8 pf = __builtin_bit_cast(bf16x8, pw);
                    LAS unsigned char* vr = vb + vtr + (32 * half + 16 * s) * VROW;
#pragma unroll
                    for (int dt = 0; dt < DV / 32; ++dt) {
                        const bf16x8 vf = cat4(trread(vr + 64 * dt), trread(vr + 8 * VROW + 64 * dt));
                        O[dt] = mfma32(vf, pf, O[dt]);
                    }
                }
        }
        if (!JOINT && kt <= myc) {
            LAS unsigned char* kb = lds + (kt & 1) * STG; LAS unsigned char* vb = kb + 64 * KROW;
            const bool far = (kt * 64 + 63 - q0w <= -91);
#pragma unroll 1
            for (int half = 0; half < 2; ++half) {
                f32x16 S;
#pragma unroll
                for (int i = 0; i < 16; ++i) S[i] = 0.f;
#pragma unroll
                for (int s = 0; s < DQK / 16; ++s) {
                    const bf16x8 kf = *(LAS const bf16x8*)(kb + koff + 32 * half * KROW + 32 * s);
                    S = mfma32(kf, qf[s], S);
                }
                if (BIAS && !far) {
                    const int rb = kt * 64 + 32 * half - (q0w + l32) + 128;
#pragma unroll
                    for (int i = 0; i < 16; ++i) { const int i0 = rb + crow(i, hh); S[i] += btab[i0 < 0 ? 0 : i0]; }
                }
                if (mnz) {
#pragma unroll
                    for (int i = 0; i < 16; ++i) S[i] -= m;
                }
                float mx = S[0];
#pragma unroll
                for (int i = 1; i < 16; ++i) mx = fmaxf(mx, S[i]);
                mx = fmaxf(mx, __shfl_xor(mx, 32));
                const bool first = (kt == 0 && half == 0);
                if (__any(mx > 64.f || (first && mx < -64.f))) {
                    const float dm = (mx > 64.f || (first && mx < -64.f)) ? mx : 0.f, alpha = __builtin_amdgcn_exp2f(-dm); m += dm; mnz = true;
                    l *= alpha;
#pragma unroll
                    for (int dt = 0; dt < DV / 32; ++dt) O[dt] *= alpha;
#pragma unroll
                    for (int i = 0; i < 16; ++i) S[i] -= dm;
                }
                float ps = 0.f;
#pragma unroll
                for (int i = 0; i < 16; ++i) { S[i] = __builtin_amdgcn_exp2f(S[i]); ps += S[i]; }
                l += ps;
#pragma unroll
                for (int s = 0; s < 2; ++s) {
                    u32x4 pw; pw.x = pk2(S[8 * s], S[8 * s + 1]); pw.y = pk2(S[8 * s + 2], S[8 * s + 3]); pw.z = pk2(S[8 * s + 4], S[8 * s + 5]); pw.w = pk2(S[8 * s + 6], S[8 * s + 7]);
                    const bf16x8 pf = __builtin_bit_cast(bf16x8, pw);
                    LAS unsigned char* vr = vb + vtr + (32 * half + 16 * s) * VROW;
#pragma unroll
                    for (int dt = 0; dt < DV / 32; ++dt) {
                        const bf16x8 vf = cat4(trread(vr + 64 * dt), trread(vr + 8 * VROW + 64 * dt));
                        O[dt] = mfma32(vf, pf, O[dt]);
                    }
                }
            }
        }
        if (kt + 1 < nkt) lstore((kt + 1) & 1);
        __syncthreads();
    }
    l += __shfl_xor(l, 32);
    const float il = 1.f / l;
#pragma unroll
    for (int dt = 0; dt < DV / 32; ++dt) O[dt] *= il;
}

DI void phase_attn_a(const Params& p, LAS unsigned char* lds) {
    const bf16_t* big = (const bf16_t*)(p.ws + ACT); bf16_t* y = (bf16_t*)(p.ws + HBUF); const float* tbg = (const float*)(p.ws + X_BIAS);
    const int tid = otid(), wid = tid >> 6, lane = tid & 63, l32 = lane & 31, hh = lane >> 5;
    constexpr int STG = 64 * (64 * 2 + 16 + 128 * 2 + 64);
    float d0 = 0.f, d1 = 0.f;
    for (int i = 0; i < 64; ++i) { d0 += p.in[5][i] * p.in[5][64 + i]; d1 += p.in[5][128 + i] * p.in[5][192 + i]; }
    const float lam_init = 0.2f, lam = __expf(d0) - __expf(d1) + lam_init;
    for (int pr = blockIdx.x; pr < 512; pr += gridDim.x) {
        const int bi = pr & 255, bh = (gridDim.x == 256) ? (bi & 7) + 8 * (bi >> 6) + 32 * (pr >> 8) : pr >> 3, j = (gridDim.x == 256) ? (bi >> 3) & 7 : pr & 7, b = bh >> 4, h = bh & 15;
        for (int half = 0; half < 2; ++half) {
            const int qb = half ? 15 - j : j;
            __syncthreads();
            if (tid < 192) ((LAS float*)(lds + 2 * STG))[tid] = tbg[h * 192 + tid];
            const size_t tok0 = (size_t)b * SEQ, tokq = tok0 + qb * 256 + wid * 32 + l32;
            f32x16 Oa[4]; LAS unsigned* Op = (LAS unsigned*)(lds + 2 * STG + 1024) + wid * 2048 + lane;
            attn_core<64, 8, 128, true, true>(lds, big + tokq * 8192 + h * 128, big + tok0 * 8192 + 2048 + h * 128, 8192, nullptr, 0, big + tok0 * 8192 + 4096 + h * 128, 8192, qb, wid, lane, nullptr, Oa);
#pragma unroll
            for (int dt = 0; dt < 4; ++dt)
#pragma unroll
                for (int i = 0; i < 8; ++i) Op[(dt * 8 + i) * 64] = pk2(Oa[dt][2 * i], Oa[dt][2 * i + 1]);
            attn_core<64, 8, 128, true, true>(lds, big + tokq * 8192 + h * 128 + 64, big + tok0 * 8192 + 2048 + h * 128 + 64, 8192, nullptr, 0, big + tok0 * 8192 + 4096 + h * 128, 8192, qb, wid, lane, nullptr, Oa);
            float ss = 0.f;
#pragma unroll
            for (int dt = 0; dt < 4; ++dt)
#pragma unroll
                for (int i = 0; i < 16; ++i) { const unsigned ow = Op[(dt * 8 + (i >> 1)) * 64]; const float o0 = (i & 1) ? __uint_as_float(ow & 0xffff0000u) : __uint_as_float(ow << 16);
                    const float o = o0 - lam * Oa[dt][i]; Oa[dt][i] = o; ss += o * o; }
            ss += __shfl_xor(ss, 32);
            const float sc = rsqrtf(ss * (1.f / 128.f) + EPS) * (1.f - lam_init);
#pragma unroll
            for (int dt = 0; dt < 4; ++dt)
#pragma unroll
                for (int g4 = 0; g4 < 4; ++g4) { const int dv = 32 * dt + 8 * g4 + 4 * hh;
                    const u32x2 gw = *(const u32x2*)(big + tokq * 8192 + 6144 + h * 128 + dv);
                    const f32x4 sg = *(const f32x4*)(p.in[6] + dv);
                    const float g0 = __uint_as_float(gw.x << 16), g1 = __uint_as_float(gw.x & 0xffff0000u), g2 = __uint_as_float(gw.y << 16), g3 = __uint_as_float(gw.y & 0xffff0000u);
                    u32x2 w; w.x = pk2(Oa[dt][4 * g4] * sc * sg[0] * silu(g0), Oa[dt][4 * g4 + 1] * sc * sg[1] * silu(g1));
                    w.y = pk2(Oa[dt][4 * g4 + 2] * sc * sg[2] * silu(g2), Oa[dt][4 * g4 + 3] * sc * sg[3] * silu(g3));
                    *(u32x2*)(y + tokq * DM + h * 128 + dv) = w; }
        }
    }
}

DI void phase_attn_d(const Params& p, LAS unsigned char* lds) {
    const bf16_t* qkv = (const bf16_t*)(p.ws + ACT); const bf16_t* lat = (const bf16_t*)(p.ws + LAT); const bf16_t* gb = (const bf16_t*)(p.ws + HBUF);
    bf16_t* y = (bf16_t*)(p.ws + HBUF);
    for (int pr = blockIdx.x; pr < 512; pr += gridDim.x) {
        const int bi = pr & 255, bh = (gridDim.x == 256) ? (bi & 7) + 8 * (bi >> 6) + 32 * (pr >> 8) : pr >> 3, j = (gridDim.x == 256) ? (bi >> 3) & 7 : pr & 7, b = bh >> 4, h = bh & 15;
        for (int half = 0; half < 2; ++half) {
            const int qb = half ? 15 - j : j;
            __syncthreads();
            const int tid = otid(), wid = tid >> 6, lane = tid & 63, l32 = lane & 31;
            const size_t tok0 = (size_t)b * SEQ, tokq = tok0 + qb * 256 + wid * 32 + l32;
            f32x16 O[4];
            attn_core<192, 16, 128, false, true>(lds, qkv + tokq * 7168 + h * 192, qkv + tok0 * 7168 + 3072 + h * 256, 7168, lat + tok0 * 1088 + 1024, 1088,
                                           qkv + tok0 * 7168 + 3072 + h * 256 + 128, 7168, qb, wid, lane, p.in[27], O);
            const int tid2 = otid(), wid2 = tid2 >> 6, lane2 = tid2 & 63;
            const size_t tokq2 = (size_t)b * SEQ + qb * 256 + wid2 * 32 + (lane2 & 31); const int hh2 = lane2 >> 5;
#pragma unroll
            for (int dt = 0; dt < 4; ++dt)
#pragma unroll
                for (int g4 = 0; g4 < 4; ++g4) { const int dv = 32 * dt + 8 * g4 + 4 * hh2;
                    const u32x2 gw = *(const u32x2*)(gb + tokq2 * DM + h * 128 + dv);
                    const float g0 = __uint_as_float(gw.x << 16), g1 = __uint_as_float(gw.x & 0xffff0000u), g2 = __uint_as_float(gw.y << 16), g3 = __uint_as_float(gw.y & 0xffff0000u);
                    u32x2 w; w.x = pk2(O[dt][4 * g4] * silu(g0), O[dt][4 * g4 + 1] * silu(g1)); w.y = pk2(O[dt][4 * g4 + 2] * silu(g2), O[dt][4 * g4 + 3] * silu(g3));
                    *(u32x2*)(y + tokq2 * DM + h * 128 + dv) = w; }
        }
    }
}

DI void phase_gla_prep(const Params& p, LAS unsigned char* lds) {
    bf16_t* big = (bf16_t*)(p.ws + ACT); float* total = (float*)(p.ws + GLA_TOT);
    LAS float* lrs = (LAS float*)lds;
    const int tid = otid(), ch0 = tid * 2;
    float wg0[16], wg1[16];
#pragma unroll
    for (int r = 0; r < 16; ++r) { wg0[r] = p.in[9][r * 1024 + ch0]; wg1[r] = p.in[9][r * 1024 + ch0 + 1]; }
    const float bs0 = p.in[10][ch0], bs1 = p.in[10][ch0 + 1];
    for (int u = blockIdx.x; u < 256; u += gridDim.x) {
        const size_t tokb = (size_t)u * 64;
        __syncthreads();
        {
            LAS bf16_t* wl = (LAS bf16_t*)(lds + 8192);
            LAS float* part = (LAS float*)(lds + 4096);
            const bf16_t* wsrc = (const bf16_t*)(p.ws + W_B_IN) + (size_t)6144 * 2048;
#pragma unroll
            for (int i = 0; i < 8; ++i) { const int c = tid + i * 512; *(LAS u32x4*)(wl + (c >> 8) * 2056 + (c & 255) * 8) = *(const u32x4*)(wsrc + (size_t)c * 8); }
            __syncthreads();
            const int w = tid >> 6, lane = tid & 63, i16 = lane & 15, quad = lane >> 4, mt = w & 3, kh = w >> 2;
            const bf16_t* xr = (const bf16_t*)(p.ws + XG) + (tokb + 16 * mt + i16) * DM + kh * 1024 + 8 * quad;
            f32x4 acc = {0.f, 0.f, 0.f, 0.f};
#pragma unroll 8
            for (int ks = 0; ks < 32; ++ks) {
                const bf16x8 a = *(const bf16x8*)(xr + 32 * ks);
                const bf16x8 bb = *(LAS const bf16x8*)(wl + i16 * 2056 + kh * 1024 + 32 * ks + 8 * quad);
                acc = __builtin_amdgcn_mfma_f32_16x16x32_bf16(a, bb, acc, 0, 0, 0);
            }
            if (kh == 1) {
#pragma unroll
                for (int j = 0; j < 4; ++j) part[(16 * mt + 4 * quad + j) * 16 + i16] = acc[j]; }
            __syncthreads();
            if (kh == 0) {
#pragma unroll
                for (int j = 0; j < 4; ++j) { const int tok = 16 * mt + 4 * quad + j;
                    const float rs = rsqrtf(((const float*)(p.ws + X_SSQ))[tokb + tok] * (1.f / DM) + EPS);
                    lrs[tok * 16 + i16] = (acc[j] + part[tok * 16 + i16]) * rs; } }
        }
        __syncthreads();
        float t0 = 0.f, t1 = 0.f;
        for (int tg = 3; tg >= 0; --tg) {
            unsigned kw[16];
#pragma unroll
            for (int i = 0; i < 16; ++i) kw[i] = *(const unsigned*)(big + (tokb + tg * 16 + i) * 6400 + 1024 + ch0);
#pragma unroll
            for (int i = 15; i >= 0; --i) { const int tok = tg * 16 + i;
                float z0 = bs0, z1 = bs1;
#pragma unroll
                for (int r = 0; r < 16; ++r) { const float lv = lrs[tok * 16 + r]; z0 += lv * wg0[r]; z1 += lv * wg1[r]; }
                *(unsigned*)(big + (tokb + tok) * 6400 + 1024 + ch0) = pk2(__uint_as_float(kw[i] << 16) * __expf(t0), __uint_as_float(kw[i] & 0xffff0000u) * __expf(t1));
                t0 += (fminf(z0, 0.f) - __logf(1.f + __expf(-fabsf(z0)))) * (1.f / 16.f); t1 += (fminf(z1, 0.f) - __logf(1.f + __expf(-fabsf(z1)))) * (1.f / 16.f);
            }
        }
        total[(size_t)u * 1024 + ch0] = t0; total[(size_t)u * 1024 + ch0 + 1] = t1;
    }
}

DI void phase_gla_scan(const Params& p, LAS unsigned char* lds) {
    const bf16_t* big = (const bf16_t*)(p.ws + ACT); const float* total = (const float*)(p.ws + GLA_TOT); bf16_t* ob = (bf16_t*)(p.ws + HBUF);
    constexpr int KR = 576, VR = 64, SR = 528, SET = 64 * KR + 64 * VR + 1024  , ST_OFF = 2 * SET, STB = 32 * SR;
    const int tid = otid(), w = tid >> 6, lane = tid & 63, l32 = lane & 31, hh = lane >> 5, i16 = lane & 15, tq = i16 >> 2, tp = i16 & 3, blk = (lane >> 4) & 1, quad = lane >> 4;
    const int mt = w >> 1, nt = w & 1;
    for (int u = blockIdx.x; u < 256; u += gridDim.x) {
        const int ux = (gridDim.x == 256) ? ((u & 7) * 2 + (u >> 7)) * 16 + ((u >> 3) & 15) : u;
        const int b = ux >> 6, h = (ux >> 4) & 3, vs = ux & 15;
        const size_t tok0 = (size_t)b * SEQ;
        f32x16 st;
#pragma unroll
        for (int i = 0; i < 16; ++i) st[i] = 0.f;
        u32x4 rkA[4], rvA, rkB[4], rvB; float rtA = 0.f, rtB = 0.f; bf16x8 qa[8], qn[8];
        rvA = (u32x4){0u, 0u, 0u, 0u}; rvB = rvA;
        unsigned offk[4];
#pragma unroll
        for (int i = 0; i < 4; ++i) { const int idx = tid + i * 512, row = idx >> 5, cc = idx & 31; offk[i] = (unsigned)((row * 6400 + 1024 + h * 256 + cc * 8) * 2); }
        const unsigned offv = (unsigned)(((tid >> 2) * 6400 + 2048 + h * 512 + vs * 32 + (tid & 3) * 8) * 2);
        const unsigned offq = (unsigned)(((16 * mt + i16) * 6400 + h * 256 + 8 * quad) * 2);
        auto gload = [&](int c, u32x4 (&rk)[4], u32x4& rv, float& rt) {
            const char* cb = (const char*)(big + (tok0 + (size_t)c * 64) * 6400);
#pragma unroll
            for (int i = 0; i < 4; ++i) rk[i] = *(const u32x4*)(cb + offk[i]);
            if (tid < 256) { rv = *(const u32x4*)(cb + offv); rt = total[(size_t)(b * 64 + c) * 1024 + h * 256 + tid]; }
        };
        auto lstore = [&](int buf, const u32x4 (&rk)[4], const u32x4& rv, const float& rt) {
            LAS unsigned char* sb = lds + buf * SET;
#pragma unroll
            for (int i = 0; i < 4; ++i) { const int idx = tid + i * 512, row = idx >> 5, cc = idx & 31; *(LAS u32x4*)(sb + row * KR + cc * 16) = rk[i]; }
            if (tid < 256) { const int row = tid >> 2, cc = tid & 3; *(LAS u32x4*)(sb + 64 * KR + row * VR + cc * 16) = rv; ((LAS float*)(sb + 64 * KR + 64 * VR))[tid] = __expf(rt); }
        };
        auto qload = [&](int c, bf16x8 (&q)[8]) {
            const char* cb = (const char*)(big + (tok0 + (size_t)c * 64) * 6400) + offq;
#pragma unroll
            for (int ks = 0; ks < 8; ++ks) q[ks] = *(const bf16x8*)(cb + 64 * ks);
        };
        auto step = [&](int c, const bf16x8 (&qc)[8]) {
            LAS unsigned char* sb = lds + (c & 1) * SET; LAS unsigned char* stb = lds + ST_OFF + (c & 1) * STB;
#pragma unroll
            for (int g = 0; g < 4; ++g) { const f32x4 e = *(LAS const f32x4*)(sb + 64 * KR + 64 * VR + (32 * w + 8 * g + 4 * hh) * 4);
                st[4 * g] *= e[0]; st[4 * g + 1] *= e[1]; st[4 * g + 2] *= e[2]; st[4 * g + 3] *= e[3]; }
#pragma unroll
            for (int sx = 0; sx < 4; ++sx) {
                LAS unsigned char* ka = sb + (16 * sx + 8 * hh + tq) * KR + (32 * w + 16 * blk + 4 * tp) * 2;
                LAS unsigned char* va = sb + 64 * KR + (16 * sx + 8 * hh + tq) * VR + (16 * blk + 4 * tp) * 2;
                const bf16x8 af = cat4(trread(ka), trread(ka + 4 * KR)), bfv = cat4(trread(va), trread(va + 4 * VR));
                st = mfma32(af, bfv, st);
            }
#pragma unroll
            for (int g = 0; g < 4; ++g) { u32x2 wv; wv.x = pk2(st[4 * g], st[4 * g + 1]); wv.y = pk2(st[4 * g + 2], st[4 * g + 3]);
                *(LAS u32x2*)(stb + l32 * SR + (32 * w + 8 * g + 4 * hh) * 2) = wv; }
            asm volatile("s_waitcnt lgkmcnt(0)" ::: "memory");
            __builtin_amdgcn_s_barrier();
            asm volatile("" ::: "memory");
            f32x4 acc = {0.f, 0.f, 0.f, 0.f};
#pragma unroll
            for (int ks = 0; ks < 8; ++ks) {
                const bf16x8 bb = *(LAS const bf16x8*)(stb + (16 * nt + i16) * SR + (32 * ks + 8 * quad) * 2);
                acc = __builtin_amdgcn_mfma_f32_16x16x32_bf16(qc[ks], bb, acc, 0, 0, 0);
            }
#pragma unroll
            for (int jj = 0; jj < 4; ++jj) ob[(tok0 + c * 64 + 16 * mt + quad * 4 + jj) * DM + h * 512 + vs * 32 + 16 * nt + i16] = f2bf(acc[jj] * (1.f / 16.f));
        };
        __syncthreads();
        gload(0, rkA, rvA, rtA); lstore(0, rkA, rvA, rtA);
        gload(1, rkA, rvA, rtA); gload(2, rkB, rvB, rtB); qload(0, qa); qload(1, qn);
        __syncthreads();
        for (int c = 0; c < 64; c += 2) {
            lstore((c + 1) & 1, rkA, rvA, rtA);
            if (c + 3 < 64) gload(c + 3, rkA, rvA, rtA);
            step(c, qa);
            if (c + 2 < 64) qload(c + 2, qa);
            if (c + 2 < 64) lstore(c & 1, rkB, rvB, rtB);
            if (c + 4 < 64) gload(c + 4, rkB, rvB, rtB);
            step(c + 1, qn);
            if (c + 3 < 64) qload(c + 3, qn);
        }
    }
}

DI void phase_gla_post(const Params& p) {
    const bf16_t* big = (const bf16_t*)(p.ws + ACT); bf16_t* y = (bf16_t*)(p.ws + HBUF);
    const int tid = otid(), lane = tid & 63, gw = blockIdx.x * 8 + (tid >> 6), nw = gridDim.x * 8;
    float og[8];
#pragma unroll
    for (int e = 0; e < 8; ++e) og[e] = p.in[11][lane * 8 + e];
    for (int row = gw; row < MTOK; row += 2 * nw) {
        u32x4 wo[2][4], wg[2][4]; bool ok[2]; size_t rr[2];
#pragma unroll
        for (int r = 0; r < 2; ++r) { ok[r] = row + r * nw < MTOK; rr[r] = ok[r] ? (size_t)(row + r * nw) : (size_t)row;
#pragma unroll
            for (int hd = 0; hd < 4; ++hd) { wo[r][hd] = *(const u32x4*)(y + rr[r] * DM + hd * 512 + lane * 8); wg[r][hd] = *(const u32x4*)(big + rr[r] * 6400 + 4096 + hd * 512 + lane * 8); } }
#pragma unroll
        for (int r = 0; r < 2; ++r)
#pragma unroll
            for (int hd = 0; hd < 4; ++hd) {
                float f[8], g[8]; unpack8(wo[r][hd], f); unpack8(wg[r][hd], g);
                float ss = 0.f;
#pragma unroll
                for (int e = 0; e < 8; ++e) ss += f[e] * f[e];
                ss = wsum(ss); const float sc = rsqrtf(ss * (1.f / 512.f) + EPS);
#pragma unroll
                for (int e = 0; e < 8; ++e) f[e] = f[e] * sc * og[e] * silu(g[e]);
                if (ok[r]) *(u32x4*)(y + rr[r] * DM + hd * 512 + lane * 8) = pack8(f);
            }
    }
}

DI void phase_conv(const Params& p) {
    const bf16_t* big = (const bf16_t*)(p.ws + ACT); bf16_t* xc = (bf16_t*)(p.ws + HBUF);
    for (size_t idx = (size_t)blockIdx.x * 512 + otid(); idx < (size_t)(MTOK / 8) * 256; idx += (size_t)gridDim.x * 512) {
        const int tok0 = (int)(idx >> 8) * 8, ch = (int)(idx & 255) * 8, t0 = tok0 & (SEQ - 1);
        float wv[4][8], bs[8];
        { const f32x4 b0 = *(const f32x4*)(p.in[15] + ch), b1 = *(const f32x4*)(p.in[15] + ch + 4);
#pragma unroll
          for (int e = 0; e < 4; ++e) { bs[e] = b0[e]; bs[4 + e] = b1[e]; } }
#pragma unroll
        for (int jx = 0; jx < 4; ++jx) { const f32x4 w0 = *(const f32x4*)(p.in[14] + jx * 2048 + ch), w1 = *(const f32x4*)(p.in[14] + jx * 2048 + ch + 4);
#pragma unroll
            for (int e = 0; e < 4; ++e) { wv[jx][e] = w0[e]; wv[jx][4 + e] = w1[e]; } }
        u32x4 raw[11];
#pragma unroll
        for (int r = 0; r < 11; ++r) raw[r] = (r >= 3 || t0 > 0) ? *(const u32x4*)(big + (size_t)(tok0 - 3 + r) * 4096 + ch) : (u32x4){0u, 0u, 0u, 0u};
#pragma unroll
        for (int o = 0; o < 8; ++o) {
            float acc[8];
#pragma unroll
            for (int e = 0; e < 8; ++e) acc[e] = bs[e];
#pragma unroll
            for (int jx = 0; jx < 4; ++jx) { float f[8]; unpack8(raw[o + jx], f);
#pragma unroll
                for (int e = 0; e < 8; ++e) acc[e] += f[e] * wv[jx][e]; }
            *(u32x4*)(xc + (size_t)(tok0 + o) * DM + ch) = pack8(acc);
        }
    }
}
DI void phase_lru_scan(const Params& p, LAS unsigned char* lds) {
    const unsigned* ax = (const unsigned*)(p.ws + ACT + 128 * MiB); const bf16_t* big = (const bf16_t*)(p.ws + ACT);
    bf16_t* y = (bf16_t*)(p.ws + HBUF);
    LAS unsigned* tile = (LAS unsigned*)lds;
    LAS float* sP = (LAS float*)(lds + 65536); LAS float* sH = sP + 512; LAS float* sC = sH + 512;
    const int tid = otid(), seg = tid >> 5, chl = tid & 31;
    for (int u = blockIdx.x; u < 256; u += gridDim.x) {
        const int b = u >> 6, ch = (u & 63) * 32 + chl;
        const size_t rowbase = (size_t)b * SEQ;
        unsigned pre[32];
#pragma unroll
        for (int i = 0; i < 32; ++i) pre[i] = ax[(rowbase + seg + 16 * i) * DM + ch];
        __syncthreads();
        if (tid < 32) sC[tid] = 0.f;
        for (int sc = 0; sc < 8; ++sc) {
#pragma unroll
            for (int i = 0; i < 32; ++i) tile[(seg + 16 * i) * 32 + chl] = pre[i];
            __syncthreads();
            if (sc + 1 < 8) {
#pragma unroll
                for (int i = 0; i < 32; ++i) pre[i] = ax[(rowbase + (sc + 1) * 512 + seg + 16 * i) * DM + ch];
            }
            const size_t r0 = rowbase + sc * 512 + seg * 32;
            bf16_t gq[32];
#pragma unroll
            for (int t = 0; t < 32; ++t) gq[t] = big[(r0 + t) * 4096 + 2048 + ch];
            float L = 0.f, H = 0.f;
#pragma unroll 8
            for (int t = 0; t < 32; ++t) { const unsigned w = tile[(seg * 32 + t) * 32 + chl]; const float la = __uint_as_float(w << 16); H = __expf(la) * H + __uint_as_float(w & 0xffff0000u); L += la; }
            sP[tid] = __expf(L); sH[tid] = H;
            __syncthreads();
            float hc = sC[chl];
            for (int sg = 0; sg < seg; ++sg) hc = sP[sg * 32 + chl] * hc + sH[sg * 32 + chl];
#pragma unroll
            for (int t = 0; t < 32; ++t) { const unsigned w = tile[(seg * 32 + t) * 32 + chl]; hc = __expf(__uint_as_float(w << 16)) * hc + __uint_as_float(w & 0xffff0000u);
                y[(r0 + t) * DM + ch] = f2bf(hc * silu(bf2f(gq[t]))); }
            __syncthreads();
            if (seg == 15) sC[chl] = hc;
        }
    }
}

DI void phase_mla_lat(const Params& p) {
    bf16_t* lat = (bf16_t*)(p.ws + LAT);
    const int tid = otid(), lane = tid & 63, gw = blockIdx.x * 8 + (tid >> 6), nw = gridDim.x * 8;
    float gq[8], gk[8];
#pragma unroll
    for (int e = 0; e < 8; ++e) { gq[e] = p.in[23][lane * 8 + e]; gk[e] = p.in[24][lane * 8 + e]; }
    const float inv = powf(10000.f, -(float)(lane & 31) * (1.f / 32.f));
    const float g1 = p.in[27][192 + 128 + (lane & 31)], g2 = p.in[27][192 + 160 + (lane & 31)];
    for (int row = gw; row < MTOK; row += nw) {
#pragma unroll
        for (int part = 0; part < 2; ++part) {
            bf16_t* ptr = lat + (size_t)row * 1088 + part * 512 + lane * 8; float f[8]; unpack8(*(const u32x4*)ptr, f);
            float ss = 0.f;
#pragma unroll
            for (int e = 0; e < 8; ++e) ss += f[e] * f[e];
            ss = wsum(ss); const float sc = rsqrtf(ss * (1.f / 512.f) + EPS);
#pragma unroll
            for (int e = 0; e < 8; ++e) f[e] = f[e] * sc * (part ? gk[e] : gq[e]);
            *(u32x4*)ptr = pack8(f);
        }
        { bf16_t* kp = lat + (size_t)row * 1088 + 1024; const int i = lane & 31;
          const float x1 = bf2f(kp[i]), x2 = bf2f(kp[i + 32]);
          float ss = (lane < 32) ? x1 * x1 + x2 * x2 : 0.f; ss = wsum(ss); const float sc = rsqrtf(ss * (1.f / 64.f) + EPS);
          const float a1 = x1 * sc * g1, a2 = x2 * sc * g2; float sn, cs; sincosf((float)(row & (SEQ - 1)) * inv, &sn, &cs);
          if (lane < 32) { kp[i] = f2bf(a1 * cs - a2 * sn); kp[i + 32] = f2bf(a2 * cs + a1 * sn); } }
    }
}
DI void phase_mla_qk(const Params& p) {
    bf16_t* qkv = (bf16_t*)(p.ws + ACT); bf16_t* lat = (bf16_t*)(p.ws + LAT); const float* qkg = p.in[27];
    const int tid = otid(), lane = tid & 63, gw = blockIdx.x * 8 + (tid >> 6), nw = gridDim.x * 8;
    const int l16 = lane & 15, l8 = lane & 7;
    float gk[8], gkr[8];
#pragma unroll
    for (int e = 0; e < 8; ++e) { gk[e] = qkg[192 + l16 * 8 + e]; gkr[e] = qkg[192 + 128 + l8 * 8 + e]; }
    float inv[8];
#pragma unroll
    for (int e = 0; e < 8; ++e) inv[e] = powf(10000.f, -(float)((l8 & 3) * 8 + e) * (1.f / 32.f));
    for (int row0 = gw; row0 < MTOK; row0 += 2 * nw) {
        u32x4 wk[2][4], wp[2]; bool ok[2]; int rw[2];
#pragma unroll
        for (int r = 0; r < 2; ++r) { ok[r] = row0 + r * nw < MTOK; rw[r] = ok[r] ? row0 + r * nw : row0;
            const bf16_t* qr = qkv + (size_t)rw[r] * 7168;
#pragma unroll
            for (int i = 0; i < 4; ++i) { const int head = 4 * i + (lane >> 4); wk[r][i] = *(const u32x4*)(qr + 3072 + head * 256 + l16 * 8); }
            wp[r] = *(const u32x4*)(lat + (size_t)rw[r] * 1088 + 1024 + l8 * 8); }
#pragma unroll
        for (int r = 0; r < 2; ++r) {
            bf16_t* qr = qkv + (size_t)rw[r] * 7168; bf16_t* kpp = lat + (size_t)rw[r] * 1088 + 1024 + l8 * 8;
            const float pos = (float)(rw[r] & (SEQ - 1));
#pragma unroll
            for (int i = 0; i < 4; ++i) {
                const int head = 4 * i + (lane >> 4);
                float f[8]; unpack8(wk[r][i], f); float ss = 0.f;
#pragma unroll
                for (int e = 0; e < 8; ++e) ss += f[e] * f[e];
                ss += __shfl_xor(ss, 1); ss += __shfl_xor(ss, 2); ss += __shfl_xor(ss, 4); ss += __shfl_xor(ss, 8);
                const float sc = rsqrtf(ss * (1.f / 128.f) + EPS);
#pragma unroll
                for (int e = 0; e < 8; ++e) f[e] *= sc * gk[e];
                if (ok[r]) *(u32x4*)(qr + 3072 + head * 256 + l16 * 8) = pack8(f);
            }
            { float f[8], o[8]; unpack8(wp[r], f); float ss = 0.f;
#pragma unroll
              for (int e = 0; e < 8; ++e) ss += f[e] * f[e];
              ss += __shfl_xor(ss, 1); ss += __shfl_xor(ss, 2); ss += __shfl_xor(ss, 4);
              const float sc = rsqrtf(ss * (1.f / 64.f) + EPS);
#pragma unroll
              for (int e = 0; e < 8; ++e) {
                  const float a = f[e] * sc * gkr[e], pa = __shfl_xor(a, 4);
                  float sn, cs; sincosf(pos * inv[e], &sn, &cs);
                  o[e] = (l8 < 4) ? a * cs - pa * sn : a * cs + pa * sn;
              }
              if (ok[r] && lane < 8) *(u32x4*)kpp = pack8(o); }
        }
    }
}

#define XB_TMO      128
#define XB_XCNT(j)  (256  + 64 * (j))
#define XB_XSUB(j)  (1280 + 64 * (j))
#define XB_XGEN(j)  (2304 + 64 * (j))
#define XB_TOP      3328
#define XB_TOPGEN   3392
#define XCD_BAR_WORDS 3456
#define XB_SPIN_CAP (1u << 22)
DI unsigned xb_ld(unsigned* p)              { return __hip_atomic_load(p, __ATOMIC_RELAXED, __HIP_MEMORY_SCOPE_AGENT); }
DI unsigned xb_add(unsigned* p, unsigned v) { return __hip_atomic_fetch_add(p, v, __ATOMIC_RELAXED, __HIP_MEMORY_SCOPE_AGENT); }
DI unsigned xb_xcc_id() { return (unsigned)__builtin_amdgcn_s_getreg((3 << 11) | 20) & 0xFu; }
#define XB_SPIN(cond, bar) do { unsigned _sp = 0; while (cond) { __builtin_amdgcn_s_sleep(1); \
    if ((++_sp & 255u) == 0u) { if (xb_ld(&(bar)[XB_TMO])) break; if (_sp > XB_SPIN_CAP) { atomicAdd(&(bar)[XB_TMO], 1u); break; } } } } while (0)
struct XcdBarrier { unsigned* bar; unsigned x; volatile LAS unsigned* st; };
DI XcdBarrier xcd_barrier_post(unsigned* bar, volatile LAS unsigned* st) {
    XcdBarrier b; b.bar = bar; b.x = xb_xcc_id(); b.st = st;
    if (threadIdx.x == 0) (void)xb_add(&bar[XB_XCNT(b.x)], 1u);
    return b;
}
DI void xcd_barrier_complete(unsigned* bar, unsigned x, unsigned& nloc, unsigned& nx) {
    const unsigned G = gridDim.x * gridDim.y * gridDim.z;
    unsigned sum, cnt, mine, sp = 0u;
    for (;;) {
        sum = 0u; cnt = 0u; mine = 0u;
#pragma unroll
        for (unsigned j = 0; j < 16; ++j) { const unsigned c = xb_ld(&bar[XB_XCNT(j)]); sum += c; cnt += (c > 0u) ? 1u : 0u; mine = (j == x) ? c : mine; }
        if (sum == G) break;
        __builtin_amdgcn_s_sleep(1);
        if ((++sp & 255u) == 0u) { if (xb_ld(&bar[XB_TMO])) break; if (sp > XB_SPIN_CAP) { atomicAdd(&bar[XB_TMO], 1u); break; } }
    }
    nloc = mine > 0u ? mine : 1u; nx = cnt > 0u ? cnt : 1u;
}
DI void xcd_barrier(const XcdBarrier& b0) {
    asm volatile("s_waitcnt vmcnt(0)" ::: "memory");
    __syncthreads();
    if (otid() == 0) {
        XcdBarrier b; b.bar = b0.bar; b.st = b0.st; b.x = xb_xcc_id();
        unsigned* bar = b.bar;
        __builtin_amdgcn_s_waitcnt(0);
        unsigned nloc = b.st[0], nx = b.st[1];
        if (nloc == 0u) { xcd_barrier_complete(bar, b.x, nloc, nx); b.st[0] = nloc; b.st[1] = nx; }
        const unsigned old = xb_add(&bar[XB_XSUB(b.x)], 1u);
        const unsigned gen = old / nloc;
        if (old + 1u == (gen + 1u) * nloc) {
            __builtin_amdgcn_fence(__ATOMIC_RELEASE, "agent");
            asm volatile("s_waitcnt vmcnt(0)" ::: "memory");
            const unsigned og = xb_add(&bar[XB_TOP], 1u);
            const unsigned tg = og / nx;
            if (og + 1u == (tg + 1u) * nx) xb_add(&bar[XB_TOPGEN], 1u);
            else XB_SPIN(xb_ld(&bar[XB_TOPGEN]) == tg, bar);
            __builtin_amdgcn_fence(__ATOMIC_ACQUIRE, "agent");
            xb_add(&bar[XB_XGEN(b.x)], 1u);
            asm volatile("s_waitcnt vmcnt(0)" ::: "memory");
        } else {
            XB_SPIN(xb_ld(&bar[XB_XGEN(b.x)]) == gen, bar);
            __builtin_amdgcn_fence(__ATOMIC_ACQUIRE, "agent");
            asm volatile("s_waitcnt vmcnt(0)" ::: "memory");
        }
    }
    __syncthreads();
}

__global__ __launch_bounds__(512, 2) void mega(const Params p) {
    extern __shared__ __attribute__((aligned(16))) unsigned char shm[];
    LAS unsigned char* lds = (LAS unsigned char*)shm;
    cg::grid_group grid = cg::this_grid();
    volatile LAS unsigned* bst = (volatile LAS unsigned*)(lds + 131072 + 1024);
    if (threadIdx.x == 0) { bst[0] = 0u; bst[1] = 0u; }
    __syncthreads();
    XcdBarrier xb = xcd_barrier_post((unsigned*)(p.ws + WS_BAR), bst); xb.x = 0;
    if constexpr ((PHMASK >> 0) & 1) { phase_convert(p, lds); }
    if constexpr ((REPMASK >> 0) & 1) { __syncthreads(); phase_convert(p, lds); }
    if constexpr ((PHMASK >> 1) & 1) { phase_bias_table(p); }
    if constexpr ((REPMASK >> 1) & 1) { __syncthreads(); phase_bias_table(p); }
    if constexpr ((PHMASK >> 2) & 1) { phase_x0(p.in[0], (bf16_t*)(uni(p.ws) + XG), (float*)(uni(p.ws) + X_SSQ) + 5 * MTOK); }
    if constexpr ((REPMASK >> 2) & 1) { __syncthreads(); phase_rmsnorm(p.in[0], p.in[1], (bf16_t*)(uni(p.ws) + HBUF)); }
    if (p.njobs < 0) grid.sync();
    xcd_barrier(xb);
    if constexpr ((PHMASK >> 3) & 1) { { pg8::EpiStoreA E{(bf16_t*)(uni(p.ws) + ACT), p.in[4], (const float*)(uni(p.ws) + X_SSQ) + 5 * MTOK}; run_gemm<0>(lds, (const bf16_t*)(uni(p.ws) + XG), (const bf16_t*)(uni(p.ws) + W_A_IN), 8192, 2048, 2048, E); } }
    if constexpr ((REPMASK >> 3) & 1) { __syncthreads(); { pg8::EpiStoreA E{(bf16_t*)(uni(p.ws) + ACT), p.in[4], (const float*)(uni(p.ws) + X_SSQ) + 5 * MTOK}; run_gemm<0>(lds, (const bf16_t*)(uni(p.ws) + XG), (const bf16_t*)(uni(p.ws) + W_A_IN), 8192, 2048, 2048, E); } }
    xcd_barrier(xb);
    if constexpr ((PHMASK >> 5) & 1) { phase_attn_a(p, lds); }
    if constexpr ((REPMASK >> 5) & 1) { __syncthreads(); phase_attn_a(p, lds); }
    xcd_barrier(xb);
    if constexpr ((PHMASK >> 6) & 1) { { pg8::EpiResid<true, false, true, true> E{nullptr, (const bf16_t*)(uni(p.ws) + XG), nullptr, (bf16_t*)(uni(p.ws) + XG), (float*)(uni(p.ws) + X_SSQ)}; run_gemm<0>(lds, (bf16_t*)(uni(p.ws) + HBUF), (const bf16_t*)(uni(p.ws) + W_A_OUT), 2048, 2048, 2048, E); } }
    if constexpr ((REPMASK >> 6) & 1) { __syncthreads(); { pg8::EpiResid<true, false, true, true> E{nullptr, (const bf16_t*)(uni(p.ws) + XG), nullptr, (bf16_t*)(uni(p.ws) + XG), (float*)(uni(p.ws) + X_SSQ)}; run_gemm<0>(lds, (bf16_t*)(uni(p.ws) + HBUF), (const bf16_t*)(uni(p.ws) + W_A_OUT), 2048, 2048, 2048, E); } }
    xcd_barrier(xb);
    if constexpr ((PHMASK >> 8) & 1) { { pg8::EpiStore E{(bf16_t*)(uni(p.ws) + ACT), 6400, (const float*)(uni(p.ws) + X_SSQ)}; run_gemm<0>(lds, (const bf16_t*)(uni(p.ws) + XG), (const bf16_t*)(uni(p.ws) + W_B_IN), 6144, 2048, 2048, E); } }
    if constexpr ((REPMASK >> 8) & 1) { __syncthreads(); { pg8::EpiStore E{(bf16_t*)(uni(p.ws) + ACT), 6400, (const float*)(uni(p.ws) + X_SSQ)}; run_gemm<0>(lds, (const bf16_t*)(uni(p.ws) + XG), (const bf16_t*)(uni(p.ws) + W_B_IN), 6144, 2048, 2048, E); } }
    xcd_barrier(xb);
    if constexpr ((PHMASK >> 9) & 1) { phase_gla_prep(p, lds); }
    if constexpr ((REPMASK >> 9) & 1) { __syncthreads(); phase_gla_prep(p, lds); }
    xcd_barrier(xb);
    if constexpr ((PHMASK >> 10) & 1) { phase_gla_scan(p, lds); }
    if constexpr ((REPMASK >> 10) & 1) { __syncthreads(); phase_gla_scan(p, lds); }
    xcd_barrier(xb);
    if constexpr ((PHMASK >> 11) & 1) { phase_gla_post(p); }
    if constexpr ((REPMASK >> 11) & 1) { __syncthreads(); phase_gla_post(p); }
    xcd_barrier(xb);
    if constexpr ((PHMASK >> 12) & 1) { { pg8::EpiResid<true, false, true, true> E{nullptr, (const bf16_t*)(uni(p.ws) + XG), nullptr, (bf16_t*)(uni(p.ws) + XG), (float*)(uni(p.ws) + X_SSQ) + MTOK}; run_gemm<0>(lds, (bf16_t*)(uni(p.ws) + HBUF), (const bf16_t*)(uni(p.ws) + W_B_OUT), 2048, 2048, 2048, E); } }
    if constexpr ((REPMASK >> 12) & 1) { __syncthreads(); { pg8::EpiResid<true, false, true, true> E{nullptr, (const bf16_t*)(uni(p.ws) + XG), nullptr, (bf16_t*)(uni(p.ws) + XG), (float*)(uni(p.ws) + X_SSQ) + MTOK}; run_gemm<0>(lds, (bf16_t*)(uni(p.ws) + HBUF), (const bf16_t*)(uni(p.ws) + W_B_OUT), 2048, 2048, 2048, E); } }
    xcd_barrier(xb);
    if constexpr ((PHMASK >> 14) & 1) { { pg8::EpiStore E{(bf16_t*)(uni(p.ws) + ACT), 4096, (const float*)(uni(p.ws) + X_SSQ) + MTOK}; run_gemm<0>(lds, (const bf16_t*)(uni(p.ws) + XG), (const bf16_t*)(uni(p.ws) + W_C_IN), 4096, 2048, 2048, E); } }
    if constexpr ((REPMASK >> 14) & 1) { __syncthreads(); { pg8::EpiStore E{(bf16_t*)(uni(p.ws) + ACT), 4096, (const float*)(uni(p.ws) + X_SSQ) + MTOK}; run_gemm<0>(lds, (const bf16_t*)(uni(p.ws) + XG), (const bf16_t*)(uni(p.ws) + W_C_IN), 4096, 2048, 2048, E); } }
    xcd_barrier(xb);
    if constexpr ((PHMASK >> 15) & 1) { phase_conv(p); }
    if constexpr ((REPMASK >> 15) & 1) { __syncthreads(); phase_conv(p); }
    xcd_barrier(xb);
    if constexpr ((PHMASK >> 16) & 1) { { pg8::EpiGates E{(bf16_t*)(uni(p.ws) + HBUF), p.in[17], p.in[19], (const float*)(uni(p.ws) + X_SP8), (unsigned*)(uni(p.ws) + ACT + 128 * MiB)}; run_gemm<2>(lds, (bf16_t*)(uni(p.ws) + HBUF), (const bf16_t*)(uni(p.ws) + W_C_GATE), 4096, 256, 2048, E); } }
    if constexpr ((REPMASK >> 16) & 1) { __syncthreads(); { pg8::EpiGates E{(bf16_t*)(uni(p.ws) + HBUF), p.in[17], p.in[19], (const float*)(uni(p.ws) + X_SP8), (unsigned*)(uni(p.ws) + ACT + 128 * MiB)}; run_gemm<2>(lds, (bf16_t*)(uni(p.ws) + HBUF), (const bf16_t*)(uni(p.ws) + W_C_GATE), 4096, 256, 2048, E); } }
    xcd_barrier(xb);
    if constexpr ((PHMASK >> 17) & 1) { phase_lru_scan(p, lds); }
    if constexpr ((REPMASK >> 17) & 1) { __syncthreads(); phase_lru_scan(p, lds); }
    xcd_barrier(xb);
    if constexpr ((PHMASK >> 18) & 1) { { pg8::EpiResid<true, false, true, true> E{nullptr, (const bf16_t*)(uni(p.ws) + XG), nullptr, (bf16_t*)(uni(p.ws) + XG), (float*)(uni(p.ws) + X_SSQ) + 2 * MTOK}; run_gemm<0>(lds, (bf16_t*)(uni(p.ws) + HBUF), (const bf16_t*)(uni(p.ws) + W_C_OUT), 2048, 2048, 2048, E); } }
    if constexpr ((REPMASK >> 18) & 1) { __syncthreads(); { pg8::EpiResid<true, false, true, true> E{nullptr, (const bf16_t*)(uni(p.ws) + XG), nullptr, (bf16_t*)(uni(p.ws) + XG), (float*)(uni(p.ws) + X_SSQ) + 2 * MTOK}; run_gemm<0>(lds, (bf16_t*)(uni(p.ws) + HBUF), (const bf16_t*)(uni(p.ws) + W_C_OUT), 2048, 2048, 2048, E); } }
    xcd_barrier(xb);
    if constexpr ((PHMASK >> 20) & 1) { { pg8::EpiStoreD E{(bf16_t*)(uni(p.ws) + LAT), (bf16_t*)(uni(p.ws) + HBUF), (const float*)(uni(p.ws) + X_SSQ) + 2 * MTOK, (float*)(uni(p.ws) + X_SSQ) + 3 * MTOK}; run_gemm<0>(lds, (const bf16_t*)(uni(p.ws) + XG), (const bf16_t*)(uni(p.ws) + W_D_IN), 3328, 2048, 2048, E); } }
    if constexpr ((REPMASK >> 20) & 1) { __syncthreads(); { pg8::EpiStoreD E{(bf16_t*)(uni(p.ws) + LAT), (bf16_t*)(uni(p.ws) + HBUF), (const float*)(uni(p.ws) + X_SSQ) + 2 * MTOK, (float*)(uni(p.ws) + X_SSQ) + 3 * MTOK}; run_gemm<0>(lds, (const bf16_t*)(uni(p.ws) + XG), (const bf16_t*)(uni(p.ws) + W_D_IN), 3328, 2048, 2048, E); } }
    xcd_barrier(xb);
    if constexpr ((PHMASK >> 22) & 1) { { pg8::EpiStoreU E{(bf16_t*)(uni(p.ws) + ACT), (const float*)(uni(p.ws) + X_SSQ) + 3 * MTOK}; run_gemm<1>(lds, (const bf16_t*)(uni(p.ws) + LAT), (const bf16_t*)(uni(p.ws) + W_D_UQKV), 7168, 512, 1088, E); } }
    if constexpr ((REPMASK >> 22) & 1) { __syncthreads(); { pg8::EpiStoreU E{(bf16_t*)(uni(p.ws) + ACT), (const float*)(uni(p.ws) + X_SSQ) + 3 * MTOK}; run_gemm<1>(lds, (const bf16_t*)(uni(p.ws) + LAT), (const bf16_t*)(uni(p.ws) + W_D_UQKV), 7168, 512, 1088, E); } }
    xcd_barrier(xb);
    if constexpr ((PHMASK >> 23) & 1) { phase_mla_qk(p); }
    if constexpr ((REPMASK >> 23) & 1) { __syncthreads(); phase_mla_qk(p); }
    xcd_barrier(xb);
    if constexpr ((PHMASK >> 24) & 1) { phase_attn_d(p, lds); }
    if constexpr ((REPMASK >> 24) & 1) { __syncthreads(); phase_attn_d(p, lds); }
    xcd_barrier(xb);
    if constexpr ((PHMASK >> 25) & 1) { { pg8::EpiResid<true, true, false, false> E{nullptr, (const bf16_t*)(uni(p.ws) + XG), uni(p.out), nullptr, nullptr}; run_gemm<0>(lds, (bf16_t*)(uni(p.ws) + HBUF), (const bf16_t*)(uni(p.ws) + W_D_OUT), 2048, 2048, 2048, E); } }
    if constexpr ((REPMASK >> 25) & 1) { __syncthreads(); { pg8::EpiResid<true, true, false, false> E{nullptr, (const bf16_t*)(uni(p.ws) + XG), uni(p.out), nullptr, nullptr}; run_gemm<0>(lds, (bf16_t*)(uni(p.ws) + HBUF), (const bf16_t*)(uni(p.ws) + W_D_OUT), 2048, 2048, 2048, E); } }
#ifdef XSYNC
    for (int i = 0; i < XSYNC; ++i) xcd_barrier(xb);
#endif
}

extern "C" void kernel_launch(void* const* d_in, const int* in_sizes, int n_in, void* d_out, int out_size, void* d_ws, size_t ws_size, hipStream_t stream) {
    static int grid_blocks = 0;
    if (!grid_blocks) {
        int dev = 0, cus = 0, per_cu = 0;
        hipGetDevice(&dev);
        hipDeviceGetAttribute(&cus, hipDeviceAttributeMultiprocessorCount, dev);
        hipFuncSetAttribute((const void*)mega, hipFuncAttributeMaxDynamicSharedMemorySize, LDS_BYTES);
        hipOccupancyMaxActiveBlocksPerMultiprocessor(&per_cu, (const void*)mega, 512, LDS_BYTES);
        if (per_cu < 1) per_cu = 1;
        grid_blocks = cus * per_cu;
        if (ws_size < EXTRA + 65536 + 6 * 65536) fprintf(stderr, "kernel_launch: workspace too small (%zu < %zu)\n", ws_size, (size_t)WS_END);
    }
    Params p; memset(&p, 0, sizeof(p));
    for (int i = 0; i < 29; ++i) p.in[i] = (const float*)d_in[i];
    p.out = (float*)d_out; p.ws = (unsigned char*)d_ws;
    unsigned char* ws = (unsigned char*)d_ws;
    int nj = 0, tiles = 0;
    auto add = [&](const float* src, size_t dst_off, int K, int N, int ldw, int npad) {
        TJob& j = p.jobs[nj++]; j.src = src; j.dst = (bf16_t*)(ws + dst_off); j.kscale = nullptr; j.K = K; j.N = N; j.ldw = ldw; j.ntn = npad / 64; j.tile0 = tiles; j.pad = 0; tiles += (npad / 64) * (K / 256);
    };
    add(p.in[3], W_A_IN, 2048, 8192, 8192, 8192); p.jobs[0].pad = 1; p.jobs[0].kscale = p.in[1];
    add(p.in[7], W_A_OUT, 2048, 2048, 2048, 2048);
    add(p.in[8], W_B_IN, 2048, 6160, 6160, 6400); p.jobs[nj - 1].kscale = p.in[1] + 2048;
    add(p.in[12], W_B_OUT, 2048, 2048, 2048, 2048);
    add(p.in[13], W_C_IN, 2048, 4096, 4096, 4096); p.jobs[nj - 1].kscale = p.in[1] + 4096;
    add(p.in[21], W_C_OUT, 2048, 2048, 2048, 2048);
    add(p.in[22], W_D_IN, 2048, 3136, 3136, 3328); p.jobs[nj - 1].kscale = p.in[1] + 6144;
    add(p.in[25], W_D_UQKV, 512, 3072, 3072, 3072); p.jobs[nj - 1].kscale = p.in[23];
    add(p.in[26], W_D_UQKV + (size_t)3072 * 512 * 2, 512, 4096, 4096, 4096); p.jobs[nj - 1].kscale = p.in[24];
    add(p.in[28], W_D_OUT, 2048, 2048, 2048, 2048);
    for (int n = 0; n < 8; ++n) for (int half = 0; half < 2; ++half) for (int bj = 0; bj < 2; ++bj)
        add(p.in[bj ? 18 : 16] + (size_t)n * 65536 + half * 128, W_C_GATE + ((size_t)((n * 2 + half) * 256 + 128 * bj)) * 256 * 2, 256, 128, 256, 128);
    p.njobs = nj; p.ntiles = tiles;
    hipMemsetAsync(ws + WS_BAR, 0, XCD_BAR_WORDS * 4, stream);
    void* args[] = {(void*)&p};
    hipError_t e = hipLaunchCooperativeKernel((const void*)mega, dim3(grid_blocks), dim3(512), args, LDS_BYTES, stream);
    if (e != hipSuccess) fprintf(stderr, "cooperative launch failed: %s (grid %d)\n", hipGetErrorString(e), grid_blocks);
}
```

```cpp
#include <hip/hip_runtime.h>
#include <hip/hip_cooperative_groups.h>
#include <cstdio>
#include <cstring>
namespace cg = cooperative_groups;

#define DI __device__ __forceinline__
#define LAS __attribute__((address_space(3)))
typedef unsigned short bf16_t;
typedef short bf16x8 __attribute__((ext_vector_type(8)));
typedef short s16x4 __attribute__((ext_vector_type(4)));
typedef float f32x2 __attribute__((ext_vector_type(2)));
typedef float f32x4 __attribute__((ext_vector_type(4)));
typedef float f32x16 __attribute__((ext_vector_type(16)));
typedef unsigned u32x2 __attribute__((ext_vector_type(2)));
typedef unsigned u32x4 __attribute__((ext_vector_type(4)));
typedef __bf16 bf16v2_t __attribute__((ext_vector_type(2)));

constexpr int MTOK = 16384, DM = 2048, SEQ = 4096;
constexpr float EPS = 1e-6f, LOG2E = 1.4426950408889634f;
constexpr size_t MiB = (size_t)1 << 20;
constexpr size_t W_A_IN = 0, W_A_OUT = 32 * MiB, W_B_IN = 40 * MiB, W_B_OUT = 65 * MiB, W_C_IN = 73 * MiB, W_C_GATE = 89 * MiB,
                 W_C_OUT = 91 * MiB, W_D_IN = 99 * MiB, W_D_UQKV = 112 * MiB, W_D_OUT = 119 * MiB, HBUF = 127 * MiB, ACT = 191 * MiB,
                 WS_END = 511 * MiB;
constexpr size_t LAT = 0;
constexpr size_t EXTRA = 511 * MiB;
constexpr size_t X_BIAS = EXTRA + 16384, X_SP8 = EXTRA + 32768, X_SSQ = EXTRA + 65536;
constexpr size_t GLA_TOT = ACT + 200 * MiB;
constexpr size_t XG = ACT + 256 * MiB;
constexpr size_t WS_BAR = EXTRA;
constexpr int LDS_BYTES = 131072 + 2048;
#ifndef PHMASK
#define PHMASK 0xffffffffull
#endif
#ifndef REPMASK
#define REPMASK 0ull
#endif

struct TJob { const float* src; bf16_t* dst; const float* kscale; int K, N, ldw, ntn, tile0, pad; };
struct Params { const float* in[29]; float* out; unsigned char* ws; int njobs, ntiles; TJob jobs[44]; };

DI int otid() { int t = threadIdx.x; asm volatile("" : "+v"(t)); return t; }
template <class T> DI T* uni(T* p) {
    const unsigned long long v = (unsigned long long)p;
    const unsigned lo = __builtin_amdgcn_readfirstlane((unsigned)v), hi = __builtin_amdgcn_readfirstlane((unsigned)(v >> 32));
    return (T*)(((unsigned long long)hi << 32) | lo);
}
DI float bf2f(bf16_t v) { return __uint_as_float((unsigned)v << 16); }
DI unsigned pk2(float a, float b) { f32x2 v = {a, b}; bf16v2_t r = __builtin_convertvector(v, bf16v2_t); return __builtin_bit_cast(unsigned, r); }
DI bf16_t f2bf(float a) { return (bf16_t)(pk2(a, 0.f) & 0xffffu); }
DI void unpack8(const u32x4 w, float (&f)[8]) {
#pragma unroll
    for (int i = 0; i < 4; ++i) { f[2 * i] = __uint_as_float(w[i] << 16); f[2 * i + 1] = __uint_as_float(w[i] & 0xffff0000u); }
}
DI u32x4 pack8(const float (&f)[8]) { u32x4 w; w.x = pk2(f[0], f[1]); w.y = pk2(f[2], f[3]); w.z = pk2(f[4], f[5]); w.w = pk2(f[6], f[7]); return w; }
DI float wsum(float v) {
#pragma unroll
    for (int m = 32; m >= 1; m >>= 1) v += __shfl_xor(v, m);
    return v;
}
DI float sigm(float x) { return 1.f / (1.f + __expf(-x)); }
DI float silu(float x) { return x / (1.f + __expf(-x)); }
DI int crow(int i, int hh) { return (i & 3) + 8 * (i >> 2) + 4 * hh; }
DI f32x16 mfma32(bf16x8 a, bf16x8 b, f32x16 c) { return __builtin_amdgcn_mfma_f32_32x32x16_bf16(a, b, c, 0, 0, 0); }
DI s16x4 trread(LAS unsigned char* p) { return __builtin_amdgcn_ds_read_tr16_b64_v4i16((LAS s16x4*)p); }
DI bf16x8 cat4(s16x4 lo, s16x4 hi) { return __builtin_shufflevector(lo, hi, 0, 1, 2, 3, 4, 5, 6, 7); }

namespace pg8 {
constexpr int BM = 256, BK = 64, HALF = 128, HTB = HALF * BK * 2, STAGE_BYTES = 8 * HTB, NXCD = 8, WGM = 8;
DI int lds_byte(int r, int c) { const int st = (r >> 4) * 2 + (c >> 5), rr = r & 15, cc = c & 31, ob = rr * 64 + cc * 2; return st * 1024 + (ob ^ (((ob >> 9) & 1) << 5)); }
DI void stage_rc(int b, int& R, int& C) { const int st = b / 1024, sb = b % 1024, swz = sb ^ (((sb >> 9) & 1) << 5); R = (st >> 1) * 16 + swz / 64; C = (st & 1) * 32 + (swz % 64) / 2; }
DI int perm32(int rho) { const int n = rho >> 4, i = rho & 15; return 8 * (i >> 2) + 4 * n + (i & 3); }
struct Unit { int pm, pn; size_t aoff, boff; };
template <int MODE> struct Sched {
    int nM, nN, nwg, G, c, lda, K;
    DI void init(int M, int N, int G_, int c_, int lda_, int K_) { nM = M / BM; nN = N / BM; nwg = nM * nN; G = G_; c = c_; lda = lda_; K = K_; }
    DI bool next(int i, Unit& u) const {
        const long L = (long)i * G + c; if (L >= nwg) return false;
        int wgid = (int)L; { const int q = nwg / NXCD, r = nwg % NXCD, xcd = wgid % NXCD, off = wgid / NXCD; wgid = (xcd < r ? xcd * (q + 1) : r * (q + 1) + (xcd - r) * q) + off; }
        const int nig = WGM * nN, gid = wgid / nig, fm = gid * WGM, gsz = (nM - fm) < WGM ? (nM - fm) : WGM;
        u.pm = fm + ((wgid % nig) % gsz); u.pn = (wgid % nig) / gsz;
        u.aoff = (size_t)u.pm * 256 * lda * 2; u.boff = (size_t)u.pn * 256 * K * 2;
        if (MODE == 1 && u.pn >= 12) u.aoff += 1024;
        if (MODE == 2) u.aoff += (size_t)(u.pn >> 1) * 512;
        return true;
    }
};

template <class Epi, class SchedT>
DI void gemm_phase(LAS unsigned char* lds, const bf16_t* Ap, const bf16_t* Btp, const int K, const int lda, const SchedT& S, const Epi& E) {
    const int tid = otid(), wid = __builtin_amdgcn_readfirstlane(tid >> 6), lane = tid & 63, wr = wid >> 2, wc = wid & 3, fr = lane & 15, fq = lane >> 4;
    const int nt = K / BK;
    unsigned voffA[2], voffB[2];
#pragma unroll
    for (int i = 0; i < 2; ++i) { int R, C; stage_rc(tid * 16 + i * 8192, R, C); const int Rb = (R & ~31) + perm32(R & 31);
        voffA[i] = (unsigned)(R * lda + C) * 2u; voffB[i] = (unsigned)(Rb * K + C) * 2u; }
    const size_t kstep = (size_t)(BK * 2);
    const size_t hstepA = (size_t)HALF * lda * 2, hstepB = (size_t)HALF * K * 2;
    const unsigned ldsw = (unsigned)wid * 1024u;
    const int aoff = lds_byte(wr * 64 + fr, fq * 8), boff = lds_byte(wc * 32 + fr, fq * 8);
#define PG8_SA(b, h) (((b) * 2 + (h)) * HTB)
#define PG8_SB(b, h) ((4 + (b) * 2 + (h)) * HTB)
#define PG8_STAGE(bufoff, gbase, voff) do { _Pragma("unroll") for (int _i = 0; _i < 2; ++_i) \
        __builtin_amdgcn_global_load_lds((const unsigned*)((const char*)(gbase) + (voff)[_i]), (LAS unsigned*)(lds + (bufoff) + ldsw + _i * 8192), 16, 0, 0); } while (0)
#define PG8_LDA(dst, b, h) do { _Pragma("unroll") for (int m = 0; m < 4; ++m) _Pragma("unroll") for (int k = 0; k < 2; ++k) dst[m][k] = *(const LAS bf16x8*)(lds + PG8_SA(b, h) + aoff + m * 2048 + k * 1024); } while (0)
#define PG8_LDB(dst, b, h) do { _Pragma("unroll") for (int n = 0; n < 2; ++n) _Pragma("unroll") for (int k = 0; k < 2; ++k) dst[n][k] = *(const LAS bf16x8*)(lds + PG8_SB(b, h) + boff + n * 2048 + k * 1024); } while (0)
#define PG8_MMA(ai, bj, At, Bt) do { __builtin_amdgcn_s_setprio(1); _Pragma("unroll") for (int m = 0; m < 4; ++m) _Pragma("unroll") for (int n = 0; n < 2; ++n) _Pragma("unroll") for (int k = 0; k < 2; ++k) \
        acc[ai][bj][m][n] = __builtin_amdgcn_mfma_f32_16x16x32_bf16(Bt[n][k], At[m][k], acc[ai][bj][m][n], 0, 0, 0); __builtin_amdgcn_s_setprio(0); } while (0)
#define PG8_WAIT_V(n) asm volatile("s_waitcnt vmcnt(" #n ")" ::: "memory")
#define PG8_WAIT_L(n) asm volatile("s_waitcnt lgkmcnt(" #n ")" ::: "memory")
#define PG8_BAR __builtin_amdgcn_s_barrier()
#define PG8_SCHED __builtin_amdgcn_sched_barrier(0)
    Unit cur, nxt; int ui = 0;
    if (!S.next(0, cur)) return;
    float pre[8]; E.prefetch(cur, wr, fr, pre);
    f32x4 acc[2][2][4][2];
#pragma unroll
    for (int a = 0; a < 2; ++a)
#pragma unroll
        for (int b = 0; b < 2; ++b)
#pragma unroll
            for (int m = 0; m < 4; ++m)
#pragma unroll
                for (int n = 0; n < 2; ++n) acc[a][b][m][n] = (f32x4){0.f, 0.f, 0.f, 0.f};
    bf16x8 At[4][2], B0[2][2], B1[2][2];
    const char* cA = (const char*)Ap + cur.aoff; const char* cB = (const char*)Btp + cur.boff;
    PG8_STAGE(PG8_SB(0, 0), cB, voffB); PG8_STAGE(PG8_SA(0, 0), cA, voffA); PG8_STAGE(PG8_SB(0, 1), cB + hstepB, voffB); PG8_STAGE(PG8_SA(0, 1), cA + hstepA, voffA);
    if (wr == 1) PG8_BAR;
    PG8_WAIT_V(4); PG8_BAR;
    PG8_STAGE(PG8_SB(1, 0), cB + kstep, voffB); PG8_STAGE(PG8_SA(1, 0), cA + kstep, voffA); PG8_STAGE(PG8_SB(1, 1), cB + hstepB + kstep, voffB);
    PG8_WAIT_V(6); PG8_BAR;
    for (;;) {
        const bool has_next = S.next(ui + 1, nxt);
        const char* nA = has_next ? (const char*)Ap + nxt.aoff : cA; const char* nB = has_next ? (const char*)Btp + nxt.boff : cB;
        for (int t = 0; t < nt; t += 2) {
            const bool last = (t == nt - 2);
            const char* a1 = cA + (size_t)(t + 1) * kstep;
            const char* a2 = last ? nA : cA + (size_t)(t + 2) * kstep; const char* b2 = last ? nB : cB + (size_t)(t + 2) * kstep;
            const char* a3 = a2 + kstep; const char* b3 = b2 + kstep;
            PG8_LDB(B0, 0, 0); PG8_SCHED; PG8_LDA(At, 0, 0); PG8_STAGE(PG8_SA(1, 1), a1 + hstepA, voffA);
            PG8_WAIT_L(8); PG8_BAR; PG8_WAIT_L(0); PG8_MMA(0, 0, At, B0); PG8_BAR; PG8_SCHED;
            PG8_LDB(B1, 0, 1); PG8_STAGE(PG8_SB(0, 0), b2, voffB);
            PG8_BAR; PG8_WAIT_L(0); PG8_MMA(0, 1, At, B1); PG8_BAR;
            PG8_LDA(At, 0, 1); PG8_STAGE(PG8_SA(0, 0), a2, voffA);
            PG8_BAR; PG8_WAIT_L(0); PG8_MMA(1, 0, At, B0); PG8_BAR; PG8_SCHED;
            PG8_STAGE(PG8_SB(0, 1), b2 + hstepB, voffB);
            PG8_WAIT_V(6); PG8_BAR; PG8_MMA(1, 1, At, B1); PG8_BAR;
            PG8_LDB(B0, 1, 0); PG8_SCHED; PG8_LDA(At, 1, 0); PG8_STAGE(PG8_SA(0, 1), a2 + hstepA, voffA);
            PG8_WAIT_L(8); PG8_BAR; PG8_WAIT_L(0); PG8_MMA(0, 0, At, B0); PG8_BAR; PG8_SCHED;
            PG8_LDB(B1, 1, 1); PG8_STAGE(PG8_SB(1, 0), b3, voffB);
            PG8_BAR; PG8_WAIT_L(0); PG8_MMA(0, 1, At, B1); PG8_BAR;
            PG8_LDA(At, 1, 1); PG8_STAGE(PG8_SA(1, 0), a3, voffA);
            PG8_BAR; PG8_WAIT_L(0); PG8_MMA(1, 0, At, B0); PG8_BAR; PG8_SCHED;
            PG8_STAGE(PG8_SB(1, 1), b3 + hstepB, voffB);
            PG8_WAIT_V(6); PG8_BAR; PG8_MMA(1, 1, At, B1); PG8_BAR;
        }
        E(acc, cur, wr, wc, fr, fq, pre);
        if (!has_next) break;
#pragma unroll
        for (int a = 0; a < 2; ++a)
#pragma unroll
            for (int b = 0; b < 2; ++b)
#pragma unroll
                for (int m = 0; m < 4; ++m)
#pragma unroll
                    for (int n = 0; n < 2; ++n) acc[a][b][m][n] = (f32x4){0.f, 0.f, 0.f, 0.f};
        cur = nxt; cA = nA; cB = nB; ++ui; E.prefetch(cur, wr, fr, pre);
    }
    PG8_WAIT_V(0);
    if (wr == 0) PG8_BAR;
    PG8_BAR;
#undef PG8_SA
#undef PG8_SB
#undef PG8_STAGE
#undef PG8_LDA
#undef PG8_LDB
#undef PG8_MMA
#undef PG8_WAIT_V
#undef PG8_WAIT_L
#undef PG8_BAR
#undef PG8_SCHED
}

typedef f32x4 Acc[2][2][4][2];
struct EpiStore {
    bf16_t* O; int ldc; const float* ssq;
    DI void prefetch(const Unit& u, int wr, int fr, float (&pre)[8]) const {
#pragma unroll
        for (int i = 0; i < 8; ++i) pre[i] = ssq ? ssq[u.pm * BM + wr * 64 + fr + (i >> 2) * HALF + (i & 3) * 16] : 0.f; }
    DI void operator()(const Acc& acc, const Unit& u, int wr, int wc, int fr, int fq, const float (&pre)[8]) const {
        const int row0 = u.pm * BM + wr * 64 + fr, col0 = u.pn * BM + wc * 32 + 8 * fq;
#pragma unroll
        for (int ai = 0; ai < 2; ++ai)
#pragma unroll
            for (int m = 0; m < 4; ++m) { bf16_t* rowp = O + (size_t)(row0 + ai * HALF + m * 16) * ldc + col0;
                const float rs = ssq ? rsqrtf(pre[ai * 4 + m] * (1.f / DM) + EPS) : 1.f;
#pragma unroll
                for (int bj = 0; bj < 2; ++bj) { const f32x4 v0 = acc[ai][bj][m][0] * rs, v1 = acc[ai][bj][m][1] * rs;
                    u32x4 w; w.x = pk2(v0[0], v0[1]); w.y = pk2(v0[2], v0[3]); w.z = pk2(v1[0], v1[1]); w.w = pk2(v1[2], v1[3]);
                    *(u32x4*)(rowp + bj * HALF) = w; } }
    }
};
struct EpiStoreA {
    bf16_t* O; const float* qkg; const float* ssq;
    DI void prefetch(const Unit& u, int wr, int fr, float (&pre)[8]) const {
#pragma unroll
        for (int i = 0; i < 8; ++i) pre[i] = ssq[u.pm * BM + wr * 64 + fr + (i >> 2) * HALF + (i & 3) * 16]; }
    DI void operator()(const Acc& acc, const Unit& u, int wr, int wc, int fr, int fq, const float (&pre)[8]) const {
        const int row0 = u.pm * BM + wr * 64 + fr, col0 = u.pn * BM + wc * 64 + 8 * fq;
        const bool nrm = u.pn < 16;
        f32x4 gn[2][2];
        if (nrm) { const float* gp = qkg + (u.pn < 8 ? 0 : 64) + 8 * fq; const float gs = u.pn < 8 ? 0.125f * LOG2E : 1.f;
#pragma unroll
            for (int bj = 0; bj < 2; ++bj) { gn[bj][0] = *(const f32x4*)(gp + 32 * bj) * gs; gn[bj][1] = *(const f32x4*)(gp + 32 * bj + 4) * gs; } }
#pragma unroll
        for (int ai = 0; ai < 2; ++ai)
#pragma unroll
            for (int m = 0; m < 4; ++m) { bf16_t* rowp = O + (size_t)(row0 + ai * HALF + m * 16) * 8192 + col0;
                f32x4 v[2][2]; const float rs = rsqrtf(pre[ai * 4 + m] * (1.f / DM) + EPS);
#pragma unroll
                for (int bj = 0; bj < 2; ++bj) { v[bj][0] = acc[ai][bj][m][0] * rs; v[bj][1] = acc[ai][bj][m][1] * rs; }
                if (nrm) { float ss = 0.f;
#pragma unroll
                    for (int bj = 0; bj < 2; ++bj)
#pragma unroll
                        for (int n = 0; n < 2; ++n) ss += v[bj][n][0] * v[bj][n][0] + v[bj][n][1] * v[bj][n][1] + v[bj][n][2] * v[bj][n][2] + v[bj][n][3] * v[bj][n][3];
                    ss += __shfl_xor(ss, 16); ss += __shfl_xor(ss, 32);
                    const float sc = rsqrtf(ss * (1.f / 64.f) + EPS);
#pragma unroll
                    for (int bj = 0; bj < 2; ++bj) { v[bj][0] = v[bj][0] * sc * gn[bj][0]; v[bj][1] = v[bj][1] * sc * gn[bj][1]; } }
#pragma unroll
                for (int bj = 0; bj < 2; ++bj) { u32x4 w; w.x = pk2(v[bj][0][0], v[bj][0][1]); w.y = pk2(v[bj][0][2], v[bj][0][3]); w.z = pk2(v[bj][1][0], v[bj][1][1]); w.w = pk2(v[bj][1][2], v[bj][1][3]);
                    *(u32x4*)(rowp + 32 * bj) = w; } }
    }
};
struct EpiStoreD {
    bf16_t* lat; bf16_t* g; const float* ssq; float* ssql;
    DI void prefetch(const Unit& u, int wr, int fr, float (&pre)[8]) const {
#pragma unroll
        for (int i = 0; i < 8; ++i) pre[i] = ssq[u.pm * BM + wr * 64 + fr + (i >> 2) * HALF + (i & 3) * 16]; }
    DI void operator()(const Acc& acc, const Unit& u, int wr, int wc, int fr, int fq, const float (&pre)[8]) const {
        const int row0 = u.pm * BM + wr * 64 + fr, col0 = u.pn * BM + wc * 32 + 8 * fq;
#pragma unroll
        for (int ai = 0; ai < 2; ++ai)
#pragma unroll
            for (int m = 0; m < 4; ++m) { const size_t row = (size_t)(row0 + ai * HALF + m * 16);
                const float rs = rsqrtf(pre[ai * 4 + m] * (1.f / DM) + EPS); float ss = 0.f;
#pragma unroll
                for (int bj = 0; bj < 2; ++bj) { const f32x4 v0 = acc[ai][bj][m][0] * rs, v1 = acc[ai][bj][m][1] * rs;
                    ss += v0[0] * v0[0] + v0[1] * v0[1] + v0[2] * v0[2] + v0[3] * v0[3] + v1[0] * v1[0] + v1[1] * v1[1] + v1[2] * v1[2] + v1[3] * v1[3];
                    u32x4 w; w.x = pk2(v0[0], v0[1]); w.y = pk2(v0[2], v0[3]); w.z = pk2(v1[0], v1[1]); w.w = pk2(v1[2], v1[3]);
                    const int col = col0 + bj * HALF;
                    if (col < 1088) *(u32x4*)(lat + row * 1088 + col) = w;
                    else if (col < 3136) *(u32x4*)(g + row * 2048 + (col - 1088)) = w; }
                if (u.pn < 4) { ss += __shfl_xor(ss, 16); ss += __shfl_xor(ss, 32); if (fq == 0) atomicAdd(ssql + (u.pn >> 1) * MTOK + row, ss); } }
    }
};
struct EpiStoreU {
    bf16_t* O; const float* ssql;
    DI void prefetch(const Unit& u, int wr, int fr, float (&pre)[8]) const {
        const float* sq = ssql + (u.pn >= 12 ? MTOK : 0);
#pragma unroll
        for (int i = 0; i < 8; ++i) pre[i] = sq[u.pm * BM + wr * 64 + fr + (i >> 2) * HALF + (i & 3) * 16]; }
    DI void operator()(const Acc& acc, const Unit& u, int wr, int wc, int fr, int fq, const float (&pre)[8]) const {
        const int row0 = u.pm * BM + wr * 64 + fr, col0 = u.pn * BM + wc * 32 + 8 * fq;
        const float* sq = ssql + (u.pn >= 12 ? MTOK : 0);
#pragma unroll
        for (int ai = 0; ai < 2; ++ai)
#pragma unroll
            for (int m = 0; m < 4; ++m) { bf16_t* rowp = O + (size_t)(row0 + ai * HALF + m * 16) * 7168 + col0;
                const float rs = rsqrtf(pre[ai * 4 + m] * (1.f / 512.f) + EPS);
#pragma unroll
                for (int bj = 0; bj < 2; ++bj) { const f32x4 v0 = acc[ai][bj][m][0] * rs, v1 = acc[ai][bj][m][1] * rs;
                    u32x4 w; w.x = pk2(v0[0], v0[1]); w.y = pk2(v0[2], v0[3]); w.z = pk2(v1[0], v1[1]); w.w = pk2(v1[2], v1[3]);
                    *(u32x4*)(rowp + bj * HALF) = w; } }
    }
};
template <bool INB, bool OUTF, bool OUTB, bool SSQ> struct EpiResid {
    const float* xf; const bf16_t* xb; float* of; bf16_t* ob; float* ssq;
    DI void prefetch(const Unit&, int, int, float (&pre)[8]) const {
#pragma unroll
        for (int i = 0; i < 8; ++i) pre[i] = 0.f; }
    DI void operator()(const Acc& acc, const Unit& u, int wr, int wc, int fr, int fq, const float (&pre)[8]) const {
        const int row0 = u.pm * BM + wr * 64 + fr, col0 = u.pn * BM + wc * 32 + 8 * fq;
#pragma unroll
        for (int am = 0; am < 4; ++am) { const int ai = am >> 1;
            u32x4 xin8[4][2];
            if (INB) {
#pragma unroll
                for (int m = (am & 1) * 2; m < (am & 1) * 2 + 2; ++m)
#pragma unroll
                    for (int bj = 0; bj < 2; ++bj) xin8[m][bj] = *(const u32x4*)(xb + (size_t)(row0 + ai * HALF + m * 16) * DM + col0 + bj * HALF);
            }
#pragma unroll
            for (int m = (am & 1) * 2; m < (am & 1) * 2 + 2; ++m) { const int row = row0 + ai * HALF + m * 16; const size_t o = (size_t)row * DM + col0;
                float ss = 0.f;
#pragma unroll
                for (int bj = 0; bj < 2; ++bj) {
                    f32x4 x0, x1;
                    if (INB) { float f[8]; unpack8(xin8[m][bj], f); x0 = (f32x4){f[0], f[1], f[2], f[3]}; x1 = (f32x4){f[4], f[5], f[6], f[7]}; }
                    else { x0 = *(const f32x4*)(xf + o + bj * HALF); x1 = *(const f32x4*)(xf + o + bj * HALF + 4); }
                    x0 += acc[ai][bj][m][0]; x1 += acc[ai][bj][m][1];
                    if (OUTF) { __builtin_nontemporal_store(x0, (f32x4*)(of + o + bj * HALF)); __builtin_nontemporal_store(x1, (f32x4*)(of + o + bj * HALF + 4)); }
                    if (SSQ) ss += x0[0] * x0[0] + x0[1] * x0[1] + x0[2] * x0[2] + x0[3] * x0[3] + x1[0] * x1[0] + x1[1] * x1[1] + x1[2] * x1[2] + x1[3] * x1[3];
                    if (OUTB) { u32x4 w; w.x = pk2(x0[0], x0[1]); w.y = pk2(x0[2], x0[3]); w.z = pk2(x1[0], x1[1]); w.w = pk2(x1[2], x1[3]);
                        *(u32x4*)(ob + o + bj * HALF) = w; } }
                if (SSQ) { ss += __shfl_xor(ss, 16); ss += __shfl_xor(ss, 32); if (fq == 0) atomicAdd(ssq + row, ss); } }
        }
    }
};
struct EpiGates {
    const bf16_t* xc; const float* brg; const float* big; const float* sp8t; unsigned* ax;
    DI void prefetch(const Unit&, int, int, float (&pre)[8]) const {
#pragma unroll
        for (int i = 0; i < 8; ++i) pre[i] = 0.f; }
    DI void operator()(const Acc& acc, const Unit& u, int wr, int wc, int fr, int fq, const float (&pre)[8]) const {
        const int row0 = u.pm * BM + wr * 64 + fr, f0 = (u.pn >> 1) * 256 + (u.pn & 1) * 128 + wc * 32 + 8 * fq;
#pragma unroll
        for (int n = 0; n < 2; ++n) {
            const f32x4 br = *(const f32x4*)(brg + f0 + 4 * n), bi = *(const f32x4*)(big + f0 + 4 * n), sp = *(const f32x4*)(sp8t + f0 + 4 * n);
#pragma unroll
            for (int ai = 0; ai < 2; ++ai)
#pragma unroll
                for (int m = 0; m < 4; ++m) { const size_t o = (size_t)(row0 + ai * HALF + m * 16) * DM + f0 + 4 * n;
                    const u32x2 xw = *(const u32x2*)(xc + o);
                    const float xv[4] = {__uint_as_float(xw.x << 16), __uint_as_float(xw.x & 0xffff0000u), __uint_as_float(xw.y << 16), __uint_as_float(xw.y & 0xffff0000u)};
                    u32x4 w;
#pragma unroll
                    for (int e = 0; e < 4; ++e) { const float r = sigm(acc[ai][0][m][n][e] + br[e]), ig = sigm(acc[ai][1][m][n][e] + bi[e]);
                        const float la = -sp[e] * r, uu = -2.f * la;
                        const float om = uu * (1.f - uu * 0.5f * (1.f - uu * (1.f / 3.f) * (1.f - uu * 0.25f * (1.f - uu * 0.2f * (1.f - uu * (1.f / 6.f))))));
                        w[e] = pk2(la, sqrtf(fmaxf(om, 0.f)) * ig * xv[e]); }
                    *(u32x4*)(ax + o) = w; __builtin_amdgcn_sched_barrier(0); }
        }
    }
};
}

template <int MODE, class Epi>
DI void run_gemm(LAS unsigned char* lds, const bf16_t* A, const bf16_t* Bt, int N, int K, int lda, const Epi& E) {
    asm volatile("" : "+s"(K));
    pg8::Sched<MODE> S; S.init(MTOK, N, (int)gridDim.x, (int)blockIdx.x, lda, K);
    pg8::gemm_phase(lds, A, Bt, K, lda, S, E);
    __syncthreads();
}

DI void phase_convert(const Params& p, LAS unsigned char* lds) {
    LAS float* sm = (LAS float*)lds;
    const int tid = otid();
    for (int t = blockIdx.x; t < p.ntiles; t += gridDim.x) {
        int j = 0; while (j + 1 < p.njobs && p.jobs[j + 1].tile0 <= t) ++j;
        const float* src = p.jobs[j].src; bf16_t* dst = p.jobs[j].dst; const int K = p.jobs[j].K, N = p.jobs[j].N, ldw = p.jobs[j].ldw, ntn = p.jobs[j].ntn;
        const int tt = t - p.jobs[j].tile0, tn = tt % ntn, tk = tt / ntn, n0 = tn * 64, k0 = tk * 256;
        { const int n4 = (tid & 15) * 4, kr = tid >> 4; f32x4 v[8];
#pragma unroll
          for (int i = 0; i < 8; ++i) v[i] = (n0 + n4 < N) ? __builtin_nontemporal_load((const f32x4*)(src + (size_t)(k0 + kr + 32 * i) * ldw + n0 + n4)) : (f32x4){0.f, 0.f, 0.f, 0.f};
#pragma unroll
          for (int i = 0; i < 8; ++i) { LAS float* d = sm + (kr + 32 * i) * 65 + n4; d[0] = v[i][0]; d[1] = v[i][1]; d[2] = v[i][2]; d[3] = v[i][3]; } }
        __syncthreads();
        { const int nr = tid >> 3, kq = tid & 7;
#pragma unroll
          for (int jj = 0; jj < 4; ++jj) { const int kc = (kq + 8 * jj) * 8; float f[8];
#pragma unroll
              for (int e = 0; e < 8; ++e) f[e] = sm[(kc + e) * 65 + nr];
              if (p.jobs[j].kscale) { const float* ks = p.jobs[j].kscale + k0 + kc;
#pragma unroll
                  for (int e = 0; e < 8; ++e) f[e] *= ks[e]; }
              int nrow = n0 + nr; if (p.jobs[j].pad) { const int jl = nrow & 255; nrow = (nrow & ~255) + 128 * ((jl >> 5) & 1) + 32 * (jl >> 6) + (jl & 31); }
              *(u32x4*)(dst + (size_t)nrow * K + k0 + kc) = pack8(f); } }
        __syncthreads();
    }
}

DI int t5_bucket(int rel) {
    const int n = rel < 0 ? -rel : rel; int b;
    if (n < 8) b = n; else b = 8 + (n >= 12) + (n >= 16) + (n >= 23) + (n >= 32) + (n >= 46) + (n >= 64) + (n >= 91);
    return (rel > 0 ? 16 : 0) + b;
}
DI void phase_bias_table(const Params& p) {
    float* tb = (float*)(p.ws + X_BIAS);
    float* sp8 = (float*)(p.ws + X_SP8); float* ssq = (float*)(p.ws + X_SSQ);
    for (int i = blockIdx.x * 512 + otid(); i < 5 * MTOK; i += gridDim.x * 512) ssq[i] = 0.f;
    for (int i = blockIdx.x * 512 + otid(); i < 16 * 192 + 2048; i += gridDim.x * 512) {
        if (i < 16 * 192) { const int h = i / 192, idx = i % 192; tb[i] = (p.in[2][t5_bucket(idx - 128) * 16 + h] - p.in[2][15 * 16 + h]) * LOG2E; }
        else sp8[i - 16 * 192] = 8.f * log1pf(expf(-p.in[20][i - 16 * 192]));
    }
}

DI void phase_x0(const float* x, bf16_t* out, float* ssq) {
    const int tid = otid(), lane = tid & 63, gw = blockIdx.x * 8 + (tid >> 6), nw = gridDim.x * 8;
    for (int row0 = gw; row0 < MTOK; row0 += 2 * nw) {
        f32x4 v[2][8]; bool ok[2]; int rw[2];
#pragma unroll
        for (int r = 0; r < 2; ++r) { ok[r] = row0 + r * nw < MTOK; rw[r] = ok[r] ? row0 + r * nw : row0;
            const f32x4* xr = (const f32x4*)(x + (size_t)rw[r] * DM);
#pragma unroll
            for (int i = 0; i < 4; ++i) { v[r][2 * i] = __builtin_nontemporal_load(xr + i * 128 + lane * 2); v[r][2 * i + 1] = __builtin_nontemporal_load(xr + i * 128 + lane * 2 + 1); } }
#pragma unroll
        for (int r = 0; r < 2; ++r) {
            float ss = 0.f;
#pragma unroll
            for (int i = 0; i < 8; ++i) ss += v[r][i][0] * v[r][i][0] + v[r][i][1] * v[r][i][1] + v[r][i][2] * v[r][i][2] + v[r][i][3] * v[r][i][3];
            ss = wsum(ss);
            if (ok[r]) {
                if (lane == 0) ssq[rw[r]] = ss;
#pragma unroll
                for (int i = 0; i < 4; ++i) { u32x4 w; w.x = pk2(v[r][2 * i][0], v[r][2 * i][1]); w.y = pk2(v[r][2 * i][2], v[r][2 * i][3]); w.z = pk2(v[r][2 * i + 1][0], v[r][2 * i + 1][1]); w.w = pk2(v[r][2 * i + 1][2], v[r][2 * i + 1][3]);
                    *(u32x4*)(out + (size_t)rw[r] * DM + i * 512 + lane * 8) = w; }
            }
        }
    }
}

DI void phase_rmsnorm(const float* x, const float* g, bf16_t* out) {
    const int tid = otid(), lane = tid & 63, gw = blockIdx.x * 8 + (tid >> 6), nw = gridDim.x * 8;
    for (int row = gw; row < MTOK; row += nw) {
        const f32x4* xr = (const f32x4*)(x + (size_t)row * DM); f32x4 v[8]; float ss = 0.f;
#pragma unroll
        for (int i = 0; i < 4; ++i) { v[2 * i] = xr[i * 128 + lane * 2]; v[2 * i + 1] = xr[i * 128 + lane * 2 + 1]; }
#pragma unroll
        for (int i = 0; i < 8; ++i) ss += v[i][0] * v[i][0] + v[i][1] * v[i][1] + v[i][2] * v[i][2] + v[i][3] * v[i][3];
        ss = wsum(ss); const float sc = rsqrtf(ss * (1.f / DM) + EPS);
#pragma unroll
        for (int i = 0; i < 4; ++i) { const int c = i * 512 + lane * 8; const f32x4 g0 = *(const f32x4*)(g + c), g1 = *(const f32x4*)(g + c + 4);
            u32x4 w; w.x = pk2(v[2 * i][0] * sc * g0[0], v[2 * i][1] * sc * g0[1]); w.y = pk2(v[2 * i][2] * sc * g0[2], v[2 * i][3] * sc * g0[3]);
            w.z = pk2(v[2 * i + 1][0] * sc * g1[0], v[2 * i + 1][1] * sc * g1[1]); w.w = pk2(v[2 * i + 1][2] * sc * g1[2], v[2 * i + 1][3] * sc * g1[3]);
            *(u32x4*)(out + (size_t)row * DM + c) = w; }
    }
}

DI void phase_qknorm_a(const Params& p) {
    bf16_t* big = (bf16_t*)(p.ws + ACT); const float* qkg = p.in[4];
    const int tid = otid(), lane = tid & 63, gw = blockIdx.x * 8 + (tid >> 6), nw = gridDim.x * 8;
    float gq[8], gk[8];
#pragma unroll
    for (int e = 0; e < 8; ++e) { gq[e] = qkg[(lane & 7) * 8 + e] * (0.125f * LOG2E); gk[e] = qkg[64 + (lane & 7) * 8 + e]; }
    for (int row = gw; row < MTOK; row += nw) {
#pragma unroll
        for (int i = 0; i < 8; ++i) {
            bf16_t* ptr = big + (size_t)row * 8192 + i * 512 + lane * 8; float f[8]; unpack8(*(const u32x4*)ptr, f);
            float ss = 0.f;
#pragma unroll
            for (int e = 0; e < 8; ++e) ss += f[e] * f[e];
            ss += __shfl_xor(ss, 1); ss += __shfl_xor(ss, 2); ss += __shfl_xor(ss, 4);
            const float sc = rsqrtf(ss * (1.f / 64.f) + EPS);
#pragma unroll
            for (int e = 0; e < 8; ++e) f[e] = f[e] * sc * (i < 4 ? gq[e] : gk[e]);
            *(u32x4*)ptr = pack8(f);
        }
    }
}

template <int DQK, int KA8, int DV, bool BIAS, bool JOINT>
DI void attn_core(LAS unsigned char* lds, const bf16_t* Qrow, const bf16_t* KpA, int ldkA, const bf16_t* KpB, int ldkB, const bf16_t* Vp, int ldv,
                  int qb, int wid, int lane, const float* qng  , f32x16 (&O)[DV / 32]) {
    constexpr int KROW = DQK * 2 + 16, VROW = DV * 2 + 64  , KC = DQK / 8, VC = DV / 8, NKC = 64 * KC, NVC = 64 * VC, NL = (NKC + NVC) / 512, STG = 64 * (KROW + VROW);
    static_assert(NKC % 512 == 0 && NVC % 512 == 0, "loader split");
    const int tid = otid(), l32 = lane & 31, hh = lane >> 5, i16 = lane & 15, tq = i16 >> 2, tp = i16 & 3, blk = (lane >> 4) & 1;
    const int q0w = qb * 256 + wid * 32, nkt = 4 * qb + 4, myc = q0w >> 6;
    bf16x8 qf[DQK / 16];
#pragma unroll
    for (int s = 0; s < DQK / 16; ++s) qf[s] = *(const bf16x8*)(Qrow + 16 * s + 8 * hh);
    if constexpr (DQK == 192) {
        if (qng) {
            float ssn = 0.f, ssr = 0.f;
#pragma unroll
            for (int s = 0; s < 12; ++s) { float f[8]; unpack8(__builtin_bit_cast(u32x4, qf[s]), f); float t = 0.f;
#pragma unroll
                for (int e = 0; e < 8; ++e) t += f[e] * f[e];
                if (s < 8) ssn += t; else ssr += t; }
            ssn += __shfl_xor(ssn, 32); ssr += __shfl_xor(ssr, 32);
            const float qs = 0.07216878364870322f * LOG2E, scn = rsqrtf(ssn * (1.f / 128.f) + EPS) * qs, scr = rsqrtf(ssr * (1.f / 64.f) + EPS) * qs;
#pragma unroll
            for (int s = 0; s < 8; ++s) { float f[8]; unpack8(__builtin_bit_cast(u32x4, qf[s]), f);
                const f32x4 g0 = *(const f32x4*)(qng + 16 * s + 8 * hh), g1 = *(const f32x4*)(qng + 16 * s + 8 * hh + 4);
#pragma unroll
                for (int e = 0; e < 4; ++e) { f[e] *= scn * g0[e]; f[4 + e] *= scn * g1[e]; }
                qf[s] = __builtin_bit_cast(bf16x8, pack8(f)); }
            const float posr = (float)(qb * 256 + wid * 32 + l32) * 0.15915494309189535f;
#pragma unroll
            for (int s = 8; s < 10; ++s) { float f1[8], f2[8]; unpack8(__builtin_bit_cast(u32x4, qf[s]), f1); unpack8(__builtin_bit_cast(u32x4, qf[s + 2]), f2);
#pragma unroll
                for (int e = 0; e < 8; ++e) { const int i = 16 * (s - 8) + 8 * hh + e;
                    const float a1 = f1[e] * scr * qng[128 + i], a2 = f2[e] * scr * qng[160 + i];
                    float rev = posr * __builtin_amdgcn_exp2f(-(float)i * 0.41524101186092029f); rev -= floorf(rev);
                    const float sn = __builtin_amdgcn_sinf(rev), cs = __builtin_amdgcn_cosf(rev);
                    f1[e] = a1 * cs - a2 * sn; f2[e] = a2 * cs + a1 * sn; }
                qf[s] = __builtin_bit_cast(bf16x8, pack8(f1)); qf[s + 2] = __builtin_bit_cast(bf16x8, pack8(f2)); }
            __builtin_amdgcn_sched_barrier(0);
        }
    }
    float m = 0.f, l = 0.f; bool mnz = false;
#pragma unroll
    for (int dt = 0; dt < DV / 32; ++dt)
#pragma unroll
        for (int i = 0; i < 16; ++i) O[dt][i] = 0.f;
    u32x4 stg[NL];
    LAS const float* btab = (LAS const float*)(lds + 2 * STG);
    const unsigned koff = l32 * KROW + 16 * hh, vtr = (4 * hh + tq) * VROW + (16 * blk + 4 * tp) * 2;

    auto gload = [&](int kt) {
#pragma unroll
        for (int i = 0; i < NL; ++i) { const int c = tid + i * 512;
            if (i * 512 < NKC) { const int row = c / KC, cc = c % KC;
                const bf16_t* src = (cc < KA8) ? KpA + (size_t)(kt * 64 + row) * ldkA + cc * 8 : KpB + (size_t)(kt * 64 + row) * ldkB + (cc - KA8) * 8;
                stg[i] = *(const u32x4*)src; }
            else { const int c2 = c - NKC, row = c2 / VC, cc = c2 % VC; stg[i] = *(const u32x4*)(Vp + (size_t)(kt * 64 + row) * ldv + cc * 8); } }
    };
    auto lstore = [&](int buf) {
#pragma unroll
        for (int i = 0; i < NL; ++i) { const int c = tid + i * 512;
            if (i * 512 < NKC) { const int row = c / KC, cc = c % KC; *(LAS u32x4*)(lds + buf * STG + row * KROW + cc * 16) = stg[i]; }
            else { const int c2 = c - NKC, row = c2 / VC, cc = c2 % VC; *(LAS u32x4*)(lds + buf * STG + 64 * KROW + row * VROW + cc * 16) = stg[i]; } }
    };

    gload(0); lstore(0); __syncthreads();
    for (int kt = 0; kt < nkt; ++kt) {
        if (kt + 1 < nkt) gload(kt + 1);
        if (JOINT && kt <= myc) {
            LAS unsigned char* kb = lds + (kt & 1) * STG; LAS unsigned char* vb = kb + 64 * KROW;
            const bool far = (kt * 64 + 63 - q0w <= -91);
            f32x16 S0, S1;
#pragma unroll
            for (int i = 0; i < 16; ++i) { S0[i] = 0.f; S1[i] = 0.f; }
#pragma unroll
            for (int s = 0; s < DQK / 16; ++s) {
                const bf16x8 k0 = *(LAS const bf16x8*)(kb + koff + 32 * s), k1 = *(LAS const bf16x8*)(kb + koff + 32 * KROW + 32 * s);
                S0 = mfma32(k0, qf[s], S0); S1 = mfma32(k1, qf[s], S1);
            }
            if (BIAS && !far) {
                const int rb = kt * 64 - (q0w + l32) + 128;
#pragma unroll
                for (int i = 0; i < 16; ++i) { const int i0 = rb + crow(i, hh); S0[i] += btab[i0 < 0 ? 0 : i0]; S1[i] += btab[i0 + 32 < 0 ? 0 : i0 + 32]; }
            }
            if (mnz) {
#pragma unroll
                for (int i = 0; i < 16; ++i) { S0[i] -= m; S1[i] -= m; }
            }
            float mx = fmaxf(S0[0], S1[0]);
#pragma unroll
            for (int i = 1; i < 16; ++i) mx = fmaxf(mx, fmaxf(S0[i], S1[i]));
            mx = fmaxf(mx, __shfl_xor(mx, 32));
            if (__any(mx > 64.f || (kt == 0 && mx < -64.f))) {
                const float dm = (mx > 64.f || (kt == 0 && mx < -64.f)) ? mx : 0.f, alpha = __builtin_amdgcn_exp2f(-dm); m += dm; mnz = true;
                l *= alpha;
#pragma unroll
                for (int dt = 0; dt < DV / 32; ++dt) O[dt] *= alpha;
#pragma unroll
                for (int i = 0; i < 16; ++i) { S0[i] -= dm; S1[i] -= dm; }
            }
            float ps = 0.f;
#pragma unroll
            for (int i = 0; i < 16; ++i) { S0[i] = __builtin_amdgcn_exp2f(S0[i]); S1[i] = __builtin_amdgcn_exp2f(S1[i]); ps += S0[i] + S1[i]; }
            l += ps;
#pragma unroll
            for (int half = 0; half < 2; ++half)
#pragma unroll
                for (int s = 0; s < 2; ++s) {
                    const f32x16& S = half ? S1 : S0;
                    u32x4 pw; pw.x = pk2(S[8 * s], S[8 * s + 1]); pw.y = pk2(S[8 * s + 2], S[8 * s + 3]); pw.z = pk2(S[8 * s + 4], S[8 * s + 5]); pw.w = pk2(S[8 * s + 6], S[8 * s + 7]);
                    const bf16x8 pf = __builtin_bit_cast(bf16x8, pw);
                    LAS unsigned char* vr = vb + vtr + (32 * half + 16 * s) * VROW;
#pragma unroll
                    for (int dt = 0; dt < DV / 32; ++dt) {
                        const bf16x8 vf = cat4(trread(vr + 64 * dt), trread(vr + 8 * VROW + 64 * dt));
                        O[dt] = mfma32(vf, pf, O[dt]);
                    }
                }
        }
        if (!JOINT && kt <= myc) {
            LAS unsigned char* kb = lds + (kt & 1) * STG; LAS unsigned char* vb = kb + 64 * KROW;
            const bool far = (kt * 64 + 63 - q0w <= -91);
#pragma unroll 1
            for (int half = 0; half < 2; ++half) {
                f32x16 S;
#pragma unroll
                for (int i = 0; i < 16; ++i) S[i] = 0.f;
#pragma unroll
                for (int s = 0; s < DQK / 16; ++s) {
                    const bf16x8 kf = *(LAS const bf16x8*)(kb + koff + 32 * half * KROW + 32 * s);
                    S = mfma32(kf, qf[s], S);
                }
                if (BIAS && !far) {
                    const int rb = kt * 64 + 32 * half - (q0w + l32) + 128;
#pragma unroll
                    for (int i = 0; i < 16; ++i) { const int i0 = rb + crow(i, hh); S[i] += btab[i0 < 0 ? 0 : i0]; }
                }
                if (mnz) {
#pragma unroll
                    for (int i = 0; i < 16; ++i) S[i] -= m;
                }
                float mx = S[0];
#pragma unroll
                for (int i = 1; i < 16; ++i) mx = fmaxf(mx, S[i]);
                mx = fmaxf(mx, __shfl_xor(mx, 32));
                const bool first = (kt == 0 && half == 0);
                if (__any(mx > 64.f || (first && mx < -64.f))) {
                    const float dm = (mx > 64.f || (first && mx < -64.f)) ? mx : 0.f, alpha = __builtin_amdgcn_exp2f(-dm); m += dm; mnz = true;
                    l *= alpha;
#pragma unroll
                    for (int dt = 0; dt < DV / 32; ++dt) O[dt] *= alpha;
#pragma unroll
                    for (int i = 0; i < 16; ++i) S[i] -= dm;
                }
                float ps = 0.f;
#pragma unroll
                for (int i = 0; i < 16; ++i) { S[i] = __builtin_amdgcn_exp2f(S[i]); ps += S[i]; }
                l += ps;
#pragma unroll
                for (int s = 0; s < 2; ++s) {
                    u32x4 pw; pw.x = pk2(S[8 * s], S[8 * s + 1]); pw.y = pk2(S[8 * s + 2], S[8 * s + 3]); pw.z = pk2(S[8 * s + 4], S[8 * s + 5]); pw.w = pk2(S[8 * s + 6], S[8 * s + 7]);
                    const bf16x8 pf = __builtin_bit_cast(bf16x8, pw);
                    LAS unsigned char* vr = vb + vtr + (32 * half + 16 * s) * VROW;
#pragma unroll
                    for (int dt = 0; dt < DV / 32; ++dt) {
                        const bf16x8 vf = cat4(trread(vr + 64 * dt), trread(vr + 8 * VROW + 64 * dt));
                        O[dt] = mfma32(vf, pf, O[dt]);
                    }
                }
            }
        }
        if (kt + 1 < nkt) lstore((kt + 1) & 1);
        __syncthreads();
    }
    l += __shfl_xor(l, 32);
    const float il = 1.f / l;
#pragma unroll
    for (int dt = 0; dt < DV / 32; ++dt) O[dt] *= il;
}

DI void phase_attn_a(const Params& p, LAS unsigned char* lds) {
    const bf16_t* big = (const bf16_t*)(p.ws + ACT); bf16_t* y = (bf16_t*)(p.ws + HBUF); const float* tbg = (const float*)(p.ws + X_BIAS);
    const int tid = otid(), wid = tid >> 6, lane = tid & 63, l32 = lane & 31, hh = lane >> 5;
    constexpr int STG = 64 * (64 * 2 + 16 + 128 * 2 + 64);
    float d0 = 0.f, d1 = 0.f;
    for (int i = 0; i < 64; ++i) { d0 += p.in[5][i] * p.in[5][64 + i]; d1 += p.in[5][128 + i] * p.in[5][192 + i]; }
    const float lam_init = 0.2f, lam = __expf(d0) - __expf(d1) + lam_init;
    for (int pr = blockIdx.x; pr < 512; pr += gridDim.x) {
        const int bi = pr & 255, bh = (gridDim.x == 256) ? (bi & 7) + 8 * (bi >> 6) + 32 * (pr >> 8) : pr >> 3, j = (gridDim.x == 256) ? (bi >> 3) & 7 : pr & 7, b = bh >> 4, h = bh & 15;
        for (int half = 0; half < 2; ++half) {
            const int qb = half ? 15 - j : j;
            __syncthreads();
            if (tid < 192) ((LAS float*)(lds + 2 * STG))[tid] = tbg[h * 192 + tid];
            const size_t tok0 = (size_t)b * SEQ, tokq = tok0 + qb * 256 + wid * 32 + l32;
            f32x16 Oa[4]; LAS unsigned* Op = (LAS unsigned*)(lds + 2 * STG + 1024) + wid * 2048 + lane;
            attn_core<64, 8, 128, true, true>(lds, big + tokq * 8192 + h * 128, big + tok0 * 8192 + 2048 + h * 128, 8192, nullptr, 0, big + tok0 * 8192 + 4096 + h * 128, 8192, qb, wid, lane, nullptr, Oa);
#pragma unroll
            for (int dt = 0; dt < 4; ++dt)
#pragma unroll
                for (int i = 0; i < 8; ++i) Op[(dt * 8 + i) * 64] = pk2(Oa[dt][2 * i], Oa[dt][2 * i + 1]);
            attn_core<64, 8, 128, true, true>(lds, big + tokq * 8192 + h * 128 + 64, big + tok0 * 8192 + 2048 + h * 128 + 64, 8192, nullptr, 0, big + tok0 * 8192 + 4096 + h * 128, 8192, qb, wid, lane, nullptr, Oa);
            float ss = 0.f;
#pragma unroll
            for (int dt = 0; dt < 4; ++dt)
#pragma unroll
                for (int i = 0; i < 16; ++i) { const unsigned ow = Op[(dt * 8 + (i >> 1)) * 64]; const float o0 = (i & 1) ? __uint_as_float(ow & 0xffff0000u) : __uint_as_float(ow << 16);
                    const float o = o0 - lam * Oa[dt][i]; Oa[dt][i] = o; ss += o * o; }
            ss += __shfl_xor(ss, 32);
            const float sc = rsqrtf(ss * (1.f / 128.f) + EPS) * (1.f - lam_init);
#pragma unroll
            for (int dt = 0; dt < 4; ++dt)
#pragma unroll
                for (int g4 = 0; g4 < 4; ++g4) { const int dv = 32 * dt + 8 * g4 + 4 * hh;
                    const u32x2 gw = *(const u32x2*)(big + tokq * 8192 + 6144 + h * 128 + dv);
                    const f32x4 sg = *(const f32x4*)(p.in[6] + dv);
                    const float g0 = __uint_as_float(gw.x << 16), g1 = __uint_as_float(gw.x & 0xffff0000u), g2 = __uint_as_float(gw.y << 16), g3 = __uint_as_float(gw.y & 0xffff0000u);
                    u32x2 w; w.x = pk2(Oa[dt][4 * g4] * sc * sg[0] * silu(g0), Oa[dt][4 * g4 + 1] * sc * sg[1] * silu(g1));
                    w.y = pk2(Oa[dt][4 * g4 + 2] * sc * sg[2] * silu(g2), Oa[dt][4 * g4 + 3] * sc * sg[3] * silu(g3));
                    *(u32x2*)(y + tokq * DM + h * 128 + dv) = w; }
        }
    }
}

DI void phase_attn_d(const Params& p, LAS unsigned char* lds) {
    const bf16_t* qkv = (const bf16_t*)(p.ws + ACT); const bf16_t* lat = (const bf16_t*)(p.ws + LAT); const bf16_t* gb = (const bf16_t*)(p.ws + HBUF);
    bf16_t* y = (bf16_t*)(p.ws + HBUF);
    for (int pr = blockIdx.x; pr < 512; pr += gridDim.x) {
        const int bi = pr & 255, bh = (gridDim.x == 256) ? (bi & 7) + 8 * (bi >> 6) + 32 * (pr >> 8) : pr >> 3, j = (gridDim.x == 256) ? (bi >> 3) & 7 : pr & 7, b = bh >> 4, h = bh & 15;
        for (int half = 0; half < 2; ++half) {
            const int qb = half ? 15 - j : j;
            __syncthreads();
            const int tid = otid(), wid = tid >> 6, lane = tid & 63, l32 = lane & 31;
            const size_t tok0 = (size_t)b * SEQ, tokq = tok0 + qb * 256 + wid * 32 + l32;
            f32x16 O[4];
            attn_core<192, 16, 128, false, true>(lds, qkv + tokq * 7168 + h * 192, qkv + tok0 * 7168 + 3072 + h * 256, 7168, lat + tok0 * 1088 + 1024, 1088,
                                           qkv + tok0 * 7168 + 3072 + h * 256 + 128, 7168, qb, wid, lane, p.in[27], O);
            const int tid2 = otid(), wid2 = tid2 >> 6, lane2 = tid2 & 63;
            const size_t tokq2 = (size_t)b * SEQ + qb * 256 + wid2 * 32 + (lane2 & 31); const int hh2 = lane2 >> 5;
#pragma unroll
            for (int dt = 0; dt < 4; ++dt)
#pragma unroll
                for (int g4 = 0; g4 < 4; ++g4) { const int dv = 32 * dt + 8 * g4 + 4 * hh2;
                    const u32x2 gw = *(const u32x2*)(gb + tokq2 * DM + h * 128 + dv);
                    const float g0 = __uint_as_float(gw.x << 16), g1 = __uint_as_float(gw.x & 0xffff0000u), g2 = __uint_as_float(gw.y << 16), g3 = __uint_as_float(gw.y & 0xffff0000u);
                    u32x2 w; w.x = pk2(O[dt][4 * g4] * silu(g0), O[dt][4 * g4 + 1] * silu(g1)); w.y = pk2(O[dt][4 * g4 + 2] * silu(g2), O[dt][4 * g4 + 3] * silu(g3));
                    *(u32x2*)(y + tokq2 * DM + h * 128 + dv) = w; }
        }
    }
}

DI void phase_gla_prep(const Params& p, LAS unsigned char* lds) {
    bf16_t* big = (bf16_t*)(p.ws + ACT); float* total = (float*)(p.ws + GLA_TOT);
    LAS float* lrs = (LAS float*)lds;
    const int tid = otid(), ch0 = tid * 2;
    float wg0[16], wg1[16];
#pragma unroll
    for (int r = 0; r < 16; ++r) { wg0[r] = p.in[9][r * 1024 + ch0]; wg1[r] = p.in[9][r * 1024 + ch0 + 1]; }
    const float bs0 = p.in[10][ch0], bs1 = p.in[10][ch0 + 1];
    for (int u = blockIdx.x; u < 256; u += gridDim.x) {
        const size_t tokb = (size_t)u * 64;
        __syncthreads();
        {
            LAS bf16_t* wl = (LAS bf16_t*)(lds + 8192);
            LAS float* part = (LAS float*)(lds + 4096);
            const bf16_t* wsrc = (const bf16_t*)(p.ws + W_B_IN) + (size_t)6144 * 2048;
#pragma unroll
            for (int i = 0; i < 8; ++i) { const int c = tid + i * 512; *(LAS u32x4*)(wl + (c >> 8) * 2056 + (c & 255) * 8) = *(const u32x4*)(wsrc + (size_t)c * 8); }
            __syncthreads();
            const int w = tid >> 6, lane = tid & 63, i16 = lane & 15, quad = lane >> 4, mt = w & 3, kh = w >> 2;
            const bf16_t* xr = (const bf16_t*)(p.ws + XG) + (tokb + 16 * mt + i16) * DM + kh * 1024 + 8 * quad;
            f32x4 acc = {0.f, 0.f, 0.f, 0.f};
#pragma unroll 8
            for (int ks = 0; ks < 32; ++ks) {
                const bf16x8 a = *(const bf16x8*)(xr + 32 * ks);
                const bf16x8 bb = *(LAS const bf16x8*)(wl + i16 * 2056 + kh * 1024 + 32 * ks + 8 * quad);
                acc = __builtin_amdgcn_mfma_f32_16x16x32_bf16(a, bb, acc, 0, 0, 0);
            }
            if (kh == 1) {
#pragma unroll
                for (int j = 0; j < 4; ++j) part[(16 * mt + 4 * quad + j) * 16 + i16] = acc[j]; }
            __syncthreads();
            if (kh == 0) {
#pragma unroll
                for (int j = 0; j < 4; ++j) { const int tok = 16 * mt + 4 * quad + j;
                    const float rs = rsqrtf(((const float*)(p.ws + X_SSQ))[tokb + tok] * (1.f / DM) + EPS);
                    lrs[tok * 16 + i16] = (acc[j] + part[tok * 16 + i16]) * rs; } }
        }
        __syncthreads();
        float t0 = 0.f, t1 = 0.f;
        for (int tg = 3; tg >= 0; --tg) {
            unsigned kw[16];
#pragma unroll
            for (int i = 0; i < 16; ++i) kw[i] = *(const unsigned*)(big + (tokb + tg * 16 + i) * 6400 + 1024 + ch0);
#pragma unroll
            for (int i = 15; i >= 0; --i) { const int tok = tg * 16 + i;
                float z0 = bs0, z1 = bs1;
#pragma unroll
                for (int r = 0; r < 16; ++r) { const float lv = lrs[tok * 16 + r]; z0 += lv * wg0[r]; z1 += lv * wg1[r]; }
                *(unsigned*)(big + (tokb + tok) * 6400 + 1024 + ch0) = pk2(__uint_as_float(kw[i] << 16) * __expf(t0), __uint_as_float(kw[i] & 0xffff0000u) * __expf(t1));
                t0 += (fminf(z0, 0.f) - __logf(1.f + __expf(-fabsf(z0)))) * (1.f / 16.f); t1 += (fminf(z1, 0.f) - __logf(1.f + __expf(-fabsf(z1)))) * (1.f / 16.f);
            }
        }
        total[(size_t)u * 1024 + ch0] = t0; total[(size_t)u * 1024 + ch0 + 1] = t1;
    }
}

DI void phase_gla_scan(const Params& p, LAS unsigned char* lds) {
    const bf16_t* big = (const bf16_t*)(p.ws + ACT); const float* total = (const float*)(p.ws + GLA_TOT); bf16_t* ob = (bf16_t*)(p.ws + HBUF);
    constexpr int KR = 576, VR = 64, SR = 528, SET = 64 * KR + 64 * VR + 1024  , ST_OFF = 2 * SET, STB = 32 * SR;
    const int tid = otid(), w = tid >> 6, lane = tid & 63, l32 = lane & 31, hh = lane >> 5, i16 = lane & 15, tq = i16 >> 2, tp = i16 & 3, blk = (lane >> 4) & 1, quad = lane >> 4;
    const int mt = w >> 1, nt = w & 1;
    for (int u = blockIdx.x; u < 256; u += gridDim.x) {
        const int ux = (gridDim.x == 256) ? ((u & 7) * 2 + (u >> 7)) * 16 + ((u >> 3) & 15) : u;
        const int b = ux >> 6, h = (ux >> 4) & 3, vs = ux & 15;
        const size_t tok0 = (size_t)b * SEQ;
        f32x16 st;
#pragma unroll
        for (int i = 0; i < 16; ++i) st[i] = 0.f;
        u32x4 rkA[4], rvA, rkB[4], rvB; float rtA = 0.f, rtB = 0.f; bf16x8 qa[8], qn[8];
        rvA = (u32x4){0u, 0u, 0u, 0u}; rvB = rvA;
        unsigned offk[4];
#pragma unroll
        for (int i = 0; i < 4; ++i) { const int idx = tid + i * 512, row = idx >> 5, cc = idx & 31; offk[i] = (unsigned)((row * 6400 + 1024 + h * 256 + cc * 8) * 2); }
        const unsigned offv = (unsigned)(((tid >> 2) * 6400 + 2048 + h * 512 + vs * 32 + (tid & 3) * 8) * 2);
        const unsigned offq = (unsigned)(((16 * mt + i16) * 6400 + h * 256 + 8 * quad) * 2);
        auto gload = [&](int c, u32x4 (&rk)[4], u32x4& rv, float& rt) {
            const char* cb = (const char*)(big + (tok0 + (size_t)c * 64) * 6400);
#pragma unroll
            for (int i = 0; i < 4; ++i) rk[i] = *(const u32x4*)(cb + offk[i]);
            if (tid < 256) { rv = *(const u32x4*)(cb + offv); rt = total[(size_t)(b * 64 + c) * 1024 + h * 256 + tid]; }
        };
        auto lstore = [&](int buf, const u32x4 (&rk)[4], const u32x4& rv, const float& rt) {
            LAS unsigned char* sb = lds + buf * SET;
#pragma unroll
            for (int i = 0; i < 4; ++i) { const int idx = tid + i * 512, row = idx >> 5, cc = idx & 31; *(LAS u32x4*)(sb + row * KR + cc * 16) = rk[i]; }
            if (tid < 256) { const int row = tid >> 2, cc = tid & 3; *(LAS u32x4*)(sb + 64 * KR + row * VR + cc * 16) = rv; ((LAS float*)(sb + 64 * KR + 64 * VR))[tid] = __expf(rt); }
        };
        auto qload = [&](int c, bf16x8 (&q)[8]) {
            const char* cb = (const char*)(big + (tok0 + (size_t)c * 64) * 6400) + offq;
#pragma unroll
            for (int ks = 0; ks < 8; ++ks) q[ks] = *(const bf16x8*)(cb + 64 * ks);
        };
        auto step = [&](int c, const bf16x8 (&qc)[8]) {
            LAS unsigned char* sb = lds + (c & 1) * SET; LAS unsigned char* stb = lds + ST_OFF + (c & 1) * STB;
#pragma unroll
            for (int g = 0; g < 4; ++g) { const f32x4 e = *(LAS const f32x4*)(sb + 64 * KR + 64 * VR + (32 * w + 8 * g + 4 * hh) * 4);
                st[4 * g] *= e[0]; st[4 * g + 1] *= e[1]; st[4 * g + 2] *= e[2]; st[4 * g + 3] *= e[3]; }
#pragma unroll
            for (int sx = 0; sx < 4; ++sx) {
                LAS unsigned char* ka = sb + (16 * sx + 8 * hh + tq) * KR + (32 * w + 16 * blk + 4 * tp) * 2;
                LAS unsigned char* va = sb + 64 * KR + (16 * sx + 8 * hh + tq) * VR + (16 * blk + 4 * tp) * 2;
                const bf16x8 af = cat4(trread(ka), trread(ka + 4 * KR)), bfv = cat4(trread(va), trread(va + 4 * VR));
                st = mfma32(af, bfv, st);
            }
#pragma unroll
            for (int g = 0; g < 4; ++g) { u32x2 wv; wv.x = pk2(st[4 * g], st[4 * g + 1]); wv.y = pk2(st[4 * g + 2], st[4 * g + 3]);
                *(LAS u32x2*)(stb + l32 * SR + (32 * w + 8 * g + 4 * hh) * 2) = wv; }
            asm volatile("s_waitcnt lgkmcnt(0)" ::: "memory");
            __builtin_amdgcn_s_barrier();
            asm volatile("" ::: "memory");
            f32x4 acc = {0.f, 0.f, 0.f, 0.f};
#pragma unroll
            for (int ks = 0; ks < 8; ++ks) {
                const bf16x8 bb = *(LAS const bf16x8*)(stb + (16 * nt + i16) * SR + (32 * ks + 8 * quad) * 2);
                acc = __builtin_amdgcn_mfma_f32_16x16x32_bf16(qc[ks], bb, acc, 0, 0, 0);
            }
#pragma unroll
            for (int jj = 0; jj < 4; ++jj) ob[(tok0 + c * 64 + 16 * mt + quad * 4 + jj) * DM + h * 512 + vs * 32 + 16 * nt + i16] = f2bf(acc[jj] * (1.f / 16.f));
        };
        __syncthreads();
        gload(0, rkA, rvA, rtA); lstore(0, rkA, rvA, rtA);
        gload(1, rkA, rvA, rtA); gload(2, rkB, rvB, rtB); qload(0, qa); qload(1, qn);
        __syncthreads();
        for (int c = 0; c < 64; c += 2) {
            lstore((c + 1) & 1, rkA, rvA, rtA);
            if (c + 3 < 64) gload(c + 3, rkA, rvA, rtA);
            step(c, qa);
            if (c + 2 < 64) qload(c + 2, qa);
            if (c + 2 < 64) lstore(c & 1, rkB, rvB, rtB);
            if (c + 4 < 64) gload(c + 4, rkB, rvB, rtB);
            step(c + 1, qn);
            if (c + 3 < 64) qload(c + 3, qn);
        }
    }
}

DI void phase_gla_post(const Params& p) {
    const bf16_t* big = (const bf16_t*)(p.ws + ACT); bf16_t* y = (bf16_t*)(p.ws + HBUF);
    const int tid = otid(), lane = tid & 63, gw = blockIdx.x * 8 + (tid >> 6), nw = gridDim.x * 8;
    float og[8];
#pragma unroll
    for (int e = 0; e < 8; ++e) og[e] = p.in[11][lane * 8 + e];
    for (int row = gw; row < MTOK; row += 2 * nw) {
        u32x4 wo[2][4], wg[2][4]; bool ok[2]; size_t rr[2];
#pragma unroll
        for (int r = 0; r < 2; ++r) { ok[r] = row + r * nw < MTOK; rr[r] = ok[r] ? (size_t)(row + r * nw) : (size_t)row;
#pragma unroll
            for (int hd = 0; hd < 4; ++hd) { wo[r][hd] = *(const u32x4*)(y + rr[r] * DM + hd * 512 + lane * 8); wg[r][hd] = *(const u32x4*)(big + rr[r] * 6400 + 4096 + hd * 512 + lane * 8); } }
#pragma unroll
        for (int r = 0; r < 2; ++r)
#pragma unroll
            for (int hd = 0; hd < 4; ++hd) {
                float f[8], g[8]; unpack8(wo[r][hd], f); unpack8(wg[r][hd], g);
                float ss = 0.f;
#pragma unroll
                for (int e = 0; e < 8; ++e) ss += f[e] * f[e];
                ss = wsum(ss); const float sc = rsqrtf(ss * (1.f / 512.f) + EPS);
#pragma unroll
                for (int e = 0; e < 8; ++e) f[e] = f[e] * sc * og[e] * silu(g[e]);
                if (ok[r]) *(u32x4*)(y + rr[r] * DM + hd * 512 + lane * 8) = pack8(f);
            }
    }
}

DI void phase_conv(const Params& p) {
    const bf16_t* big = (const bf16_t*)(p.ws + ACT); bf16_t* xc = (bf16_t*)(p.ws + HBUF);
    for (size_t idx = (size_t)blockIdx.x * 512 + otid(); idx < (size_t)(MTOK / 8) * 256; idx += (size_t)gridDim.x * 512) {
        const int tok0 = (int)(idx >> 8) * 8, ch = (int)(idx & 255) * 8, t0 = tok0 & (SEQ - 1);
        float wv[4][8], bs[8];
        { const f32x4 b0 = *(const f32x4*)(p.in[15] + ch), b1 = *(const f32x4*)(p.in[15] + ch + 4);
#pragma unroll
          for (int e = 0; e < 4; ++e) { bs[e] = b0[e]; bs[4 + e] = b1[e]; } }
#pragma unroll
        for (int jx = 0; jx < 4; ++jx) { const f32x4 w0 = *(const f32x4*)(p.in[14] + jx * 2048 + ch), w1 = *(const f32x4*)(p.in[14] + jx * 2048 + ch + 4);
#pragma unroll
            for (int e = 0; e < 4; ++e) { wv[jx][e] = w0[e]; wv[jx][4 + e] = w1[e]; } }
        u32x4 raw[11];
#pragma unroll
        for (int r = 0; r < 11; ++r) raw[r] = (r >= 3 || t0 > 0) ? *(const u32x4*)(big + (size_t)(tok0 - 3 + r) * 4096 + ch) : (u32x4){0u, 0u, 0u, 0u};
#pragma unroll
        for (int o = 0; o < 8; ++o) {
            float acc[8];
#pragma unroll
            for (int e = 0; e < 8; ++e) acc[e] = bs[e];
#pragma unroll
            for (int jx = 0; jx < 4; ++jx) { float f[8]; unpack8(raw[o + jx], f);
#pragma unroll
                for (int e = 0; e < 8; ++e) acc[e] += f[e] * wv[jx][e]; }
            *(u32x4*)(xc + (size_t)(tok0 + o) * DM + ch) = pack8(acc);
        }
    }
}
DI void phase_lru_scan(const Params& p, LAS unsigned char* lds) {
    const unsigned* ax = (const unsigned*)(p.ws + ACT + 128 * MiB); const bf16_t* big = (const bf16_t*)(p.ws + ACT);
    bf16_t* y = (bf16_t*)(p.ws + HBUF);
    LAS unsigned* tile = (LAS unsigned*)lds;
    LAS float* sP = (LAS float*)(lds + 65536); LAS float* sH = sP + 512; LAS float* sC = sH + 512;
    const int tid = otid(), seg = tid >> 5, chl = tid & 31;
    for (int u = blockIdx.x; u < 256; u += gridDim.x) {
        const int b = u >> 6, ch = (u & 63) * 32 + chl;
        const size_t rowbase = (size_t)b * SEQ;
        unsigned pre[32];
#pragma unroll
        for (int i = 0; i < 32; ++i) pre[i] = ax[(rowbase + seg + 16 * i) * DM + ch];
        __syncthreads();
        if (tid < 32) sC[tid] = 0.f;
        for (int sc = 0; sc < 8; ++sc) {
#pragma unroll
            for (int i = 0; i < 32; ++i) tile[(seg + 16 * i) * 32 + chl] = pre[i];
            __syncthreads();
            if (sc + 1 < 8) {
#pragma unroll
                for (int i = 0; i < 32; ++i) pre[i] = ax[(rowbase + (sc + 1) * 512 + seg + 16 * i) * DM + ch];
            }
            const size_t r0 = rowbase + sc * 512 + seg * 32;
            bf16_t gq[32];
#pragma unroll
            for (int t = 0; t < 32; ++t) gq[t] = big[(r0 + t) * 4096 + 2048 + ch];
            float L = 0.f, H = 0.f;
#pragma unroll 8
            for (int t = 0; t < 32; ++t) { const unsigned w = tile[(seg * 32 + t) * 32 + chl]; const float la = __uint_as_float(w << 16); H = __expf(la) * H + __uint_as_float(w & 0xffff0000u); L += la; }
            sP[tid] = __expf(L); sH[tid] = H;
            __syncthreads();
            float hc = sC[chl];
            for (int sg = 0; sg < seg; ++sg) hc = sP[sg * 32 + chl] * hc + sH[sg * 32 + chl];
#pragma unroll
            for (int t = 0; t < 32; ++t) { const unsigned w = tile[(seg * 32 + t) * 32 + chl]; hc = __expf(__uint_as_float(w << 16)) * hc + __uint_as_float(w & 0xffff0000u);
                y[(r0 + t) * DM + ch] = f2bf(hc * silu(bf2f(gq[t]))); }
            __syncthreads();
            if (seg == 15) sC[chl] = hc;
        }
    }
}

DI void phase_mla_lat(const Params& p) {
    bf16_t* lat = (bf16_t*)(p.ws + LAT);
    const int tid = otid(), lane = tid & 63, gw = blockIdx.x * 8 + (tid >> 6), nw = gridDim.x * 8;
    float gq[8], gk[8];
#pragma unroll
    for (int e = 0; e < 8; ++e) { gq[e] = p.in[23][lane * 8 + e]; gk[e] = p.in[24][lane * 8 + e]; }
    const float inv = powf(10000.f, -(float)(lane & 31) * (1.f / 32.f));
    const float g1 = p.in[27][192 + 128 + (lane & 31)], g2 = p.in[27][192 + 160 + (lane & 31)];
    for (int row = gw; row < MTOK; row += nw) {
#pragma unroll
        for (int part = 0; part < 2; ++part) {
            bf16_t* ptr = lat + (size_t)row * 1088 + part * 512 + lane * 8; float f[8]; unpack8(*(const u32x4*)ptr, f);
            float ss = 0.f;
#pragma unroll
            for (int e = 0; e < 8; ++e) ss += f[e] * f[e];
            ss = wsum(ss); const float sc = rsqrtf(ss * (1.f / 512.f) + EPS);
#pragma unroll
            for (int e = 0; e < 8; ++e) f[e] = f[e] * sc * (part ? gk[e] : gq[e]);
            *(u32x4*)ptr = pack8(f);
        }
        { bf16_t* kp = lat + (size_t)row * 1088 + 1024; const int i = lane & 31;
          const float x1 = bf2f(kp[i]), x2 = bf2f(kp[i + 32]);
          float ss = (lane < 32) ? x1 * x1 + x2 * x2 : 0.f; ss = wsum(ss); const float sc = rsqrtf(ss * (1.f / 64.f) + EPS);
          const float a1 = x1 * sc * g1, a2 = x2 * sc * g2; float sn, cs; sincosf((float)(row & (SEQ - 1)) * inv, &sn, &cs);
          if (lane < 32) { kp[i] = f2bf(a1 * cs - a2 * sn); kp[i + 32] = f2bf(a2 * cs + a1 * sn); } }
    }
}
DI void phase_mla_qk(const Params& p) {
    bf16_t* qkv = (bf16_t*)(p.ws + ACT); bf16_t* lat = (bf16_t*)(p.ws + LAT); const float* qkg = p.in[27];
    const int tid = otid(), lane = tid & 63, gw = blockIdx.x * 8 + (tid >> 6), nw = gridDim.x * 8;
    const int l16 = lane & 15, l8 = lane & 7;
    float gk[8], gkr[8];
#pragma unroll
    for (int e = 0; e < 8; ++e) { gk[e] = qkg[192 + l16 * 8 + e]; gkr[e] = qkg[192 + 128 + l8 * 8 + e]; }
    float inv[8];
#pragma unroll
    for (int e = 0; e < 8; ++e) inv[e] = powf(10000.f, -(float)((l8 & 3) * 8 + e) * (1.f / 32.f));
    for (int row0 = gw; row0 < MTOK; row0 += 2 * nw) {
        u32x4 wk[2][4], wp[2]; bool ok[2]; int rw[2];
#pragma unroll
        for (int r = 0; r < 2; ++r) { ok[r] = row0 + r * nw < MTOK; rw[r] = ok[r] ? row0 + r * nw : row0;
            const bf16_t* qr = qkv + (size_t)rw[r] * 7168;
#pragma unroll
            for (int i = 0; i < 4; ++i) { const int head = 4 * i + (lane >> 4); wk[r][i] = *(const u32x4*)(qr + 3072 + head * 256 + l16 * 8); }
            wp[r] = *(const u32x4*)(lat + (size_t)rw[r] * 1088 + 1024 + l8 * 8); }
#pragma unroll
        for (int r = 0; r < 2; ++r) {
            bf16_t* qr = qkv + (size_t)rw[r] * 7168; bf16_t* kpp = lat + (size_t)rw[r] * 1088 + 1024 + l8 * 8;
            const float pos = (float)(rw[r] & (SEQ - 1));
#pragma unroll
            for (int i = 0; i < 4; ++i) {
                const int head = 4 * i + (lane >> 4);
                float f[8]; unpack8(wk[r][i], f); float ss = 0.f;
#pragma unroll
                for (int e = 0; e < 8; ++e) ss += f[e] * f[e];
                ss += __shfl_xor(ss, 1); ss += __shfl_xor(ss, 2); ss += __shfl_xor(ss, 4); ss += __shfl_xor(ss, 8);
                const float sc = rsqrtf(ss * (1.f / 128.f) + EPS);
#pragma unroll
                for (int e = 0; e < 8; ++e) f[e] *= sc * gk[e];
                if (ok[r]) *(u32x4*)(qr + 3072 + head * 256 + l16 * 8) = pack8(f);
            }
            { float f[8], o[8]; unpack8(wp[r], f); float ss = 0.f;
#pragma unroll
              for (int e = 0; e < 8; ++e) ss += f[e] * f[e];
              ss += __shfl_xor(ss, 1); ss += __shfl_xor(ss, 2); ss += __shfl_xor(ss, 4);
              const float sc = rsqrtf(ss * (1.f / 64.f) + EPS);
#pragma unroll
              for (int e = 0; e < 8; ++e) {
                  const float a = f[e] * sc * gkr[e], pa = __shfl_xor(a, 4);
                  float sn, cs; sincosf(pos * inv[e], &sn, &cs);
                  o[e] = (l8 < 4) ? a * cs - pa * sn : a * cs + pa * sn;
              }
              if (ok[r] && lane < 8) *(u32x4*)kpp = pack8(o); }
        }
    }
}

#define XB_TMO      128
#define XB_XCNT(j)  (256  + 64 * (j))
#define XB_XSUB(j)  (1280 + 64 * (j))
#define XB_XGEN(j)  (2304 + 64 * (j))
#define XB_TOP      3328
#define XB_TOPGEN   3392
#define XCD_BAR_WORDS 3456
#define XB_SPIN_CAP (1u << 22)
DI unsigned xb_ld(unsigned* p)              { return __hip_atomic_load(p, __ATOMIC_RELAXED, __HIP_MEMORY_SCOPE_AGENT); }
DI unsigned xb_add(unsigned* p, unsigned v) { return __hip_atomic_fetch_add(p, v, __ATOMIC_RELAXED, __HIP_MEMORY_SCOPE_AGENT); }
DI unsigned xb_xcc_id() { return (unsigned)__builtin_amdgcn_s_getreg((3 << 11) | 20) & 0xFu; }
#define XB_SPIN(cond, bar) do { unsigned _sp = 0; while (cond) { __builtin_amdgcn_s_sleep(1); \
    if ((++_sp & 255u) == 0u) { if (xb_ld(&(bar)[XB_TMO])) break; if (_sp > XB_SPIN_CAP) { atomicAdd(&(bar)[XB_TMO], 1u); break; } } } } while (0)
struct XcdBarrier { unsigned* bar; unsigned x; volatile LAS unsigned* st; };
DI XcdBarrier xcd_barrier_post(unsigned* bar, volatile LAS unsigned* st) {
    XcdBarrier b; b.bar = bar; b.x = xb_xcc_id(); b.st = st;
    if (threadIdx.x == 0) (void)xb_add(&bar[XB_XCNT(b.x)], 1u);
    return b;
}
DI void xcd_barrier_complete(unsigned* bar, unsigned x, unsigned& nloc, unsigned& nx) {
    const unsigned G = gridDim.x * gridDim.y * gridDim.z;
    unsigned sum, cnt, mine, sp = 0u;
    for (;;) {
        sum = 0u; cnt = 0u; mine = 0u;
#pragma unroll
        for (unsigned j = 0; j < 16; ++j) { const unsigned c = xb_ld(&bar[XB_XCNT(j)]); sum += c; cnt += (c > 0u) ? 1u : 0u; mine = (j == x) ? c : mine; }
        if (sum == G) break;
        __builtin_amdgcn_s_sleep(1);
        if ((++sp & 255u) == 0u) { if (xb_ld(&bar[XB_TMO])) break; if (sp > XB_SPIN_CAP) { atomicAdd(&bar[XB_TMO], 1u); break; } }
    }
    nloc = mine > 0u ? mine : 1u; nx = cnt > 0u ? cnt : 1u;
}
DI void xcd_barrier(const XcdBarrier& b0) {
    asm volatile("s_waitcnt vmcnt(0)" ::: "memory");
    __syncthreads();
    if (otid() == 0) {
        XcdBarrier b; b.bar = b0.bar; b.st = b0.st; b.x = xb_xcc_id();
        unsigned* bar = b.bar;
        __builtin_amdgcn_s_waitcnt(0);
        unsigned nloc = b.st[0], nx = b.st[1];
        if (nloc == 0u) { xcd_barrier_complete(bar, b.x, nloc, nx); b.st[0] = nloc; b.st[1] = nx; }
        const unsigned old = xb_add(&bar[XB_XSUB(b.x)], 1u);
        const unsigned gen = old / nloc;
        if (old + 1u == (gen + 1u) * nloc) {
            __builtin_amdgcn_fence(__ATOMIC_RELEASE, "agent");
            asm volatile("s_waitcnt vmcnt(0)" ::: "memory");
            const unsigned og = xb_add(&bar[XB_TOP], 1u);
            const unsigned tg = og / nx;
            if (og + 1u == (tg + 1u) * nx) xb_add(&bar[XB_TOPGEN], 1u);
            else XB_SPIN(xb_ld(&bar[XB_TOPGEN]) == tg, bar);
            __builtin_amdgcn_fence(__ATOMIC_ACQUIRE, "agent");
            xb_add(&bar[XB_XGEN(b.x)], 1u);
            asm volatile("s_waitcnt vmcnt(0)" ::: "memory");
        } else {
            XB_SPIN(xb_ld(&bar[XB_XGEN(b.x)]) == gen, bar);
            __builtin_amdgcn_fence(__ATOMIC_ACQUIRE, "agent");
            asm volatile("s_waitcnt vmcnt(0)" ::: "memory");
        }
    }
    __syncthreads();
}

__global__ __launch_bounds__(512, 2) void mega(const Params p) {
    extern __shared__ __attribute__((aligned(16))) unsigned char shm[];
    LAS unsigned char* lds = (LAS unsigned char*)shm;
    cg::grid_group grid = cg::this_grid();
    volatile LAS unsigned* bst = (volatile LAS unsigned*)(lds + 131072 + 1024);
    if (threadIdx.x == 0) { bst[0] = 0u; bst[1] = 0u; }
    __syncthreads();
    XcdBarrier xb = xcd_barrier_post((unsigned*)(p.ws + WS_BAR), bst); xb.x = 0;
    if constexpr ((PHMASK >> 0) & 1) { phase_convert(p, lds); }
    if constexpr ((REPMASK >> 0) & 1) { __syncthreads(); phase_convert(p, lds); }
    if constexpr ((PHMASK >> 1) & 1) { phase_bias_table(p); }
    if constexpr ((REPMASK >> 1) & 1) { __syncthreads(); phase_bias_table(p); }
    if constexpr ((PHMASK >> 2) & 1) { phase_x0(p.in[0], (bf16_t*)(uni(p.ws) + XG), (float*)(uni(p.ws) + X_SSQ) + 5 * MTOK); }
    if constexpr ((REPMASK >> 2) & 1) { __syncthreads(); phase_rmsnorm(p.in[0], p.in[1], (bf16_t*)(uni(p.ws) + HBUF)); }
    if (p.njobs < 0) grid.sync();
    xcd_barrier(xb);
    if constexpr ((PHMASK >> 3) & 1) { { pg8::EpiStoreA E{(bf16_t*)(uni(p.ws) + ACT), p.in[4], (const float*)(uni(p.ws) + X_SSQ) + 5 * MTOK}; run_gemm<0>(lds, (const bf16_t*)(uni(p.ws) + XG), (const bf16_t*)(uni(p.ws) + W_A_IN), 8192, 2048, 2048, E); } }
    if constexpr ((REPMASK >> 3) & 1) { __syncthreads(); { pg8::EpiStoreA E{(bf16_t*)(uni(p.ws) + ACT), p.in[4], (const float*)(uni(p.ws) + X_SSQ) + 5 * MTOK}; run_gemm<0>(lds, (const bf16_t*)(uni(p.ws) + XG), (const bf16_t*)(uni(p.ws) + W_A_IN), 8192, 2048, 2048, E); } }
    xcd_barrier(xb);
    if constexpr ((PHMASK >> 5) & 1) { phase_attn_a(p, lds); }
    if constexpr ((REPMASK >> 5) & 1) { __syncthreads(); phase_attn_a(p, lds); }
    xcd_barrier(xb);
    if constexpr ((PHMASK >> 6) & 1) { { pg8::EpiResid<true, false, true, true> E{nullptr, (const bf16_t*)(uni(p.ws) + XG), nullptr, (bf16_t*)(uni(p.ws) + XG), (float*)(uni(p.ws) + X_SSQ)}; run_gemm<0>(lds, (bf16_t*)(uni(p.ws) + HBUF), (const bf16_t*)(uni(p.ws) + W_A_OUT), 2048, 2048, 2048, E); } }
    if constexpr ((REPMASK >> 6) & 1) { __syncthreads(); { pg8::EpiResid<true, false, true, true> E{nullptr, (const bf16_t*)(uni(p.ws) + XG), nullptr, (bf16_t*)(uni(p.ws) + XG), (float*)(uni(p.ws) + X_SSQ)}; run_gemm<0>(lds, (bf16_t*)(uni(p.ws) + HBUF), (const bf16_t*)(uni(p.ws) + W_A_OUT), 2048, 2048, 2048, E); } }
    xcd_barrier(xb);
    if constexpr ((PHMASK >> 8) & 1) { { pg8::EpiStore E{(bf16_t*)(uni(p.ws) + ACT), 6400, (const float*)(uni(p.ws) + X_SSQ)}; run_gemm<0>(lds, (const bf16_t*)(uni(p.ws) + XG), (const bf16_t*)(uni(p.ws) + W_B_IN), 6144, 2048, 2048, E); } }
    if constexpr ((REPMASK >> 8) & 1) { __syncthreads(); { pg8::EpiStore E{(bf16_t*)(uni(p.ws) + ACT), 6400, (const float*)(uni(p.ws) + X_SSQ)}; run_gemm<0>(lds, (const bf16_t*)(uni(p.ws) + XG), (const bf16_t*)(uni(p.ws) + W_B_IN), 6144, 2048, 2048, E); } }
    xcd_barrier(xb);
    if constexpr ((PHMASK >> 9) & 1) { phase_gla_prep(p, lds); }
    if constexpr ((REPMASK >> 9) & 1) { __syncthreads(); phase_gla_prep(p, lds); }
    xcd_barrier(xb);
    if constexpr ((PHMASK >> 10) & 1) { phase_gla_scan(p, lds); }
    if constexpr ((REPMASK >> 10) & 1) { __syncthreads(); phase_gla_scan(p, lds); }
    xcd_barrier(xb);
    if constexpr ((PHMASK >> 11) & 1) { phase_gla_post(p); }
    if constexpr ((REPMASK >> 11) & 1) { __syncthreads(); phase_gla_post(p); }
    xcd_barrier(xb);
    if constexpr ((PHMASK >> 12) & 1) { { pg8::EpiResid<true, false, true, true> E{nullptr, (const bf16_t*)(uni(p.ws) + XG), nullptr, (bf16_t*)(uni(p.ws) + XG), (float*)(uni(p.ws) + X_SSQ) + MTOK}; run_gemm<0>(lds, (bf16_t*)(uni(p.ws) + HBUF), (const bf16_t*)(uni(p.ws) + W_B_OUT), 2048, 2048, 2048, E); } }
    if constexpr ((REPMASK >> 12) & 1) { __syncthreads(); { pg8::EpiResid<true, false, true, true> E{nullptr, (const bf16_t*)(uni(p.ws) + XG), nullptr, (bf16_t*)(uni(p.ws) + XG), (float*)(uni(p.ws) + X_SSQ) + MTOK}; run_gemm<0>(lds, (bf16_t*)(uni(p.ws) + HBUF), (const bf16_t*)(uni(p.ws) + W_B_OUT), 2048, 2048, 2048, E); } }
    xcd_barrier(xb);
    if constexpr ((PHMASK >> 14) & 1) { { pg8::EpiStore E{(bf16_t*)(uni(p.ws) + ACT), 4096, (const float*)(uni(p.ws) + X_SSQ) + MTOK}; run_gemm<0>(lds, (const bf16_t*)(uni(p.ws) + XG), (const bf16_t*)(uni(p.ws) + W_C_IN), 4096, 2048, 2048, E); } }
    if constexpr ((REPMASK >> 14) & 1) { __syncthreads(); { pg8::EpiStore E{(bf16_t*)(uni(p.ws) + ACT), 4096, (const float*)(uni(p.ws) + X_SSQ) + MTOK}; run_gemm<0>(lds, (const bf16_t*)(uni(p.ws) + XG), (const bf16_t*)(uni(p.ws) + W_C_IN), 4096, 2048, 2048, E); } }
    xcd_barrier(xb);
    if constexpr ((PHMASK >> 15) & 1) { phase_conv(p); }
    if constexpr ((REPMASK >> 15) & 1) { __syncthreads(); phase_conv(p); }
    xcd_barrier(xb);
    if constexpr ((PHMASK >> 16) & 1) { { pg8::EpiGates E{(bf16_t*)(uni(p.ws) + HBUF), p.in[17], p.in[19], (const float*)(uni(p.ws) + X_SP8), (unsigned*)(uni(p.ws) + ACT + 128 * MiB)}; run_gemm<2>(lds, (bf16_t*)(uni(p.ws) + HBUF), (const bf16_t*)(uni(p.ws) + W_C_GATE), 4096, 256, 2048, E); } }
    if constexpr ((REPMASK >> 16) & 1) { __syncthreads(); { pg8::EpiGates E{(bf16_t*)(uni(p.ws) + HBUF), p.in[17], p.in[19], (const float*)(uni(p.ws) + X_SP8), (unsigned*)(uni(p.ws) + ACT + 128 * MiB)}; run_gemm<2>(lds, (bf16_t*)(uni(p.ws) + HBUF), (const bf16_t*)(uni(p.ws) + W_C_GATE), 4096, 256, 2048, E); } }
    xcd_barrier(xb);
    if constexpr ((PHMASK >> 17) & 1) { phase_lru_scan(p, lds); }
    if constexpr ((REPMASK >> 17) & 1) { __syncthreads(); phase_lru_scan(p, lds); }
    xcd_barrier(xb);
    if constexpr ((PHMASK >> 18) & 1) { { pg8::EpiResid<true, false, true, true> E{nullptr, (const bf16_t*)(uni(p.ws) + XG), nullptr, (bf16_t*)(uni(p.ws) + XG), (float*)(uni(p.ws) + X_SSQ) + 2 * MTOK}; run_gemm<0>(lds, (bf16_t*)(uni(p.ws) + HBUF), (const bf16_t*)(uni(p.ws) + W_C_OUT), 2048, 2048, 2048, E); } }
    if constexpr ((REPMASK >> 18) & 1) { __syncthreads(); { pg8::EpiResid<true, false, true, true> E{nullptr, (const bf16_t*)(uni(p.ws) + XG), nullptr, (bf16_t*)(uni(p.ws) + XG), (float*)(uni(p.ws) + X_SSQ) + 2 * MTOK}; run_gemm<0>(lds, (bf16_t*)(uni(p.ws) + HBUF), (const bf16_t*)(uni(p.ws) + W_C_OUT), 2048, 2048, 2048, E); } }
    xcd_barrier(xb);
    if constexpr ((PHMASK >> 20) & 1) { { pg8::EpiStoreD E{(bf16_t*)(uni(p.ws) + LAT), (bf16_t*)(uni(p.ws) + HBUF), (const float*)(uni(p.ws) + X_SSQ) + 2 * MTOK, (float*)(uni(p.ws) + X_SSQ) + 3 * MTOK}; run_gemm<0>(lds, (const bf16_t*)(uni(p.ws) + XG), (const bf16_t*)(uni(p.ws) + W_D_IN), 3328, 2048, 2048, E); } }
    if constexpr ((REPMASK >> 20) & 1) { __syncthreads(); { pg8::EpiStoreD E{(bf16_t*)(uni(p.ws) + LAT), (bf16_t*)(uni(p.ws) + HBUF), (const float*)(uni(p.ws) + X_SSQ) + 2 * MTOK, (float*)(uni(p.ws) + X_SSQ) + 3 * MTOK}; run_gemm<0>(lds, (const bf16_t*)(uni(p.ws) + XG), (const bf16_t*)(uni(p.ws) + W_D_IN), 3328, 2048, 2048, E); } }
    xcd_barrier(xb);
    if constexpr ((PHMASK >> 22) & 1) { { pg8::EpiStoreU E{(bf16_t*)(uni(p.ws) + ACT), (const float*)(uni(p.ws) + X_SSQ) + 3 * MTOK}; run_gemm<1>(lds, (const bf16_t*)(uni(p.ws) + LAT), (const bf16_t*)(uni(p.ws) + W_D_UQKV), 7168, 512, 1088, E); } }
    if constexpr ((REPMASK >> 22) & 1) { __syncthreads(); { pg8::EpiStoreU E{(bf16_t*)(uni(p.ws) + ACT), (const float*)(uni(p.ws) + X_SSQ) + 3 * MTOK}; run_gemm<1>(lds, (const bf16_t*)(uni(p.ws) + LAT), (const bf16_t*)(uni(p.ws) + W_D_UQKV), 7168, 512, 1088, E); } }
    xcd_barrier(xb);
    if constexpr ((PHMASK >> 23) & 1) { phase_mla_qk(p); }
    if constexpr ((REPMASK >> 23) & 1) { __syncthreads(); phase_mla_qk(p); }
    xcd_barrier(xb);
    if constexpr ((PHMASK >> 24) & 1) { phase_attn_d(p, lds); }
    if constexpr ((REPMASK >> 24) & 1) { __syncthreads(); phase_attn_d(p, lds); }
    xcd_barrier(xb);
    if constexpr ((PHMASK >> 25) & 1) { { pg8::EpiResid<true, true, false, false> E{nullptr, (const bf16_t*)(uni(p.ws) + XG), uni(p.out), nullptr, nullptr}; run_gemm<0>(lds, (bf16_t*)(uni(p.ws) + HBUF), (const bf16_t*)(uni(p.ws) + W_D_OUT), 2048, 2048, 2048, E); } }
    if constexpr ((REPMASK >> 25) & 1) { __syncthreads(); { pg8::EpiResid<true, true, false, false> E{nullptr, (const bf16_t*)(uni(p.ws) + XG), uni(p.out), nullptr, nullptr}; run_gemm<0>(lds, (bf16_t*)(uni(p.ws) + HBUF), (const bf16_t*)(uni(p.ws) + W_D_OUT), 2048, 2048, 2048, E); } }
#ifdef XSYNC
    for (int i = 0; i < XSYNC; ++i) xcd_barrier(xb);
#endif
}

extern "C" void kernel_launch(void* const* d_in, const int* in_sizes, int n_in, void* d_out, int out_size, void* d_ws, size_t ws_size, hipStream_t stream) {
    static int grid_blocks = 0;
    if (!grid_blocks) {
        int dev = 0, cus = 0, per_cu = 0;
        hipGetDevice(&dev);
        hipDeviceGetAttribute(&cus, hipDeviceAttributeMultiprocessorCount, dev);
        hipFuncSetAttribute((const void*)mega, hipFuncAttributeMaxDynamicSharedMemorySize, LDS_BYTES);
        hipOccupancyMaxActiveBlocksPerMultiprocessor(&per_cu, (const void*)mega, 512, LDS_BYTES);
        if (per_cu < 1) per_cu = 1;
        grid_blocks = cus * per_cu;
        if (ws_size < EXTRA + 65536 + 6 * 65536) fprintf(stderr, "kernel_launch: workspace too small (%zu < %zu)\n", ws_size, (size_t)WS_END);
    }
    Params p; memset(&p, 0, sizeof(p));
    for (int i = 0; i < 29; ++i) p.in[i] = (const float*)d_in[i];
    p.out = (float*)d_out; p.ws = (unsigned char*)d_ws;
    unsigned char* ws = (unsigned char*)d_ws;
    int nj = 0, tiles = 0;
    auto add = [&](const float* src, size_t dst_off, int K, int N, int ldw, int npad) {
        TJob& j = p.jobs[nj++]; j.src = src; j.dst = (bf16_t*)(ws + dst_off); j.kscale = nullptr; j.K = K; j.N = N; j.ldw = ldw; j.ntn = npad / 64; j.tile0 = tiles; j.pad = 0; tiles += (npad / 64) * (K / 256);
    };
    add(p.in[3], W_A_IN, 2048, 8192, 8192, 8192); p.jobs[0].pad = 1; p.jobs[0].kscale = p.in[1];
    add(p.in[7], W_A_OUT, 2048, 2048, 2048, 2048);
    add(p.in[8], W_B_IN, 2048, 6160, 6160, 6400); p.jobs[nj - 1].kscale = p.in[1] + 2048;
    add(p.in[12], W_B_OUT, 2048, 2048, 2048, 2048);
    add(p.in[13], W_C_IN, 2048, 4096, 4096, 4096); p.jobs[nj - 1].kscale = p.in[1] + 4096;
    add(p.in[21], W_C_OUT, 2048, 2048, 2048, 2048);
    add(p.in[22], W_D_IN, 2048, 3136, 3136, 3328); p.jobs[nj - 1].kscale = p.in[1] + 6144;
    add(p.in[25], W_D_UQKV, 512, 3072, 3072, 3072); p.jobs[nj - 1].kscale = p.in[23];
    add(p.in[26], W_D_UQKV + (size_t)3072 * 512 * 2, 512, 4096, 4096, 4096); p.jobs[nj - 1].kscale = p.in[24];
    add(p.in[28], W_D_OUT, 2048, 2048, 2048, 2048);
    for (int n = 0; n < 8; ++n) for (int half = 0; half < 2; ++half) for (int bj = 0; bj < 2; ++bj)
        add(p.in[bj ? 18 : 16] + (size_t)n * 65536 + half * 128, W_C_GATE + ((size_t)((n * 2 + half) * 256 + 128 * bj)) * 256 * 2, 256, 128, 256, 128);
    p.njobs = nj; p.ntiles = tiles;
    hipMemsetAsync(ws + WS_BAR, 0, XCD_BAR_WORDS * 4, stream);
    void* args[] = {(void*)&p};
    hipError_t e = hipLaunchCooperativeKernel((const void*)mega, dim3(grid_blocks), dim3(512), args, LDS_BYTES, stream);
    if (e != hipSuccess) fprintf(stderr, "cooperative launch failed: %s (grid %d)\n", hipGetErrorString(e), grid_blocks);
}
```
